# Optimizing an MI355X kernel written in HIP

```python
import math, functools
import jax, jax.numpy as jnp
from jax import lax
import numpy as np

D_MODEL = 1024
BATCH = 32
SEQ = 256
DEPTH = 4
DEC_BATCH = 2
DEC_SEQ = 1024
PAST_LEN = 256

GRID_W = 64
N_ATTN_LAYERS = (DEPTH + 1) // 2
N_DELTA_LAYERS = DEPTH // 2
HEAD_DIM = 128
N_HEADS = D_MODEL // HEAD_DIM
KV_HEADS = 2
GROUP = N_HEADS // KV_HEADS
Q_WIDTH = N_HEADS * HEAD_DIM
KV_WIDTH = KV_HEADS * HEAD_DIM
Q_BLOCK = 128
ROPE_THETA = 10000.0
ROPE_FREQS = HEAD_DIM // 4
DN_DK = 128
DN_DV = 128
DN_HEADS = D_MODEL // DN_DV
DN_KEY = DN_HEADS * DN_DK
DN_VAL = DN_HEADS * DN_DV
DN_QKV = 2 * DN_KEY + DN_VAL
DN_IN = DN_QKV + DN_VAL + 4 * DN_HEADS
CONV_K = 5
CHUNK = 64
D_FF = 4 * D_MODEL
N_MOD = 6
EPS = 1e-6

kernel_name = 'hybrid_diffusion_gqa_deltanet_step'


def rms_norm(x, gain):
    xf = x.astype(jnp.float32)
    y = xf * lax.rsqrt(jnp.mean(xf * xf, axis=-1, keepdims=True) + EPS)
    return (y * gain.astype(jnp.float32)).astype(x.dtype)


def l2_norm(x):
    xf = x.astype(jnp.float32)
    return xf * lax.rsqrt(jnp.sum(xf * xf, axis=-1, keepdims=True) + EPS)


def modulation(cond, w_mod, b_mod):
    m = jax.nn.silu(cond) @ w_mod + b_mod
    return jnp.split(m[..., None, :], N_MOD, axis=-1)


def trunk_layer(x, mods, gain1, gain2, w1, w2, mixer):
    shift1, scale1, gate1, shift2, scale2, gate2 = mods
    mix, aux = mixer(rms_norm(x, gain1) * (1 + scale1) + shift1)
    x = x + gate1 * mix
    h = rms_norm(x, gain2) * (1 + scale2) + shift2
    x = x + gate2 * (jnp.square(jax.nn.relu(h @ w1)) @ w2)
    return x, aux


def axial_angles(n_tokens):
    rows = n_tokens // GRID_W
    row = jnp.repeat(jnp.arange(rows), GRID_W).astype(jnp.float32)
    col = jnp.tile(jnp.arange(GRID_W), rows).astype(jnp.float32)
    inv = ROPE_THETA ** (-jnp.arange(ROPE_FREQS, dtype=jnp.float32) / ROPE_FREQS)
    return jnp.stack([row[:, None] * inv, col[:, None] * inv], axis=1)


def axial_rope(x, ang):
    xs = x.reshape(*x.shape[:-1], 2, 2, ROPE_FREQS)
    x1, x2 = xs[..., 0, :], xs[..., 1, :]
    cos = jnp.cos(ang)[:, None].astype(x.dtype)
    sin = jnp.sin(ang)[:, None].astype(x.dtype)
    out = jnp.stack([x1 * cos - x2 * sin, x2 * cos + x1 * sin], axis=-2)
    return out.reshape(x.shape)


def attn_qkv(h, w_in, q_gain, k_gain):
    B, T, _ = h.shape
    proj = h @ w_in
    q = proj[..., :Q_WIDTH].reshape(B, T, N_HEADS, HEAD_DIM)
    k = proj[..., Q_WIDTH:Q_WIDTH + KV_WIDTH].reshape(B, T, KV_HEADS, HEAD_DIM)
    v = proj[..., Q_WIDTH + KV_WIDTH:].reshape(B, T, KV_HEADS, HEAD_DIM)
    return rms_norm(q, q_gain), rms_norm(k, k_gain), v


def block_attention(q, k, v):
    B, Tq, _, _ = q.shape
    nb = Tq // Q_BLOCK
    qb = q.reshape(B, nb, Q_BLOCK, KV_HEADS, GROUP, HEAD_DIM).transpose(1, 0, 2, 3, 4, 5)
    scale = HEAD_DIM ** -0.5

    def one_block(qi):
        s = jnp.einsum('bqkgd,bskd->bkgqs', qi, k).astype(jnp.float32) * scale
        p = jax.nn.softmax(s, axis=-1).astype(v.dtype)
        return jnp.einsum('bkgqs,bskd->bqkgd', p, v)

    o = lax.map(one_block, qb)
    return o.transpose(1, 0, 2, 3, 4, 5).reshape(B, Tq, Q_WIDTH)


def context_attention(h, w_in, q_gain, k_gain, w_out):
    q, k, v = attn_qkv(h, w_in, q_gain, k_gain)
    return block_attention(q, k, v) @ w_out, (k, v)


def latent_attention(h, ck, cv, ang, w_in, q_gain, k_gain, w_out):
    q, k, v = attn_qkv(h, w_in, q_gain, k_gain)
    q, k = axial_rope(q, ang), axial_rope(k, ang)
    keys = jnp.concatenate([ck.astype(k.dtype), k], axis=1)
    vals = jnp.concatenate([cv.astype(v.dtype), v], axis=1)
    return block_attention(q, keys, vals) @ w_out, None


def centred_depthwise_conv(x, w):
    return lax.conv_general_dilated(
        x, w[:, None, :].astype(x.dtype), window_strides=(1,),
        padding=[(CONV_K // 2, CONV_K // 2)], dimension_numbers=('NWC', 'WIO', 'NWC'),
        feature_group_count=x.shape[-1])


def chunk_gated_delta(q, k, v, g, beta, s0):
    B, T, H, DK = q.shape
    DV = v.shape[-1]
    N = T // CHUNK
    f32 = jnp.float32
    to_chunks = lambda a: a.astype(f32).reshape(B, N, CHUNK, H, a.shape[-1]).transpose(1, 0, 3, 2, 4)
    q, k, v = to_chunks(q) * (DK ** -0.5), to_chunks(k), to_chunks(v)
    g = g.astype(f32).reshape(B, N, CHUNK, H).transpose(1, 0, 3, 2)
    beta = beta.astype(f32).reshape(B, N, CHUNK, H).transpose(1, 0, 3, 2)
    gc = jnp.cumsum(g, axis=-1)
    tril = jnp.tril(jnp.ones((CHUNK, CHUNK), bool))
    strict = jnp.tril(jnp.ones((CHUNK, CHUNK), bool), -1)
    diff = gc[..., :, None] - gc[..., None, :]
    decay = jnp.where(tril, jnp.exp(jnp.where(tril, diff, 0.0)), 0.0)
    kb = k * beta[..., None]
    vb = v * beta[..., None]
    lower = jnp.where(strict, jnp.einsum('nbhcd,nbhed->nbhce', kb, k) * decay, 0.0)
    eye = jnp.eye(CHUNK, dtype=f32)
    tinv = lax.linalg.triangular_solve(eye + lower, jnp.broadcast_to(eye, lower.shape),
                                       left_side=True, lower=True, unit_diagonal=True)
    u = tinv @ vb
    w = tinv @ (kb * jnp.exp(gc)[..., None])
    qk = jnp.where(tril, jnp.einsum('nbhcd,nbhed->nbhce', q, k) * decay, 0.0)

    def step(S, xs):
        q_i, k_i, u_i, w_i, qk_i, gc_i = xs
        v_new = u_i - w_i @ S
        o = (q_i * jnp.exp(gc_i)[..., None]) @ S + qk_i @ v_new
        g_last = gc_i[..., -1]
        S = S * jnp.exp(g_last)[..., None, None] + jnp.einsum(
            'bhcd,bhce->bhde', k_i * jnp.exp(g_last[..., None] - gc_i)[..., None], v_new)
        return S, o

    S, o = lax.scan(step, s0.astype(f32), (q, k, u, w, qk, gc))
    return o.transpose(1, 0, 3, 2, 4).reshape(B, T, H, DV), S


def delta_mixer(h, s0, w_in, conv_w, a_log, dt_bias, norm_gain, w_out):
    B, T, _ = h.shape
    proj = h @ w_in
    qkv, z, a, b = jnp.split(proj, [DN_QKV, DN_QKV + DN_VAL, DN_QKV + DN_VAL + 2 * DN_HEADS], axis=-1)
    qkv = jax.nn.silu(centred_depthwise_conv(qkv, conv_w))
    q, k, v = jnp.split(qkv, [DN_KEY, 2 * DN_KEY], axis=-1)
    q = l2_norm(q.reshape(B, T, DN_HEADS, DN_DK))
    k = l2_norm(k.reshape(B, T, DN_HEADS, DN_DK))
    v = v.reshape(B, T, DN_HEADS, DN_DV)
    a = a.reshape(B, T, 2, DN_HEADS).astype(jnp.float32)
    b = b.reshape(B, T, 2, DN_HEADS).astype(jnp.float32)
    g = -jnp.exp(a_log.astype(jnp.float32)) * jax.nn.softplus(a + dt_bias.astype(jnp.float32))
    beta = jax.nn.sigmoid(b)
    o_f, s_f = chunk_gated_delta(q, k, v, g[:, :, 0], beta[:, :, 0], s0[:, 0])
    rev = lambda t: jnp.flip(t, axis=1)
    o_b, s_b = chunk_gated_delta(rev(q), rev(k), rev(v), rev(g[:, :, 1]), rev(beta[:, :, 1]), s0[:, 1])
    o = o_f + rev(o_b)
    o = rms_norm(o, norm_gain) * jax.nn.silu(z.reshape(B, T, DN_HEADS, DN_DV).astype(jnp.float32))
    out = o.reshape(B, T, DN_VAL).astype(h.dtype) @ w_out
    return out, jnp.stack([s_f, s_b], axis=1)


def setup_inputs(seed: int = 0) -> dict:
    key = jax.random.key(seed)
    ks = jax.random.split(key, 24)
    f32 = jnp.float32
    D = D_MODEL
    nrm = lambda k, shape, s: jax.random.normal(k, shape, f32) * s
    dn_a_log = jnp.log(jax.random.uniform(ks[17], (N_DELTA_LAYERS, 2, DN_HEADS), f32, 1.0, 16.0))
    dt = jnp.exp(jax.random.uniform(ks[18], (N_DELTA_LAYERS, 2, DN_HEADS), f32,
                                    math.log(1e-3), math.log(1e-1)))
    dn_dt_bias = dt + jnp.log(-jnp.expm1(-dt))
    return {
        'x_prompt': nrm(ks[0], (BATCH, SEQ, D), 1.0),
        'x_sample': nrm(ks[1], (DEC_BATCH, DEC_SEQ, D), 1.0),
        'cache_k': nrm(ks[2], (DEC_BATCH, N_ATTN_LAYERS, PAST_LEN, KV_HEADS, HEAD_DIM), 1.0),
        'cache_v': nrm(ks[3], (DEC_BATCH, N_ATTN_LAYERS, PAST_LEN, KV_HEADS, HEAD_DIM), 1.0),
        'state_delta': nrm(ks[4], (DEC_BATCH, N_DELTA_LAYERS, 2, DN_HEADS, DN_DK, DN_DV), 0.1),
        'c': nrm(ks[5], (DEC_BATCH, D), 1.0),
        'c_ctx': nrm(ks[6], (D,), 1.0),
        'w_mod': nrm(ks[7], (DEPTH, D, N_MOD * D), 0.5 * D ** -0.5),
        'b_mod': nrm(ks[8], (DEPTH, N_MOD * D), 0.02),
        'norm1': 1.0 + nrm(ks[9], (DEPTH, D), 0.02),
        'norm2': 1.0 + nrm(ks[10], (DEPTH, D), 0.02),
        'attn_w_in': nrm(ks[11], (N_ATTN_LAYERS, D, Q_WIDTH + 2 * KV_WIDTH), D ** -0.5),
        'attn_q_gain': 1.0 + nrm(ks[12], (N_ATTN_LAYERS, HEAD_DIM), 0.02),
        'attn_k_gain': 1.0 + nrm(ks[13], (N_ATTN_LAYERS, HEAD_DIM), 0.02),
        'attn_w_out': nrm(ks[14], (N_ATTN_LAYERS, Q_WIDTH, D), Q_WIDTH ** -0.5),
        'dn_w_in': nrm(ks[15], (N_DELTA_LAYERS, D, DN_IN), D ** -0.5),
        'dn_conv': nrm(ks[16], (N_DELTA_LAYERS, CONV_K, DN_QKV), CONV_K ** -0.5),
        'dn_a_log': dn_a_log,
        'dn_dt_bias': dn_dt_bias,
        'dn_norm': 1.0 + nrm(ks[19], (N_DELTA_LAYERS, DN_DV), 0.02),
        'dn_w_out': nrm(ks[20], (N_DELTA_LAYERS, DN_VAL, D), DN_VAL ** -0.5),
        'mlp_w1': nrm(ks[21], (DEPTH, D, D_FF), D ** -0.5),
        'mlp_w2': nrm(ks[22], (DEPTH, D_FF, D), D_FF ** -0.5),
        'final_norm': 1.0 + nrm(ks[23], (D,), 0.02),
    }


def reference(x_prompt, x_sample, cache_k, cache_v, state_delta, c, c_ctx,
              w_mod, b_mod, norm1, norm2,
              attn_w_in, attn_q_gain, attn_k_gain, attn_w_out,
              dn_w_in, dn_conv, dn_a_log, dn_dt_bias, dn_norm, dn_w_out,
              mlp_w1, mlp_w2, final_norm):
    x = x_prompt
    bsz = x.shape[0]
    keys_out, vals_out, states_out = [], [], []
    for l in range(DEPTH):
        j = l // 2
        mods = modulation(c_ctx, w_mod[l], b_mod[l])
        if l % 2 == 0:
            mixer = functools.partial(context_attention, w_in=attn_w_in[j], q_gain=attn_q_gain[j],
                                      k_gain=attn_k_gain[j], w_out=attn_w_out[j])
        else:
            s0 = jnp.zeros((bsz, 2, DN_HEADS, DN_DK, DN_DV), jnp.float32)
            mixer = functools.partial(delta_mixer, s0=s0, w_in=dn_w_in[j], conv_w=dn_conv[j],
                                      a_log=dn_a_log[j], dt_bias=dn_dt_bias[j],
                                      norm_gain=dn_norm[j], w_out=dn_w_out[j])
        x, aux = trunk_layer(x, mods, norm1[l], norm2[l], mlp_w1[l], mlp_w2[l], mixer)
        if l % 2 == 0:
            keys_out.append(aux[0])
            vals_out.append(aux[1])
        else:
            states_out.append(aux)
    y_prompt = rms_norm(x, final_norm)
    new_cache_k = jnp.stack(keys_out, axis=1)
    new_cache_v = jnp.stack(vals_out, axis=1)
    new_state_delta = jnp.stack(states_out, axis=1).astype(x_prompt.dtype)

    ang = axial_angles(x_sample.shape[1])
    x = x_sample
    for l in range(DEPTH):
        j = l // 2
        mods = modulation(c, w_mod[l], b_mod[l])
        if l % 2 == 0:
            mixer = functools.partial(latent_attention, ck=cache_k[:, j], cv=cache_v[:, j], ang=ang,
                                      w_in=attn_w_in[j], q_gain=attn_q_gain[j],
                                      k_gain=attn_k_gain[j], w_out=attn_w_out[j])
        else:
            mixer = functools.partial(delta_mixer, s0=state_delta[:, j], w_in=dn_w_in[j],
                                      conv_w=dn_conv[j], a_log=dn_a_log[j], dt_bias=dn_dt_bias[j],
                                      norm_gain=dn_norm[j], w_out=dn_w_out[j])
        x, _ = trunk_layer(x, mods, norm1[l], norm2[l], mlp_w1[l], mlp_w2[l], mixer)
    y_sample = rms_norm(x, final_norm)
    return (y_prompt, y_sample, new_cache_k, new_cache_v, new_state_delta)
```

```cpp
#include <hip/hip_runtime.h>
#include <stdint.h>
#include <stdio.h>
#include <string.h>

namespace {
constexpr int D = 1024, NCTX = 8192, M = 10240, FF = 4096;
constexpr int QKVW = 1536, DNIN = 4128, DNQKV = 3072, ZABW = 1056;
constexpr float EPS = 1e-6f;
constexpr size_t O_Y = 0, O_CK = (size_t)M * D, O_CV = O_CK + 4194304, O_ST = O_CV + 4194304;
constexpr size_t W_X = 0;
constexpr size_t W_HO = W_X + (size_t)M * D;
constexpr size_t W_RAW = W_HO + (size_t)M * D;
constexpr size_t W_CONV = W_RAW + (size_t)M * DNQKV;
constexpr size_t W_ZAB = W_CONV + (size_t)M * DNQKV;
constexpr size_t W_MODS = W_ZAB + (size_t)M * ZABW;
constexpr size_t W_G = W_MODS + 4 * 3 * 6144;
constexpr size_t W_BETA = W_G + (size_t)M * 16;
constexpr size_t W_END = W_BETA + (size_t)M * 16;

__device__ __forceinline__ float silu(float x) { return x / (1.f + __expf(-x)); }
__device__ __forceinline__ int cond_of(int row) { return row < NCTX ? 0 : 1 + ((row - NCTX) >> 10); }
__device__ __forceinline__ float wave_sum(float v) {
#pragma unroll
    for (int o = 1; o < 64; o <<= 1) v += __shfl_xor(v, o);
    return v;
}

__global__ void k_copy_x(const float* xp, const float* xs, float* X) {
    size_t i = (size_t)blockIdx.x * blockDim.x + threadIdx.x;
    size_t n1 = (size_t)NCTX * D, n = (size_t)M * D;
    if (i < n) X[i] = i < n1 ? xp[i] : xs[i - n1];
}

__global__ void k_mods(const float* c, const float* cctx, const float* wmod, const float* bmod, float* mods) {
    int idx = blockIdx.x * blockDim.x + threadIdx.x;
    if (idx >= 4 * 6144) return;
    int l = idx / 6144, n = idx % 6144;
    float a0 = 0.f, a1 = 0.f, a2 = 0.f;
    const float* w = wmod + (size_t)l * 1024 * 6144 + n;
    for (int k = 0; k < 1024; ++k) {
        float wv = w[(size_t)k * 6144];
        a0 += silu(cctx[k]) * wv; a1 += silu(c[k]) * wv; a2 += silu(c[1024 + k]) * wv;
    }
    float b = bmod[l * 6144 + n];
    mods[(l * 3 + 0) * 6144 + n] = a0 + b; mods[(l * 3 + 1) * 6144 + n] = a1 + b; mods[(l * 3 + 2) * 6144 + n] = a2 + b;
}

__global__ void k_norm_mod(const float* X, const float* gain, const float* mods_l, int off, float* H) {
    int row = blockIdx.x * 4 + (threadIdx.x >> 6), lane = threadIdx.x & 63;
    if (row >= M) return;
    const float* x = X + (size_t)row * D;
    float v[16]; float ss = 0.f;
#pragma unroll
    for (int j = 0; j < 16; ++j) { v[j] = x[lane + 64 * j]; ss += v[j] * v[j]; }
    ss = wave_sum(ss);
    float rinv = rsqrtf(ss * (1.f / D) + EPS);
    const float* md = mods_l ? mods_l + cond_of(row) * 6144 + off : nullptr;
#pragma unroll
    for (int j = 0; j < 16; ++j) {
        int c = lane + 64 * j;
        float y = v[j] * rinv * gain[c];
        if (md) y = y * (1.f + md[1024 + c]) + md[c];
        H[(size_t)row * D + c] = y;
    }
}

struct GemmP { const float* A; const float* B; float* C; const float* mods_l; float* C2; int lda, N, K, ldc, gate_off, pad; };
static GemmP mk(const float* A, int lda, const float* B, int N, int K, float* C, int ldc, const float* mods_l, int gate_off, float* C2) {
    GemmP p; memset(&p, 0, sizeof(p)); p.A = A; p.B = B; p.C = C; p.mods_l = mods_l; p.C2 = C2; p.lda = lda; p.N = N; p.K = K; p.ldc = ldc; p.gate_off = gate_off; p.pad = 0; return p; }
template <int EPI> __global__ void __launch_bounds__(256) k_gemm(GemmP p) {
    __shared__ float As[16][68];
    __shared__ float Bs[16][68];
    const int t = threadIdx.x, ty = t >> 4, tx = t & 15;
    const int m0 = blockIdx.y * 64, n0 = blockIdx.x * 64;
    float acc[4][4];
#pragma unroll
    for (int i = 0; i < 4; ++i)
#pragma unroll
        for (int j = 0; j < 4; ++j) acc[i][j] = 0.f;
    const int ar = t >> 2, ak = (t & 3) * 4;
    const int bk = t >> 4, bn = (t & 15) * 4;
    for (int k0 = 0; k0 < p.K; k0 += 16) {
        float4 av = *(const float4*)(p.A + (size_t)(m0 + ar) * p.lda + k0 + ak);
        float4 bv = make_float4(0.f, 0.f, 0.f, 0.f);
        if (n0 + bn < p.N) bv = *(const float4*)(p.B + (size_t)(k0 + bk) * p.N + n0 + bn);
        __syncthreads();
        As[ak + 0][ar] = av.x; As[ak + 1][ar] = av.y; As[ak + 2][ar] = av.z; As[ak + 3][ar] = av.w;
        *(float4*)&Bs[bk][bn] = bv;
        __syncthreads();
#pragma unroll
        for (int k = 0; k < 16; ++k) {
            float4 a4 = *(const float4*)&As[k][ty * 4];
            float4 b4 = *(const float4*)&Bs[k][tx * 4];
            float a[4] = {a4.x, a4.y, a4.z, a4.w}, b[4] = {b4.x, b4.y, b4.z, b4.w};
#pragma unroll
            for (int i = 0; i < 4; ++i)
#pragma unroll
                for (int j = 0; j < 4; ++j) acc[i][j] += a[i] * b[j];
        }
    }
#pragma unroll
    for (int i = 0; i < 4; ++i) {
        int r = m0 + ty * 4 + i;
#pragma unroll
        for (int j = 0; j < 4; ++j) {
            int n = n0 + tx * 4 + j;
            if (n >= p.N) continue;
            float v = acc[i][j];
            if (EPI == 0) p.C[(size_t)r * p.ldc + n] = v;
            else if (EPI == 1) { float g = p.mods_l[cond_of(r) * 6144 + p.gate_off + n]; p.C[(size_t)r * p.ldc + n] += g * v; }
            else if (EPI == 2) { float q = v > 0.f ? v : 0.f; p.C[(size_t)r * p.ldc + n] = q * q; }
            else { if (n < DNQKV) p.C[(size_t)r * DNQKV + n] = v; else p.C2[(size_t)r * ZABW + n - DNQKV] = v; }
        }
    }
}

__global__ void k_qknorm_rope(float* P, const float* qg, const float* kg, float* out, int j) {
    int gw = blockIdx.x * 4 + (threadIdx.x >> 6), lane = threadIdx.x & 63;
    if (gw >= M * 12) return;
    int row = gw / 12, hs = gw % 12;
    float* x = P + (size_t)row * QKVW + hs * 128;
    float v0 = x[lane], v1 = x[lane + 64];
    if (hs < 10) {
        float ss = wave_sum(v0 * v0 + v1 * v1);
        float rinv = rsqrtf(ss * (1.f / 128.f) + EPS);
        const float* g = hs < 8 ? qg : kg;
        v0 = v0 * rinv * g[lane]; v1 = v1 * rinv * g[lane + 64];
        if (row >= NCTX) {
            int t = (row - NCTX) & 1023;
            int f = lane & 31, p = lane >> 5;
            float inv = powf(10000.f, -(float)f / 32.f);
            float a0 = (float)(t >> 6) * inv, a1 = (float)(t & 63) * inv;
            float y0 = __shfl_xor(v0, 32), y1 = __shfl_xor(v1, 32);
            float c0 = cosf(a0), s0 = sinf(a0), c1 = cosf(a1), s1 = sinf(a1);
            v0 = v0 * c0 + (p ? y0 : -y0) * s0;
            v1 = v1 * c1 + (p ? y1 : -y1) * s1;
        }
        x[lane] = v0; x[lane + 64] = v1;
    }
    if (row < NCTX && hs >= 8) {
        int b = row >> 8, t = row & 255;
        size_t o = (hs < 10 ? O_CK : O_CV) + ((size_t)(b * 2 + j) * 256 + t) * 256 + (hs & 1) * 128;
        out[o + lane] = v0; out[o + lane + 64] = v1;
    }
}

__global__ void __launch_bounds__(128) k_attn(const float* P, const float* ck, const float* cv, int j, float* O) {
    __shared__ float qs[128];
    __shared__ float ps[1280];
    __shared__ float red[4];
    int row = blockIdx.x >> 3, hq = blockIdx.x & 7, kvh = hq >> 2, tid = threadIdx.x;
    bool lat = row >= NCTX;
    int b = lat ? (row - NCTX) >> 10 : row >> 8;
    int Tk = lat ? 1280 : 256;
    int base = lat ? NCTX + b * 1024 : b * 256;
    qs[tid] = P[(size_t)row * QKVW + hq * 128 + tid];
    __syncthreads();
    float mx = -1e30f;
    for (int key = tid; key < Tk; key += 128) {
        const float* kp;
        if (lat && key < 256) kp = ck + ((size_t)(b * 2 + j) * 256 + key) * 256 + kvh * 128;
        else kp = P + (size_t)(base + (lat ? key - 256 : key)) * QKVW + 1024 + kvh * 128;
        float s = 0.f;
        for (int d = 0; d < 128; ++d) s += qs[d] * kp[d];
        s *= 0.08838834764831845f;
        ps[key] = s; mx = fmaxf(mx, s);
    }
#pragma unroll
    for (int o = 1; o < 64; o <<= 1) mx = fmaxf(mx, __shfl_xor(mx, o));
    if ((tid & 63) == 0) red[tid >> 6] = mx;
    __syncthreads();
    mx = fmaxf(red[0], red[1]);
    float sm = 0.f;
    for (int key = tid; key < Tk; key += 128) { float e = __expf(ps[key] - mx); ps[key] = e; sm += e; }
    sm = wave_sum(sm);
    if ((tid & 63) == 0) red[2 + (tid >> 6)] = sm;
    __syncthreads();
    sm = red[2] + red[3];
    float acc = 0.f;
    for (int key = 0; key < Tk; ++key) {
        const float* vp;
        if (lat && key < 256) vp = cv + ((size_t)(b * 2 + j) * 256 + key) * 256 + kvh * 128;
        else vp = P + (size_t)(base + (lat ? key - 256 : key)) * QKVW + 1280 + kvh * 128;
        acc += ps[key] * vp[tid];
    }
    O[(size_t)row * D + hq * 128 + tid] = acc / sm;
}

__global__ void k_dn_conv(const float* RAW, const float* cw, float* CONV) {
    int gw = blockIdx.x * 4 + (threadIdx.x >> 6), lane = threadIdx.x & 63;
    if (gw >= M * 24) return;
    int row = gw / 24, slot = gw % 24;
    int T = row < NCTX ? 256 : 1024;
    int t = row < NCTX ? (row & 255) : ((row - NCTX) & 1023);
    float v[2];
#pragma unroll
    for (int e = 0; e < 2; ++e) {
        int c = slot * 128 + lane + 64 * e;
        float a = 0.f;
#pragma unroll
        for (int i = 0; i < 5; ++i) {
            int tt = t + i - 2;
            if (tt >= 0 && tt < T) a += RAW[(size_t)(row + i - 2) * DNQKV + c] * cw[i * DNQKV + c];
        }
        v[e] = silu(a);
    }
    if (slot < 16) {
        float ss = wave_sum(v[0] * v[0] + v[1] * v[1]);
        float rinv = rsqrtf(ss + EPS);
        v[0] *= rinv; v[1] *= rinv;
    }
    CONV[(size_t)row * DNQKV + slot * 128 + lane] = v[0];
    CONV[(size_t)row * DNQKV + slot * 128 + lane + 64] = v[1];
}

__global__ void k_dn_gates(const float* ZAB, const float* alog, const float* dtb, float* G, float* BETA) {
    int idx = blockIdx.x * blockDim.x + threadIdx.x;
    if (idx >= M * 16) return;
    int row = idx >> 4, dh = idx & 15;
    float a = ZAB[(size_t)row * ZABW + 1024 + dh], b = ZAB[(size_t)row * ZABW + 1040 + dh];
    float x = a + dtb[dh];
    float sp = x > 20.f ? x : log1pf(expf(x));
    G[idx] = -expf(alog[dh]) * sp;
    BETA[idx] = 1.f / (1.f + expf(-b));
}

__global__ void __launch_bounds__(128) k_dn_scan(const float* CONV, const float* G, const float* BETA, const float* s0in, int j, float* OF, float* OB, float* out) {
    __shared__ float ks[2][128];
    __shared__ float qs[2][128];
    int seq = blockIdx.x >> 4, h = (blockIdx.x >> 1) & 7, dir = blockIdx.x & 1, tid = threadIdx.x;
    bool lat = seq >= 32;
    int T = lat ? 1024 : 256;
    int base = lat ? NCTX + (seq - 32) * 1024 : seq * 256;
    float S[128];
    if (lat) {
        const float* sp = s0in + ((((size_t)(seq - 32) * 2 + j) * 2 + dir) * 8 + h) * 16384;
#pragma unroll
        for (int k = 0; k < 128; ++k) S[k] = sp[k * 128 + tid];
    } else {
#pragma unroll
        for (int k = 0; k < 128; ++k) S[k] = 0.f;
    }
    float* Od = dir ? OB : OF;
    for (int p = 0; p < T; ++p) {
        int tok = dir ? T - 1 - p : p;
        size_t row = (size_t)(base + tok);
        int bufi = p & 1;
        qs[bufi][tid] = CONV[row * DNQKV + h * 128 + tid];
        ks[bufi][tid] = CONV[row * DNQKV + 1024 + h * 128 + tid];
        float v = CONV[row * DNQKV + 2048 + h * 128 + tid];
        float g = G[row * 16 + dir * 8 + h], beta = BETA[row * 16 + dir * 8 + h];
        float eg = expf(g);
        __syncthreads();
        float kS = 0.f;
#pragma unroll
        for (int k = 0; k < 128; ++k) kS += ks[bufi][k] * S[k];
        float vn = beta * (v - eg * kS);
        float o = 0.f;
#pragma unroll
        for (int k = 0; k < 128; ++k) { S[k] = eg * S[k] + ks[bufi][k] * vn; o += qs[bufi][k] * S[k]; }
        Od[row * D + h * 128 + tid] = o * 0.08838834764831845f;
    }
    if (!lat) {
        float* sp = out + O_ST + ((((size_t)seq * 2 + j) * 2 + dir) * 8 + h) * 16384;
#pragma unroll
        for (int k = 0; k < 128; ++k) sp[k * 128 + tid] = S[k];
    }
}

__global__ void k_dn_gate_norm(const float* OF, const float* OB, const float* ZAB, const float* gain, float* Y) {
    int gw = blockIdx.x * 4 + (threadIdx.x >> 6), lane = threadIdx.x & 63;
    if (gw >= M * 8) return;
    int row = gw >> 3, h = gw & 7;
    size_t o = (size_t)row * D + h * 128;
    float v0 = OF[o + lane] + OB[o + lane], v1 = OF[o + lane + 64] + OB[o + lane + 64];
    float ss = wave_sum(v0 * v0 + v1 * v1);
    float rinv = rsqrtf(ss * (1.f / 128.f) + EPS);
    float z0 = ZAB[(size_t)row * ZABW + h * 128 + lane], z1 = ZAB[(size_t)row * ZABW + h * 128 + lane + 64];
    Y[o + lane] = v0 * rinv * gain[lane] * silu(z0);
    Y[o + lane + 64] = v1 * rinv * gain[lane + 64] * silu(z1);
}
}

extern "C" void kernel_launch(void* const* d_in, const int* in_sizes, int n_in, void* d_out, int out_size, void* d_ws, size_t ws_size, hipStream_t stream) {
    if (ws_size < W_END * 4) { fprintf(stderr, "ws too small: %zu < %zu\n", ws_size, W_END * 4); return; }
    const float* x_prompt = (const float*)d_in[0]; const float* x_sample = (const float*)d_in[1];
    const float* cache_k = (const float*)d_in[2]; const float* cache_v = (const float*)d_in[3];
    const float* state_delta = (const float*)d_in[4]; const float* c = (const float*)d_in[5]; const float* c_ctx = (const float*)d_in[6];
    const float* w_mod = (const float*)d_in[7]; const float* b_mod = (const float*)d_in[8];
    const float* norm1 = (const float*)d_in[9]; const float* norm2 = (const float*)d_in[10];
    const float* attn_w_in = (const float*)d_in[11]; const float* attn_q_gain = (const float*)d_in[12]; const float* attn_k_gain = (const float*)d_in[13];
    const float* attn_w_out = (const float*)d_in[14]; const float* dn_w_in = (const float*)d_in[15]; const float* dn_conv = (const float*)d_in[16];
    const float* dn_a_log = (const float*)d_in[17]; const float* dn_dt_bias = (const float*)d_in[18]; const float* dn_norm = (const float*)d_in[19];
    const float* dn_w_out = (const float*)d_in[20]; const float* mlp_w1 = (const float*)d_in[21]; const float* mlp_w2 = (const float*)d_in[22];
    const float* final_norm = (const float*)d_in[23];
    float* out = (float*)d_out; float* ws = (float*)d_ws;
    float *X = ws + W_X, *HO = ws + W_HO, *RAW = ws + W_RAW, *CONV = ws + W_CONV, *ZAB = ws + W_ZAB, *MODS = ws + W_MODS, *G = ws + W_G, *BETA = ws + W_BETA;
    float* HM = RAW;

    k_copy_x<<<(M * D + 255) / 256, 256, 0, stream>>>(x_prompt, x_sample, X);
    k_mods<<<(4 * 6144 + 255) / 256, 256, 0, stream>>>(c, c_ctx, w_mod, b_mod, MODS);
    for (int l = 0; l < 4; ++l) {
        const int j = l >> 1;
        const float* mods_l = MODS + (size_t)l * 3 * 6144;
        k_norm_mod<<<M / 4, 256, 0, stream>>>(X, norm1 + l * D, mods_l, 0, HO);
        if ((l & 1) == 0) {
            GemmP p = mk(HO, D, attn_w_in + (size_t)j * D * QKVW, QKVW, D, RAW, QKVW, nullptr, 0, nullptr);
            k_gemm<0><<<dim3(QKVW / 64, M / 64), 256, 0, stream>>>(p);
            k_qknorm_rope<<<M * 12 / 4, 256, 0, stream>>>(RAW, attn_q_gain + j * 128, attn_k_gain + j * 128, out, j);
            k_attn<<<M * 8, 128, 0, stream>>>(RAW, cache_k, cache_v, j, HO);
            GemmP p2 = mk(HO, D, attn_w_out + (size_t)j * D * D, D, D, X, D, mods_l, 2048, nullptr);
            k_gemm<1><<<dim3(D / 64, M / 64), 256, 0, stream>>>(p2);
        } else {
            GemmP p = mk(HO, D, dn_w_in + (size_t)j * D * DNIN, DNIN, D, RAW, DNQKV, nullptr, 0, ZAB);
            k_gemm<3><<<dim3((DNIN + 63) / 64, M / 64), 256, 0, stream>>>(p);
            k_dn_conv<<<M * 24 / 4, 256, 0, stream>>>(RAW, dn_conv + (size_t)j * 5 * DNQKV, CONV);
            k_dn_gates<<<M * 16 / 256, 256, 0, stream>>>(ZAB, dn_a_log + j * 16, dn_dt_bias + j * 16, G, BETA);
            float* OF = HO; float* OB = RAW;
            k_dn_scan<<<34 * 16, 128, 0, stream>>>(CONV, G, BETA, state_delta, j, OF, OB, out);
            k_dn_gate_norm<<<M * 8 / 4, 256, 0, stream>>>(OF, OB, ZAB, dn_norm + j * 128, HO);
            GemmP p2 = mk(HO, D, dn_w_out + (size_t)j * D * D, D, D, X, D, mods_l, 2048, nullptr);
            k_gemm<1><<<dim3(D / 64, M / 64), 256, 0, stream>>>(p2);
        }
        k_norm_mod<<<M / 4, 256, 0, stream>>>(X, norm2 + l * D, mods_l, 3072, HO);
        GemmP p3 = mk(HO, D, mlp_w1 + (size_t)l * D * FF, FF, D, HM, FF, nullptr, 0, nullptr);
        k_gemm<2><<<dim3(FF / 64, M / 64), 256, 0, stream>>>(p3);
        GemmP p4 = mk(HM, FF, mlp_w2 + (size_t)l * FF * D, D, FF, X, D, mods_l, 5120, nullptr);
        k_gemm<1><<<dim3(D / 64, M / 64), 256, 0, stream>>>(p4);
    }
    k_norm_mod<<<M / 4, 256, 0, stream>>>(X, final_norm, nullptr, 0, out + O_Y);
}
```

```cpp
#include <hip/hip_runtime.h>
#include <hip/hip_cooperative_groups.h>
#include <cstdio>
#include <cstdint>
#include <cstring>
namespace cg = cooperative_groups;

constexpr int D = 1024, NCTX = 8192, NLAT = 2048, MTOK = 10240, FF = 4096;
constexpr int QKVW = 1536, DNIN = 4128, DNINP = 4352, PROJW = 4096;
constexpr int KVROWS = 8192 + 2 * 1280;
constexpr float EPS = 1e-6f;
constexpr float ATT_SCALE = 0.08838834764831845f;
constexpr size_t O_Y = 0, O_CK = (size_t)MTOK * D, O_CV = O_CK + 4194304, O_ST = O_CV + 4194304;

typedef unsigned short bf16raw;
typedef float f32x4_t __attribute__((ext_vector_type(4)));
typedef float f32x2_t __attribute__((ext_vector_type(2)));
typedef unsigned u32x4_t __attribute__((ext_vector_type(4)));
typedef unsigned u32x2_t __attribute__((ext_vector_type(2)));

__device__ __forceinline__ unsigned f2bf(float f) { unsigned u = __builtin_bit_cast(unsigned, f); return (u + 0x7fffu + ((u >> 16) & 1u)) >> 16; }
__device__ __forceinline__ unsigned pk2(float lo, float hi) { return f2bf(lo) | (f2bf(hi) << 16); }
__device__ __forceinline__ float bf_lo(unsigned w) { return __builtin_bit_cast(float, w << 16); }
__device__ __forceinline__ float bf_hi(unsigned w) { return __builtin_bit_cast(float, w & 0xffff0000u); }
__device__ __forceinline__ float bf2f(bf16raw h) { return __builtin_bit_cast(float, (unsigned)h << 16); }
__device__ __forceinline__ float silu_f(float x) { return x / (1.f + __expf(-x)); }
__device__ __forceinline__ int cond_of(int row) { return row < NCTX ? 0 : 1 + ((row - NCTX) >> 10); }
__device__ __forceinline__ float lane_xor_f(float v, int lane, int k) { return __builtin_bit_cast(float, __builtin_amdgcn_ds_bpermute((lane ^ k) << 2, __builtin_bit_cast(int, v))); }
__device__ __forceinline__ float wave_sum(float v, int lane) {
#pragma unroll
    for (int o = 1; o < 64; o <<= 1) v += lane_xor_f(v, lane, o);
    return v;
}
__device__ __forceinline__ float wave_max(float v, int lane) {
#pragma unroll
    for (int o = 1; o < 64; o <<= 1) v = fmaxf(v, lane_xor_f(v, lane, o));
    return v;
}
namespace pg8 {
#define PG8_LAS __attribute__((address_space(3)))
typedef unsigned short bf16_t;
typedef short bf16x8 __attribute__((ext_vector_type(8)));
typedef float f32x4 __attribute__((ext_vector_type(4)));
typedef unsigned u32x4 __attribute__((ext_vector_type(4)));
constexpr int BM = 256, BK = 64, HALF = 128, HTB = HALF * BK * 2  , STAGE_BYTES = 8 * HTB, NXCD = 8, WGM = 8;

__host__ __device__ __forceinline__ int lds_byte(int r, int c) { const int st = (r >> 4) * 2 + (c >> 5), rr = r & 15, cc = c & 31, ob = rr * 64 + cc * 2; return st * 1024 + (ob ^ (((ob >> 9) & 1) << 5)); }
__host__ __device__ __forceinline__ void stage_rc(int b, int& R, int& C) { const int st = b / 1024, sb = b % 1024, swz = sb ^ (((sb >> 9) & 1) << 5); R = (st >> 1) * 16 + swz / 64; C = (st & 1) * 32 + (swz % 64) / 2; }
__host__ __device__ __forceinline__ int perm32(int rho) { const int n = rho >> 4, i = rho & 15; return 8 * (i >> 2) + 4 * n + (i & 3); }

struct Unit { int pm, pn; };
struct Gemm { const bf16_t* A; const bf16_t* Bt; int M, N, K; int z; };

struct StaticOrder {
    int nM, nN, nwg, G, c;
    __host__ __device__ void init(int M, int N, int G_, int c_) { nM = M / BM; nN = N / BM; nwg = nM * nN; G = G_; c = c_; }
    __host__ __device__ bool next(int i, Unit& u) const {
        const long L = (long)i * G + c; if (L >= nwg) return false;
        int wgid = (int)L; { const int q = nwg / NXCD, r = nwg % NXCD, xcd = wgid % NXCD, off = wgid / NXCD; wgid = (xcd < r ? xcd * (q + 1) : r * (q + 1) + (xcd - r) * q) + off; }
        const int nig = WGM * nN, gid = wgid / nig, fm = gid * WGM, gsz = (nM - fm) < WGM ? (nM - fm) : WGM;
        u.pm = fm + ((wgid % nig) % gsz); u.pn = (wgid % nig) / gsz; return true;
    }
    __device__ __forceinline__ void a_ready(const Unit&) const {}
    __device__ __forceinline__ void done(const Unit&) const {}
};

__device__ __forceinline__ unsigned cvt_pk_bf16(float lo, float hi) { unsigned r; asm volatile("v_cvt_pk_bf16_f32 %0, %1, %2" : "=v"(r) : "v"(lo), "v"(hi)); return r; }
typedef float f32x2 __attribute__((ext_vector_type(2)));
__device__ __forceinline__ f32x2 gelu_pk(f32x2 v) {
    const f32x2 av = __builtin_elementwise_abs(v), d = av * 0.2316418882f + 1.0f;
    f32x2 t; t.x = __builtin_amdgcn_rcpf(d.x); t.y = __builtin_amdgcn_rcpf(d.y);
    f32x2 q = t * 0.5307027145f + (-0.7265760135f); q = q * t + 0.7107068705f; q = q * t + (-0.142248368f); q = q * t + 0.127414796f; q = q * t;
    const f32x2 s = (v * v) * (-0.72134752044f);
    f32x2 e; e.x = __builtin_amdgcn_exp2f(s.x); e.y = __builtin_amdgcn_exp2f(s.y);
    const f32x2 m = v * (q * e), r = v - m;
    f32x2 o; o.x = v.x < 0.f ? m.x : r.x; o.y = v.y < 0.f ? m.y : r.y; return o;
}

template <int ACT  > struct EpiBf16 {
    static constexpr bool PERM = true, AFTER_DRAIN = false; static_assert(ACT >= 0 && ACT <= 2, "EpiBf16: ACT is 0 (none), 1 (gelu_pk) or 2 (squared relu)");
    bf16_t* O; int ldc; const float* bias; int split_cols; size_t split_stride; float scale0;
    __device__ __forceinline__ void operator()(const f32x4 (&acc)[2][2][4][2], const Unit& u, int wr, int wc, int fr, int fq) const {
        const int row0 = u.pm * BM + wr * 64 + fr; int colt = u.pn * BM; bf16_t* base = O;
        float sc = 1.f; if (split_cols) { const int t = colt / split_cols; base += (size_t)t * split_stride; colt -= t * split_cols; if (t == 0) sc = scale0; }
        const int col0 = colt + wc * 32 + 8 * fq, bcol0 = u.pn * BM + wc * 32 + 8 * fq;
        f32x4 bv[2][2];
#pragma unroll
        for (int bj = 0; bj < 2; ++bj)
#pragma unroll
            for (int n = 0; n < 2; ++n) bv[bj][n] = bias ? *(const f32x4*)(bias + bcol0 + bj * HALF + 4 * n) : (f32x4){0.f, 0.f, 0.f, 0.f};
#pragma unroll
        for (int ai = 0; ai < 2; ++ai)
#pragma unroll
            for (int m = 0; m < 4; ++m) { bf16_t* rowp = base + (size_t)(row0 + ai * HALF + m * 16) * ldc + col0;
#pragma unroll
                for (int bj = 0; bj < 2; ++bj) { f32x4 v0 = acc[ai][bj][m][0] + bv[bj][0], v1 = acc[ai][bj][m][1] + bv[bj][1];
                    if (ACT == 1) { f32x2 a = gelu_pk((f32x2){v0[0], v0[1]}), b = gelu_pk((f32x2){v0[2], v0[3]}), c = gelu_pk((f32x2){v1[0], v1[1]}), d = gelu_pk((f32x2){v1[2], v1[3]});
                        v0 = (f32x4){a.x, a.y, b.x, b.y}; v1 = (f32x4){c.x, c.y, d.x, d.y}; }
                    if (ACT == 2) { v0 = __builtin_elementwise_max(v0, (f32x4){0.f, 0.f, 0.f, 0.f}); v1 = __builtin_elementwise_max(v1, (f32x4){0.f, 0.f, 0.f, 0.f}); v0 = v0 * v0; v1 = v1 * v1; }
                    v0 = v0 * sc; v1 = v1 * sc; u32x4 w; w.x = cvt_pk_bf16(v0[0], v0[1]); w.y = cvt_pk_bf16(v0[2], v0[3]); w.z = cvt_pk_bf16(v1[0], v1[1]); w.w = cvt_pk_bf16(v1[2], v1[3]);
                    *(u32x4*)(rowp + bj * HALF) = w; } }
    }
};

struct PanelStats {
    unsigned* xbuf;
    unsigned* cnt;
    unsigned* tmo;
    int ntn; float eps;
    unsigned code;
    __device__ __forceinline__ bool run(const f32x4 (&v)[2][2][4][2], const Unit& u, int wr, int wc, int fr, int fq, PG8_LAS unsigned char* lds, int wid, int lane) const {
        typedef float f32x2v __attribute__((ext_vector_type(2)));
        PG8_LAS f32x2v* P = (PG8_LAS f32x2v*)lds;
        PG8_LAS f32x2v* S = (PG8_LAS f32x2v*)(lds + 8192);
        PG8_LAS unsigned* flag = (PG8_LAS unsigned*)(lds + 8192 + 2048);
#pragma unroll
        for (int ai = 0; ai < 2; ++ai)
#pragma unroll
            for (int m = 0; m < 4; ++m) {
                float s = 0.f;
#pragma unroll
                for (int bj = 0; bj < 2; ++bj)
#pragma unroll
                    for (int n = 0; n < 2; ++n) { const f32x4 x = v[ai][bj][m][n]; s += (x[0] + x[1]) + (x[2] + x[3]); }
                s += __shfl_xor(s, 16); s += __shfl_xor(s, 32);
                const float mw = s * (1.0f / 64.0f); float q = 0.f;
#pragma unroll
                for (int bj = 0; bj < 2; ++bj)
#pragma unroll
                    for (int n = 0; n < 2; ++n) { const f32x4 d = v[ai][bj][m][n] - mw; q += (d[0] * d[0] + d[1] * d[1]) + (d[2] * d[2] + d[3] * d[3]); }
                q += __shfl_xor(q, 16); q += __shfl_xor(q, 32);
                if (fq == 0) P[(ai * HALF + wr * 64 + m * 16 + fr) * 4 + wc] = (f32x2v){mw, q};
            }
        asm volatile("s_waitcnt lgkmcnt(0)" ::: "memory"); __builtin_amdgcn_s_barrier(); asm volatile("" ::: "memory");
#if defined(BROKEN_EXCHANGE_NO_WAIT)
#warning BROKEN CONTROL BUILD: the row-statistics exchange does not wait; results are wrong by design
        if (blockIdx.x >= 64) { const long long t0_ = clock64(); while (clock64() - t0_ < 60000) __builtin_amdgcn_s_sleep(8); }
#endif
        const int row = wid * 32 + (lane & 31);
        if (lane < 32) {
            const f32x2v a = P[row * 4 + 0], b = P[row * 4 + 1], c = P[row * 4 + 2], d = P[row * 4 + 3];
            const float mt = (a.x + b.x + c.x + d.x) * 0.25f;
            const float da = a.x - mt, db = b.x - mt, dc = c.x - mt, dd = d.x - mt;
            const float m2 = (a.y + b.y) + (c.y + d.y) + 64.0f * ((da * da + db * db) + (dc * dc + dd * dd));
            unsigned long long* slot = (unsigned long long*)xbuf + ((size_t)(u.pm * BM + row) * 4 + u.pn);
            __hip_atomic_store(slot, ((unsigned long long)__float_as_uint(m2) << 32) | __float_as_uint(mt), __ATOMIC_RELAXED, __HIP_MEMORY_SCOPE_AGENT);
        }
        asm volatile("s_waitcnt vmcnt(0)" ::: "memory");
        if (lane == 0) __hip_atomic_fetch_add(cnt + 64 * u.pm, 1u, __ATOMIC_RELAXED, __HIP_MEMORY_SCOPE_AGENT);
        if (wid == 0) {
            bool dead = false; const unsigned long long t0 = __builtin_amdgcn_s_memrealtime(); const unsigned want = 8u * (unsigned)ntn;
            for (;;) {
#if defined(BROKEN_EXCHANGE_NO_WAIT)
                break;
#endif
                if ((unsigned)__builtin_amdgcn_readfirstlane(__hip_atomic_load(cnt + 64 * u.pm, __ATOMIC_RELAXED, __HIP_MEMORY_SCOPE_AGENT)) >= want) break;
                if (__builtin_amdgcn_s_memrealtime() - t0 > 2000000ull) {
                    if (lane == 0) { unsigned expect = 0u; __hip_atomic_compare_exchange_strong(tmo + 1, &expect, code | (unsigned)(u.pm & 0xff), __ATOMIC_RELAXED, __ATOMIC_RELAXED, __HIP_MEMORY_SCOPE_AGENT);
                                     __hip_atomic_store(tmo, 1u, __ATOMIC_RELAXED, __HIP_MEMORY_SCOPE_AGENT); }
                    dead = true; break; }
                __builtin_amdgcn_s_sleep(2);
            }
            __builtin_amdgcn_fence(__ATOMIC_ACQUIRE, "agent");
            if (lane == 0) flag[0] = dead ? 1u : 0u;
        }
        asm volatile("s_waitcnt vmcnt(0) lgkmcnt(0)" ::: "memory"); __builtin_amdgcn_s_barrier(); asm volatile("" ::: "memory");
        const bool bad = flag[0] != 0u;
        if (lane < 32) {
            const unsigned long long* slot = (const unsigned long long*)xbuf + (size_t)(u.pm * BM + row) * 4; float mt[4], m2[4]; float ms = 0.f;
#pragma unroll
            for (int t = 0; t < 4; ++t) { if (t < ntn) { const unsigned long long w = __hip_atomic_load(slot + t, __ATOMIC_RELAXED, __HIP_MEMORY_SCOPE_AGENT); mt[t] = __uint_as_float((unsigned)w); m2[t] = __uint_as_float((unsigned)(w >> 32)); } else { mt[t] = 0.f; m2[t] = 0.f; } ms += mt[t]; }
            const float mean = ms / (float)ntn; float q = 0.f;
#pragma unroll
            for (int t = 0; t < 4; ++t) if (t < ntn) { const float dm = mt[t] - mean; q += m2[t] + 256.0f * dm * dm; }
            S[row] = (f32x2v){mean, 1.0f / sqrtf(q / (256.0f * (float)ntn) + eps)};
        }
        asm volatile("s_waitcnt lgkmcnt(0)" ::: "memory"); __builtin_amdgcn_s_barrier(); asm volatile("" ::: "memory");
        return bad;
    }
};
struct EpiLnRes {
    static constexpr bool PERM = false, AFTER_DRAIN = true;
    const float* base; float* out; int ldc; const float* bias; PanelStats st; unsigned poison;
    __device__ __forceinline__ void fused(f32x4 (&acc)[2][2][4][2], const Unit& u, int wr, int wc, int fr, int fq, PG8_LAS unsigned char* lds, int wid, int lane) const {
        typedef float f32x2v __attribute__((ext_vector_type(2)));
        const PG8_LAS f32x2v* S = (const PG8_LAS f32x2v*)(lds + 8192);
        const int col0 = u.pn * BM + wc * 32 + 4 * fq;
#pragma unroll
        for (int bj = 0; bj < 2; ++bj)
#pragma unroll
            for (int n = 0; n < 2; ++n) { const f32x4 bv = bias ? *(const f32x4*)(bias + col0 + bj * HALF + n * 16) : (f32x4){0.f, 0.f, 0.f, 0.f};
#pragma unroll
                for (int ai = 0; ai < 2; ++ai)
#pragma unroll
                    for (int m = 0; m < 4; ++m) acc[ai][bj][m][n] += bv; }
        f32x4 pre[4][2][2];
#pragma unroll
        for (int m = 0; m < 4; ++m) { const size_t off = (size_t)(u.pm * BM + wr * 64 + m * 16 + fr) * ldc + col0;
#pragma unroll
            for (int bj = 0; bj < 2; ++bj)
#pragma unroll
                for (int n = 0; n < 2; ++n) pre[m][bj][n] = *(const f32x4*)(base + off + bj * HALF + n * 16); }
        const bool bad = st.run(acc, u, wr, wc, fr, fq, lds, wid, lane) || poison != 0u;
        const float qnan = __builtin_nanf("");
#pragma unroll
        for (int ai = 0; ai < 2; ++ai)
#pragma unroll
            for (int m = 0; m < 4; ++m) { const int r = ai * HALF + wr * 64 + m * 16 + fr; const f32x2v sr = S[r]; const size_t off = (size_t)(u.pm * BM + r) * ldc + col0;
#pragma unroll
                for (int bj = 0; bj < 2; ++bj)
#pragma unroll
                    for (int n = 0; n < 2; ++n) { const f32x4 bs = ai == 0 ? pre[m][bj][n] : *(const f32x4*)(base + off + bj * HALF + n * 16); f32x4 o = bs + (acc[ai][bj][m][n] - sr.x) * sr.y;
                        if (bad) o = (f32x4){qnan, qnan, qnan, qnan}; *(f32x4*)(out + off + bj * HALF + n * 16) = o; }
                if (m & 1) asm volatile("" ::: "memory"); }
    }
};
struct EpiLnResLn {
    static constexpr bool PERM = false, AFTER_DRAIN = true;
    const float* base; float* out; bf16_t* xn; int ldc; const float* bias; PanelStats st1, st2; unsigned poison;
    __device__ __forceinline__ void fused(f32x4 (&acc)[2][2][4][2], const Unit& u, int wr, int wc, int fr, int fq, PG8_LAS unsigned char* lds, int wid, int lane) const {
        typedef float f32x2v __attribute__((ext_vector_type(2))); typedef unsigned u32x2v __attribute__((ext_vector_type(2)));
        const PG8_LAS f32x2v* S = (const PG8_LAS f32x2v*)(lds + 8192);
        const int col0 = u.pn * BM + wc * 32 + 4 * fq;
#pragma unroll
        for (int bj = 0; bj < 2; ++bj)
#pragma unroll
            for (int n = 0; n < 2; ++n) { const f32x4 bv = bias ? *(const f32x4*)(bias + col0 + bj * HALF + n * 16) : (f32x4){0.f, 0.f, 0.f, 0.f};
#pragma unroll
                for (int ai = 0; ai < 2; ++ai)
#pragma unroll
                    for (int m = 0; m < 4; ++m) acc[ai][bj][m][n] += bv; }
        bool bad = st1.run(acc, u, wr, wc, fr, fq, lds, wid, lane) || poison != 0u;
        const float qnan = __builtin_nanf("");
#pragma unroll
        for (int ai = 0; ai < 2; ++ai)
#pragma unroll
            for (int m = 0; m < 4; ++m) { const int r = ai * HALF + wr * 64 + m * 16 + fr; const f32x2v sr = S[r]; const size_t off = (size_t)(u.pm * BM + r) * ldc + col0;
#pragma unroll
                for (int bj = 0; bj < 2; ++bj)
#pragma unroll
                    for (int n = 0; n < 2; ++n) { const f32x4 bs = *(const f32x4*)(base + off + bj * HALF + n * 16); acc[ai][bj][m][n] = bs + (acc[ai][bj][m][n] - sr.x) * sr.y; }
                asm volatile("" : "+v"(acc[ai][0][m][0]), "+v"(acc[ai][0][m][1]), "+v"(acc[ai][1][m][0]), "+v"(acc[ai][1][m][1]));
                if (m & 1) asm volatile("" ::: "memory"); }
        const bool bad1 = bad;
        bad = st2.run(acc, u, wr, wc, fr, fq, lds, wid, lane) || bad;
#pragma unroll
        for (int ai = 0; ai < 2; ++ai)
#pragma unroll
            for (int m = 0; m < 4; ++m) { const int r = ai * HALF + wr * 64 + m * 16 + fr; const f32x2v sr = S[r]; const size_t off = (size_t)(u.pm * BM + r) * ldc + col0;
#pragma unroll
                for (int bj = 0; bj < 2; ++bj)
#pragma unroll
                    for (int n = 0; n < 2; ++n) { const f32x4 x1 = acc[ai][bj][m][n]; *(f32x4*)(out + off + bj * HALF + n * 16) = bad1 ? (f32x4){qnan, qnan, qnan, qnan} : x1;
                        const f32x4 o = (x1 - sr.x) * sr.y; u32x2v w; w.x = cvt_pk_bf16(o[0], o[1]); w.y = cvt_pk_bf16(o[2], o[3]);
                        if (bad) { w.x = 0x7fc07fc0u; w.y = 0x7fc07fc0u; } *(u32x2v*)(xn + off + bj * HALF + n * 16) = w; }
                asm volatile("" ::: "memory"); }
    }
};

template <class Epi, class Sched, bool ALIGN_EPI = false, bool SP2 = false>
__device__ __forceinline__ void gemm_phase(PG8_LAS unsigned char* lds, const Gemm g, const Sched& S, const Epi& E) {
    const int tid = threadIdx.x + g.z, wid = __builtin_amdgcn_readfirstlane(tid >> 6), lane = tid & 63, wr = wid >> 2, wc = wid & 3, fr = lane & 15, fq = lane >> 4;
    const int K = g.K, nt = K / BK;
    unsigned voffA[2], voffB[2];
#pragma unroll
    for (int i = 0; i < 2; ++i) { int R, C; stage_rc(tid * 16 + i * 8192, R, C); const int Rb = Epi::PERM ? ((R & ~31) + perm32(R & 31)) : R;
        voffA[i] = (unsigned)(R * K + C) * 2u; voffB[i] = (unsigned)(Rb * K + C) * 2u; }
    const size_t kstep = (size_t)(BK * 2);
    const size_t hstep = (size_t)HALF * K * 2;
    const size_t tstep = 2 * hstep;
    const unsigned ldsw = (unsigned)wid * 1024u;
    const int aoff = lds_byte(wr * 64 + fr, fq * 8), boff = lds_byte(wc * 32 + fr, fq * 8);
#define PG8_SA(b, h) (((b) * 2 + (h)) * HTB)
#define PG8_SB(b, h) ((4 + (b) * 2 + (h)) * HTB)
#define PG8_STAGE(bufoff, gbase, voff) do { _Pragma("unroll") for (int _i = 0; _i < 2; ++_i) \
        __builtin_amdgcn_global_load_lds((const unsigned*)((const char*)(gbase) + (voff)[_i]), (PG8_LAS unsigned*)(lds + (bufoff) + ldsw + _i * 8192), 16, 0, 0); } while (0)
#define PG8_LDA(dst, b, h) do { _Pragma("unroll") for (int m = 0; m < 4; ++m) _Pragma("unroll") for (int k = 0; k < 2; ++k) dst[m][k] = *(const PG8_LAS bf16x8*)(lds + PG8_SA(b, h) + aoff + m * 2048 + k * 1024); } while (0)
#define PG8_LDB(dst, b, h) do { _Pragma("unroll") for (int n = 0; n < 2; ++n) _Pragma("unroll") for (int k = 0; k < 2; ++k) dst[n][k] = *(const PG8_LAS bf16x8*)(lds + PG8_SB(b, h) + boff + n * 2048 + k * 1024); } while (0)
#define PG8_MMA(ai, bj, At, Bt) do { __builtin_amdgcn_s_setprio(1); _Pragma("unroll") for (int m = 0; m < 4; ++m) _Pragma("unroll") for (int n = 0; n < 2; ++n) _Pragma("unroll") for (int k = 0; k < 2; ++k) \
        acc[ai][bj][m][n] = __builtin_amdgcn_mfma_f32_16x16x32_bf16(Bt[n][k], At[m][k], acc[ai][bj][m][n], 0, 0, 0); __builtin_amdgcn_s_setprio(0); } while (0)
#define PG8_WAIT_V(n) asm volatile("s_waitcnt vmcnt(" #n ")" ::: "memory")
#define PG8_WAIT_L(n) asm volatile("s_waitcnt lgkmcnt(" #n ")" ::: "memory")
#define PG8_BAR __builtin_amdgcn_s_barrier()
#define PG8_SCHED __builtin_amdgcn_sched_barrier(0)
    Unit cur, nxt; int ui = 0;
    if (!S.next(0, cur)) return;
    f32x4 acc[2][2][4][2];
#pragma unroll
    for (int a = 0; a < 2; ++a)
#pragma unroll
        for (int b = 0; b < 2; ++b)
#pragma unroll
            for (int m = 0; m < 4; ++m)
#pragma unroll
                for (int n = 0; n < 2; ++n) acc[a][b][m][n] = (f32x4){0.f, 0.f, 0.f, 0.f};
    bf16x8 At[4][2], B0[2][2], B1[2][2];
    const char* cA = (const char*)g.A + (size_t)cur.pm * tstep; const char* cB = (const char*)g.Bt + (size_t)cur.pn * tstep;
    S.a_ready(cur);
    if constexpr (SP2) {
        PG8_STAGE(PG8_SB(0, 0), cB, voffB); PG8_STAGE(PG8_SB(0, 1), cB + hstep, voffB); PG8_STAGE(PG8_SA(0, 0), cA, voffA); PG8_STAGE(PG8_SA(0, 1), cA + hstep, voffA);
        if (wr == 1) PG8_BAR;
        PG8_WAIT_V(2); PG8_BAR;
        PG8_STAGE(PG8_SB(1, 0), cB + kstep, voffB); PG8_STAGE(PG8_SA(1, 0), cA + kstep, voffA); PG8_STAGE(PG8_SB(1, 1), cB + hstep + kstep, voffB);
        PG8_WAIT_V(6); PG8_BAR;
    } else {
        PG8_STAGE(PG8_SB(0, 0), cB, voffB); PG8_STAGE(PG8_SA(0, 0), cA, voffA); PG8_STAGE(PG8_SB(0, 1), cB + hstep, voffB); PG8_STAGE(PG8_SA(0, 1), cA + hstep, voffA);
        if (wr == 1) PG8_BAR;
        PG8_WAIT_V(4); PG8_BAR;
        PG8_STAGE(PG8_SB(1, 0), cB + kstep, voffB); PG8_STAGE(PG8_SA(1, 0), cA + kstep, voffA); PG8_STAGE(PG8_SB(1, 1), cB + hstep + kstep, voffB);
        PG8_WAIT_V(6); PG8_BAR;
    }
    for (;;) {
        const bool has_next = S.next(ui + 1, nxt);
        const char* nA = has_next ? (const char*)g.A + (size_t)nxt.pm * tstep : cA; const char* nB = has_next ? (const char*)g.Bt + (size_t)nxt.pn * tstep : cB;
        for (int t = 0; t < nt; t += 2) {
            const bool last = (t == nt - 2);
            const char* a1 = cA + (size_t)(t + 1) * kstep;
            const char* a2 = last ? nA : cA + (size_t)(t + 2) * kstep; const char* b2 = last ? nB : cB + (size_t)(t + 2) * kstep;
            const char* a3 = a2 + kstep; const char* b3 = b2 + kstep;
            if (last && has_next) S.a_ready(nxt);
            if constexpr (SP2) {
            PG8_LDB(B0, 0, 0); PG8_LDB(B1, 0, 1); PG8_SCHED; PG8_LDA(At, 0, 0); PG8_STAGE(PG8_SA(1, 1), a1 + hstep, voffA);
            PG8_WAIT_V(8); PG8_WAIT_L(0); PG8_BAR; PG8_MMA(0, 0, At, B0); PG8_MMA(0, 1, At, B1); PG8_BAR; PG8_SCHED;
            PG8_LDA(At, 0, 1); PG8_STAGE(PG8_SB(0, 0), b2, voffB); PG8_STAGE(PG8_SB(0, 1), b2 + hstep, voffB); PG8_STAGE(PG8_SA(0, 0), a2, voffA);
            PG8_WAIT_V(8); PG8_WAIT_L(0); PG8_BAR; PG8_MMA(1, 0, At, B0); PG8_MMA(1, 1, At, B1); PG8_BAR; PG8_SCHED;
            PG8_LDB(B0, 1, 0); PG8_LDB(B1, 1, 1); PG8_SCHED; PG8_LDA(At, 1, 0); PG8_STAGE(PG8_SA(0, 1), a2 + hstep, voffA);
            PG8_WAIT_V(8); PG8_WAIT_L(0); PG8_BAR; PG8_MMA(0, 0, At, B0); PG8_MMA(0, 1, At, B1); PG8_BAR; PG8_SCHED;
            PG8_LDA(At, 1, 1); PG8_STAGE(PG8_SB(1, 0), b3, voffB); PG8_STAGE(PG8_SB(1, 1), b3 + hstep, voffB); PG8_STAGE(PG8_SA(1, 0), a3, voffA);
            PG8_WAIT_V(8); PG8_WAIT_L(0); PG8_BAR; PG8_MMA(1, 0, At, B0); PG8_MMA(1, 1, At, B1); PG8_BAR; PG8_SCHED;
            } else {
            PG8_LDB(B0, 0, 0); PG8_SCHED; PG8_LDA(At, 0, 0); PG8_STAGE(PG8_SA(1, 1), a1 + hstep, voffA);
            PG8_WAIT_L(8); PG8_BAR; PG8_WAIT_L(0); PG8_MMA(0, 0, At, B0); PG8_BAR; PG8_SCHED;
            PG8_LDB(B1, 0, 1); PG8_STAGE(PG8_SB(0, 0), b2, voffB);
            PG8_BAR; PG8_WAIT_L(0); PG8_MMA(0, 1, At, B1); PG8_BAR;
            PG8_LDA(At, 0, 1); PG8_STAGE(PG8_SA(0, 0), a2, voffA);
            PG8_BAR; PG8_WAIT_L(0); PG8_MMA(1, 0, At, B0); PG8_BAR; PG8_SCHED;
            PG8_STAGE(PG8_SB(0, 1), b2 + hstep, voffB);
            PG8_WAIT_V(6); PG8_BAR; PG8_MMA(1, 1, At, B1); PG8_BAR;
            PG8_LDB(B0, 1, 0); PG8_SCHED; PG8_LDA(At, 1, 0); PG8_STAGE(PG8_SA(0, 1), a2 + hstep, voffA);
            PG8_WAIT_L(8); PG8_BAR; PG8_WAIT_L(0); PG8_MMA(0, 0, At, B0); PG8_BAR; PG8_SCHED;
            PG8_LDB(B1, 1, 1); PG8_STAGE(PG8_SB(1, 0), b3, voffB);
            PG8_BAR; PG8_WAIT_L(0); PG8_MMA(0, 1, At, B1); PG8_BAR;
            PG8_LDA(At, 1, 1); PG8_STAGE(PG8_SA(1, 0), a3, voffA);
            PG8_BAR; PG8_WAIT_L(0); PG8_MMA(1, 0, At, B0); PG8_BAR; PG8_SCHED;
            PG8_STAGE(PG8_SB(1, 1), b3 + hstep, voffB);
            PG8_WAIT_V(6); PG8_BAR; PG8_MMA(1, 1, At, B1); PG8_BAR;
            }
        }
        if constexpr (ALIGN_EPI) { if (wr == 0) PG8_BAR; }
        if constexpr (!Epi::AFTER_DRAIN) { E(acc, cur, wr, wc, fr, fq); S.done(cur); }
        if (!has_next) break;
#pragma unroll
        for (int a = 0; a < 2; ++a)
#pragma unroll
            for (int b = 0; b < 2; ++b)
#pragma unroll
                for (int m = 0; m < 4; ++m)
#pragma unroll
                    for (int n = 0; n < 2; ++n) acc[a][b][m][n] = (f32x4){0.f, 0.f, 0.f, 0.f};
        cur = nxt; cA = nA; cB = nB; ++ui;
        if constexpr (ALIGN_EPI) { if (wr == 1) PG8_BAR; }
    }
    PG8_WAIT_V(0);
    if constexpr (!ALIGN_EPI) { if (wr == 0) PG8_BAR; }
    PG8_BAR;
    if constexpr (Epi::AFTER_DRAIN) { E.fused(acc, cur, wr, wc, fr, fq, lds, wid, lane); S.done(cur); }
#undef PG8_SA
#undef PG8_SB
#undef PG8_STAGE
#undef PG8_LDA
#undef PG8_LDB
#undef PG8_MMA
#undef PG8_WAIT_V
#undef PG8_WAIT_L
#undef PG8_BAR
#undef PG8_SCHED
}
}

#ifndef PG8_SP2
#define PG8_SP2 true
#endif
#ifndef PG8_ALIGN
#define PG8_ALIGN true
#endif
namespace pg8 {
struct EpiRes {
    static constexpr bool PERM = false, AFTER_DRAIN = false;
    const float* src_ctx; const float* src_lat; float* X; const float* gate;
    __device__ __forceinline__ void operator()(const f32x4 (&acc)[2][2][4][2], const Unit& u, int wr, int wc, int fr, int fq) const {
        const int cond = u.pm < 32 ? 0 : 1 + ((u.pm - 32) >> 2);
        const float* g = gate + cond * 6144;
        const float* sb = u.pm < 32 ? src_ctx + (size_t)u.pm * BM * 1024 : src_lat + (size_t)(u.pm - 32) * BM * 1024;
        float* xb = X + (size_t)u.pm * BM * 1024;
        const int col0 = u.pn * BM + wc * 32 + 4 * fq;
        f32x4 gv[2][2];
#pragma unroll
        for (int bj = 0; bj < 2; ++bj)
#pragma unroll
            for (int n = 0; n < 2; ++n) gv[bj][n] = *(const f32x4*)(g + col0 + bj * HALF + n * 16);
#pragma unroll
        for (int ai = 0; ai < 2; ++ai)
#pragma unroll
            for (int m = 0; m < 4; ++m) { const size_t off = (size_t)(ai * HALF + wr * 64 + m * 16 + fr) * 1024 + col0;
#pragma unroll
                for (int bj = 0; bj < 2; ++bj)
#pragma unroll
                    for (int n = 0; n < 2; ++n) { const f32x4 xv = *(const f32x4*)(sb + off + bj * HALF + n * 16);
                        *(f32x4*)(xb + off + bj * HALF + n * 16) = xv + gv[bj][n] * acc[ai][bj][m][n]; } }
    }
};
struct EpiDnIn {
    static constexpr bool PERM = true, AFTER_DRAIN = false;
    bf16_t* O; float* AB;
    __device__ __forceinline__ void operator()(const f32x4 (&acc)[2][2][4][2], const Unit& u, int wr, int wc, int fr, int fq) const {
        const int row0 = u.pm * BM + wr * 64 + fr;
        if (u.pn < 16) {
            const int col0 = u.pn * BM + wc * 32 + 8 * fq;
#pragma unroll
            for (int ai = 0; ai < 2; ++ai)
#pragma unroll
                for (int m = 0; m < 4; ++m) { bf16_t* rowp = O + (size_t)(row0 + ai * HALF + m * 16) * 4096 + col0;
#pragma unroll
                    for (int bj = 0; bj < 2; ++bj) { const f32x4 v0 = acc[ai][bj][m][0], v1 = acc[ai][bj][m][1];
                        u32x4 w; w.x = cvt_pk_bf16(v0[0], v0[1]); w.y = cvt_pk_bf16(v0[2], v0[3]); w.z = cvt_pk_bf16(v1[0], v1[1]); w.w = cvt_pk_bf16(v1[2], v1[3]);
                        *(u32x4*)(rowp + bj * HALF) = w; } }
        } else if (wc == 0) {
#pragma unroll
            for (int ai = 0; ai < 2; ++ai)
#pragma unroll
                for (int m = 0; m < 4; ++m) { float* rp = AB + (size_t)(row0 + ai * HALF + m * 16) * 32 + 8 * fq;
                    *(f32x4*)rp = acc[ai][0][m][0]; *(f32x4*)(rp + 4) = acc[ai][0][m][1]; }
        }
    }
};
}
#define LAS __attribute__((address_space(3)))
constexpr int NWAVES = 8;
constexpr int LDS_BYTES = 147456;
constexpr size_t MiB = (size_t)1 << 20;
constexpr size_t WS_CTL = 0, CTL_ZERO_BYTES = 1 * MiB;
constexpr size_t WS_MODS = 1 * MiB, WS_ROPE = WS_MODS + MiB / 2;
constexpr size_t WS_WT_AIN = 2 * MiB, WS_WT_AOUT = 8 * MiB, WS_WT_DIN = 12 * MiB, WS_WT_DOUT = 29 * MiB, WS_WT_W1 = 33 * MiB, WS_WT_W2 = 65 * MiB;
constexpr size_t WS_X = 97 * MiB, WS_H = 137 * MiB, WS_Y = 157 * MiB, WS_PROJ = 177 * MiB, WS_AB = 257 * MiB, WS_G = 259 * MiB, WS_BETA = 260 * MiB;
constexpr size_t WS_QB = 261 * MiB, WS_KB = 281 * MiB, WS_VB = 287 * MiB, WS_CONV = 293 * MiB, WS_OF = 353 * MiB, WS_OB = 373 * MiB, WS_END = 393 * MiB;

struct Ctx {
    LAS unsigned char* lds;
    int tid, lane, wid, gw, ngw, nblk, blk;
};
struct ProPtrs { const float *c, *c_ctx, *w_mod, *b_mod, *attn_w_in, *attn_w_out, *dn_w_in, *dn_w_out, *mlp_w1, *mlp_w2; float *mods, *rope; bf16raw *wt_ain, *wt_aout, *wt_din, *wt_dout, *wt_w1, *wt_w2; };

#define LDS_WAIT() asm volatile("s_waitcnt lgkmcnt(0)" ::: "memory")

__device__ __forceinline__ void p0_transpose_item(const float* W, int K, int N, bf16raw* WT, LAS float* scr, int item, int lane) {
    const int nblk = N / 32, kb = item / nblk, nb = item % nblk, k0 = 64 * kb, n0 = 32 * nb;
#pragma unroll 8
    for (int i = 0; i < 32; ++i) { const int kk = 2 * i + (lane >> 5); scr[kk * 33 + (lane & 31)] = W[(size_t)(k0 + kk) * N + n0 + (lane & 31)]; }
    LDS_WAIT(); asm volatile("" ::: "memory");
    const int c = lane & 7;
#pragma unroll
    for (int j = 0; j < 4; ++j) { const int n = (lane >> 3) + 8 * j; const LAS float* s = scr + (8 * c) * 33 + n;
        u32x4_t o; o.x = pk2(s[0 * 33], s[1 * 33]); o.y = pk2(s[2 * 33], s[3 * 33]); o.z = pk2(s[4 * 33], s[5 * 33]); o.w = pk2(s[6 * 33], s[7 * 33]);
        *(u32x4_t*)(WT + (size_t)(n0 + n) * K + k0 + 8 * c) = o; }
    LDS_WAIT(); asm volatile("" ::: "memory");
}

__device__ __forceinline__ void phase_prologue(Ctx& C, const ProPtrs& P) {
    LAS float* sc = (LAS float*)C.lds;
    LAS float* red = (LAS float*)(C.lds + 12288);
    for (int k = C.tid; k < 1024; k += 512) { sc[k] = silu_f(P.c_ctx[k]); sc[1024 + k] = silu_f(P.c[k]); sc[2048 + k] = silu_f(P.c[1024 + k]); }
    __syncthreads();
    for (int u = C.blk; u < 4 * 96; u += C.nblk) {
        const int l = u / 96, n0 = (u % 96) * 64;
        const float* w = P.w_mod + ((size_t)l * 1024 + C.wid * 128) * 6144 + n0 + C.lane;
        float a0 = 0.f, a1 = 0.f, a2 = 0.f;
#pragma unroll 8
        for (int k = 0; k < 128; ++k) { const float wv = w[(size_t)k * 6144]; const int kk = C.wid * 128 + k; a0 += sc[kk] * wv; a1 += sc[1024 + kk] * wv; a2 += sc[2048 + kk] * wv; }
        red[(C.wid * 3 + 0) * 64 + C.lane] = a0; red[(C.wid * 3 + 1) * 64 + C.lane] = a1; red[(C.wid * 3 + 2) * 64 + C.lane] = a2;
        __syncthreads();
        if (C.tid < 192) { const int s = C.tid >> 6, ln = C.tid & 63; float t = 0.f;
#pragma unroll
            for (int w8 = 0; w8 < 8; ++w8) t += red[(w8 * 3 + s) * 64 + ln];
            P.mods[(size_t)(l * 3 + s) * 6144 + n0 + ln] = t + P.b_mod[l * 6144 + n0 + ln]; }
        __syncthreads();
    }
    __syncthreads();
    LAS float* scr = (LAS float*)(C.lds + C.wid * 16384);
    constexpr int I0 = 2 * 768, I1 = 2 * 512, I2 = 2 * 2064, I3 = 2 * 512, I4 = 4 * 2048, I5 = 4 * 2048;
    for (int it = C.gw; it < I0 + I1 + I2 + I3 + I4 + I5; it += C.ngw) {
        int r = it;
        if (r < I0) { const int j = r / 768; p0_transpose_item(P.attn_w_in + (size_t)j * 1024 * 1536, 1024, 1536, P.wt_ain + (size_t)j * 1536 * 1024, scr, r % 768, C.lane); continue; } r -= I0;
        if (r < I1) { const int j = r / 512; p0_transpose_item(P.attn_w_out + (size_t)j * 1024 * 1024, 1024, 1024, P.wt_aout + (size_t)j * 1024 * 1024, scr, r % 512, C.lane); continue; } r -= I1;
        if (r < I2) { const int j = r / 2064; p0_transpose_item(P.dn_w_in + (size_t)j * 1024 * DNIN, 1024, DNIN, P.wt_din + (size_t)j * DNINP * 1024, scr, r % 2064, C.lane); continue; } r -= I2;
        if (r < I3) { const int j = r / 512; p0_transpose_item(P.dn_w_out + (size_t)j * 1024 * 1024, 1024, 1024, P.wt_dout + (size_t)j * 1024 * 1024, scr, r % 512, C.lane); continue; } r -= I3;
        if (r < I4) { const int l = r / 2048; p0_transpose_item(P.mlp_w1 + (size_t)l * 1024 * 4096, 1024, 4096, P.wt_w1 + (size_t)l * 4096 * 1024, scr, r % 2048, C.lane); continue; } r -= I4;
        { const int l = r / 2048; p0_transpose_item(P.mlp_w2 + (size_t)l * 4096 * 1024, 4096, 1024, P.wt_w2 + (size_t)l * 1024 * 4096, scr, r % 2048, C.lane); }
    }
    const int gt = C.blk * 512 + C.tid, ngt = C.nblk * 512;
    for (int i = gt; i < 2 * 28672; i += ngt) { const int j = i / 28672, o = i % 28672;
        *(u32x4_t*)(P.wt_din + ((size_t)j * DNINP + DNIN) * 1024 + (size_t)o * 8) = (u32x4_t){0u, 0u, 0u, 0u}; }
    for (int i = gt; i < 1024 * 64; i += ngt) { const int t = i >> 6, a = (i >> 5) & 1, f = i & 31;
        const float inv = powf(10000.f, -(float)f / 32.f); const float ang = (float)(a ? (t & 63) : (t >> 6)) * inv;
        P.rope[2 * i] = cosf(ang); P.rope[2 * i + 1] = sinf(ang); }
}

__device__ __forceinline__ void phase_norm(Ctx& C, const float* src_ctx, const float* src_lat, const float* gain, const float* md0, bf16raw* H) {
    for (int row = C.gw; row < MTOK; row += C.ngw) {
        const float* xr = row < NCTX ? src_ctx + (size_t)row * D : src_lat + (size_t)(row - NCTX) * D;
        const float* md = md0 + cond_of(row) * 6144;
        f32x4_t v[4]; float ss = 0.f;
#pragma unroll
        for (int j = 0; j < 4; ++j) { v[j] = *(const f32x4_t*)(xr + 4 * C.lane + 256 * j); ss += (v[j].x * v[j].x + v[j].y * v[j].y) + (v[j].z * v[j].z + v[j].w * v[j].w); }
        const float rinv = rsqrtf(wave_sum(ss, C.lane) * (1.f / D) + EPS);
#pragma unroll
        for (int j = 0; j < 4; ++j) { const int c = 4 * C.lane + 256 * j;
            const f32x4_t g = *(const f32x4_t*)(gain + c), sh = *(const f32x4_t*)(md + c), sc = *(const f32x4_t*)(md + 1024 + c);
            const f32x4_t y = v[j] * rinv * g * (sc + 1.f) + sh;
            u32x2_t o; o.x = pk2(y.x, y.y); o.y = pk2(y.z, y.w);
            *(u32x2_t*)(H + (size_t)row * D + c) = o; }
    }
}
__device__ __forceinline__ void phase_final(Ctx& C, const float* X, const float* final_norm, float* out) {
    for (int row = C.gw; row < MTOK; row += C.ngw) {
        const float* xr = X + (size_t)row * D;
        f32x4_t v[4]; float ss = 0.f;
#pragma unroll
        for (int j = 0; j < 4; ++j) { v[j] = *(const f32x4_t*)(xr + 4 * C.lane + 256 * j); ss += (v[j].x * v[j].x + v[j].y * v[j].y) + (v[j].z * v[j].z + v[j].w * v[j].w); }
        const float rinv = rsqrtf(wave_sum(ss, C.lane) * (1.f / D) + EPS);
#pragma unroll
        for (int j = 0; j < 4; ++j) { const int c = 4 * C.lane + 256 * j; const f32x4_t g = *(const f32x4_t*)(final_norm + c);
            *(f32x4_t*)(out + O_Y + (size_t)row * D + c) = v[j] * rinv * g; }
    }
}

struct QknPtrs { const bf16raw* PROJ; bf16raw *QB, *KB, *VB; const float *qg, *kg, *rope, *cache_k, *cache_v; float* out; };
__device__ __forceinline__ void phase_qkn(Ctx& C, const QknPtrs& P, int j) {
    const unsigned* P32 = (const unsigned*)P.PROJ; unsigned* Q32 = (unsigned*)P.QB; unsigned* K32 = (unsigned*)P.KB; unsigned* V32 = (unsigned*)P.VB;
    const float* qg = P.qg; const float* kg = P.kg;
    const int lane = C.lane;
    const f32x2_t gq = *(const f32x2_t*)(qg + 2 * lane), gk = *(const f32x2_t*)(kg + 2 * lane);
    for (int row = C.gw; row < MTOK; row += C.ngw) {
        const bool lat = row >= NCTX;
        const int b = lat ? (row - NCTX) >> 10 : row >> 8, t = lat ? (row - NCTX) & 1023 : row & 255;
        const int krow = lat ? 8192 + b * 1280 + 256 + t : row;
        f32x4_t rp = (f32x4_t){1.f, 0.f, 1.f, 0.f};
        if (lat) rp = *(const f32x4_t*)(P.rope + ((size_t)t * 64 + (lane >> 5) * 32 + 2 * (lane & 15)) * 2);
        const bool ph = (lane >> 4) & 1;
#pragma unroll
        for (int slot = 0; slot < 12; ++slot) {
            const unsigned w = P32[(size_t)row * 768 + slot * 64 + lane];
            float v0 = bf_lo(w), v1 = bf_hi(w);
            if (slot < 10) {
                const float rinv = rsqrtf(wave_sum(v0 * v0 + v1 * v1, lane) * (1.f / 128.f) + EPS);
                const f32x2_t g = slot < 8 ? gq : gk;
                v0 = v0 * rinv * g.x; v1 = v1 * rinv * g.y;
                if (lat) { const float y0 = lane_xor_f(v0, lane, 16), y1 = lane_xor_f(v1, lane, 16);
                    v0 = v0 * rp.x + (ph ? y0 : -y0) * rp.y; v1 = v1 * rp.z + (ph ? y1 : -y1) * rp.w; }
            }
            const unsigned o = pk2(v0, v1);
            if (slot < 8) Q32[(size_t)row * 512 + slot * 64 + lane] = o;
            else if (slot < 10) K32[(size_t)krow * 128 + (slot - 8) * 64 + lane] = o;
            else V32[(size_t)krow * 128 + (slot - 10) * 64 + lane] = o;
            if (!lat && slot >= 8) { float* op = P.out + (slot < 10 ? O_CK : O_CV) + ((size_t)(b * 2 + j) * 256 + t) * 256 + (slot & 1) * 128 + 2 * lane;
                *(f32x2_t*)op = (f32x2_t){v0, v1}; }
        }
    }
    for (int it = C.gw; it < 2 * 256 * 2; it += C.ngw) {
        const int kv = it & 1, key = (it >> 1) & 255, b = it >> 9;
        const float* src = (kv ? P.cache_v : P.cache_k) + ((size_t)(b * 2 + j) * 256 + key) * 256 + 4 * lane;
        const f32x4_t v = *(const f32x4_t*)src;
        u32x2_t o; o.x = pk2(v.x, v.y); o.y = pk2(v.z, v.w);
        *(u32x2_t*)((kv ? P.VB : P.KB) + (size_t)(8192 + b * 1280 + key) * 256 + 4 * lane) = o;
    }
}

struct AttnPtrs { const bf16raw *QB, *KB, *VB; bf16raw* Y; };
template <int NI> __device__ __forceinline__ void attn_item(Ctx& C, const AttnPtrs& P, int row, int hq, int kbase, LAS float* qs, LAS float* ps) {
    const int lane = C.lane, kvh = hq >> 2;
    { const unsigned w = ((const unsigned*)P.QB)[(size_t)row * 512 + hq * 64 + lane]; qs[2 * lane] = bf_lo(w); qs[2 * lane + 1] = bf_hi(w); }
    LDS_WAIT();
    float sc[NI]; float mx = -1e30f;
#pragma unroll
    for (int i = 0; i < NI; ++i) {
        const u32x4_t* kp = (const u32x4_t*)(P.KB + (size_t)(kbase + lane + 64 * i) * 256 + kvh * 128);
        float s = 0.f;
#pragma unroll
        for (int d = 0; d < 16; ++d) { const u32x4_t kw = kp[d]; const f32x4_t qa = *(const LAS f32x4_t*)(qs + 8 * d), qb = *(const LAS f32x4_t*)(qs + 8 * d + 4);
            s += bf_lo(kw.x) * qa.x + bf_hi(kw.x) * qa.y + bf_lo(kw.y) * qa.z + bf_hi(kw.y) * qa.w + bf_lo(kw.z) * qb.x + bf_hi(kw.z) * qb.y + bf_lo(kw.w) * qb.z + bf_hi(kw.w) * qb.w; }
        sc[i] = s * ATT_SCALE; mx = fmaxf(mx, sc[i]);
    }
    mx = wave_max(mx, lane);
    float sm = 0.f;
#pragma unroll
    for (int i = 0; i < NI; ++i) { const float e = __expf(sc[i] - mx); sm += e; ps[lane + 64 * i] = e; }
    sm = wave_sum(sm, lane);
    LDS_WAIT();
    float a0 = 0.f, a1 = 0.f;
    const unsigned* vp = (const unsigned*)P.VB + (size_t)kbase * 128 + kvh * 64 + lane;
#pragma unroll 8
    for (int key = 0; key < NI * 64; ++key) { const float p = ps[key]; const unsigned w = vp[(size_t)key * 128]; a0 += p * bf_lo(w); a1 += p * bf_hi(w); }
    const float inv = 1.f / sm;
    ((unsigned*)P.Y)[(size_t)row * 512 + hq * 64 + lane] = pk2(a0 * inv, a1 * inv);
    LDS_WAIT();
}
__device__ __forceinline__ void phase_attn_ref(Ctx& C, const AttnPtrs& P) {
    LAS float* qs = (LAS float*)C.lds + C.wid * 1408; LAS float* ps = qs + 128;
    for (int it = C.gw; it < NCTX * 8; it += C.ngw) { const int row = it >> 3; attn_item<4>(C, P, row, it & 7, (row >> 8) * 256, qs, ps); }
    for (int it = C.gw; it < NLAT * 8; it += C.ngw) { const int r = it >> 3; attn_item<20>(C, P, NCTX + r, it & 7, 8192 + (r >> 10) * 1280, qs, ps); }
}

struct ConvPtrs { const bf16raw* PROJ; bf16raw* CONV; const float *cw, *alog, *dtb, *AB; float *G, *BETA; };
__device__ __forceinline__ void phase_conv_ref(Ctx& C, const ConvPtrs& P) {
    const unsigned* P32 = (const unsigned*)P.PROJ; unsigned* C32 = (unsigned*)P.CONV;
    const float* cw = P.cw;
    const int lane = C.lane;
    for (int it = C.gw; it < MTOK * 24; it += C.ngw) {
        const int row = it / 24, slot = it % 24;
        const int T = row < NCTX ? 256 : 1024, t = row < NCTX ? (row & 255) : ((row - NCTX) & 1023);
        float a0 = 0.f, a1 = 0.f;
#pragma unroll
        for (int i = 0; i < 5; ++i) { const int tt = t + i - 2;
            if (tt >= 0 && tt < T) { const unsigned w = P32[(size_t)(row + i - 2) * 2048 + slot * 64 + lane]; const f32x2_t cv = *(const f32x2_t*)(cw + i * 3072 + slot * 128 + 2 * lane);
                a0 += bf_lo(w) * cv.x; a1 += bf_hi(w) * cv.y; } }
        a0 = silu_f(a0); a1 = silu_f(a1);
        if (slot < 16) { const float rinv = rsqrtf(wave_sum(a0 * a0 + a1 * a1, lane) + EPS); a0 *= rinv; a1 *= rinv; }
        C32[(size_t)row * 1536 + slot * 64 + lane] = pk2(a0, a1);
    }
    const float* alog = P.alog; const float* dtb = P.dtb;
    for (int idx = C.blk * 512 + C.tid; idx < MTOK * 16; idx += C.nblk * 512) {
        const int row = idx >> 4, dh = idx & 15;
        const float a = P.AB[(size_t)row * 32 + dh], b = P.AB[(size_t)row * 32 + 16 + dh];
        const float x = a + dtb[dh]; const float sp = x > 20.f ? x : log1pf(expf(x));
        P.G[idx] = -expf(alog[dh]) * sp; P.BETA[idx] = 1.f / (1.f + expf(-b));
    }
}
struct ScanPtrs { const bf16raw* CONV; const float *G, *BETA, *state_delta; bf16raw *OF, *OB; float* out; };
__device__ __forceinline__ void phase_scan_ref(Ctx& C, const ScanPtrs& P, int j) {
    const int sc2 = C.tid >> 8, half = (C.tid >> 7) & 1, t1 = C.tid & 127;
    LAS float* ks = (LAS float*)C.lds + sc2 * 1024;
    LAS float* qs = ks + 256;
    LAS float* part = ks + 512;
    LAS float* parto = ks + 768;
    for (int u = C.blk; u < 272; u += C.nblk) {
        const bool lat = u < 16;
        const int s = lat ? 2 * u + sc2 : 2 * (u - 16) + sc2;
        const int seq = lat ? 32 + (s >> 4) : s >> 4, h = (s >> 1) & 7, dir = s & 1;
        const int T = lat ? 1024 : 256, base = lat ? NCTX + (seq - 32) * 1024 : seq * 256;
        float S[64];
        if (lat) { const float* sp = P.state_delta + ((((size_t)(seq - 32) * 2 + j) * 2 + dir) * 8 + h) * 16384 + (size_t)half * 64 * 128;
#pragma unroll
            for (int k = 0; k < 64; ++k) S[k] = sp[k * 128 + t1]; }
        else {
#pragma unroll
            for (int k = 0; k < 64; ++k) S[k] = 0.f; }
        bf16raw* Od = (dir ? P.OB : P.OF) + h * 128 + t1;
        const bf16raw* cqk = P.CONV + (half ? 0 : 1024) + h * 128 + t1;
        const bf16raw* cv = P.CONV + 2048 + h * 128 + t1;
        const float* gp = P.G + dir * 8 + h; const float* bp = P.BETA + dir * 8 + h;
        size_t row = (size_t)(base + (dir ? T - 1 : 0));
        float nqk = bf2f(cqk[row * 3072]), nv = bf2f(cv[row * 3072]), ng = gp[row * 16], nb = bp[row * 16];
        for (int p = 0; p < T; ++p) {
            const int bufi = p & 1; const size_t crow = row;
            (half ? qs : ks)[bufi * 128 + t1] = nqk;
            const float v = nv, eg = expf(ng), beta = nb;
            if (p + 1 < T) { row = (size_t)(base + (dir ? T - 2 - p : p + 1));
                nqk = bf2f(cqk[row * 3072]); nv = bf2f(cv[row * 3072]); ng = gp[row * 16]; nb = bp[row * 16]; }
            __syncthreads();
            const LAS float* kk = ks + bufi * 128 + half * 64; const LAS float* qq = qs + bufi * 128 + half * 64;
            float kS = 0.f;
#pragma unroll
            for (int k = 0; k < 64; ++k) kS += kk[k] * S[k];
            part[half * 128 + t1] = kS;
            __syncthreads();
            kS = part[t1] + part[128 + t1];
            const float vn = beta * (v - eg * kS);
            float o = 0.f;
#pragma unroll
            for (int k = 0; k < 64; ++k) { S[k] = eg * S[k] + kk[k] * vn; o += qq[k] * S[k]; }
            parto[half * 128 + t1] = o;
            __syncthreads();
            if (half == 0) Od[crow * D] = (bf16raw)f2bf((parto[t1] + parto[128 + t1]) * ATT_SCALE);
        }
        if (!lat) { float* sp = P.out + O_ST + ((((size_t)seq * 2 + j) * 2 + dir) * 8 + h) * 16384 + (size_t)half * 64 * 128;
#pragma unroll
            for (int k = 0; k < 64; ++k) sp[k * 128 + t1] = S[k]; }
        __syncthreads();
    }
}
struct GatePtrs { const bf16raw *OF, *OB, *PROJ; bf16raw* Y; const float* gain; };
__device__ __forceinline__ void phase_gate(Ctx& C, const GatePtrs& P) {
    const unsigned* F32 = (const unsigned*)P.OF; const unsigned* B32 = (const unsigned*)P.OB; const unsigned* P32 = (const unsigned*)P.PROJ; unsigned* Y32 = (unsigned*)P.Y;
    const int lane = C.lane;
    const f32x2_t g = *(const f32x2_t*)(P.gain + 2 * lane);
    for (int it = C.gw; it < MTOK * 8; it += C.ngw) {
        const int row = it >> 3, h = it & 7;
        const unsigned wf = F32[(size_t)row * 512 + h * 64 + lane], wb = B32[(size_t)row * 512 + h * 64 + lane], wz = P32[(size_t)row * 2048 + 1536 + h * 64 + lane];
        const float v0 = bf_lo(wf) + bf_lo(wb), v1 = bf_hi(wf) + bf_hi(wb);
        const float rinv = rsqrtf(wave_sum(v0 * v0 + v1 * v1, lane) * (1.f / 128.f) + EPS);
        Y32[(size_t)row * 512 + h * 64 + lane] = pk2(v0 * rinv * g.x * silu_f(bf_lo(wz)), v1 * rinv * g.y * silu_f(bf_hi(wz)));
    }
}
struct Args { const float* in[24]; float* out; unsigned char* ws; int ph_lo, ph_hi; };
enum { I_XP = 0, I_XS, I_CK, I_CV, I_SD, I_C, I_CCTX, I_WMOD, I_BMOD, I_N1, I_N2, I_AWIN, I_AQG, I_AKG, I_AWOUT, I_DWIN, I_DCONV, I_DALOG, I_DDTB, I_DNORM, I_DWOUT, I_W1, I_W2, I_FN };

__global__ void __launch_bounds__(NWAVES * 64, 2) mk_fwd(Args args) {
    extern __shared__ __attribute__((aligned(16))) unsigned char lds_raw[];
    cg::grid_group grid = cg::this_grid();

    const int lo = args.ph_lo, hi = args.ph_hi;
    int ph = 0;
#define PHASE_BEGIN() if (ph >= lo && ph < hi) { int z = 0; asm volatile("" : "+s"(z)); unsigned char* const ws = args.ws + z; (void)ws; \
    Ctx C; C.lds = (LAS unsigned char*)lds_raw + z; C.tid = threadIdx.x + z; C.lane = C.tid & 63; C.wid = __builtin_amdgcn_readfirstlane(C.tid >> 6); \
    C.nblk = gridDim.x + z; C.blk = blockIdx.x + z; C.gw = C.blk * NWAVES + C.wid; C.ngw = C.nblk * NWAVES;
#define PHASE_END() if (ph + 1 < hi) { grid.sync(); } } ++ph;
#define INP(i) (args.in[(i) + z])
#define WSF(off) ((float*)(ws + (off)))
#define WSB(off) ((bf16raw*)(ws + (off)))

    PHASE_BEGIN() {
        ProPtrs P{INP(I_C), INP(I_CCTX), INP(I_WMOD), INP(I_BMOD), INP(I_AWIN), INP(I_AWOUT), INP(I_DWIN), INP(I_DWOUT), INP(I_W1), INP(I_W2), WSF(WS_MODS), WSF(WS_ROPE),
                  WSB(WS_WT_AIN), WSB(WS_WT_AOUT), WSB(WS_WT_DIN), WSB(WS_WT_DOUT), WSB(WS_WT_W1), WSB(WS_WT_W2)};
        phase_prologue(C, P); } PHASE_END()
    for (int l = 0; l < 4; ++l) {
        const int j = l >> 1;
        PHASE_BEGIN() { const float* mods_l = WSF(WS_MODS) + (size_t)l * 3 * 6144;
            const float* xs_ctx = l == 0 ? INP(I_XP) : WSF(WS_X); const float* xs_lat = l == 0 ? INP(I_XS) : WSF(WS_X) + (size_t)NCTX * D;
            phase_norm(C, xs_ctx, xs_lat, INP(I_N1) + l * D, mods_l, WSB(WS_H)); } PHASE_END()
        if ((l & 1) == 0) {
            PHASE_BEGIN() { pg8::Gemm g{WSB(WS_H), WSB(WS_WT_AIN) + (size_t)j * QKVW * D, MTOK, QKVW, D, z}; pg8::StaticOrder S; S.init(MTOK, QKVW, C.nblk, C.blk);
                pg8::EpiBf16<0> E{WSB(WS_PROJ), QKVW, nullptr, 0, 0, 1.f};
                pg8::gemm_phase<pg8::EpiBf16<0>, pg8::StaticOrder, true, true>(C.lds, g, S, E); } PHASE_END()
            PHASE_BEGIN() { QknPtrs P{WSB(WS_PROJ), WSB(WS_QB), WSB(WS_KB), WSB(WS_VB), INP(I_AQG) + j * 128, INP(I_AKG) + j * 128, WSF(WS_ROPE), INP(I_CK), INP(I_CV), args.out + z};
                phase_qkn(C, P, j); } PHASE_END()
            PHASE_BEGIN() { AttnPtrs P{WSB(WS_QB), WSB(WS_KB), WSB(WS_VB), WSB(WS_Y)}; phase_attn_ref(C, P); } PHASE_END()
        } else {
            PHASE_BEGIN() { pg8::Gemm g{WSB(WS_H), WSB(WS_WT_DIN) + (size_t)j * DNINP * D, MTOK, DNINP, D, z}; pg8::StaticOrder S; S.init(MTOK, DNINP, C.nblk, C.blk);
                pg8::EpiDnIn E{WSB(WS_PROJ), WSF(WS_AB)};
                pg8::gemm_phase<pg8::EpiDnIn, pg8::StaticOrder, true, true>(C.lds, g, S, E); } PHASE_END()
            PHASE_BEGIN() { ConvPtrs P{WSB(WS_PROJ), WSB(WS_CONV), INP(I_DCONV) + (size_t)j * 5 * 3072, INP(I_DALOG) + j * 16, INP(I_DDTB) + j * 16, WSF(WS_AB), WSF(WS_G), WSF(WS_BETA)};
                phase_conv_ref(C, P); } PHASE_END()
            PHASE_BEGIN() { ScanPtrs P{WSB(WS_CONV), WSF(WS_G), WSF(WS_BETA), INP(I_SD), WSB(WS_OF), WSB(WS_OB), args.out + z}; phase_scan_ref(C, P, j); } PHASE_END()
            PHASE_BEGIN() { GatePtrs P{WSB(WS_OF), WSB(WS_OB), WSB(WS_PROJ), WSB(WS_Y), INP(I_DNORM) + j * 128}; phase_gate(C, P); } PHASE_END()
        }
        PHASE_BEGIN() { const float* mods_l = WSF(WS_MODS) + (size_t)l * 3 * 6144;
            const float* xs_ctx = l == 0 ? INP(I_XP) : WSF(WS_X); const float* xs_lat = l == 0 ? INP(I_XS) : WSF(WS_X) + (size_t)NCTX * D;
            pg8::Gemm g{WSB(WS_Y), ((l & 1) ? WSB(WS_WT_DOUT) : WSB(WS_WT_AOUT)) + (size_t)j * D * D, MTOK, D, D, z}; pg8::StaticOrder S; S.init(MTOK, D, C.nblk, C.blk);
            pg8::EpiRes E{xs_ctx, xs_lat, WSF(WS_X), mods_l + 2048};
            pg8::gemm_phase<pg8::EpiRes, pg8::StaticOrder, true, true>(C.lds, g, S, E); } PHASE_END()
        PHASE_BEGIN() { const float* mods_l = WSF(WS_MODS) + (size_t)l * 3 * 6144;
            phase_norm(C, WSF(WS_X), WSF(WS_X) + (size_t)NCTX * D, INP(I_N2) + l * D, mods_l + 3072, WSB(WS_H)); } PHASE_END()
        PHASE_BEGIN() { pg8::Gemm g{WSB(WS_H), WSB(WS_WT_W1) + (size_t)l * FF * D, MTOK, FF, D, z}; pg8::StaticOrder S; S.init(MTOK, FF, C.nblk, C.blk);
            pg8::EpiBf16<2> E{WSB(WS_PROJ), FF, nullptr, 0, 0, 1.f};
            pg8::gemm_phase<pg8::EpiBf16<2>, pg8::StaticOrder, true, true>(C.lds, g, S, E); } PHASE_END()
        PHASE_BEGIN() { const float* mods_l = WSF(WS_MODS) + (size_t)l * 3 * 6144;
            pg8::Gemm g{WSB(WS_PROJ), WSB(WS_WT_W2) + (size_t)l * D * FF, MTOK, D, FF, z}; pg8::StaticOrder S; S.init(MTOK, D, C.nblk, C.blk);
            pg8::EpiRes E{WSF(WS_X), WSF(WS_X) + (size_t)NCTX * D, WSF(WS_X), mods_l + 5120};
            pg8::gemm_phase<pg8::EpiRes, pg8::StaticOrder, true, true>(C.lds, g, S, E); } PHASE_END()
    }
    PHASE_BEGIN() { phase_final(C, WSF(WS_X), INP(I_FN), args.out + z); } PHASE_END()
#undef PHASE_BEGIN
#undef PHASE_END
}

extern "C" void kernel_launch(void* const* d_in, const int* in_sizes, int n_in, void* d_out, int out_size, void* d_ws, size_t ws_size, hipStream_t stream) {
    static int grid = 0;
    if (grid == 0) {
        if (n_in != 24 || ws_size < WS_END) { fprintf(stderr, "kernel_launch: unexpected n_in %d / ws %zu\n", n_in, ws_size); grid = -1; return; }
        int dev = 0, cus = 0, per_cu = 0;
        if (hipGetDevice(&dev) != hipSuccess || hipDeviceGetAttribute(&cus, hipDeviceAttributeMultiprocessorCount, dev) != hipSuccess) { grid = -1; return; }
        if (hipFuncSetAttribute((const void*)mk_fwd, hipFuncAttributeMaxDynamicSharedMemorySize, LDS_BYTES) != hipSuccess) { fprintf(stderr, "kernel_launch: hipFuncSetAttribute failed\n"); grid = -1; return; }
        if (hipOccupancyMaxActiveBlocksPerMultiprocessor(&per_cu, (const void*)mk_fwd, NWAVES * 64, LDS_BYTES) != hipSuccess || per_cu < 1) { fprintf(stderr, "kernel_launch: occupancy query failed (%d)\n", per_cu); (void)hipGetLastError(); grid = -1; return; }
        grid = cus * 1;
    }
    if (grid < 0) return;
    (void)hipMemsetAsync((char*)d_ws + WS_CTL, 0, CTL_ZERO_BYTES, stream);
    Args a; memset(&a, 0, sizeof(a));
    for (int i = 0; i < 24; ++i) a.in[i] = (const float*)d_in[i];
    a.out = (float*)d_out; a.ws = (unsigned char*)d_ws; a.ph_lo = 0; a.ph_hi = 1000;
    void* kargs[] = {&a};
    hipError_t e = hipLaunchCooperativeKernel((const void*)mk_fwd, dim3(grid), dim3(NWAVES * 64), kargs, LDS_BYTES, stream);
    if (e != hipSuccess) fprintf(stderr, "kernel_launch: cooperative launch failed: %s (grid %d)\n", hipGetErrorString(e), grid);
}
```

```cpp
#include <hip/hip_runtime.h>
#include <hip/hip_cooperative_groups.h>
#include <cstdio>
#include <cstdint>
#include <cstring>
namespace cg = cooperative_groups;

constexpr int D = 1024, NCTX = 8192, NLAT = 2048, MTOK = 10240, FF = 4096;
constexpr int QKVW = 1536, DNIN = 4128, DNINP = 4352, PROJW = 4096;
constexpr int KVROWS = 8192 + 2 * 1280;
constexpr float EPS = 1e-6f;
constexpr float ATT_SCALE = 0.08838834764831845f;
constexpr size_t O_Y = 0, O_CK = (size_t)MTOK * D, O_CV = O_CK + 4194304, O_ST = O_CV + 4194304;

typedef unsigned short bf16raw;
typedef float f32x4_t __attribute__((ext_vector_type(4)));
typedef float f32x2_t __attribute__((ext_vector_type(2)));
typedef unsigned u32x4_t __attribute__((ext_vector_type(4)));
typedef unsigned u32x2_t __attribute__((ext_vector_type(2)));

__device__ __forceinline__ unsigned f2bf(float f) { unsigned u = __builtin_bit_cast(unsigned, f); return (u + 0x7fffu + ((u >> 16) & 1u)) >> 16; }
__device__ __forceinline__ unsigned pk2(float lo, float hi) { return f2bf(lo) | (f2bf(hi) << 16); }
__device__ __forceinline__ float bf_lo(unsigned w) { return __builtin_bit_cast(float, w << 16); }
__device__ __forceinline__ float bf_hi(unsigned w) { return __builtin_bit_cast(float, w & 0xffff0000u); }
__device__ __forceinline__ float bf2f(bf16raw h) { return __builtin_bit_cast(float, (unsigned)h << 16); }
__device__ __forceinline__ float silu_f(float x) { return x / (1.f + __expf(-x)); }
__device__ __forceinline__ int cond_of(int row) { return row < NCTX ? 0 : 1 + ((row - NCTX) >> 10); }
__device__ __forceinline__ float lane_xor_f(float v, int lane, int k) { return __builtin_bit_cast(float, __builtin_amdgcn_ds_bpermute((lane ^ k) << 2, __builtin_bit_cast(int, v))); }
__device__ __forceinline__ float wave_sum(float v, int lane) {
#pragma unroll
    for (int o = 1; o < 64; o <<= 1) v += lane_xor_f(v, lane, o);
    return v;
}
__device__ __forceinline__ float wave_max(float v, int lane) {
#pragma unroll
    for (int o = 1; o < 64; o <<= 1) v = fmaxf(v, lane_xor_f(v, lane, o));
    return v;
}
namespace pg8 {
#define PG8_LAS __attribute__((address_space(3)))
typedef unsigned short bf16_t;
typedef short bf16x8 __attribute__((ext_vector_type(8)));
typedef float f32x4 __attribute__((ext_vector_type(4)));
typedef unsigned u32x4 __attribute__((ext_vector_type(4)));
constexpr int BM = 256, BK = 64, HALF = 128, HTB = HALF * BK * 2  , STAGE_BYTES = 8 * HTB, NXCD = 8, WGM = 8;

__host__ __device__ __forceinline__ int lds_byte(int r, int c) { const int st = (r >> 4) * 2 + (c >> 5), rr = r & 15, cc = c & 31, ob = rr * 64 + cc * 2; return st * 1024 + (ob ^ (((ob >> 9) & 1) << 5)); }
__host__ __device__ __forceinline__ void stage_rc(int b, int& R, int& C) { const int st = b / 1024, sb = b % 1024, swz = sb ^ (((sb >> 9) & 1) << 5); R = (st >> 1) * 16 + swz / 64; C = (st & 1) * 32 + (swz % 64) / 2; }
__host__ __device__ __forceinline__ int perm32(int rho) { const int n = rho >> 4, i = rho & 15; return 8 * (i >> 2) + 4 * n + (i & 3); }

struct Unit { int pm, pn; };
struct Gemm { const bf16_t* A; const bf16_t* Bt; int M, N, K; int z; };

struct StaticOrder {
    int nM, nN, nwg, G, c;
    __host__ __device__ void init(int M, int N, int G_, int c_) { nM = M / BM; nN = N / BM; nwg = nM * nN; G = G_; c = c_; }
    __host__ __device__ bool next(int i, Unit& u) const {
        const long L = (long)i * G + c; if (L >= nwg) return false;
        int wgid = (int)L; { const int q = nwg / NXCD, r = nwg % NXCD, xcd = wgid % NXCD, off = wgid / NXCD; wgid = (xcd < r ? xcd * (q + 1) : r * (q + 1) + (xcd - r) * q) + off; }
        const int nig = WGM * nN, gid = wgid / nig, fm = gid * WGM, gsz = (nM - fm) < WGM ? (nM - fm) : WGM;
        u.pm = fm + ((wgid % nig) % gsz); u.pn = (wgid % nig) / gsz; return true;
    }
    __device__ __forceinline__ void a_ready(const Unit&) const {}
    __device__ __forceinline__ void done(const Unit&) const {}
};

__device__ __forceinline__ unsigned cvt_pk_bf16(float lo, float hi) { unsigned r; asm volatile("v_cvt_pk_bf16_f32 %0, %1, %2" : "=v"(r) : "v"(lo), "v"(hi)); return r; }
typedef float f32x2 __attribute__((ext_vector_type(2)));
__device__ __forceinline__ f32x2 gelu_pk(f32x2 v) {
    const f32x2 av = __builtin_elementwise_abs(v), d = av * 0.2316418882f + 1.0f;
    f32x2 t; t.x = __builtin_amdgcn_rcpf(d.x); t.y = __builtin_amdgcn_rcpf(d.y);
    f32x2 q = t * 0.5307027145f + (-0.7265760135f); q = q * t + 0.7107068705f; q = q * t + (-0.142248368f); q = q * t + 0.127414796f; q = q * t;
    const f32x2 s = (v * v) * (-0.72134752044f);
    f32x2 e; e.x = __builtin_amdgcn_exp2f(s.x); e.y = __builtin_amdgcn_exp2f(s.y);
    const f32x2 m = v * (q * e), r = v - m;
    f32x2 o; o.x = v.x < 0.f ? m.x : r.x; o.y = v.y < 0.f ? m.y : r.y; return o;
}

template <int ACT  > struct EpiBf16 {
    static constexpr bool PERM = true, AFTER_DRAIN = false; static_assert(ACT >= 0 && ACT <= 2, "EpiBf16: ACT is 0 (none), 1 (gelu_pk) or 2 (squared relu)");
    bf16_t* O; int ldc; const float* bias; int split_cols; size_t split_stride; float scale0;
    __device__ __forceinline__ void operator()(const f32x4 (&acc)[2][2][4][2], const Unit& u, int wr, int wc, int fr, int fq) const {
        const int row0 = u.pm * BM + wr * 64 + fr; int colt = u.pn * BM; bf16_t* base = O;
        float sc = 1.f; if (split_cols) { const int t = colt / split_cols; base += (size_t)t * split_stride; colt -= t * split_cols; if (t == 0) sc = scale0; }
        const int col0 = colt + wc * 32 + 8 * fq, bcol0 = u.pn * BM + wc * 32 + 8 * fq;
        f32x4 bv[2][2];
#pragma unroll
        for (int bj = 0; bj < 2; ++bj)
#pragma unroll
            for (int n = 0; n < 2; ++n) bv[bj][n] = bias ? *(const f32x4*)(bias + bcol0 + bj * HALF + 4 * n) : (f32x4){0.f, 0.f, 0.f, 0.f};
#pragma unroll
        for (int ai = 0; ai < 2; ++ai)
#pragma unroll
            for (int m = 0; m < 4; ++m) { bf16_t* rowp = base + (size_t)(row0 + ai * HALF + m * 16) * ldc + col0;
#pragma unroll
                for (int bj = 0; bj < 2; ++bj) { f32x4 v0 = acc[ai][bj][m][0] + bv[bj][0], v1 = acc[ai][bj][m][1] + bv[bj][1];
                    if (ACT == 1) { f32x2 a = gelu_pk((f32x2){v0[0], v0[1]}), b = gelu_pk((f32x2){v0[2], v0[3]}), c = gelu_pk((f32x2){v1[0], v1[1]}), d = gelu_pk((f32x2){v1[2], v1[3]});
                        v0 = (f32x4){a.x, a.y, b.x, b.y}; v1 = (f32x4){c.x, c.y, d.x, d.y}; }
                    if (ACT == 2) { v0 = __builtin_elementwise_max(v0, (f32x4){0.f, 0.f, 0.f, 0.f}); v1 = __builtin_elementwise_max(v1, (f32x4){0.f, 0.f, 0.f, 0.f}); v0 = v0 * v0; v1 = v1 * v1; }
                    v0 = v0 * sc; v1 = v1 * sc; u32x4 w; w.x = cvt_pk_bf16(v0[0], v0[1]); w.y = cvt_pk_bf16(v0[2], v0[3]); w.z = cvt_pk_bf16(v1[0], v1[1]); w.w = cvt_pk_bf16(v1[2], v1[3]);
                    *(u32x4*)(rowp + bj * HALF) = w; } }
    }
};

struct PanelStats {
    unsigned* xbuf;
    unsigned* cnt;
    unsigned* tmo;
    int ntn; float eps;
    unsigned code;
    __device__ __forceinline__ bool run(const f32x4 (&v)[2][2][4][2], const Unit& u, int wr, int wc, int fr, int fq, PG8_LAS unsigned char* lds, int wid, int lane) const {
        typedef float f32x2v __attribute__((ext_vector_type(2)));
        PG8_LAS f32x2v* P = (PG8_LAS f32x2v*)lds;
        PG8_LAS f32x2v* S = (PG8_LAS f32x2v*)(lds + 8192);
        PG8_LAS unsigned* flag = (PG8_LAS unsigned*)(lds + 8192 + 2048);
#pragma unroll
        for (int ai = 0; ai < 2; ++ai)
#pragma unroll
            for (int m = 0; m < 4; ++m) {
                float s = 0.f;
#pragma unroll
                for (int bj = 0; bj < 2; ++bj)
#pragma unroll
                    for (int n = 0; n < 2; ++n) { const f32x4 x = v[ai][bj][m][n]; s += (x[0] + x[1]) + (x[2] + x[3]); }
                s += __shfl_xor(s, 16); s += __shfl_xor(s, 32);
                const float mw = s * (1.0f / 64.0f); float q = 0.f;
#pragma unroll
                for (int bj = 0; bj < 2; ++bj)
#pragma unroll
                    for (int n = 0; n < 2; ++n) { const f32x4 d = v[ai][bj][m][n] - mw; q += (d[0] * d[0] + d[1] * d[1]) + (d[2] * d[2] + d[3] * d[3]); }
                q += __shfl_xor(q, 16); q += __shfl_xor(q, 32);
                if (fq == 0) P[(ai * HALF + wr * 64 + m * 16 + fr) * 4 + wc] = (f32x2v){mw, q};
            }
        asm volatile("s_waitcnt lgkmcnt(0)" ::: "memory"); __builtin_amdgcn_s_barrier(); asm volatile("" ::: "memory");
#if defined(BROKEN_EXCHANGE_NO_WAIT)
#warning BROKEN CONTROL BUILD: the row-statistics exchange does not wait; results are wrong by design
        if (blockIdx.x >= 64) { const long long t0_ = clock64(); while (clock64() - t0_ < 60000) __builtin_amdgcn_s_sleep(8); }
#endif
        const int row = wid * 32 + (lane & 31);
        if (lane < 32) {
            const f32x2v a = P[row * 4 + 0], b = P[row * 4 + 1], c = P[row * 4 + 2], d = P[row * 4 + 3];
            const float mt = (a.x + b.x + c.x + d.x) * 0.25f;
            const float da = a.x - mt, db = b.x - mt, dc = c.x - mt, dd = d.x - mt;
            const float m2 = (a.y + b.y) + (c.y + d.y) + 64.0f * ((da * da + db * db) + (dc * dc + dd * dd));
            unsigned long long* slot = (unsigned long long*)xbuf + ((size_t)(u.pm * BM + row) * 4 + u.pn);
            __hip_atomic_store(slot, ((unsigned long long)__float_as_uint(m2) << 32) | __float_as_uint(mt), __ATOMIC_RELAXED, __HIP_MEMORY_SCOPE_AGENT);
        }
        asm volatile("s_waitcnt vmcnt(0)" ::: "memory");
        if (lane == 0) __hip_atomic_fetch_add(cnt + 64 * u.pm, 1u, __ATOMIC_RELAXED, __HIP_MEMORY_SCOPE_AGENT);
        if (wid == 0) {
            bool dead = false; const unsigned long long t0 = __builtin_amdgcn_s_memrealtime(); const unsigned want = 8u * (unsigned)ntn;
            for (;;) {
#if defined(BROKEN_EXCHANGE_NO_WAIT)
                break;
#endif
                if ((unsigned)__builtin_amdgcn_readfirstlane(__hip_atomic_load(cnt + 64 * u.pm, __ATOMIC_RELAXED, __HIP_MEMORY_SCOPE_AGENT)) >= want) break;
                if (__builtin_amdgcn_s_memrealtime() - t0 > 2000000ull) {
                    if (lane == 0) { unsigned expect = 0u; __hip_atomic_compare_exchange_strong(tmo + 1, &expect, code | (unsigned)(u.pm & 0xff), __ATOMIC_RELAXED, __ATOMIC_RELAXED, __HIP_MEMORY_SCOPE_AGENT);
                                     __hip_atomic_store(tmo, 1u, __ATOMIC_RELAXED, __HIP_MEMORY_SCOPE_AGENT); }
                    dead = true; break; }
                __builtin_amdgcn_s_sleep(2);
            }
            __builtin_amdgcn_fence(__ATOMIC_ACQUIRE, "agent");
            if (lane == 0) flag[0] = dead ? 1u : 0u;
        }
        asm volatile("s_waitcnt vmcnt(0) lgkmcnt(0)" ::: "memory"); __builtin_amdgcn_s_barrier(); asm volatile("" ::: "memory");
        const bool bad = flag[0] != 0u;
        if (lane < 32) {
            const unsigned long long* slot = (const unsigned long long*)xbuf + (size_t)(u.pm * BM + row) * 4; float mt[4], m2[4]; float ms = 0.f;
#pragma unroll
            for (int t = 0; t < 4; ++t) { if (t < ntn) { const unsigned long long w = __hip_atomic_load(slot + t, __ATOMIC_RELAXED, __HIP_MEMORY_SCOPE_AGENT); mt[t] = __uint_as_float((unsigned)w); m2[t] = __uint_as_float((unsigned)(w >> 32)); } else { mt[t] = 0.f; m2[t] = 0.f; } ms += mt[t]; }
            const float mean = ms / (float)ntn; float q = 0.f;
#pragma unroll
            for (int t = 0; t < 4; ++t) if (t < ntn) { const float dm = mt[t] - mean; q += m2[t] + 256.0f * dm * dm; }
            S[row] = (f32x2v){mean, 1.0f / sqrtf(q / (256.0f * (float)ntn) + eps)};
        }
        asm volatile("s_waitcnt lgkmcnt(0)" ::: "memory"); __builtin_amdgcn_s_barrier(); asm volatile("" ::: "memory");
        return bad;
    }
};
struct EpiLnRes {
    static constexpr bool PERM = false, AFTER_DRAIN = true;
    const float* base; float* out; int ldc; const float* bias; PanelStats st; unsigned poison;
    __device__ __forceinline__ void fused(f32x4 (&acc)[2][2][4][2], const Unit& u, int wr, int wc, int fr, int fq, PG8_LAS unsigned char* lds, int wid, int lane) const {
        typedef float f32x2v __attribute__((ext_vector_type(2)));
        const PG8_LAS f32x2v* S = (const PG8_LAS f32x2v*)(lds + 8192);
        const int col0 = u.pn * BM + wc * 32 + 4 * fq;
#pragma unroll
        for (int bj = 0; bj < 2; ++bj)
#pragma unroll
            for (int n = 0; n < 2; ++n) { const f32x4 bv = bias ? *(const f32x4*)(bias + col0 + bj * HALF + n * 16) : (f32x4){0.f, 0.f, 0.f, 0.f};
#pragma unroll
                for (int ai = 0; ai < 2; ++ai)
#pragma unroll
                    for (int m = 0; m < 4; ++m) acc[ai][bj][m][n] += bv; }
        f32x4 pre[4][2][2];
#pragma unroll
        for (int m = 0; m < 4; ++m) { const size_t off = (size_t)(u.pm * BM + wr * 64 + m * 16 + fr) * ldc + col0;
#pragma unroll
            for (int bj = 0; bj < 2; ++bj)
#pragma unroll
                for (int n = 0; n < 2; ++n) pre[m][bj][n] = *(const f32x4*)(base + off + bj * HALF + n * 16); }
        const bool bad = st.run(acc, u, wr, wc, fr, fq, lds, wid, lane) || poison != 0u;
        const float qnan = __builtin_nanf("");
#pragma unroll
        for (int ai = 0; ai < 2; ++ai)
#pragma unroll
            for (int m = 0; m < 4; ++m) { const int r = ai * HALF + wr * 64 + m * 16 + fr; const f32x2v sr = S[r]; const size_t off = (size_t)(u.pm * BM + r) * ldc + col0;
#pragma unroll
                for (int bj = 0; bj < 2; ++bj)
#pragma unroll
                    for (int n = 0; n < 2; ++n) { const f32x4 bs = ai == 0 ? pre[m][bj][n] : *(const f32x4*)(base + off + bj * HALF + n * 16); f32x4 o = bs + (acc[ai][bj][m][n] - sr.x) * sr.y;
                        if (bad) o = (f32x4){qnan, qnan, qnan, qnan}; *(f32x4*)(out + off + bj * HALF + n * 16) = o; }
                if (m & 1) asm volatile("" ::: "memory"); }
    }
};
struct EpiLnResLn {
    static constexpr bool PERM = false, AFTER_DRAIN = true;
    const float* base; float* out; bf16_t* xn; int ldc; const float* bias; PanelStats st1, st2; unsigned poison;
    __device__ __forceinline__ void fused(f32x4 (&acc)[2][2][4][2], const Unit& u, int wr, int wc, int fr, int fq, PG8_LAS unsigned char* lds, int wid, int lane) const {
        typedef float f32x2v __attribute__((ext_vector_type(2))); typedef unsigned u32x2v __attribute__((ext_vector_type(2)));
        const PG8_LAS f32x2v* S = (const PG8_LAS f32x2v*)(lds + 8192);
        const int col0 = u.pn * BM + wc * 32 + 4 * fq;
#pragma unroll
        for (int bj = 0; bj < 2; ++bj)
#pragma unroll
            for (int n = 0; n < 2; ++n) { const f32x4 bv = bias ? *(const f32x4*)(bias + col0 + bj * HALF + n * 16) : (f32x4){0.f, 0.f, 0.f, 0.f};
#pragma unroll
                for (int ai = 0; ai < 2; ++ai)
#pragma unroll
                    for (int m = 0; m < 4; ++m) acc[ai][bj][m][n] += bv; }
        bool bad = st1.run(acc, u, wr, wc, fr, fq, lds, wid, lane) || poison != 0u;
        const float qnan = __builtin_nanf("");
#pragma unroll
        for (int ai = 0; ai < 2; ++ai)
#pragma unroll
            for (int m = 0; m < 4; ++m) { const int r = ai * HALF + wr * 64 + m * 16 + fr; const f32x2v sr = S[r]; const size_t off = (size_t)(u.pm * BM + r) * ldc + col0;
#pragma unroll
                for (int bj = 0; bj < 2; ++bj)
#pragma unroll
                    for (int n = 0; n < 2; ++n) { const f32x4 bs = *(const f32x4*)(base + off + bj * HALF + n * 16); acc[ai][bj][m][n] = bs + (acc[ai][bj][m][n] - sr.x) * sr.y; }
                asm volatile("" : "+v"(acc[ai][0][m][0]), "+v"(acc[ai][0][m][1]), "+v"(acc[ai][1][m][0]), "+v"(acc[ai][1][m][1]));
                if (m & 1) asm volatile("" ::: "memory"); }
        const bool bad1 = bad;
        bad = st2.run(acc, u, wr, wc, fr, fq, lds, wid, lane) || bad;
#pragma unroll
        for (int ai = 0; ai < 2; ++ai)
#pragma unroll
            for (int m = 0; m < 4; ++m) { const int r = ai * HALF + wr * 64 + m * 16 + fr; const f32x2v sr = S[r]; const size_t off = (size_t)(u.pm * BM + r) * ldc + col0;
#pragma unroll
                for (int bj = 0; bj < 2; ++bj)
#pragma unroll
                    for (int n = 0; n < 2; ++n) { const f32x4 x1 = acc[ai][bj][m][n]; *(f32x4*)(out + off + bj * HALF + n * 16) = bad1 ? (f32x4){qnan, qnan, qnan, qnan} : x1;
                        const f32x4 o = (x1 - sr.x) * sr.y; u32x2v w; w.x = cvt_pk_bf16(o[0], o[1]); w.y = cvt_pk_bf16(o[2], o[3]);
                        if (bad) { w.x = 0x7fc07fc0u; w.y = 0x7fc07fc0u; } *(u32x2v*)(xn + off + bj * HALF + n * 16) = w; }
                asm volatile("" ::: "memory"); }
    }
};

template <class Epi, class Sched, bool ALIGN_EPI = false, bool SP2 = false>
__device__ __forceinline__ void gemm_phase(PG8_LAS unsigned char* lds, const Gemm g, const Sched& S, const Epi& E) {
    const int tid = threadIdx.x + g.z, wid = __builtin_amdgcn_readfirstlane(tid >> 6), lane = tid & 63, wr = wid >> 2, wc = wid & 3, fr = lane & 15, fq = lane >> 4;
    const int K = g.K, nt = K / BK;
    unsigned voffA[2], voffB[2];
#pragma unroll
    for (int i = 0; i < 2; ++i) { int R, C; stage_rc(tid * 16 + i * 8192, R, C); const int Rb = Epi::PERM ? ((R & ~31) + perm32(R & 31)) : R;
        voffA[i] = (unsigned)(R * K + C) * 2u; voffB[i] = (unsigned)(Rb * K + C) * 2u; }
    const size_t kstep = (size_t)(BK * 2);
    const size_t hstep = (size_t)HALF * K * 2;
    const size_t tstep = 2 * hstep;
    const unsigned ldsw = (unsigned)wid * 1024u;
    const int aoff = lds_byte(wr * 64 + fr, fq * 8), boff = lds_byte(wc * 32 + fr, fq * 8);
#define PG8_SA(b, h) (((b) * 2 + (h)) * HTB)
#define PG8_SB(b, h) ((4 + (b) * 2 + (h)) * HTB)
#define PG8_STAGE(bufoff, gbase, voff) do { _Pragma("unroll") for (int _i = 0; _i < 2; ++_i) \
        __builtin_amdgcn_global_load_lds((const unsigned*)((const char*)(gbase) + (voff)[_i]), (PG8_LAS unsigned*)(lds + (bufoff) + ldsw + _i * 8192), 16, 0, 0); } while (0)
#define PG8_LDA(dst, b, h) do { _Pragma("unroll") for (int m = 0; m < 4; ++m) _Pragma("unroll") for (int k = 0; k < 2; ++k) dst[m][k] = *(const PG8_LAS bf16x8*)(lds + PG8_SA(b, h) + aoff + m * 2048 + k * 1024); } while (0)
#define PG8_LDB(dst, b, h) do { _Pragma("unroll") for (int n = 0; n < 2; ++n) _Pragma("unroll") for (int k = 0; k < 2; ++k) dst[n][k] = *(const PG8_LAS bf16x8*)(lds + PG8_SB(b, h) + boff + n * 2048 + k * 1024); } while (0)
#define PG8_MMA(ai, bj, At, Bt) do { __builtin_amdgcn_s_setprio(1); _Pragma("unroll") for (int m = 0; m < 4; ++m) _Pragma("unroll") for (int n = 0; n < 2; ++n) _Pragma("unroll") for (int k = 0; k < 2; ++k) \
        acc[ai][bj][m][n] = __builtin_amdgcn_mfma_f32_16x16x32_bf16(Bt[n][k], At[m][k], acc[ai][bj][m][n], 0, 0, 0); __builtin_amdgcn_s_setprio(0); } while (0)
#define PG8_WAIT_V(n) asm volatile("s_waitcnt vmcnt(" #n ")" ::: "memory")
#define PG8_WAIT_L(n) asm volatile("s_waitcnt lgkmcnt(" #n ")" ::: "memory")
#define PG8_BAR __builtin_amdgcn_s_barrier()
#define PG8_SCHED __builtin_amdgcn_sched_barrier(0)
    Unit cur, nxt; int ui = 0;
    if (!S.next(0, cur)) return;
    f32x4 acc[2][2][4][2];
#pragma unroll
    for (int a = 0; a < 2; ++a)
#pragma unroll
        for (int b = 0; b < 2; ++b)
#pragma unroll
            for (int m = 0; m < 4; ++m)
#pragma unroll
                for (int n = 0; n < 2; ++n) acc[a][b][m][n] = (f32x4){0.f, 0.f, 0.f, 0.f};
    bf16x8 At[4][2], B0[2][2], B1[2][2];
    const char* cA = (const char*)g.A + (size_t)cur.pm * tstep; const char* cB = (const char*)g.Bt + (size_t)cur.pn * tstep;
    S.a_ready(cur);
    if constexpr (SP2) {
        PG8_STAGE(PG8_SB(0, 0), cB, voffB); PG8_STAGE(PG8_SB(0, 1), cB + hstep, voffB); PG8_STAGE(PG8_SA(0, 0), cA, voffA); PG8_STAGE(PG8_SA(0, 1), cA + hstep, voffA);
        if (wr == 1) PG8_BAR;
        PG8_WAIT_V(2); PG8_BAR;
        PG8_STAGE(PG8_SB(1, 0), cB + kstep, voffB); PG8_STAGE(PG8_SA(1, 0), cA + kstep, voffA); PG8_STAGE(PG8_SB(1, 1), cB + hstep + kstep, voffB);
        PG8_WAIT_V(6); PG8_BAR;
    } else {
        PG8_STAGE(PG8_SB(0, 0), cB, voffB); PG8_STAGE(PG8_SA(0, 0), cA, voffA); PG8_STAGE(PG8_SB(0, 1), cB + hstep, voffB); PG8_STAGE(PG8_SA(0, 1), cA + hstep, voffA);
        if (wr == 1) PG8_BAR;
        PG8_WAIT_V(4); PG8_BAR;
        PG8_STAGE(PG8_SB(1, 0), cB + kstep, voffB); PG8_STAGE(PG8_SA(1, 0), cA + kstep, voffA); PG8_STAGE(PG8_SB(1, 1), cB + hstep + kstep, voffB);
        PG8_WAIT_V(6); PG8_BAR;
    }
    for (;;) {
        const bool has_next = S.next(ui + 1, nxt);
        const char* nA = has_next ? (const char*)g.A + (size_t)nxt.pm * tstep : cA; const char* nB = has_next ? (const char*)g.Bt + (size_t)nxt.pn * tstep : cB;
        for (int t = 0; t < nt; t += 2) {
            const bool last = (t == nt - 2);
            const char* a1 = cA + (size_t)(t + 1) * kstep;
            const char* a2 = last ? nA : cA + (size_t)(t + 2) * kstep; const char* b2 = last ? nB : cB + (size_t)(t + 2) * kstep;
            const char* a3 = a2 + kstep; const char* b3 = b2 + kstep;
            if (last && has_next) S.a_ready(nxt);
            if constexpr (SP2) {
            PG8_LDB(B0, 0, 0); PG8_LDB(B1, 0, 1); PG8_SCHED; PG8_LDA(At, 0, 0); PG8_STAGE(PG8_SA(1, 1), a1 + hstep, voffA);
            PG8_WAIT_V(8); PG8_WAIT_L(0); PG8_BAR; PG8_MMA(0, 0, At, B0); PG8_MMA(0, 1, At, B1); PG8_BAR; PG8_SCHED;
            PG8_LDA(At, 0, 1); PG8_STAGE(PG8_SB(0, 0), b2, voffB); PG8_STAGE(PG8_SB(0, 1), b2 + hstep, voffB); PG8_STAGE(PG8_SA(0, 0), a2, voffA);
            PG8_WAIT_V(8); PG8_WAIT_L(0); PG8_BAR; PG8_MMA(1, 0, At, B0); PG8_MMA(1, 1, At, B1); PG8_BAR; PG8_SCHED;
            PG8_LDB(B0, 1, 0); PG8_LDB(B1, 1, 1); PG8_SCHED; PG8_LDA(At, 1, 0); PG8_STAGE(PG8_SA(0, 1), a2 + hstep, voffA);
            PG8_WAIT_V(8); PG8_WAIT_L(0); PG8_BAR; PG8_MMA(0, 0, At, B0); PG8_MMA(0, 1, At, B1); PG8_BAR; PG8_SCHED;
            PG8_LDA(At, 1, 1); PG8_STAGE(PG8_SB(1, 0), b3, voffB); PG8_STAGE(PG8_SB(1, 1), b3 + hstep, voffB); PG8_STAGE(PG8_SA(1, 0), a3, voffA);
            PG8_WAIT_V(8); PG8_WAIT_L(0); PG8_BAR; PG8_MMA(1, 0, At, B0); PG8_MMA(1, 1, At, B1); PG8_BAR; PG8_SCHED;
            } else {
            PG8_LDB(B0, 0, 0); PG8_SCHED; PG8_LDA(At, 0, 0); PG8_STAGE(PG8_SA(1, 1), a1 + hstep, voffA);
            PG8_WAIT_L(8); PG8_BAR; PG8_WAIT_L(0); PG8_MMA(0, 0, At, B0); PG8_BAR; PG8_SCHED;
            PG8_LDB(B1, 0, 1); PG8_STAGE(PG8_SB(0, 0), b2, voffB);
            PG8_BAR; PG8_WAIT_L(0); PG8_MMA(0, 1, At, B1); PG8_BAR;
            PG8_LDA(At, 0, 1); PG8_STAGE(PG8_SA(0, 0), a2, voffA);
            PG8_BAR; PG8_WAIT_L(0); PG8_MMA(1, 0, At, B0); PG8_BAR; PG8_SCHED;
            PG8_STAGE(PG8_SB(0, 1), b2 + hstep, voffB);
            PG8_WAIT_V(6); PG8_BAR; PG8_MMA(1, 1, At, B1); PG8_BAR;
            PG8_LDB(B0, 1, 0); PG8_SCHED; PG8_LDA(At, 1, 0); PG8_STAGE(PG8_SA(0, 1), a2 + hstep, voffA);
            PG8_WAIT_L(8); PG8_BAR; PG8_WAIT_L(0); PG8_MMA(0, 0, At, B0); PG8_BAR; PG8_SCHED;
            PG8_LDB(B1, 1, 1); PG8_STAGE(PG8_SB(1, 0), b3, voffB);
            PG8_BAR; PG8_WAIT_L(0); PG8_MMA(0, 1, At, B1); PG8_BAR;
            PG8_LDA(At, 1, 1); PG8_STAGE(PG8_SA(1, 0), a3, voffA);
            PG8_BAR; PG8_WAIT_L(0); PG8_MMA(1, 0, At, B0); PG8_BAR; PG8_SCHED;
            PG8_STAGE(PG8_SB(1, 1), b3 + hstep, voffB);
            PG8_WAIT_V(6); PG8_BAR; PG8_MMA(1, 1, At, B1); PG8_BAR;
            }
        }
        if constexpr (ALIGN_EPI) { if (wr == 0) PG8_BAR; }
        if constexpr (!Epi::AFTER_DRAIN) { E(acc, cur, wr, wc, fr, fq); S.done(cur); }
        if (!has_next) break;
#pragma unroll
        for (int a = 0; a < 2; ++a)
#pragma unroll
            for (int b = 0; b < 2; ++b)
#pragma unroll
                for (int m = 0; m < 4; ++m)
#pragma unroll
                    for (int n = 0; n < 2; ++n) acc[a][b][m][n] = (f32x4){0.f, 0.f, 0.f, 0.f};
        cur = nxt; cA = nA; cB = nB; ++ui;
        if constexpr (ALIGN_EPI) { if (wr == 1) PG8_BAR; }
    }
    PG8_WAIT_V(0);
    if constexpr (!ALIGN_EPI) { if (wr == 0) PG8_BAR; }
    PG8_BAR;
    if constexpr (Epi::AFTER_DRAIN) { E.fused(acc, cur, wr, wc, fr, fq, lds, wid, lane); S.done(cur); }
#undef PG8_SA
#undef PG8_SB
#undef PG8_STAGE
#undef PG8_LDA
#undef PG8_LDB
#undef PG8_MMA
#undef PG8_WAIT_V
#undef PG8_WAIT_L
#undef PG8_BAR
#undef PG8_SCHED
}
}

#ifndef PG8_SP2
#define PG8_SP2 true
#endif
#ifndef PG8_ALIGN
#define PG8_ALIGN true
#endif
namespace pg8 {
struct EpiRes {
    static constexpr bool PERM = false, AFTER_DRAIN = false;
    const float* src_ctx; const float* src_lat; float* X; const float* gate;
    __device__ __forceinline__ void operator()(const f32x4 (&acc)[2][2][4][2], const Unit& u, int wr, int wc, int fr, int fq) const {
        const int cond = u.pm < 32 ? 0 : 1 + ((u.pm - 32) >> 2);
        const float* g = gate + cond * 6144;
        const float* sb = u.pm < 32 ? src_ctx + (size_t)u.pm * BM * 1024 : src_lat + (size_t)(u.pm - 32) * BM * 1024;
        float* xb = X + (size_t)u.pm * BM * 1024;
        const int col0 = u.pn * BM + wc * 32 + 4 * fq;
        f32x4 gv[2][2];
#pragma unroll
        for (int bj = 0; bj < 2; ++bj)
#pragma unroll
            for (int n = 0; n < 2; ++n) gv[bj][n] = *(const f32x4*)(g + col0 + bj * HALF + n * 16);
#pragma unroll
        for (int ai = 0; ai < 2; ++ai)
#pragma unroll
            for (int m = 0; m < 4; ++m) { const size_t off = (size_t)(ai * HALF + wr * 64 + m * 16 + fr) * 1024 + col0;
#pragma unroll
                for (int bj = 0; bj < 2; ++bj)
#pragma unroll
                    for (int n = 0; n < 2; ++n) { const f32x4 xv = *(const f32x4*)(sb + off + bj * HALF + n * 16);
                        *(f32x4*)(xb + off + bj * HALF + n * 16) = xv + gv[bj][n] * acc[ai][bj][m][n]; } }
    }
};
struct EpiDnIn {
    static constexpr bool PERM = true, AFTER_DRAIN = false;
    bf16_t* O; float* AB;
    __device__ __forceinline__ void operator()(const f32x4 (&acc)[2][2][4][2], const Unit& u, int wr, int wc, int fr, int fq) const {
        const int row0 = u.pm * BM + wr * 64 + fr;
        if (u.pn < 16) {
            const int col0 = u.pn * BM + wc * 32 + 8 * fq;
#pragma unroll
            for (int ai = 0; ai < 2; ++ai)
#pragma unroll
                for (int m = 0; m < 4; ++m) { bf16_t* rowp = O + (size_t)(row0 + ai * HALF + m * 16) * 4096 + col0;
#pragma unroll
                    for (int bj = 0; bj < 2; ++bj) { const f32x4 v0 = acc[ai][bj][m][0], v1 = acc[ai][bj][m][1];
                        u32x4 w; w.x = cvt_pk_bf16(v0[0], v0[1]); w.y = cvt_pk_bf16(v0[2], v0[3]); w.z = cvt_pk_bf16(v1[0], v1[1]); w.w = cvt_pk_bf16(v1[2], v1[3]);
                        *(u32x4*)(rowp + bj * HALF) = w; } }
        } else if (wc == 0) {
#pragma unroll
            for (int ai = 0; ai < 2; ++ai)
#pragma unroll
                for (int m = 0; m < 4; ++m) { float* rp = AB + (size_t)(row0 + ai * HALF + m * 16) * 32 + 8 * fq;
                    *(f32x4*)rp = acc[ai][0][m][0]; *(f32x4*)(rp + 4) = acc[ai][0][m][1]; }
        }
    }
};
}
#include <hip/hip_bf16.h>
namespace attn {
using bf16 = __hip_bfloat16;
constexpr int D = 128, NW = 8, QBLK = 32, KVBLK = 64;
constexpr float SCALE = 0.088388347648318440f;
constexpr float THR = 8.f;
constexpr int SDEPTH = 2;
constexpr int LDQ = 1024, LDK = 256, LDO = 1024;
constexpr size_t SHM_V = KVBLK * D * 2, SHM_K = KVBLK * D * 2, SHM_ATTN = 2 * SHM_V + 2 * SHM_K + NW * 64 * 4;
using bf16x8 = __attribute__((ext_vector_type(8))) short;
using s16x4  = __attribute__((ext_vector_type(4))) short;
using f32x16 = __attribute__((ext_vector_type(16))) float;
using f32x8  = __attribute__((ext_vector_type(8))) float;
using u32x4  = __attribute__((ext_vector_type(4))) unsigned;
#define KSWZ(row, colB) ((row) * 256 + ((colB) ^ (((row) & 7) << 4)))
#define SBAR() __builtin_amdgcn_sched_barrier(0)
__device__ __forceinline__ int crow(int r, int hi) { return (r & 3) + 8 * (r >> 2) + 4 * hi; }
__device__ __forceinline__ unsigned cvtpk(float lo, float hi) {
  unsigned r; asm volatile("v_cvt_pk_bf16_f32 %0, %1, %2" : "=v"(r) : "v"(lo), "v"(hi)); return r;
}
template <typename TIn> struct Stage;
template <> struct Stage<bf16>  { using T = bf16x8;
  __device__ static __forceinline__ T ld8(const bf16* p) { return *reinterpret_cast<const bf16x8*>(p); }
  __device__ static __forceinline__ bf16x8 tobf(T x) { return x; } };
template <> struct Stage<float> { using T = f32x8;
  __device__ static __forceinline__ T ld8(const float* p) { return *reinterpret_cast<const f32x8*>(p); }
  __device__ static __forceinline__ bf16x8 tobf(T x) {
    u32x4 w = {cvtpk(x[0], x[1]), cvtpk(x[2], x[3]), cvtpk(x[4], x[5]), cvtpk(x[6], x[7])}; return *reinterpret_cast<bf16x8*>(&w); } };

__device__ __forceinline__ void partialSM(f32x16& p0, f32x16& p1, float& m_reg, float& mn, float& alpha) {
  constexpr float C = SCALE * 1.4426950408889634f;
  float pmax = p0[0]; for (int r = 1; r < 16; ++r) pmax = fmaxf(pmax, p0[r]); for (int r = 0; r < 16; ++r) pmax = fmaxf(pmax, p1[r]);
  { auto rr = __builtin_amdgcn_permlane32_swap(__float_as_uint(pmax), __float_as_uint(pmax), false, false);
    pmax = fmaxf(__uint_as_float(rr[0]), __uint_as_float(rr[1])); }
  if (__builtin_expect(__all(pmax - m_reg <= THR / SCALE), 1)) { mn = m_reg; alpha = 1.f; }
  else { mn = fmaxf(m_reg, pmax); alpha = __builtin_amdgcn_exp2f((m_reg - mn) * C); m_reg = mn; }
  float mnC = -mn * C;
  for (int r = 0; r < 16; ++r) p0[r] = fmaf(p0[r], C, mnC); for (int r = 0; r < 16; ++r) p1[r] = fmaf(p1[r], C, mnC);
  for (int r = 0; r < 16; ++r) p0[r] = __builtin_amdgcn_exp2f(p0[r]);
}
__device__ __forceinline__ void finishSM(f32x16& p0, f32x16& p1, float alpha, float& l_reg, bf16x8& pa0, bf16x8& pa1, bf16x8& pa2, bf16x8& pa3) {
  for (int r = 0; r < 16; ++r) p1[r] = __builtin_amdgcn_exp2f(p1[r]);
  float ps = 0; for (int r = 0; r < 16; ++r) ps += p0[r]; for (int r = 0; r < 16; ++r) ps += p1[r];
  { auto rr = __builtin_amdgcn_permlane32_swap(__float_as_uint(ps), __float_as_uint(ps), false, false);
    ps = __uint_as_float(rr[0]) + __uint_as_float(rr[1]); }
  l_reg = l_reg * alpha + ps;
#define PK4(P, BASE, OUT) do { unsigned a0 = cvtpk(P[BASE + 0], P[BASE + 1]), a1 = cvtpk(P[BASE + 2], P[BASE + 3]);   \
    unsigned b0 = cvtpk(P[BASE + 4], P[BASE + 5]), b1 = cvtpk(P[BASE + 6], P[BASE + 7]);                              \
    auto r0 = __builtin_amdgcn_permlane32_swap(a0, b0, false, false); auto r1 = __builtin_amdgcn_permlane32_swap(a1, b1, false, false); \
    u32x4 w = {r0[0], r1[0], r0[1], r1[1]}; OUT = *reinterpret_cast<bf16x8*>(&w); } while (0)
  PK4(p0, 0, pa0); PK4(p0, 8, pa1); PK4(p1, 0, pa2); PK4(p1, 8, pa3);
#undef PK4
}
__device__ __forceinline__ void qkt(f32x16& p0, f32x16& p1, const bf16* Ks, const bf16x8* qr, int r32, int hi) {
  p0 = f32x16{}; p1 = f32x16{};
  for (int d0 = 0; d0 < 8; ++d0) { int cb = (d0 * 16 + hi * 8) * 2;
    bf16x8 b0 = *reinterpret_cast<const bf16x8*>((const char*)Ks + KSWZ(r32, cb));
    bf16x8 b1 = *reinterpret_cast<const bf16x8*>((const char*)Ks + KSWZ(32 + r32, cb));
    p0 = __builtin_amdgcn_mfma_f32_32x32x16_bf16(b0, qr[d0], p0, 0, 0, 0);
    p1 = __builtin_amdgcn_mfma_f32_32x32x16_bf16(b1, qr[d0], p1, 0, 0, 0); }
}
__device__ __forceinline__ int v_st(int k, int c) { const int kk = (k & ~0xC) | ((k & 4) << 1) | ((k & 8) >> 1); return ((kk >> 3) * 4 + (c >> 5)) * 512 + ((kk & 7) * 32 + (c & 31)) * 2; }
__device__ __forceinline__ int v_rd_base(int lane) { return ((lane & 3) << 3) | (((lane >> 2) & 3) << 6) | (((lane >> 4) & 1) << 5) | (((lane >> 5) & 1) << 8); }
constexpr int v_rd_off(int d0, int ks, int half) { return d0 * 512 + ks * 4096 + half * 2048; }
template <int OFF> __device__ __forceinline__ s16x4 tr_read(int vb) {
  s16x4 r; asm volatile("ds_read_b64_tr_b16 %0, %1 offset:%2" : "=&v"(r) : "v"(vb), "i"(OFF) : "memory"); return r;
}
template <int D0> __device__ __forceinline__ void pv_one(f32x16& od, int vb, bf16x8 pa0, bf16x8 pa1, bf16x8 pa2, bf16x8 pa3) {
  const s16x4 l0 = tr_read<v_rd_off(D0, 0, 0)>(vb), h0 = tr_read<v_rd_off(D0, 0, 1)>(vb), l1 = tr_read<v_rd_off(D0, 1, 0)>(vb), h1 = tr_read<v_rd_off(D0, 1, 1)>(vb);
  const s16x4 l2 = tr_read<v_rd_off(D0, 2, 0)>(vb), h2 = tr_read<v_rd_off(D0, 2, 1)>(vb), l3 = tr_read<v_rd_off(D0, 3, 0)>(vb), h3 = tr_read<v_rd_off(D0, 3, 1)>(vb);
  asm volatile("s_waitcnt lgkmcnt(0)" ::: "memory"); SBAR();
#define PK(L, H) (bf16x8){L[0], L[1], L[2], L[3], H[0], H[1], H[2], H[3]}
  od = __builtin_amdgcn_mfma_f32_32x32x16_bf16(pa0, PK(l0, h0), od, 0, 0, 0);
  od = __builtin_amdgcn_mfma_f32_32x32x16_bf16(pa1, PK(l1, h1), od, 0, 0, 0);
  od = __builtin_amdgcn_mfma_f32_32x32x16_bf16(pa2, PK(l2, h2), od, 0, 0, 0);
  od = __builtin_amdgcn_mfma_f32_32x32x16_bf16(pa3, PK(l3, h3), od, 0, 0, 0);
#undef PK
}
__device__ __forceinline__ void pv_d0(f32x16* o, int vb, bf16x8 pa0, bf16x8 pa1, bf16x8 pa2, bf16x8 pa3) {
  pv_one<0>(o[0], vb, pa0, pa1, pa2, pa3); pv_one<1>(o[1], vb, pa0, pa1, pa2, pa3); pv_one<2>(o[2], vb, pa0, pa1, pa2, pa3); pv_one<3>(o[3], vb, pa0, pa1, pa2, pa3);
}

template <typename TQ>
__device__ __forceinline__ void attn_dense_body(const TQ* __restrict__ Qb, const bf16* __restrict__ Kh, const bf16* __restrict__ Vh,
                                                unsigned short* __restrict__ Ob, int seq, char* lds, const int tid) {
  using St = Stage<bf16>; using SQ = Stage<TQ>;
  const int wid = tid >> 6, lane = tid & 63, r32 = lane & 31, hi = lane >> 5;
  bf16* V_lds = (bf16*)lds; bf16* K_lds = (bf16*)(lds + 2 * SHM_V);
  float* ws = (float*)(lds + 2 * SHM_V + 2 * SHM_K) + wid * 64; float* li_l = ws; float* al_l = ws + 32;
  float m_reg = -1e30f, l_reg = 0; f32x16 o[4] = {}; bf16x8 qr[8];
  const TQ* Qw = Qb + (int)(wid * QBLK + r32) * LDQ + hi * 8;
#pragma unroll
  for (int d0 = 0; d0 < 8; ++d0) qr[d0] = SQ::tobf(SQ::ld8(Qw + d0 * 16));
  const int sr = tid >> 4, sc = (tid & 15) * 8, vst0 = v_st(sr, sc), vst1 = v_st(32 + sr, sc);
  const int vb0 = (int)(uintptr_t)V_lds + v_rd_base(lane);
  struct { typename St::T vs0, vs1, ks0, ks1; } sr_[SDEPTH];
#define SLOAD(i, k0) do { sr_[i].vs0 = St::ld8(&Vh[(int)((k0) + sr) * LDK + sc]); sr_[i].vs1 = St::ld8(&Vh[(int)((k0) + 32 + sr) * LDK + sc]); \
    sr_[i].ks0 = St::ld8(&Kh[(int)((k0) + sr) * LDK + sc]); sr_[i].ks1 = St::ld8(&Kh[(int)((k0) + 32 + sr) * LDK + sc]); } while (0)
#define SWRITE(b, i) do { *(bf16x8*)((char*)V_lds + (b) * SHM_V + vst0) = St::tobf(sr_[i].vs0);          \
    *(bf16x8*)((char*)V_lds + (b) * SHM_V + vst1) = St::tobf(sr_[i].vs1); int kc = sc * 2;               \
    *(bf16x8*)((char*)K_lds + (b) * SHM_K + KSWZ(sr, kc)) = St::tobf(sr_[i].ks0);                       \
    *(bf16x8*)((char*)K_lds + (b) * SHM_K + KSWZ(32 + sr, kc)) = St::tobf(sr_[i].ks1); } while (0)
#define SWAIT() do { if constexpr (SDEPTH == 2) asm volatile("s_waitcnt vmcnt(4)" ::: "memory"); else asm volatile("s_waitcnt vmcnt(0)" ::: "memory"); } while (0)
#define RESC(a) do { if (__any((a) < 1.f)) { if (hi == 0) al_l[r32] = (a); asm volatile("s_waitcnt lgkmcnt(0)" ::: "memory"); \
    for (int d = 0; d < 4; ++d) for (int r = 0; r < 16; ++r) o[d][r] *= al_l[crow(r, hi)]; } } while (0)
  f32x16 pA0, pA1, pB0, pB1; float mnA, mnB, alA, alB; bf16x8 pa0, pa1, pa2, pa3; const int NT = seq / KVBLK;
  constexpr int SE = 0, SO = SDEPTH - 1;
  SLOAD(SE, 0); asm volatile("s_waitcnt vmcnt(0)" ::: "memory"); SWRITE(0, SE); __syncthreads();
  qkt(pA0, pA1, K_lds, qr, r32, hi); partialSM(pA0, pA1, m_reg, mnA, alA);
  SLOAD(SO, KVBLK); if constexpr (SDEPTH == 2) { if (2 < NT) SLOAD(SE, 2 * KVBLK); }
  SWAIT(); SWRITE(1, SO); __syncthreads();
  for (int j = 1; j + 1 < NT; j += 2) {
    SBAR(); qkt(pB0, pB1, (bf16*)((char*)K_lds + SHM_K), qr, r32, hi);
    finishSM(pA0, pA1, alA, l_reg, pa0, pa1, pa2, pa3); SBAR();
    SLOAD(SO, (j + SDEPTH) * KVBLK); SBAR();
    pv_d0(o, vb0, pa0, pa1, pa2, pa3); partialSM(pB0, pB1, m_reg, mnB, alB);
    __syncthreads(); SWAIT(); SWRITE(0, SE);
    RESC(alB); __syncthreads();
    SBAR(); qkt(pA0, pA1, K_lds, qr, r32, hi);
    finishSM(pB0, pB1, alB, l_reg, pa0, pa1, pa2, pa3); SBAR();
    if (SDEPTH == 1 || j + 3 < NT) SLOAD(SE, (j + 1 + SDEPTH) * KVBLK); SBAR();
    pv_d0(o, vb0 + (int)SHM_V, pa0, pa1, pa2, pa3); partialSM(pA0, pA1, m_reg, mnA, alA);
    __syncthreads(); SWAIT(); SWRITE(1, SO);
    RESC(alA); __syncthreads();
  }
  SBAR(); qkt(pB0, pB1, (bf16*)((char*)K_lds + SHM_K), qr, r32, hi);
  finishSM(pA0, pA1, alA, l_reg, pa0, pa1, pa2, pa3); SBAR();
  pv_d0(o, vb0, pa0, pa1, pa2, pa3); partialSM(pB0, pB1, m_reg, mnB, alB);
  __syncthreads(); RESC(alB);
  finishSM(pB0, pB1, alB, l_reg, pa0, pa1, pa2, pa3); SBAR();
  pv_d0(o, vb0 + (int)SHM_V, pa0, pa1, pa2, pa3);
  if (hi == 0) li_l[r32] = l_reg; asm volatile("s_waitcnt lgkmcnt(0)" ::: "memory");
  float rli[16];
#pragma unroll
  for (int r = 0; r < 16; ++r) rli[r] = __builtin_amdgcn_rcpf(li_l[crow(r, hi)]);
  unsigned short* Ow = Ob + (int)(wid * QBLK) * LDO;
#pragma unroll
  for (int r = 0; r < 16; ++r) { int orow = crow(r, hi);
    for (int d0 = 0; d0 < 4; ++d0) Ow[(int)orow * LDO + d0 * 32 + r32] = (unsigned short)f2bf(o[d0][r] * rli[r]); }
#undef SLOAD
#undef SWRITE
#undef SWAIT
#undef RESC
}

#undef KSWZ
#undef SBAR
}
#define LAS __attribute__((address_space(3)))
constexpr int NWAVES = 8;
constexpr int LDS_BYTES = 147456;
constexpr size_t MiB = (size_t)1 << 20;
constexpr size_t WS_CTL = 0, CTL_ZERO_BYTES = 1 * MiB;
constexpr size_t WS_MODS = 1 * MiB, WS_ROPE = WS_MODS + MiB / 2;
constexpr size_t WS_WT_AIN = 2 * MiB, WS_WT_AOUT = 8 * MiB, WS_WT_DIN = 12 * MiB, WS_WT_DOUT = 29 * MiB, WS_WT_W1 = 33 * MiB, WS_WT_W2 = 65 * MiB;
constexpr size_t WS_X = 97 * MiB, WS_H = 137 * MiB, WS_Y = 157 * MiB, WS_PROJ = 177 * MiB, WS_AB = 257 * MiB, WS_G = 259 * MiB, WS_BETA = 260 * MiB;
constexpr size_t WS_QB = 261 * MiB, WS_KB = 281 * MiB, WS_VB = 287 * MiB, WS_CONV = 293 * MiB, WS_OF = 353 * MiB, WS_OB = 373 * MiB, WS_END = 393 * MiB;

struct Ctx {
    LAS unsigned char* lds;
    int tid, lane, wid, gw, ngw, nblk, blk;
};
struct ProPtrs { const float *c, *c_ctx, *w_mod, *b_mod, *attn_w_in, *attn_w_out, *dn_w_in, *dn_w_out, *mlp_w1, *mlp_w2; float *mods, *rope; bf16raw *wt_ain, *wt_aout, *wt_din, *wt_dout, *wt_w1, *wt_w2; };

#define LDS_WAIT() asm volatile("s_waitcnt lgkmcnt(0)" ::: "memory")

__device__ __forceinline__ void p0_transpose_item(const float* W, int K, int N, bf16raw* WT, LAS float* scr, int item, int lane) {
    const int nblk = N / 32, kb = item / nblk, nb = item % nblk, k0 = 64 * kb, n0 = 32 * nb;
#pragma unroll 8
    for (int i = 0; i < 32; ++i) { const int kk = 2 * i + (lane >> 5); scr[kk * 33 + (lane & 31)] = W[(size_t)(k0 + kk) * N + n0 + (lane & 31)]; }
    LDS_WAIT(); asm volatile("" ::: "memory");
    const int c = lane & 7;
#pragma unroll
    for (int j = 0; j < 4; ++j) { const int n = (lane >> 3) + 8 * j; const LAS float* s = scr + (8 * c) * 33 + n;
        u32x4_t o; o.x = pk2(s[0 * 33], s[1 * 33]); o.y = pk2(s[2 * 33], s[3 * 33]); o.z = pk2(s[4 * 33], s[5 * 33]); o.w = pk2(s[6 * 33], s[7 * 33]);
        *(u32x4_t*)(WT + (size_t)(n0 + n) * K + k0 + 8 * c) = o; }
    LDS_WAIT(); asm volatile("" ::: "memory");
}

__device__ __forceinline__ void phase_prologue(Ctx& C, const ProPtrs& P) {
    LAS float* sc = (LAS float*)C.lds;
    LAS float* red = (LAS float*)(C.lds + 12288);
    for (int k = C.tid; k < 1024; k += 512) { sc[k] = silu_f(P.c_ctx[k]); sc[1024 + k] = silu_f(P.c[k]); sc[2048 + k] = silu_f(P.c[1024 + k]); }
    __syncthreads();
    for (int u = C.blk; u < 4 * 96; u += C.nblk) {
        const int l = u / 96, n0 = (u % 96) * 64;
        const float* w = P.w_mod + ((size_t)l * 1024 + C.wid * 128) * 6144 + n0 + C.lane;
        float a0 = 0.f, a1 = 0.f, a2 = 0.f;
#pragma unroll 8
        for (int k = 0; k < 128; ++k) { const float wv = w[(size_t)k * 6144]; const int kk = C.wid * 128 + k; a0 += sc[kk] * wv; a1 += sc[1024 + kk] * wv; a2 += sc[2048 + kk] * wv; }
        red[(C.wid * 3 + 0) * 64 + C.lane] = a0; red[(C.wid * 3 + 1) * 64 + C.lane] = a1; red[(C.wid * 3 + 2) * 64 + C.lane] = a2;
        __syncthreads();
        if (C.tid < 192) { const int s = C.tid >> 6, ln = C.tid & 63; float t = 0.f;
#pragma unroll
            for (int w8 = 0; w8 < 8; ++w8) t += red[(w8 * 3 + s) * 64 + ln];
            P.mods[(size_t)(l * 3 + s) * 6144 + n0 + ln] = t + P.b_mod[l * 6144 + n0 + ln]; }
        __syncthreads();
    }
    __syncthreads();
    LAS float* scr = (LAS float*)(C.lds + C.wid * 16384);
    constexpr int I0 = 2 * 768, I1 = 2 * 512, I2 = 2 * 2064, I3 = 2 * 512, I4 = 4 * 2048, I5 = 4 * 2048;
    for (int it = C.gw; it < I0 + I1 + I2 + I3 + I4 + I5; it += C.ngw) {
        int r = it;
        if (r < I0) { const int j = r / 768; p0_transpose_item(P.attn_w_in + (size_t)j * 1024 * 1536, 1024, 1536, P.wt_ain + (size_t)j * 1536 * 1024, scr, r % 768, C.lane); continue; } r -= I0;
        if (r < I1) { const int j = r / 512; p0_transpose_item(P.attn_w_out + (size_t)j * 1024 * 1024, 1024, 1024, P.wt_aout + (size_t)j * 1024 * 1024, scr, r % 512, C.lane); continue; } r -= I1;
        if (r < I2) { const int j = r / 2064; p0_transpose_item(P.dn_w_in + (size_t)j * 1024 * DNIN, 1024, DNIN, P.wt_din + (size_t)j * DNINP * 1024, scr, r % 2064, C.lane); continue; } r -= I2;
        if (r < I3) { const int j = r / 512; p0_transpose_item(P.dn_w_out + (size_t)j * 1024 * 1024, 1024, 1024, P.wt_dout + (size_t)j * 1024 * 1024, scr, r % 512, C.lane); continue; } r -= I3;
        if (r < I4) { const int l = r / 2048; p0_transpose_item(P.mlp_w1 + (size_t)l * 1024 * 4096, 1024, 4096, P.wt_w1 + (size_t)l * 4096 * 1024, scr, r % 2048, C.lane); continue; } r -= I4;
        { const int l = r / 2048; p0_transpose_item(P.mlp_w2 + (size_t)l * 4096 * 1024, 4096, 1024, P.wt_w2 + (size_t)l * 1024 * 4096, scr, r % 2048, C.lane); }
    }
    const int gt = C.blk * 512 + C.tid, ngt = C.nblk * 512;
    for (int i = gt; i < 2 * 28672; i += ngt) { const int j = i / 28672, o = i % 28672;
        *(u32x4_t*)(P.wt_din + ((size_t)j * DNINP + DNIN) * 1024 + (size_t)o * 8) = (u32x4_t){0u, 0u, 0u, 0u}; }
    for (int i = gt; i < 1024 * 64; i += ngt) { const int t = i >> 6, a = (i >> 5) & 1, f = i & 31;
        const float inv = powf(10000.f, -(float)f / 32.f); const float ang = (float)(a ? (t & 63) : (t >> 6)) * inv;
        P.rope[2 * i] = cosf(ang); P.rope[2 * i + 1] = sinf(ang); }
}

__device__ __forceinline__ void phase_norm(Ctx& C, const float* src_ctx, const float* src_lat, const float* gain, const float* md0, bf16raw* H) {
    for (int row = C.gw; row < MTOK; row += C.ngw) {
        const float* xr = row < NCTX ? src_ctx + (size_t)row * D : src_lat + (size_t)(row - NCTX) * D;
        const float* md = md0 + cond_of(row) * 6144;
        f32x4_t v[4]; float ss = 0.f;
#pragma unroll
        for (int j = 0; j < 4; ++j) { v[j] = *(const f32x4_t*)(xr + 4 * C.lane + 256 * j); ss += (v[j].x * v[j].x + v[j].y * v[j].y) + (v[j].z * v[j].z + v[j].w * v[j].w); }
        const float rinv = rsqrtf(wave_sum(ss, C.lane) * (1.f / D) + EPS);
#pragma unroll
        for (int j = 0; j < 4; ++j) { const int c = 4 * C.lane + 256 * j;
            const f32x4_t g = *(const f32x4_t*)(gain + c), sh = *(const f32x4_t*)(md + c), sc = *(const f32x4_t*)(md + 1024 + c);
            const f32x4_t y = v[j] * rinv * g * (sc + 1.f) + sh;
            u32x2_t o; o.x = pk2(y.x, y.y); o.y = pk2(y.z, y.w);
            *(u32x2_t*)(H + (size_t)row * D + c) = o; }
    }
}
__device__ __forceinline__ void phase_final(Ctx& C, const float* X, const float* final_norm, float* out) {
    for (int row = C.gw; row < MTOK; row += C.ngw) {
        const float* xr = X + (size_t)row * D;
        f32x4_t v[4]; float ss = 0.f;
#pragma unroll
        for (int j = 0; j < 4; ++j) { v[j] = *(const f32x4_t*)(xr + 4 * C.lane + 256 * j); ss += (v[j].x * v[j].x + v[j].y * v[j].y) + (v[j].z * v[j].z + v[j].w * v[j].w); }
        const float rinv = rsqrtf(wave_sum(ss, C.lane) * (1.f / D) + EPS);
#pragma unroll
        for (int j = 0; j < 4; ++j) { const int c = 4 * C.lane + 256 * j; const f32x4_t g = *(const f32x4_t*)(final_norm + c);
            *(f32x4_t*)(out + O_Y + (size_t)row * D + c) = v[j] * rinv * g; }
    }
}

struct QknPtrs { const bf16raw* PROJ; bf16raw *QB, *KB, *VB; const float *qg, *kg, *rope, *cache_k, *cache_v; float* out; };
__device__ __forceinline__ void phase_qkn(Ctx& C, const QknPtrs& P, int j) {
    const unsigned* P32 = (const unsigned*)P.PROJ; unsigned* Q32 = (unsigned*)P.QB; unsigned* K32 = (unsigned*)P.KB; unsigned* V32 = (unsigned*)P.VB;
    const float* qg = P.qg; const float* kg = P.kg;
    const int lane = C.lane;
    const f32x2_t gq = *(const f32x2_t*)(qg + 2 * lane), gk = *(const f32x2_t*)(kg + 2 * lane);
    for (int row = C.gw; row < MTOK; row += C.ngw) {
        const bool lat = row >= NCTX;
        const int b = lat ? (row - NCTX) >> 10 : row >> 8, t = lat ? (row - NCTX) & 1023 : row & 255;
        const int krow = lat ? 8192 + b * 1280 + 256 + t : row;
        f32x4_t rp = (f32x4_t){1.f, 0.f, 1.f, 0.f};
        if (lat) rp = *(const f32x4_t*)(P.rope + ((size_t)t * 64 + (lane >> 5) * 32 + 2 * (lane & 15)) * 2);
        const bool ph = (lane >> 4) & 1;
#pragma unroll
        for (int slot = 0; slot < 12; ++slot) {
            const unsigned w = P32[(size_t)row * 768 + slot * 64 + lane];
            float v0 = bf_lo(w), v1 = bf_hi(w);
            if (slot < 10) {
                const float rinv = rsqrtf(wave_sum(v0 * v0 + v1 * v1, lane) * (1.f / 128.f) + EPS);
                const f32x2_t g = slot < 8 ? gq : gk;
                v0 = v0 * rinv * g.x; v1 = v1 * rinv * g.y;
                if (lat) { const float y0 = lane_xor_f(v0, lane, 16), y1 = lane_xor_f(v1, lane, 16);
                    v0 = v0 * rp.x + (ph ? y0 : -y0) * rp.y; v1 = v1 * rp.z + (ph ? y1 : -y1) * rp.w; }
            }
            const unsigned o = pk2(v0, v1);
            if (slot < 8) Q32[(size_t)row * 512 + slot * 64 + lane] = o;
            else if (slot < 10) K32[(size_t)krow * 128 + (slot - 8) * 64 + lane] = o;
            else V32[(size_t)krow * 128 + (slot - 10) * 64 + lane] = o;
            if (!lat && slot >= 8) { float* op = P.out + (slot < 10 ? O_CK : O_CV) + ((size_t)(b * 2 + j) * 256 + t) * 256 + (slot & 1) * 128 + 2 * lane;
                *(f32x2_t*)op = (f32x2_t){v0, v1}; }
        }
    }
    for (int it = C.gw; it < 2 * 256 * 2; it += C.ngw) {
        const int kv = it & 1, key = (it >> 1) & 255, b = it >> 9;
        const float* src = (kv ? P.cache_v : P.cache_k) + ((size_t)(b * 2 + j) * 256 + key) * 256 + 4 * lane;
        const f32x4_t v = *(const f32x4_t*)src;
        u32x2_t o; o.x = pk2(v.x, v.y); o.y = pk2(v.z, v.w);
        *(u32x2_t*)((kv ? P.VB : P.KB) + (size_t)(8192 + b * 1280 + key) * 256 + 4 * lane) = o;
    }
}

struct AttnPtrs { const bf16raw *QB, *KB, *VB; bf16raw* Y; };
template <int NI> __device__ __forceinline__ void attn_item(Ctx& C, const AttnPtrs& P, int row, int hq, int kbase, LAS float* qs, LAS float* ps) {
    const int lane = C.lane, kvh = hq >> 2;
    { const unsigned w = ((const unsigned*)P.QB)[(size_t)row * 512 + hq * 64 + lane]; qs[2 * lane] = bf_lo(w); qs[2 * lane + 1] = bf_hi(w); }
    LDS_WAIT();
    float sc[NI]; float mx = -1e30f;
#pragma unroll
    for (int i = 0; i < NI; ++i) {
        const u32x4_t* kp = (const u32x4_t*)(P.KB + (size_t)(kbase + lane + 64 * i) * 256 + kvh * 128);
        float s = 0.f;
#pragma unroll
        for (int d = 0; d < 16; ++d) { const u32x4_t kw = kp[d]; const f32x4_t qa = *(const LAS f32x4_t*)(qs + 8 * d), qb = *(const LAS f32x4_t*)(qs + 8 * d + 4);
            s += bf_lo(kw.x) * qa.x + bf_hi(kw.x) * qa.y + bf_lo(kw.y) * qa.z + bf_hi(kw.y) * qa.w + bf_lo(kw.z) * qb.x + bf_hi(kw.z) * qb.y + bf_lo(kw.w) * qb.z + bf_hi(kw.w) * qb.w; }
        sc[i] = s * ATT_SCALE; mx = fmaxf(mx, sc[i]);
    }
    mx = wave_max(mx, lane);
    float sm = 0.f;
#pragma unroll
    for (int i = 0; i < NI; ++i) { const float e = __expf(sc[i] - mx); sm += e; ps[lane + 64 * i] = e; }
    sm = wave_sum(sm, lane);
    LDS_WAIT();
    float a0 = 0.f, a1 = 0.f;
    const unsigned* vp = (const unsigned*)P.VB + (size_t)kbase * 128 + kvh * 64 + lane;
#pragma unroll 8
    for (int key = 0; key < NI * 64; ++key) { const float p = ps[key]; const unsigned w = vp[(size_t)key * 128]; a0 += p * bf_lo(w); a1 += p * bf_hi(w); }
    const float inv = 1.f / sm;
    ((unsigned*)P.Y)[(size_t)row * 512 + hq * 64 + lane] = pk2(a0 * inv, a1 * inv);
    LDS_WAIT();
}
__device__ __forceinline__ void phase_attn_ref(Ctx& C, const AttnPtrs& P) {
    LAS float* qs = (LAS float*)C.lds + C.wid * 1408; LAS float* ps = qs + 128;
    for (int it = C.gw; it < NCTX * 8; it += C.ngw) { const int row = it >> 3; attn_item<4>(C, P, row, it & 7, (row >> 8) * 256, qs, ps); }
    for (int it = C.gw; it < NLAT * 8; it += C.ngw) { const int r = it >> 3; attn_item<20>(C, P, NCTX + r, it & 7, 8192 + (r >> 10) * 1280, qs, ps); }
}


__device__ __forceinline__ void phase_attn(Ctx& C, const AttnPtrs& P) {
    char* lds = (char*)C.lds;
    for (int r = 0; r * C.nblk < 320; ++r) {
        const int u = r * C.nblk + (C.blk + r * (C.nblk - 64)) % C.nblk;
        if (u >= 320) continue;
        int row0, krow0, hq, seq;
        if (u < 64) { const int b = u >> 5, qb = u & 3; hq = (u >> 2) & 7; row0 = NCTX + b * 1024 + qb * 256; krow0 = 8192 + b * 1280; seq = 1280; }
        else { const int c = u - 64, b = c >> 3; hq = c & 7; row0 = b * 256; krow0 = b * 256; seq = 256; }
        const int kvh = hq >> 2;
        if (r > 0) __syncthreads();
        attn::attn_dense_body<attn::bf16>((const attn::bf16*)(P.QB + (size_t)row0 * 1024 + hq * 128), (const attn::bf16*)(P.KB + (size_t)krow0 * 256 + kvh * 128),
                                          (const attn::bf16*)(P.VB + (size_t)krow0 * 256 + kvh * 128), P.Y + (size_t)row0 * 1024 + hq * 128, seq, lds, C.tid);
    }
}
struct ConvPtrs { const bf16raw* PROJ; bf16raw* CONV; const float *cw, *alog, *dtb, *AB; float *G, *BETA; };
__device__ __forceinline__ void phase_conv_ref(Ctx& C, const ConvPtrs& P) {
    const unsigned* P32 = (const unsigned*)P.PROJ; unsigned* C32 = (unsigned*)P.CONV;
    const float* cw = P.cw;
    const int lane = C.lane;
    for (int it = C.gw; it < MTOK * 24; it += C.ngw) {
        const int row = it / 24, slot = it % 24;
        const int T = row < NCTX ? 256 : 1024, t = row < NCTX ? (row & 255) : ((row - NCTX) & 1023);
        float a0 = 0.f, a1 = 0.f;
#pragma unroll
        for (int i = 0; i < 5; ++i) { const int tt = t + i - 2;
            if (tt >= 0 && tt < T) { const unsigned w = P32[(size_t)(row + i - 2) * 2048 + slot * 64 + lane]; const f32x2_t cv = *(const f32x2_t*)(cw + i * 3072 + slot * 128 + 2 * lane);
                a0 += bf_lo(w) * cv.x; a1 += bf_hi(w) * cv.y; } }
        a0 = silu_f(a0); a1 = silu_f(a1);
        if (slot < 16) { const float rinv = rsqrtf(wave_sum(a0 * a0 + a1 * a1, lane) + EPS); a0 *= rinv; a1 *= rinv; }
        C32[(size_t)row * 1536 + slot * 64 + lane] = pk2(a0, a1);
    }
    const float* alog = P.alog; const float* dtb = P.dtb;
    for (int idx = C.blk * 512 + C.tid; idx < MTOK * 16; idx += C.nblk * 512) {
        const int row = idx >> 4, dh = idx & 15;
        const float a = P.AB[(size_t)row * 32 + dh], b = P.AB[(size_t)row * 32 + 16 + dh];
        const float x = a + dtb[dh]; const float sp = x > 20.f ? x : log1pf(expf(x));
        P.G[idx] = -expf(alog[dh]) * sp; P.BETA[idx] = 1.f / (1.f + expf(-b));
    }
}
struct ScanPtrs { const bf16raw* CONV; const float *G, *BETA, *state_delta; bf16raw *OF, *OB; float* out; };
__device__ __forceinline__ void phase_scan_ref(Ctx& C, const ScanPtrs& P, int j) {
    const int sc2 = C.tid >> 8, half = (C.tid >> 7) & 1, t1 = C.tid & 127;
    LAS float* ks = (LAS float*)C.lds + sc2 * 1024;
    LAS float* qs = ks + 256;
    LAS float* part = ks + 512;
    LAS float* parto = ks + 768;
    for (int u = C.blk; u < 272; u += C.nblk) {
        const bool lat = u < 16;
        const int s = lat ? 2 * u + sc2 : 2 * (u - 16) + sc2;
        const int seq = lat ? 32 + (s >> 4) : s >> 4, h = (s >> 1) & 7, dir = s & 1;
        const int T = lat ? 1024 : 256, base = lat ? NCTX + (seq - 32) * 1024 : seq * 256;
        float S[64];
        if (lat) { const float* sp = P.state_delta + ((((size_t)(seq - 32) * 2 + j) * 2 + dir) * 8 + h) * 16384 + (size_t)half * 64 * 128;
#pragma unroll
            for (int k = 0; k < 64; ++k) S[k] = sp[k * 128 + t1]; }
        else {
#pragma unroll
            for (int k = 0; k < 64; ++k) S[k] = 0.f; }
        bf16raw* Od = (dir ? P.OB : P.OF) + h * 128 + t1;
        const bf16raw* cqk = P.CONV + (half ? 0 : 1024) + h * 128 + t1;
        const bf16raw* cv = P.CONV + 2048 + h * 128 + t1;
        const float* gp = P.G + dir * 8 + h; const float* bp = P.BETA + dir * 8 + h;
        size_t row = (size_t)(base + (dir ? T - 1 : 0));
        float nqk = bf2f(cqk[row * 3072]), nv = bf2f(cv[row * 3072]), ng = gp[row * 16], nb = bp[row * 16];
        for (int p = 0; p < T; ++p) {
            const int bufi = p & 1; const size_t crow = row;
            (half ? qs : ks)[bufi * 128 + t1] = nqk;
            const float v = nv, eg = expf(ng), beta = nb;
            if (p + 1 < T) { row = (size_t)(base + (dir ? T - 2 - p : p + 1));
                nqk = bf2f(cqk[row * 3072]); nv = bf2f(cv[row * 3072]); ng = gp[row * 16]; nb = bp[row * 16]; }
            __syncthreads();
            const LAS float* kk = ks + bufi * 128 + half * 64; const LAS float* qq = qs + bufi * 128 + half * 64;
            float kS = 0.f;
#pragma unroll
            for (int k = 0; k < 64; ++k) kS += kk[k] * S[k];
            part[half * 128 + t1] = kS;
            __syncthreads();
            kS = part[t1] + part[128 + t1];
            const float vn = beta * (v - eg * kS);
            float o = 0.f;
#pragma unroll
            for (int k = 0; k < 64; ++k) { S[k] = eg * S[k] + kk[k] * vn; o += qq[k] * S[k]; }
            parto[half * 128 + t1] = o;
            __syncthreads();
            if (half == 0) Od[crow * D] = (bf16raw)f2bf((parto[t1] + parto[128 + t1]) * ATT_SCALE);
        }
        if (!lat) { float* sp = P.out + O_ST + ((((size_t)seq * 2 + j) * 2 + dir) * 8 + h) * 16384 + (size_t)half * 64 * 128;
#pragma unroll
            for (int k = 0; k < 64; ++k) sp[k * 128 + t1] = S[k]; }
        __syncthreads();
    }
}
struct GatePtrs { const bf16raw *OF, *OB, *PROJ; bf16raw* Y; const float* gain; };
__device__ __forceinline__ void phase_gate(Ctx& C, const GatePtrs& P) {
    const unsigned* F32 = (const unsigned*)P.OF; const unsigned* B32 = (const unsigned*)P.OB; const unsigned* P32 = (const unsigned*)P.PROJ; unsigned* Y32 = (unsigned*)P.Y;
    const int lane = C.lane;
    const f32x2_t g = *(const f32x2_t*)(P.gain + 2 * lane);
    for (int it = C.gw; it < MTOK * 8; it += C.ngw) {
        const int row = it >> 3, h = it & 7;
        const unsigned wf = F32[(size_t)row * 512 + h * 64 + lane], wb = B32[(size_t)row * 512 + h * 64 + lane], wz = P32[(size_t)row * 2048 + 1536 + h * 64 + lane];
        const float v0 = bf_lo(wf) + bf_lo(wb), v1 = bf_hi(wf) + bf_hi(wb);
        const float rinv = rsqrtf(wave_sum(v0 * v0 + v1 * v1, lane) * (1.f / 128.f) + EPS);
        Y32[(size_t)row * 512 + h * 64 + lane] = pk2(v0 * rinv * g.x * silu_f(bf_lo(wz)), v1 * rinv * g.y * silu_f(bf_hi(wz)));
    }
}
#define XB_TMO      128
#define XB_XCNT(j)  (256  + 64 * (j))
#define XB_XSUB(j)  (1280 + 64 * (j))
#define XB_XGEN(j)  (2304 + 64 * (j))
#define XB_TOP      3328
#define XB_TOPGEN   3392
#define XCD_BAR_WORDS 3456
#define XB_SPIN_CAP (1u << 18)

__device__ __forceinline__ unsigned xb_ld(unsigned* p)              { return __hip_atomic_load(p, __ATOMIC_RELAXED, __HIP_MEMORY_SCOPE_AGENT); }
__device__ __forceinline__ unsigned xb_add(unsigned* p, unsigned v) { return __hip_atomic_fetch_add(p, v, __ATOMIC_RELAXED, __HIP_MEMORY_SCOPE_AGENT); }
__device__ __forceinline__ unsigned xb_xcc_id() { return (unsigned)__builtin_amdgcn_s_getreg((3 << 11) | 20) & 0xFu; }
#define XB_SPIN(cond, bar) do { unsigned _sp = 0; while (cond) { __builtin_amdgcn_s_sleep(1); \
    if ((++_sp & 255u) == 0u) { if (xb_ld(&(bar)[XB_TMO])) break; if (_sp > XB_SPIN_CAP) { atomicAdd(&(bar)[XB_TMO], 1u); break; } } } } while (0)

struct XcdBarrier {
    unsigned* bar; unsigned x;
    volatile LAS unsigned* st;
};

__device__ __forceinline__ XcdBarrier xcd_barrier_post(unsigned* bar, volatile LAS unsigned* st) {
    XcdBarrier b; b.bar = bar; b.x = xb_xcc_id(); b.st = st;
    if (threadIdx.x == 0) (void)xb_add(&bar[XB_XCNT(b.x)], 1u);
    return b;
}
__device__ __forceinline__ void xcd_barrier_complete(unsigned* bar, unsigned x, unsigned& nloc, unsigned& nx) {
    const unsigned G = gridDim.x * gridDim.y * gridDim.z;
    unsigned sum, cnt, mine, sp = 0u;
    for (;;) {
        sum = 0u; cnt = 0u; mine = 0u;
#pragma unroll
        for (unsigned j = 0; j < 16; ++j) { const unsigned c = xb_ld(&bar[XB_XCNT(j)]); sum += c; cnt += (c > 0u) ? 1u : 0u; mine = (j == x) ? c : mine; }
        if (sum == G) break;
        __builtin_amdgcn_s_sleep(1);
        if ((++sp & 255u) == 0u) { if (xb_ld(&bar[XB_TMO])) break; if (sp > XB_SPIN_CAP) { atomicAdd(&bar[XB_TMO], 1u); break; } }
    }
    nloc = mine > 0u ? mine : 1u; nx = cnt > 0u ? cnt : 1u;
}

__device__ __forceinline__ void xcd_barrier(const XcdBarrier& b) {
    asm volatile("s_waitcnt vmcnt(0)" ::: "memory");
    __syncthreads();
    if (threadIdx.x == 0) {
        unsigned* bar = b.bar;
        __builtin_amdgcn_s_waitcnt(0);
        unsigned nloc = b.st[0], nx = b.st[1];
        if (nloc == 0u) { xcd_barrier_complete(bar, b.x, nloc, nx); b.st[0] = nloc; b.st[1] = nx; }
        const unsigned old = xb_add(&bar[XB_XSUB(b.x)], 1u);
        const unsigned gen = old / nloc;
        if (old + 1u == (gen + 1u) * nloc) {
            __builtin_amdgcn_fence(__ATOMIC_RELEASE, "agent");
            asm volatile("s_waitcnt vmcnt(0)" ::: "memory");
            const unsigned og = xb_add(&bar[XB_TOP], 1u);
            const unsigned tg = og / nx;
            if (og + 1u == (tg + 1u) * nx) xb_add(&bar[XB_TOPGEN], 1u);
            else XB_SPIN(xb_ld(&bar[XB_TOPGEN]) == tg, bar);
            __builtin_amdgcn_fence(__ATOMIC_ACQUIRE, "agent");
            xb_add(&bar[XB_XGEN(b.x)], 1u);
            asm volatile("s_waitcnt vmcnt(0)" ::: "memory");
        } else {
            XB_SPIN(xb_ld(&bar[XB_XGEN(b.x)]) == gen, bar);
            __builtin_amdgcn_fence(__ATOMIC_ACQUIRE, "agent");
            asm volatile("s_waitcnt vmcnt(0)" ::: "memory");
        }
    }
    __syncthreads();
}

constexpr int LDSCTL_OFF = 131072, MISC_OFF = LDSCTL_OFF + 320, CW_BAR = 4096;
struct Args { const float* in[24]; float* out; unsigned char* ws; int ph_lo, ph_hi; };
enum { I_XP = 0, I_XS, I_CK, I_CV, I_SD, I_C, I_CCTX, I_WMOD, I_BMOD, I_N1, I_N2, I_AWIN, I_AQG, I_AKG, I_AWOUT, I_DWIN, I_DCONV, I_DALOG, I_DDTB, I_DNORM, I_DWOUT, I_W1, I_W2, I_FN };

__global__ void __launch_bounds__(NWAVES * 64, 2) mk_fwd(Args args) {
    extern __shared__ __attribute__((aligned(16))) unsigned char lds_raw[];
    cg::grid_group grid = cg::this_grid();
    for (int u = threadIdx.x; u < (LDS_BYTES - LDSCTL_OFF) / 4; u += NWAVES * 64) ((LAS unsigned*)((LAS unsigned char*)lds_raw + LDSCTL_OFF))[u] = 0u;
    __syncthreads();
    const XcdBarrier bar = xcd_barrier_post((unsigned*)(args.ws + WS_CTL) + CW_BAR, (volatile LAS unsigned*)((LAS unsigned char*)lds_raw + MISC_OFF) + 8);

    const int lo = args.ph_lo, hi = args.ph_hi;
    int ph = 0;
#define PHASE_BEGIN() if (ph >= lo && ph < hi) { int z = 0; asm volatile("" : "+s"(z)); unsigned char* const ws = args.ws + z; (void)ws; \
    Ctx C; C.lds = (LAS unsigned char*)lds_raw + z; C.tid = threadIdx.x + z; C.lane = C.tid & 63; C.wid = __builtin_amdgcn_readfirstlane(C.tid >> 6); \
    C.nblk = gridDim.x + z; C.blk = blockIdx.x + z; C.gw = C.blk * NWAVES + C.wid; C.ngw = C.nblk * NWAVES;
#define PHASE_END() if (ph + 1 < hi) { if (ph == 0) grid.sync(); else xcd_barrier(bar); } } ++ph;
#define INP(i) (args.in[(i) + z])
#define WSF(off) ((float*)(ws + (off)))
#define WSB(off) ((bf16raw*)(ws + (off)))

    PHASE_BEGIN() {
        ProPtrs P{INP(I_C), INP(I_CCTX), INP(I_WMOD), INP(I_BMOD), INP(I_AWIN), INP(I_AWOUT), INP(I_DWIN), INP(I_DWOUT), INP(I_W1), INP(I_W2), WSF(WS_MODS), WSF(WS_ROPE),
                  WSB(WS_WT_AIN), WSB(WS_WT_AOUT), WSB(WS_WT_DIN), WSB(WS_WT_DOUT), WSB(WS_WT_W1), WSB(WS_WT_W2)};
        phase_prologue(C, P); } PHASE_END()
    for (int l = 0; l < 4; ++l) {
        const int j = l >> 1;
        PHASE_BEGIN() { const float* mods_l = WSF(WS_MODS) + (size_t)l * 3 * 6144;
            const float* xs_ctx = l == 0 ? INP(I_XP) : WSF(WS_X); const float* xs_lat = l == 0 ? INP(I_XS) : WSF(WS_X) + (size_t)NCTX * D;
            phase_norm(C, xs_ctx, xs_lat, INP(I_N1) + l * D, mods_l, WSB(WS_H)); } PHASE_END()
        if ((l & 1) == 0) {
            PHASE_BEGIN() { pg8::Gemm g{WSB(WS_H), WSB(WS_WT_AIN) + (size_t)j * QKVW * D, MTOK, QKVW, D, z}; pg8::StaticOrder S; S.init(MTOK, QKVW, C.nblk, C.blk);
                pg8::EpiBf16<0> E{WSB(WS_PROJ), QKVW, nullptr, 0, 0, 1.f};
                pg8::gemm_phase<pg8::EpiBf16<0>, pg8::StaticOrder, true, true>(C.lds, g, S, E); } PHASE_END()
            PHASE_BEGIN() { QknPtrs P{WSB(WS_PROJ), WSB(WS_QB), WSB(WS_KB), WSB(WS_VB), INP(I_AQG) + j * 128, INP(I_AKG) + j * 128, WSF(WS_ROPE), INP(I_CK), INP(I_CV), args.out + z};
                phase_qkn(C, P, j); } PHASE_END()
            PHASE_BEGIN() { AttnPtrs P{WSB(WS_QB), WSB(WS_KB), WSB(WS_VB), WSB(WS_Y)}; phase_attn(C, P); } PHASE_END()
        } else {
            PHASE_BEGIN() { pg8::Gemm g{WSB(WS_H), WSB(WS_WT_DIN) + (size_t)j * DNINP * D, MTOK, DNINP, D, z}; pg8::StaticOrder S; S.init(MTOK, DNINP, C.nblk, C.blk);
                pg8::EpiDnIn E{WSB(WS_PROJ), WSF(WS_AB)};
                pg8::gemm_phase<pg8::EpiDnIn, pg8::StaticOrder, true, true>(C.lds, g, S, E); } PHASE_END()
            PHASE_BEGIN() { ConvPtrs P{WSB(WS_PROJ), WSB(WS_CONV), INP(I_DCONV) + (size_t)j * 5 * 3072, INP(I_DALOG) + j * 16, INP(I_DDTB) + j * 16, WSF(WS_AB), WSF(WS_G), WSF(WS_BETA)};
                phase_conv_ref(C, P); } PHASE_END()
            PHASE_BEGIN() { ScanPtrs P{WSB(WS_CONV), WSF(WS_G), WSF(WS_BETA), INP(I_SD), WSB(WS_OF), WSB(WS_OB), args.out + z}; phase_scan_ref(C, P, j); } PHASE_END()
            PHASE_BEGIN() { GatePtrs P{WSB(WS_OF), WSB(WS_OB), WSB(WS_PROJ), WSB(WS_Y), INP(I_DNORM) + j * 128}; phase_gate(C, P); } PHASE_END()
        }
        PHASE_BEGIN() { const float* mods_l = WSF(WS_MODS) + (size_t)l * 3 * 6144;
            const float* xs_ctx = l == 0 ? INP(I_XP) : WSF(WS_X); const float* xs_lat = l == 0 ? INP(I_XS) : WSF(WS_X) + (size_t)NCTX * D;
            pg8::Gemm g{WSB(WS_Y), ((l & 1) ? WSB(WS_WT_DOUT) : WSB(WS_WT_AOUT)) + (size_t)j * D * D, MTOK, D, D, z}; pg8::StaticOrder S; S.init(MTOK, D, C.nblk, C.blk);
            pg8::EpiRes E{xs_ctx, xs_lat, WSF(WS_X), mods_l + 2048};
            pg8::gemm_phase<pg8::EpiRes, pg8::StaticOrder, true, true>(C.lds, g, S, E); } PHASE_END()
        PHASE_BEGIN() { const float* mods_l = WSF(WS_MODS) + (size_t)l * 3 * 6144;
            phase_norm(C, WSF(WS_X), WSF(WS_X) + (size_t)NCTX * D, INP(I_N2) + l * D, mods_l + 3072, WSB(WS_H)); } PHASE_END()
        PHASE_BEGIN() { pg8::Gemm g{WSB(WS_H), WSB(WS_WT_W1) + (size_t)l * FF * D, MTOK, FF, D, z}; pg8::StaticOrder S; S.init(MTOK, FF, C.nblk, C.blk);
            pg8::EpiBf16<2> E{WSB(WS_PROJ), FF, nullptr, 0, 0, 1.f};
            pg8::gemm_phase<pg8::EpiBf16<2>, pg8::StaticOrder, true, true>(C.lds, g, S, E); } PHASE_END()
        PHASE_BEGIN() { const float* mods_l = WSF(WS_MODS) + (size_t)l * 3 * 6144;
            pg8::Gemm g{WSB(WS_PROJ), WSB(WS_WT_W2) + (size_t)l * D * FF, MTOK, D, FF, z}; pg8::StaticOrder S; S.init(MTOK, D, C.nblk, C.blk);
            pg8::EpiRes E{WSF(WS_X), WSF(WS_X) + (size_t)NCTX * D, WSF(WS_X), mods_l + 5120};
            pg8::gemm_phase<pg8::EpiRes, pg8::StaticOrder, true, true>(C.lds, g, S, E); } PHASE_END()
    }
    PHASE_BEGIN() { phase_final(C, WSF(WS_X), INP(I_FN), args.out + z); } PHASE_END()
#undef PHASE_BEGIN
#undef PHASE_END
}

extern "C" void kernel_launch(void* const* d_in, const int* in_sizes, int n_in, void* d_out, int out_size, void* d_ws, size_t ws_size, hipStream_t stream) {
    static int grid = 0;
    if (grid == 0) {
        if (n_in != 24 || ws_size < WS_END) { fprintf(stderr, "kernel_launch: unexpected n_in %d / ws %zu\n", n_in, ws_size); grid = -1; return; }
        int dev = 0, cus = 0, per_cu = 0;
        if (hipGetDevice(&dev) != hipSuccess || hipDeviceGetAttribute(&cus, hipDeviceAttributeMultiprocessorCount, dev) != hipSuccess) { grid = -1; return; }
        if (hipFuncSetAttribute((const void*)mk_fwd, hipFuncAttributeMaxDynamicSharedMemorySize, LDS_BYTES) != hipSuccess) { fprintf(stderr, "kernel_launch: hipFuncSetAttribute failed\n"); grid = -1; return; }
        if (hipOccupancyMaxActiveBlocksPerMultiprocessor(&per_cu, (const void*)mk_fwd, NWAVES * 64, LDS_BYTES) != hipSuccess || per_cu < 1) { fprintf(stderr, "kernel_launch: occupancy query failed (%d)\n", per_cu); (void)hipGetLastError(); grid = -1; return; }
        grid = cus * 1;
    }
    if (grid < 0) return;
    (void)hipMemsetAsync((char*)d_ws + WS_CTL, 0, CTL_ZERO_BYTES, stream);
    Args a; memset(&a, 0, sizeof(a));
    for (int i = 0; i < 24; ++i) a.in[i] = (const float*)d_in[i];
    a.out = (float*)d_out; a.ws = (unsigned char*)d_ws; a.ph_lo = 0; a.ph_hi = 1000;
    void* kargs[] = {&a};
    hipError_t e = hipLaunchCooperativeKernel((const void*)mk_fwd, dim3(grid), dim3(NWAVES * 64), kargs, LDS_BYTES, stream);
    if (e != hipSuccess) fprintf(stderr, "kernel_launch: cooperative launch failed: %s (grid %d)\n", hipGetErrorString(e), grid);
}
```

```cpp
#include <hip/hip_runtime.h>
#include <hip/hip_cooperative_groups.h>
#include <cstdio>
#include <cstdint>
#include <cstring>
namespace cg = cooperative_groups;

constexpr int D = 1024, NCTX = 8192, NLAT = 2048, MTOK = 10240, FF = 4096;
constexpr int QKVW = 1536, DNIN = 4128, DNINP = 4352, PROJW = 4096;
constexpr int KVROWS = 8192 + 2 * 1280;
constexpr float EPS = 1e-6f;
constexpr float ATT_SCALE = 0.08838834764831845f;
constexpr size_t O_Y = 0, O_CK = (size_t)MTOK * D, O_CV = O_CK + 4194304, O_ST = O_CV + 4194304;

typedef unsigned short bf16raw;
typedef float f32x4_t __attribute__((ext_vector_type(4)));
typedef float f32x2_t __attribute__((ext_vector_type(2)));
typedef unsigned u32x4_t __attribute__((ext_vector_type(4)));
typedef unsigned u32x2_t __attribute__((ext_vector_type(2)));

__device__ __forceinline__ unsigned f2bf(float f) { unsigned u = __builtin_bit_cast(unsigned, f); return (u + 0x7fffu + ((u >> 16) & 1u)) >> 16; }
__device__ __forceinline__ unsigned pk2(float lo, float hi) { return f2bf(lo) | (f2bf(hi) << 16); }
__device__ __forceinline__ float bf_lo(unsigned w) { return __builtin_bit_cast(float, w << 16); }
__device__ __forceinline__ float bf_hi(unsigned w) { return __builtin_bit_cast(float, w & 0xffff0000u); }
__device__ __forceinline__ float bf2f(bf16raw h) { return __builtin_bit_cast(float, (unsigned)h << 16); }
__device__ __forceinline__ float silu_f(float x) { return x / (1.f + __expf(-x)); }
__device__ __forceinline__ int cond_of(int row) { return row < NCTX ? 0 : 1 + ((row - NCTX) >> 10); }
__device__ __forceinline__ float lane_xor_f(float v, int lane, int k) { return __builtin_bit_cast(float, __builtin_amdgcn_ds_bpermute((lane ^ k) << 2, __builtin_bit_cast(int, v))); }
__device__ __forceinline__ float wave_sum(float v, int lane) {
#pragma unroll
    for (int o = 1; o < 64; o <<= 1) v += lane_xor_f(v, lane, o);
    return v;
}
__device__ __forceinline__ float wave_max(float v, int lane) {
#pragma unroll
    for (int o = 1; o < 64; o <<= 1) v = fmaxf(v, lane_xor_f(v, lane, o));
    return v;
}
namespace pg8 {
#define PG8_LAS __attribute__((address_space(3)))
typedef unsigned short bf16_t;
typedef short bf16x8 __attribute__((ext_vector_type(8)));
typedef float f32x4 __attribute__((ext_vector_type(4)));
typedef unsigned u32x4 __attribute__((ext_vector_type(4)));
constexpr int BM = 256, BK = 64, HALF = 128, HTB = HALF * BK * 2  , STAGE_BYTES = 8 * HTB, NXCD = 8, WGM = 8;

__host__ __device__ __forceinline__ int lds_byte(int r, int c) { const int st = (r >> 4) * 2 + (c >> 5), rr = r & 15, cc = c & 31, ob = rr * 64 + cc * 2; return st * 1024 + (ob ^ (((ob >> 9) & 1) << 5)); }
__host__ __device__ __forceinline__ void stage_rc(int b, int& R, int& C) { const int st = b / 1024, sb = b % 1024, swz = sb ^ (((sb >> 9) & 1) << 5); R = (st >> 1) * 16 + swz / 64; C = (st & 1) * 32 + (swz % 64) / 2; }
__host__ __device__ __forceinline__ int perm32(int rho) { const int n = rho >> 4, i = rho & 15; return 8 * (i >> 2) + 4 * n + (i & 3); }

struct Unit { int pm, pn; };
struct Gemm { const bf16_t* A; const bf16_t* Bt; int M, N, K; int z; };

struct StaticOrder {
    int nM, nN, nwg, G, c;
    __host__ __device__ void init(int M, int N, int G_, int c_) { nM = M / BM; nN = N / BM; nwg = nM * nN; G = G_; c = c_; }
    __host__ __device__ bool next(int i, Unit& u) const {
        const long L = (long)i * G + c; if (L >= nwg) return false;
        int wgid = (int)L; { const int q = nwg / NXCD, r = nwg % NXCD, xcd = wgid % NXCD, off = wgid / NXCD; wgid = (xcd < r ? xcd * (q + 1) : r * (q + 1) + (xcd - r) * q) + off; }
        const int nig = WGM * nN, gid = wgid / nig, fm = gid * WGM, gsz = (nM - fm) < WGM ? (nM - fm) : WGM;
        u.pm = fm + ((wgid % nig) % gsz); u.pn = (wgid % nig) / gsz; return true;
    }
    __device__ __forceinline__ void a_ready(const Unit&) const {}
    __device__ __forceinline__ void done(const Unit&) const {}
};

__device__ __forceinline__ unsigned cvt_pk_bf16(float lo, float hi) { unsigned r; asm volatile("v_cvt_pk_bf16_f32 %0, %1, %2" : "=v"(r) : "v"(lo), "v"(hi)); return r; }
typedef float f32x2 __attribute__((ext_vector_type(2)));
__device__ __forceinline__ f32x2 gelu_pk(f32x2 v) {
    const f32x2 av = __builtin_elementwise_abs(v), d = av * 0.2316418882f + 1.0f;
    f32x2 t; t.x = __builtin_amdgcn_rcpf(d.x); t.y = __builtin_amdgcn_rcpf(d.y);
    f32x2 q = t * 0.5307027145f + (-0.7265760135f); q = q * t + 0.7107068705f; q = q * t + (-0.142248368f); q = q * t + 0.127414796f; q = q * t;
    const f32x2 s = (v * v) * (-0.72134752044f);
    f32x2 e; e.x = __builtin_amdgcn_exp2f(s.x); e.y = __builtin_amdgcn_exp2f(s.y);
    const f32x2 m = v * (q * e), r = v - m;
    f32x2 o; o.x = v.x < 0.f ? m.x : r.x; o.y = v.y < 0.f ? m.y : r.y; return o;
}

template <int ACT  > struct EpiBf16 {
    static constexpr bool PERM = true, AFTER_DRAIN = false; static_assert(ACT >= 0 && ACT <= 2, "EpiBf16: ACT is 0 (none), 1 (gelu_pk) or 2 (squared relu)");
    bf16_t* O; int ldc; const float* bias; int split_cols; size_t split_stride; float scale0;
    __device__ __forceinline__ void operator()(const f32x4 (&acc)[2][2][4][2], const Unit& u, int wr, int wc, int fr, int fq) const {
        const int row0 = u.pm * BM + wr * 64 + fr; int colt = u.pn * BM; bf16_t* base = O;
        float sc = 1.f; if (split_cols) { const int t = colt / split_cols; base += (size_t)t * split_stride; colt -= t * split_cols; if (t == 0) sc = scale0; }
        const int col0 = colt + wc * 32 + 8 * fq, bcol0 = u.pn * BM + wc * 32 + 8 * fq;
        f32x4 bv[2][2];
#pragma unroll
        for (int bj = 0; bj < 2; ++bj)
#pragma unroll
            for (int n = 0; n < 2; ++n) bv[bj][n] = bias ? *(const f32x4*)(bias + bcol0 + bj * HALF + 4 * n) : (f32x4){0.f, 0.f, 0.f, 0.f};
#pragma unroll
        for (int ai = 0; ai < 2; ++ai)
#pragma unroll
            for (int m = 0; m < 4; ++m) { bf16_t* rowp = base + (size_t)(row0 + ai * HALF + m * 16) * ldc + col0;
#pragma unroll
                for (int bj = 0; bj < 2; ++bj) { f32x4 v0 = acc[ai][bj][m][0] + bv[bj][0], v1 = acc[ai][bj][m][1] + bv[bj][1];
                    if (ACT == 1) { f32x2 a = gelu_pk((f32x2){v0[0], v0[1]}), b = gelu_pk((f32x2){v0[2], v0[3]}), c = gelu_pk((f32x2){v1[0], v1[1]}), d = gelu_pk((f32x2){v1[2], v1[3]});
                        v0 = (f32x4){a.x, a.y, b.x, b.y}; v1 = (f32x4){c.x, c.y, d.x, d.y}; }
                    if (ACT == 2) { v0 = __builtin_elementwise_max(v0, (f32x4){0.f, 0.f, 0.f, 0.f}); v1 = __builtin_elementwise_max(v1, (f32x4){0.f, 0.f, 0.f, 0.f}); v0 = v0 * v0; v1 = v1 * v1; }
                    v0 = v0 * sc; v1 = v1 * sc; u32x4 w; w.x = cvt_pk_bf16(v0[0], v0[1]); w.y = cvt_pk_bf16(v0[2], v0[3]); w.z = cvt_pk_bf16(v1[0], v1[1]); w.w = cvt_pk_bf16(v1[2], v1[3]);
                    *(u32x4*)(rowp + bj * HALF) = w; } }
    }
};

struct PanelStats {
    unsigned* xbuf;
    unsigned* cnt;
    unsigned* tmo;
    int ntn; float eps;
    unsigned code;
    __device__ __forceinline__ bool run(const f32x4 (&v)[2][2][4][2], const Unit& u, int wr, int wc, int fr, int fq, PG8_LAS unsigned char* lds, int wid, int lane) const {
        typedef float f32x2v __attribute__((ext_vector_type(2)));
        PG8_LAS f32x2v* P = (PG8_LAS f32x2v*)lds;
        PG8_LAS f32x2v* S = (PG8_LAS f32x2v*)(lds + 8192);
        PG8_LAS unsigned* flag = (PG8_LAS unsigned*)(lds + 8192 + 2048);
#pragma unroll
        for (int ai = 0; ai < 2; ++ai)
#pragma unroll
            for (int m = 0; m < 4; ++m) {
                float s = 0.f;
#pragma unroll
                for (int bj = 0; bj < 2; ++bj)
#pragma unroll
                    for (int n = 0; n < 2; ++n) { const f32x4 x = v[ai][bj][m][n]; s += (x[0] + x[1]) + (x[2] + x[3]); }
                s += __shfl_xor(s, 16); s += __shfl_xor(s, 32);
                const float mw = s * (1.0f / 64.0f); float q = 0.f;
#pragma unroll
                for (int bj = 0; bj < 2; ++bj)
#pragma unroll
                    for (int n = 0; n < 2; ++n) { const f32x4 d = v[ai][bj][m][n] - mw; q += (d[0] * d[0] + d[1] * d[1]) + (d[2] * d[2] + d[3] * d[3]); }
                q += __shfl_xor(q, 16); q += __shfl_xor(q, 32);
                if (fq == 0) P[(ai * HALF + wr * 64 + m * 16 + fr) * 4 + wc] = (f32x2v){mw, q};
            }
        asm volatile("s_waitcnt lgkmcnt(0)" ::: "memory"); __builtin_amdgcn_s_barrier(); asm volatile("" ::: "memory");
#if defined(BROKEN_EXCHANGE_NO_WAIT)
#warning BROKEN CONTROL BUILD: the row-statistics exchange does not wait; results are wrong by design
        if (blockIdx.x >= 64) { const long long t0_ = clock64(); while (clock64() - t0_ < 60000) __builtin_amdgcn_s_sleep(8); }
#endif
        const int row = wid * 32 + (lane & 31);
        if (lane < 32) {
            const f32x2v a = P[row * 4 + 0], b = P[row * 4 + 1], c = P[row * 4 + 2], d = P[row * 4 + 3];
            const float mt = (a.x + b.x + c.x + d.x) * 0.25f;
            const float da = a.x - mt, db = b.x - mt, dc = c.x - mt, dd = d.x - mt;
            const float m2 = (a.y + b.y) + (c.y + d.y) + 64.0f * ((da * da + db * db) + (dc * dc + dd * dd));
            unsigned long long* slot = (unsigned long long*)xbuf + ((size_t)(u.pm * BM + row) * 4 + u.pn);
            __hip_atomic_store(slot, ((unsigned long long)__float_as_uint(m2) << 32) | __float_as_uint(mt), __ATOMIC_RELAXED, __HIP_MEMORY_SCOPE_AGENT);
        }
        asm volatile("s_waitcnt vmcnt(0)" ::: "memory");
        if (lane == 0) __hip_atomic_fetch_add(cnt + 64 * u.pm, 1u, __ATOMIC_RELAXED, __HIP_MEMORY_SCOPE_AGENT);
        if (wid == 0) {
            bool dead = false; const unsigned long long t0 = __builtin_amdgcn_s_memrealtime(); const unsigned want = 8u * (unsigned)ntn;
            for (;;) {
#if defined(BROKEN_EXCHANGE_NO_WAIT)
                break;
#endif
                if ((unsigned)__builtin_amdgcn_readfirstlane(__hip_atomic_load(cnt + 64 * u.pm, __ATOMIC_RELAXED, __HIP_MEMORY_SCOPE_AGENT)) >= want) break;
                if (__builtin_amdgcn_s_memrealtime() - t0 > 2000000ull) {
                    if (lane == 0) { unsigned expect = 0u; __hip_atomic_compare_exchange_strong(tmo + 1, &expect, code | (unsigned)(u.pm & 0xff), __ATOMIC_RELAXED, __ATOMIC_RELAXED, __HIP_MEMORY_SCOPE_AGENT);
                                     __hip_atomic_store(tmo, 1u, __ATOMIC_RELAXED, __HIP_MEMORY_SCOPE_AGENT); }
                    dead = true; break; }
                __builtin_amdgcn_s_sleep(2);
            }
            __builtin_amdgcn_fence(__ATOMIC_ACQUIRE, "agent");
            if (lane == 0) flag[0] = dead ? 1u : 0u;
        }
        asm volatile("s_waitcnt vmcnt(0) lgkmcnt(0)" ::: "memory"); __builtin_amdgcn_s_barrier(); asm volatile("" ::: "memory");
        const bool bad = flag[0] != 0u;
        if (lane < 32) {
            const unsigned long long* slot = (const unsigned long long*)xbuf + (size_t)(u.pm * BM + row) * 4; float mt[4], m2[4]; float ms = 0.f;
#pragma unroll
            for (int t = 0; t < 4; ++t) { if (t < ntn) { const unsigned long long w = __hip_atomic_load(slot + t, __ATOMIC_RELAXED, __HIP_MEMORY_SCOPE_AGENT); mt[t] = __uint_as_float((unsigned)w); m2[t] = __uint_as_float((unsigned)(w >> 32)); } else { mt[t] = 0.f; m2[t] = 0.f; } ms += mt[t]; }
            const float mean = ms / (float)ntn; float q = 0.f;
#pragma unroll
            for (int t = 0; t < 4; ++t) if (t < ntn) { const float dm = mt[t] - mean; q += m2[t] + 256.0f * dm * dm; }
            S[row] = (f32x2v){mean, 1.0f / sqrtf(q / (256.0f * (float)ntn) + eps)};
        }
        asm volatile("s_waitcnt lgkmcnt(0)" ::: "memory"); __builtin_amdgcn_s_barrier(); asm volatile("" ::: "memory");
        return bad;
    }
};
struct EpiLnRes {
    static constexpr bool PERM = false, AFTER_DRAIN = true;
    const float* base; float* out; int ldc; const float* bias; PanelStats st; unsigned poison;
    __device__ __forceinline__ void fused(f32x4 (&acc)[2][2][4][2], const Unit& u, int wr, int wc, int fr, int fq, PG8_LAS unsigned char* lds, int wid, int lane) const {
        typedef float f32x2v __attribute__((ext_vector_type(2)));
        const PG8_LAS f32x2v* S = (const PG8_LAS f32x2v*)(lds + 8192);
        const int col0 = u.pn * BM + wc * 32 + 4 * fq;
#pragma unroll
        for (int bj = 0; bj < 2; ++bj)
#pragma unroll
            for (int n = 0; n < 2; ++n) { const f32x4 bv = bias ? *(const f32x4*)(bias + col0 + bj * HALF + n * 16) : (f32x4){0.f, 0.f, 0.f, 0.f};
#pragma unroll
                for (int ai = 0; ai < 2; ++ai)
#pragma unroll
                    for (int m = 0; m < 4; ++m) acc[ai][bj][m][n] += bv; }
        f32x4 pre[4][2][2];
#pragma unroll
        for (int m = 0; m < 4; ++m) { const size_t off = (size_t)(u.pm * BM + wr * 64 + m * 16 + fr) * ldc + col0;
#pragma unroll
            for (int bj = 0; bj < 2; ++bj)
#pragma unroll
                for (int n = 0; n < 2; ++n) pre[m][bj][n] = *(const f32x4*)(base + off + bj * HALF + n * 16); }
        const bool bad = st.run(acc, u, wr, wc, fr, fq, lds, wid, lane) || poison != 0u;
        const float qnan = __builtin_nanf("");
#pragma unroll
        for (int ai = 0; ai < 2; ++ai)
#pragma unroll
            for (int m = 0; m < 4; ++m) { const int r = ai * HALF + wr * 64 + m * 16 + fr; const f32x2v sr = S[r]; const size_t off = (size_t)(u.pm * BM + r) * ldc + col0;
#pragma unroll
                for (int bj = 0; bj < 2; ++bj)
#pragma unroll
                    for (int n = 0; n < 2; ++n) { const f32x4 bs = ai == 0 ? pre[m][bj][n] : *(const f32x4*)(base + off + bj * HALF + n * 16); f32x4 o = bs + (acc[ai][bj][m][n] - sr.x) * sr.y;
                        if (bad) o = (f32x4){qnan, qnan, qnan, qnan}; *(f32x4*)(out + off + bj * HALF + n * 16) = o; }
                if (m & 1) asm volatile("" ::: "memory"); }
    }
};
struct EpiLnResLn {
    static constexpr bool PERM = false, AFTER_DRAIN = true;
    const float* base; float* out; bf16_t* xn; int ldc; const float* bias; PanelStats st1, st2; unsigned poison;
    __device__ __forceinline__ void fused(f32x4 (&acc)[2][2][4][2], const Unit& u, int wr, int wc, int fr, int fq, PG8_LAS unsigned char* lds, int wid, int lane) const {
        typedef float f32x2v __attribute__((ext_vector_type(2))); typedef unsigned u32x2v __attribute__((ext_vector_type(2)));
        const PG8_LAS f32x2v* S = (const PG8_LAS f32x2v*)(lds + 8192);
        const int col0 = u.pn * BM + wc * 32 + 4 * fq;
#pragma unroll
        for (int bj = 0; bj < 2; ++bj)
#pragma unroll
            for (int n = 0; n < 2; ++n) { const f32x4 bv = bias ? *(const f32x4*)(bias + col0 + bj * HALF + n * 16) : (f32x4){0.f, 0.f, 0.f, 0.f};
#pragma unroll
                for (int ai = 0; ai < 2; ++ai)
#pragma unroll
                    for (int m = 0; m < 4; ++m) acc[ai][bj][m][n] += bv; }
        bool bad = st1.run(acc, u, wr, wc, fr, fq, lds, wid, lane) || poison != 0u;
        const float qnan = __builtin_nanf("");
#pragma unroll
        for (int ai = 0; ai < 2; ++ai)
#pragma unroll
            for (int m = 0; m < 4; ++m) { const int r = ai * HALF + wr * 64 + m * 16 + fr; const f32x2v sr = S[r]; const size_t off = (size_t)(u.pm * BM + r) * ldc + col0;
#pragma unroll
                for (int bj = 0; bj < 2; ++bj)
#pragma unroll
                    for (int n = 0; n < 2; ++n) { const f32x4 bs = *(const f32x4*)(base + off + bj * HALF + n * 16); acc[ai][bj][m][n] = bs + (acc[ai][bj][m][n] - sr.x) * sr.y; }
                asm volatile("" : "+v"(acc[ai][0][m][0]), "+v"(acc[ai][0][m][1]), "+v"(acc[ai][1][m][0]), "+v"(acc[ai][1][m][1]));
                if (m & 1) asm volatile("" ::: "memory"); }
        const bool bad1 = bad;
        bad = st2.run(acc, u, wr, wc, fr, fq, lds, wid, lane) || bad;
#pragma unroll
        for (int ai = 0; ai < 2; ++ai)
#pragma unroll
            for (int m = 0; m < 4; ++m) { const int r = ai * HALF + wr * 64 + m * 16 + fr; const f32x2v sr = S[r]; const size_t off = (size_t)(u.pm * BM + r) * ldc + col0;
#pragma unroll
                for (int bj = 0; bj < 2; ++bj)
#pragma unroll
                    for (int n = 0; n < 2; ++n) { const f32x4 x1 = acc[ai][bj][m][n]; *(f32x4*)(out + off + bj * HALF + n * 16) = bad1 ? (f32x4){qnan, qnan, qnan, qnan} : x1;
                        const f32x4 o = (x1 - sr.x) * sr.y; u32x2v w; w.x = cvt_pk_bf16(o[0], o[1]); w.y = cvt_pk_bf16(o[2], o[3]);
                        if (bad) { w.x = 0x7fc07fc0u; w.y = 0x7fc07fc0u; } *(u32x2v*)(xn + off + bj * HALF + n * 16) = w; }
                asm volatile("" ::: "memory"); }
    }
};

template <class Epi, class Sched, bool ALIGN_EPI = false, bool SP2 = false>
__device__ __forceinline__ void gemm_phase(PG8_LAS unsigned char* lds, const Gemm g, const Sched& S, const Epi& E) {
    const int tid = threadIdx.x + g.z, wid = __builtin_amdgcn_readfirstlane(tid >> 6), lane = tid & 63, wr = wid >> 2, wc = wid & 3, fr = lane & 15, fq = lane >> 4;
    const int K = g.K, nt = K / BK;
    unsigned voffA[2], voffB[2];
#pragma unroll
    for (int i = 0; i < 2; ++i) { int R, C; stage_rc(tid * 16 + i * 8192, R, C); const int Rb = Epi::PERM ? ((R & ~31) + perm32(R & 31)) : R;
        voffA[i] = (unsigned)(R * K + C) * 2u; voffB[i] = (unsigned)(Rb * K + C) * 2u; }
    const size_t kstep = (size_t)(BK * 2);
    const size_t hstep = (size_t)HALF * K * 2;
    const size_t tstep = 2 * hstep;
    const unsigned ldsw = (unsigned)wid * 1024u;
    const int aoff = lds_byte(wr * 64 + fr, fq * 8), boff = lds_byte(wc * 32 + fr, fq * 8);
#define PG8_SA(b, h) (((b) * 2 + (h)) * HTB)
#define PG8_SB(b, h) ((4 + (b) * 2 + (h)) * HTB)
#define PG8_STAGE(bufoff, gbase, voff) do { _Pragma("unroll") for (int _i = 0; _i < 2; ++_i) \
        __builtin_amdgcn_global_load_lds((const unsigned*)((const char*)(gbase) + (voff)[_i]), (PG8_LAS unsigned*)(lds + (bufoff) + ldsw + _i * 8192), 16, 0, 0); } while (0)
#define PG8_LDA(dst, b, h) do { _Pragma("unroll") for (int m = 0; m < 4; ++m) _Pragma("unroll") for (int k = 0; k < 2; ++k) dst[m][k] = *(const PG8_LAS bf16x8*)(lds + PG8_SA(b, h) + aoff + m * 2048 + k * 1024); } while (0)
#define PG8_LDB(dst, b, h) do { _Pragma("unroll") for (int n = 0; n < 2; ++n) _Pragma("unroll") for (int k = 0; k < 2; ++k) dst[n][k] = *(const PG8_LAS bf16x8*)(lds + PG8_SB(b, h) + boff + n * 2048 + k * 1024); } while (0)
#define PG8_MMA(ai, bj, At, Bt) do { __builtin_amdgcn_s_setprio(1); _Pragma("unroll") for (int m = 0; m < 4; ++m) _Pragma("unroll") for (int n = 0; n < 2; ++n) _Pragma("unroll") for (int k = 0; k < 2; ++k) \
        acc[ai][bj][m][n] = __builtin_amdgcn_mfma_f32_16x16x32_bf16(Bt[n][k], At[m][k], acc[ai][bj][m][n], 0, 0, 0); __builtin_amdgcn_s_setprio(0); } while (0)
#define PG8_WAIT_V(n) asm volatile("s_waitcnt vmcnt(" #n ")" ::: "memory")
#define PG8_WAIT_L(n) asm volatile("s_waitcnt lgkmcnt(" #n ")" ::: "memory")
#define PG8_BAR __builtin_amdgcn_s_barrier()
#define PG8_SCHED __builtin_amdgcn_sched_barrier(0)
    Unit cur, nxt; int ui = 0;
    if (!S.next(0, cur)) return;
    f32x4 acc[2][2][4][2];
#pragma unroll
    for (int a = 0; a < 2; ++a)
#pragma unroll
        for (int b = 0; b < 2; ++b)
#pragma unroll
            for (int m = 0; m < 4; ++m)
#pragma unroll
                for (int n = 0; n < 2; ++n) acc[a][b][m][n] = (f32x4){0.f, 0.f, 0.f, 0.f};
    bf16x8 At[4][2], B0[2][2], B1[2][2];
    const char* cA = (const char*)g.A + (size_t)cur.pm * tstep; const char* cB = (const char*)g.Bt + (size_t)cur.pn * tstep;
    S.a_ready(cur);
    if constexpr (SP2) {
        PG8_STAGE(PG8_SB(0, 0), cB, voffB); PG8_STAGE(PG8_SB(0, 1), cB + hstep, voffB); PG8_STAGE(PG8_SA(0, 0), cA, voffA); PG8_STAGE(PG8_SA(0, 1), cA + hstep, voffA);
        if (wr == 1) PG8_BAR;
        PG8_WAIT_V(2); PG8_BAR;
        PG8_STAGE(PG8_SB(1, 0), cB + kstep, voffB); PG8_STAGE(PG8_SA(1, 0), cA + kstep, voffA); PG8_STAGE(PG8_SB(1, 1), cB + hstep + kstep, voffB);
        PG8_WAIT_V(6); PG8_BAR;
    } else {
        PG8_STAGE(PG8_SB(0, 0), cB, voffB); PG8_STAGE(PG8_SA(0, 0), cA, voffA); PG8_STAGE(PG8_SB(0, 1), cB + hstep, voffB); PG8_STAGE(PG8_SA(0, 1), cA + hstep, voffA);
        if (wr == 1) PG8_BAR;
        PG8_WAIT_V(4); PG8_BAR;
        PG8_STAGE(PG8_SB(1, 0), cB + kstep, voffB); PG8_STAGE(PG8_SA(1, 0), cA + kstep, voffA); PG8_STAGE(PG8_SB(1, 1), cB + hstep + kstep, voffB);
        PG8_WAIT_V(6); PG8_BAR;
    }
    for (;;) {
        const bool has_next = S.next(ui + 1, nxt);
        const char* nA = has_next ? (const char*)g.A + (size_t)nxt.pm * tstep : cA; const char* nB = has_next ? (const char*)g.Bt + (size_t)nxt.pn * tstep : cB;
        for (int t = 0; t < nt; t += 2) {
            const bool last = (t == nt - 2);
            const char* a1 = cA + (size_t)(t + 1) * kstep;
            const char* a2 = last ? nA : cA + (size_t)(t + 2) * kstep; const char* b2 = last ? nB : cB + (size_t)(t + 2) * kstep;
            const char* a3 = a2 + kstep; const char* b3 = b2 + kstep;
            if (last && has_next) S.a_ready(nxt);
            if constexpr (SP2) {
            PG8_LDB(B0, 0, 0); PG8_LDB(B1, 0, 1); PG8_SCHED; PG8_LDA(At, 0, 0); PG8_STAGE(PG8_SA(1, 1), a1 + hstep, voffA);
            PG8_WAIT_V(8); PG8_WAIT_L(0); PG8_BAR; PG8_MMA(0, 0, At, B0); PG8_MMA(0, 1, At, B1); PG8_BAR; PG8_SCHED;
            PG8_LDA(At, 0, 1); PG8_STAGE(PG8_SB(0, 0), b2, voffB); PG8_STAGE(PG8_SB(0, 1), b2 + hstep, voffB); PG8_STAGE(PG8_SA(0, 0), a2, voffA);
            PG8_WAIT_V(8); PG8_WAIT_L(0); PG8_BAR; PG8_MMA(1, 0, At, B0); PG8_MMA(1, 1, At, B1); PG8_BAR; PG8_SCHED;
            PG8_LDB(B0, 1, 0); PG8_LDB(B1, 1, 1); PG8_SCHED; PG8_LDA(At, 1, 0); PG8_STAGE(PG8_SA(0, 1), a2 + hstep, voffA);
            PG8_WAIT_V(8); PG8_WAIT_L(0); PG8_BAR; PG8_MMA(0, 0, At, B0); PG8_MMA(0, 1, At, B1); PG8_BAR; PG8_SCHED;
            PG8_LDA(At, 1, 1); PG8_STAGE(PG8_SB(1, 0), b3, voffB); PG8_STAGE(PG8_SB(1, 1), b3 + hstep, voffB); PG8_STAGE(PG8_SA(1, 0), a3, voffA);
            PG8_WAIT_V(8); PG8_WAIT_L(0); PG8_BAR; PG8_MMA(1, 0, At, B0); PG8_MMA(1, 1, At, B1); PG8_BAR; PG8_SCHED;
            } else {
            PG8_LDB(B0, 0, 0); PG8_SCHED; PG8_LDA(At, 0, 0); PG8_STAGE(PG8_SA(1, 1), a1 + hstep, voffA);
            PG8_WAIT_L(8); PG8_BAR; PG8_WAIT_L(0); PG8_MMA(0, 0, At, B0); PG8_BAR; PG8_SCHED;
            PG8_LDB(B1, 0, 1); PG8_STAGE(PG8_SB(0, 0), b2, voffB);
            PG8_BAR; PG8_WAIT_L(0); PG8_MMA(0, 1, At, B1); PG8_BAR;
            PG8_LDA(At, 0, 1); PG8_STAGE(PG8_SA(0, 0), a2, voffA);
            PG8_BAR; PG8_WAIT_L(0); PG8_MMA(1, 0, At, B0); PG8_BAR; PG8_SCHED;
            PG8_STAGE(PG8_SB(0, 1), b2 + hstep, voffB);
            PG8_WAIT_V(6); PG8_BAR; PG8_MMA(1, 1, At, B1); PG8_BAR;
            PG8_LDB(B0, 1, 0); PG8_SCHED; PG8_LDA(At, 1, 0); PG8_STAGE(PG8_SA(0, 1), a2 + hstep, voffA);
            PG8_WAIT_L(8); PG8_BAR; PG8_WAIT_L(0); PG8_MMA(0, 0, At, B0); PG8_BAR; PG8_SCHED;
            PG8_LDB(B1, 1, 1); PG8_STAGE(PG8_SB(1, 0), b3, voffB);
            PG8_BAR; PG8_WAIT_L(0); PG8_MMA(0, 1, At, B1); PG8_BAR;
            PG8_LDA(At, 1, 1); PG8_STAGE(PG8_SA(1, 0), a3, voffA);
            PG8_BAR; PG8_WAIT_L(0); PG8_MMA(1, 0, At, B0); PG8_BAR; PG8_SCHED;
            PG8_STAGE(PG8_SB(1, 1), b3 + hstep, voffB);
            PG8_WAIT_V(6); PG8_BAR; PG8_MMA(1, 1, At, B1); PG8_BAR;
            }
        }
        if constexpr (ALIGN_EPI) { if (wr == 0) PG8_BAR; }
        if constexpr (!Epi::AFTER_DRAIN) { E(acc, cur, wr, wc, fr, fq); S.done(cur); }
        if (!has_next) break;
#pragma unroll
        for (int a = 0; a < 2; ++a)
#pragma unroll
            for (int b = 0; b < 2; ++b)
#pragma unroll
                for (int m = 0; m < 4; ++m)
#pragma unroll
                    for (int n = 0; n < 2; ++n) acc[a][b][m][n] = (f32x4){0.f, 0.f, 0.f, 0.f};
        cur = nxt; cA = nA; cB = nB; ++ui;
        if constexpr (ALIGN_EPI) { if (wr == 1) PG8_BAR; }
    }
    PG8_WAIT_V(0);
    if constexpr (!ALIGN_EPI) { if (wr == 0) PG8_BAR; }
    PG8_BAR;
    if constexpr (Epi::AFTER_DRAIN) { E.fused(acc, cur, wr, wc, fr, fq, lds, wid, lane); S.done(cur); }
#undef PG8_SA
#undef PG8_SB
#undef PG8_STAGE
#undef PG8_LDA
#undef PG8_LDB
#undef PG8_MMA
#undef PG8_WAIT_V
#undef PG8_WAIT_L
#undef PG8_BAR
#undef PG8_SCHED
}
}

#ifndef PG8_SP2
#define PG8_SP2 true
#endif
#ifndef PG8_ALIGN
#define PG8_ALIGN true
#endif
namespace pg8 {
struct EpiRes {
    static constexpr bool PERM = false, AFTER_DRAIN = false;
    const float* src_ctx; const float* src_lat; float* X; const float* gate;
    __device__ __forceinline__ void operator()(const f32x4 (&acc)[2][2][4][2], const Unit& u, int wr, int wc, int fr, int fq) const {
        const int cond = u.pm < 32 ? 0 : 1 + ((u.pm - 32) >> 2);
        const float* g = gate + cond * 6144;
        const float* sb = u.pm < 32 ? src_ctx + (size_t)u.pm * BM * 1024 : src_lat + (size_t)(u.pm - 32) * BM * 1024;
        float* xb = X + (size_t)u.pm * BM * 1024;
        const int col0 = u.pn * BM + wc * 32 + 4 * fq;
        f32x4 gv[2][2];
#pragma unroll
        for (int bj = 0; bj < 2; ++bj)
#pragma unroll
            for (int n = 0; n < 2; ++n) gv[bj][n] = *(const f32x4*)(g + col0 + bj * HALF + n * 16);
#pragma unroll
        for (int ai = 0; ai < 2; ++ai)
#pragma unroll
            for (int m = 0; m < 4; ++m) { const size_t off = (size_t)(ai * HALF + wr * 64 + m * 16 + fr) * 1024 + col0;
#pragma unroll
                for (int bj = 0; bj < 2; ++bj)
#pragma unroll
                    for (int n = 0; n < 2; ++n) { const f32x4 xv = *(const f32x4*)(sb + off + bj * HALF + n * 16);
                        *(f32x4*)(xb + off + bj * HALF + n * 16) = xv + gv[bj][n] * acc[ai][bj][m][n]; } }
    }
};
struct EpiDnIn {
    static constexpr bool PERM = true, AFTER_DRAIN = false;
    bf16_t* O; float* AB;
    __device__ __forceinline__ void operator()(const f32x4 (&acc)[2][2][4][2], const Unit& u, int wr, int wc, int fr, int fq) const {
        const int row0 = u.pm * BM + wr * 64 + fr;
        if (u.pn < 16) {
            const int col0 = u.pn * BM + wc * 32 + 8 * fq;
#pragma unroll
            for (int ai = 0; ai < 2; ++ai)
#pragma unroll
                for (int m = 0; m < 4; ++m) { bf16_t* rowp = O + (size_t)(row0 + ai * HALF + m * 16) * 4096 + col0;
#pragma unroll
                    for (int bj = 0; bj < 2; ++bj) { const f32x4 v0 = acc[ai][bj][m][0], v1 = acc[ai][bj][m][1];
                        u32x4 w; w.x = cvt_pk_bf16(v0[0], v0[1]); w.y = cvt_pk_bf16(v0[2], v0[3]); w.z = cvt_pk_bf16(v1[0], v1[1]); w.w = cvt_pk_bf16(v1[2], v1[3]);
                        *(u32x4*)(rowp + bj * HALF) = w; } }
        } else if (wc == 0) {
#pragma unroll
            for (int ai = 0; ai < 2; ++ai)
#pragma unroll
                for (int m = 0; m < 4; ++m) { float* rp = AB + (size_t)(row0 + ai * HALF + m * 16) * 32 + 8 * fq;
                    *(f32x4*)rp = acc[ai][0][m][0]; *(f32x4*)(rp + 4) = acc[ai][0][m][1]; }
        }
    }
};
}
#include <hip/hip_bf16.h>
namespace attn {
using bf16 = __hip_bfloat16;
constexpr int D = 128, NW = 8, QBLK = 32, KVBLK = 64;
constexpr float SCALE = 0.088388347648318440f;
constexpr float THR = 8.f;
constexpr int SDEPTH = 2;
constexpr int LDQ = 1024, LDK = 256, LDO = 1024;
constexpr size_t SHM_V = KVBLK * D * 2, SHM_K = KVBLK * D * 2, SHM_ATTN = 2 * SHM_V + 2 * SHM_K + NW * 64 * 4;
using bf16x8 = __attribute__((ext_vector_type(8))) short;
using s16x4  = __attribute__((ext_vector_type(4))) short;
using f32x16 = __attribute__((ext_vector_type(16))) float;
using f32x8  = __attribute__((ext_vector_type(8))) float;
using u32x4  = __attribute__((ext_vector_type(4))) unsigned;
#define KSWZ(row, colB) ((row) * 256 + ((colB) ^ (((row) & 7) << 4)))
#define SBAR() __builtin_amdgcn_sched_barrier(0)
__device__ __forceinline__ int crow(int r, int hi) { return (r & 3) + 8 * (r >> 2) + 4 * hi; }
__device__ __forceinline__ unsigned cvtpk(float lo, float hi) {
  unsigned r; asm volatile("v_cvt_pk_bf16_f32 %0, %1, %2" : "=v"(r) : "v"(lo), "v"(hi)); return r;
}
template <typename TIn> struct Stage;
template <> struct Stage<bf16>  { using T = bf16x8;
  __device__ static __forceinline__ T ld8(const bf16* p) { return *reinterpret_cast<const bf16x8*>(p); }
  __device__ static __forceinline__ bf16x8 tobf(T x) { return x; } };
template <> struct Stage<float> { using T = f32x8;
  __device__ static __forceinline__ T ld8(const float* p) { return *reinterpret_cast<const f32x8*>(p); }
  __device__ static __forceinline__ bf16x8 tobf(T x) {
    u32x4 w = {cvtpk(x[0], x[1]), cvtpk(x[2], x[3]), cvtpk(x[4], x[5]), cvtpk(x[6], x[7])}; return *reinterpret_cast<bf16x8*>(&w); } };

__device__ __forceinline__ void partialSM(f32x16& p0, f32x16& p1, float& m_reg, float& mn, float& alpha) {
  constexpr float C = SCALE * 1.4426950408889634f;
  float pmax = p0[0]; for (int r = 1; r < 16; ++r) pmax = fmaxf(pmax, p0[r]); for (int r = 0; r < 16; ++r) pmax = fmaxf(pmax, p1[r]);
  { auto rr = __builtin_amdgcn_permlane32_swap(__float_as_uint(pmax), __float_as_uint(pmax), false, false);
    pmax = fmaxf(__uint_as_float(rr[0]), __uint_as_float(rr[1])); }
  if (__builtin_expect(__all(pmax - m_reg <= THR / SCALE), 1)) { mn = m_reg; alpha = 1.f; }
  else { mn = fmaxf(m_reg, pmax); alpha = __builtin_amdgcn_exp2f((m_reg - mn) * C); m_reg = mn; }
  float mnC = -mn * C;
  for (int r = 0; r < 16; ++r) p0[r] = fmaf(p0[r], C, mnC); for (int r = 0; r < 16; ++r) p1[r] = fmaf(p1[r], C, mnC);
  for (int r = 0; r < 16; ++r) p0[r] = __builtin_amdgcn_exp2f(p0[r]);
}
__device__ __forceinline__ void finishSM(f32x16& p0, f32x16& p1, float alpha, float& l_reg, bf16x8& pa0, bf16x8& pa1, bf16x8& pa2, bf16x8& pa3) {
  for (int r = 0; r < 16; ++r) p1[r] = __builtin_amdgcn_exp2f(p1[r]);
  float ps = 0; for (int r = 0; r < 16; ++r) ps += p0[r]; for (int r = 0; r < 16; ++r) ps += p1[r];
  { auto rr = __builtin_amdgcn_permlane32_swap(__float_as_uint(ps), __float_as_uint(ps), false, false);
    ps = __uint_as_float(rr[0]) + __uint_as_float(rr[1]); }
  l_reg = l_reg * alpha + ps;
#define PK4(P, BASE, OUT) do { unsigned a0 = cvtpk(P[BASE + 0], P[BASE + 1]), a1 = cvtpk(P[BASE + 2], P[BASE + 3]);   \
    unsigned b0 = cvtpk(P[BASE + 4], P[BASE + 5]), b1 = cvtpk(P[BASE + 6], P[BASE + 7]);                              \
    auto r0 = __builtin_amdgcn_permlane32_swap(a0, b0, false, false); auto r1 = __builtin_amdgcn_permlane32_swap(a1, b1, false, false); \
    u32x4 w = {r0[0], r1[0], r0[1], r1[1]}; OUT = *reinterpret_cast<bf16x8*>(&w); } while (0)
  PK4(p0, 0, pa0); PK4(p0, 8, pa1); PK4(p1, 0, pa2); PK4(p1, 8, pa3);
#undef PK4
}
__device__ __forceinline__ void qkt(f32x16& p0, f32x16& p1, const bf16* Ks, const bf16x8* qr, int r32, int hi) {
  p0 = f32x16{}; p1 = f32x16{};
  for (int d0 = 0; d0 < 8; ++d0) { int cb = (d0 * 16 + hi * 8) * 2;
    bf16x8 b0 = *reinterpret_cast<const bf16x8*>((const char*)Ks + KSWZ(r32, cb));
    bf16x8 b1 = *reinterpret_cast<const bf16x8*>((const char*)Ks + KSWZ(32 + r32, cb));
    p0 = __builtin_amdgcn_mfma_f32_32x32x16_bf16(b0, qr[d0], p0, 0, 0, 0);
    p1 = __builtin_amdgcn_mfma_f32_32x32x16_bf16(b1, qr[d0], p1, 0, 0, 0); }
}
__device__ __forceinline__ int v_st(int k, int c) { const int kk = (k & ~0xC) | ((k & 4) << 1) | ((k & 8) >> 1); return ((kk >> 3) * 4 + (c >> 5)) * 512 + ((kk & 7) * 32 + (c & 31)) * 2; }
__device__ __forceinline__ int v_rd_base(int lane) { return ((lane & 3) << 3) | (((lane >> 2) & 3) << 6) | (((lane >> 4) & 1) << 5) | (((lane >> 5) & 1) << 8); }
constexpr int v_rd_off(int d0, int ks, int half) { return d0 * 512 + ks * 4096 + half * 2048; }
template <int OFF> __device__ __forceinline__ s16x4 tr_read(int vb) {
  s16x4 r; asm volatile("ds_read_b64_tr_b16 %0, %1 offset:%2" : "=&v"(r) : "v"(vb), "i"(OFF) : "memory"); return r;
}
template <int D0> __device__ __forceinline__ void pv_one(f32x16& od, int vb, bf16x8 pa0, bf16x8 pa1, bf16x8 pa2, bf16x8 pa3) {
  const s16x4 l0 = tr_read<v_rd_off(D0, 0, 0)>(vb), h0 = tr_read<v_rd_off(D0, 0, 1)>(vb), l1 = tr_read<v_rd_off(D0, 1, 0)>(vb), h1 = tr_read<v_rd_off(D0, 1, 1)>(vb);
  const s16x4 l2 = tr_read<v_rd_off(D0, 2, 0)>(vb), h2 = tr_read<v_rd_off(D0, 2, 1)>(vb), l3 = tr_read<v_rd_off(D0, 3, 0)>(vb), h3 = tr_read<v_rd_off(D0, 3, 1)>(vb);
  asm volatile("s_waitcnt lgkmcnt(0)" ::: "memory"); SBAR();
#define PK(L, H) (bf16x8){L[0], L[1], L[2], L[3], H[0], H[1], H[2], H[3]}
  od = __builtin_amdgcn_mfma_f32_32x32x16_bf16(pa0, PK(l0, h0), od, 0, 0, 0);
  od = __builtin_amdgcn_mfma_f32_32x32x16_bf16(pa1, PK(l1, h1), od, 0, 0, 0);
  od = __builtin_amdgcn_mfma_f32_32x32x16_bf16(pa2, PK(l2, h2), od, 0, 0, 0);
  od = __builtin_amdgcn_mfma_f32_32x32x16_bf16(pa3, PK(l3, h3), od, 0, 0, 0);
#undef PK
}
__device__ __forceinline__ void pv_d0(f32x16* o, int vb, bf16x8 pa0, bf16x8 pa1, bf16x8 pa2, bf16x8 pa3) {
  pv_one<0>(o[0], vb, pa0, pa1, pa2, pa3); pv_one<1>(o[1], vb, pa0, pa1, pa2, pa3); pv_one<2>(o[2], vb, pa0, pa1, pa2, pa3); pv_one<3>(o[3], vb, pa0, pa1, pa2, pa3);
}

template <typename TQ>
__device__ __forceinline__ void attn_dense_body(const TQ* __restrict__ Qb, const bf16* __restrict__ Kh, const bf16* __restrict__ Vh,
                                                unsigned short* __restrict__ Ob, int seq, char* lds, const int tid) {
  using St = Stage<bf16>; using SQ = Stage<TQ>;
  const int wid = tid >> 6, lane = tid & 63, r32 = lane & 31, hi = lane >> 5;
  bf16* V_lds = (bf16*)lds; bf16* K_lds = (bf16*)(lds + 2 * SHM_V);
  float* ws = (float*)(lds + 2 * SHM_V + 2 * SHM_K) + wid * 64; float* li_l = ws; float* al_l = ws + 32;
  float m_reg = -1e30f, l_reg = 0; f32x16 o[4] = {}; bf16x8 qr[8];
  const TQ* Qw = Qb + (int)(wid * QBLK + r32) * LDQ + hi * 8;
#pragma unroll
  for (int d0 = 0; d0 < 8; ++d0) qr[d0] = SQ::tobf(SQ::ld8(Qw + d0 * 16));
  const int sr = tid >> 4, sc = (tid & 15) * 8, vst0 = v_st(sr, sc), vst1 = v_st(32 + sr, sc);
  const int vb0 = (int)(uintptr_t)V_lds + v_rd_base(lane);
  struct { typename St::T vs0, vs1, ks0, ks1; } sr_[SDEPTH];
#define SLOAD(i, k0) do { sr_[i].vs0 = St::ld8(&Vh[(int)((k0) + sr) * LDK + sc]); sr_[i].vs1 = St::ld8(&Vh[(int)((k0) + 32 + sr) * LDK + sc]); \
    sr_[i].ks0 = St::ld8(&Kh[(int)((k0) + sr) * LDK + sc]); sr_[i].ks1 = St::ld8(&Kh[(int)((k0) + 32 + sr) * LDK + sc]); } while (0)
#define SWRITE(b, i) do { *(bf16x8*)((char*)V_lds + (b) * SHM_V + vst0) = St::tobf(sr_[i].vs0);          \
    *(bf16x8*)((char*)V_lds + (b) * SHM_V + vst1) = St::tobf(sr_[i].vs1); int kc = sc * 2;               \
    *(bf16x8*)((char*)K_lds + (b) * SHM_K + KSWZ(sr, kc)) = St::tobf(sr_[i].ks0);                       \
    *(bf16x8*)((char*)K_lds + (b) * SHM_K + KSWZ(32 + sr, kc)) = St::tobf(sr_[i].ks1); } while (0)
#define SWAIT() do { if constexpr (SDEPTH == 2) asm volatile("s_waitcnt vmcnt(4)" ::: "memory"); else asm volatile("s_waitcnt vmcnt(0)" ::: "memory"); } while (0)
#define RESC(a) do { if (__any((a) < 1.f)) { if (hi == 0) al_l[r32] = (a); asm volatile("s_waitcnt lgkmcnt(0)" ::: "memory"); \
    for (int d = 0; d < 4; ++d) for (int r = 0; r < 16; ++r) o[d][r] *= al_l[crow(r, hi)]; } } while (0)
  f32x16 pA0, pA1, pB0, pB1; float mnA, mnB, alA, alB; bf16x8 pa0, pa1, pa2, pa3; const int NT = seq / KVBLK;
  constexpr int SE = 0, SO = SDEPTH - 1;
  SLOAD(SE, 0); asm volatile("s_waitcnt vmcnt(0)" ::: "memory"); SWRITE(0, SE); __syncthreads();
  qkt(pA0, pA1, K_lds, qr, r32, hi); partialSM(pA0, pA1, m_reg, mnA, alA);
  SLOAD(SO, KVBLK); if constexpr (SDEPTH == 2) { if (2 < NT) SLOAD(SE, 2 * KVBLK); }
  SWAIT(); SWRITE(1, SO); __syncthreads();
  for (int j = 1; j + 1 < NT; j += 2) {
    SBAR(); qkt(pB0, pB1, (bf16*)((char*)K_lds + SHM_K), qr, r32, hi);
    finishSM(pA0, pA1, alA, l_reg, pa0, pa1, pa2, pa3); SBAR();
    SLOAD(SO, (j + SDEPTH) * KVBLK); SBAR();
    pv_d0(o, vb0, pa0, pa1, pa2, pa3); partialSM(pB0, pB1, m_reg, mnB, alB);
    __syncthreads(); SWAIT(); SWRITE(0, SE);
    RESC(alB); __syncthreads();
    SBAR(); qkt(pA0, pA1, K_lds, qr, r32, hi);
    finishSM(pB0, pB1, alB, l_reg, pa0, pa1, pa2, pa3); SBAR();
    if (SDEPTH == 1 || j + 3 < NT) SLOAD(SE, (j + 1 + SDEPTH) * KVBLK); SBAR();
    pv_d0(o, vb0 + (int)SHM_V, pa0, pa1, pa2, pa3); partialSM(pA0, pA1, m_reg, mnA, alA);
    __syncthreads(); SWAIT(); SWRITE(1, SO);
    RESC(alA); __syncthreads();
  }
  SBAR(); qkt(pB0, pB1, (bf16*)((char*)K_lds + SHM_K), qr, r32, hi);
  finishSM(pA0, pA1, alA, l_reg, pa0, pa1, pa2, pa3); SBAR();
  pv_d0(o, vb0, pa0, pa1, pa2, pa3); partialSM(pB0, pB1, m_reg, mnB, alB);
  __syncthreads(); RESC(alB);
  finishSM(pB0, pB1, alB, l_reg, pa0, pa1, pa2, pa3); SBAR();
  pv_d0(o, vb0 + (int)SHM_V, pa0, pa1, pa2, pa3);
  if (hi == 0) li_l[r32] = l_reg; asm volatile("s_waitcnt lgkmcnt(0)" ::: "memory");
  float rli[16];
#pragma unroll
  for (int r = 0; r < 16; ++r) rli[r] = __builtin_amdgcn_rcpf(li_l[crow(r, hi)]);
  unsigned short* Ow = Ob + (int)(wid * QBLK) * LDO;
#pragma unroll
  for (int r = 0; r < 16; ++r) { int orow = crow(r, hi);
    for (int d0 = 0; d0 < 4; ++d0) Ow[(int)orow * LDO + d0 * 32 + r32] = (unsigned short)f2bf(o[d0][r] * rli[r]); }
#undef SLOAD
#undef SWRITE
#undef SWAIT
#undef RESC
}

#undef KSWZ
#undef SBAR
}
#define LAS __attribute__((address_space(3)))
constexpr int NWAVES = 8;
constexpr int LDS_BYTES = 147456;
constexpr size_t MiB = (size_t)1 << 20;
constexpr size_t WS_CTL = 0, CTL_ZERO_BYTES = 1 * MiB;
constexpr size_t WS_MODS = 1 * MiB, WS_ROPE = WS_MODS + MiB / 2;
constexpr size_t WS_WT_AIN = 2 * MiB, WS_WT_AOUT = 8 * MiB, WS_WT_DIN = 12 * MiB, WS_WT_DOUT = 29 * MiB, WS_WT_W1 = 33 * MiB, WS_WT_W2 = 65 * MiB;
constexpr size_t WS_X = 97 * MiB, WS_H = 137 * MiB, WS_Y = 157 * MiB, WS_PROJ = 177 * MiB, WS_AB = 257 * MiB;
constexpr size_t WS_SOP = 291 * MiB, WS_QB = 291 * MiB, WS_KB = 311 * MiB, WS_VB = 317 * MiB;
constexpr size_t WS_EGL = 471 * MiB, WS_OF = 472 * MiB, WS_OB = 492 * MiB, WS_END = 512 * MiB;
static_assert(WS_SOP + (size_t)2560 * 73728 <= WS_EGL, "operand records");

struct Ctx {
    LAS unsigned char* lds;
    int tid, lane, wid, gw, ngw, nblk, blk;
};
struct ProPtrs { const float *c, *c_ctx, *w_mod, *b_mod, *attn_w_in, *attn_w_out, *dn_w_in, *dn_w_out, *mlp_w1, *mlp_w2; float *mods, *rope; bf16raw *wt_ain, *wt_aout, *wt_din, *wt_dout, *wt_w1, *wt_w2; };

#define LDS_WAIT() asm volatile("s_waitcnt lgkmcnt(0)" ::: "memory")

__device__ __forceinline__ void p0_transpose_item(const float* W, int K, int N, bf16raw* WT, LAS float* scr, int item, int lane) {
    const int nblk = N / 32, kb = item / nblk, nb = item % nblk, k0 = 64 * kb, n0 = 32 * nb;
#pragma unroll 8
    for (int i = 0; i < 32; ++i) { const int kk = 2 * i + (lane >> 5); scr[kk * 33 + (lane & 31)] = W[(size_t)(k0 + kk) * N + n0 + (lane & 31)]; }
    LDS_WAIT(); asm volatile("" ::: "memory");
    const int c = lane & 7;
#pragma unroll
    for (int j = 0; j < 4; ++j) { const int n = (lane >> 3) + 8 * j; const LAS float* s = scr + (8 * c) * 33 + n;
        u32x4_t o; o.x = pk2(s[0 * 33], s[1 * 33]); o.y = pk2(s[2 * 33], s[3 * 33]); o.z = pk2(s[4 * 33], s[5 * 33]); o.w = pk2(s[6 * 33], s[7 * 33]);
        *(u32x4_t*)(WT + (size_t)(n0 + n) * K + k0 + 8 * c) = o; }
    LDS_WAIT(); asm volatile("" ::: "memory");
}

__device__ __forceinline__ void phase_prologue(Ctx& C, const ProPtrs& P) {
    LAS float* sc = (LAS float*)C.lds;
    LAS float* red = (LAS float*)(C.lds + 12288);
    for (int k = C.tid; k < 1024; k += 512) { sc[k] = silu_f(P.c_ctx[k]); sc[1024 + k] = silu_f(P.c[k]); sc[2048 + k] = silu_f(P.c[1024 + k]); }
    __syncthreads();
    for (int u = C.blk; u < 4 * 96; u += C.nblk) {
        const int l = u / 96, n0 = (u % 96) * 64;
        const float* w = P.w_mod + ((size_t)l * 1024 + C.wid * 128) * 6144 + n0 + C.lane;
        float a0 = 0.f, a1 = 0.f, a2 = 0.f;
#pragma unroll 8
        for (int k = 0; k < 128; ++k) { const float wv = w[(size_t)k * 6144]; const int kk = C.wid * 128 + k; a0 += sc[kk] * wv; a1 += sc[1024 + kk] * wv; a2 += sc[2048 + kk] * wv; }
        red[(C.wid * 3 + 0) * 64 + C.lane] = a0; red[(C.wid * 3 + 1) * 64 + C.lane] = a1; red[(C.wid * 3 + 2) * 64 + C.lane] = a2;
        __syncthreads();
        if (C.tid < 192) { const int s = C.tid >> 6, ln = C.tid & 63; float t = 0.f;
#pragma unroll
            for (int w8 = 0; w8 < 8; ++w8) t += red[(w8 * 3 + s) * 64 + ln];
            P.mods[(size_t)(l * 3 + s) * 6144 + n0 + ln] = t + P.b_mod[l * 6144 + n0 + ln]; }
        __syncthreads();
    }
    __syncthreads();
    LAS float* scr = (LAS float*)(C.lds + C.wid * 16384);
    constexpr int I0 = 2 * 768, I1 = 2 * 512, I2 = 2 * 2064, I3 = 2 * 512, I4 = 4 * 2048, I5 = 4 * 2048;
    for (int it = C.gw; it < I0 + I1 + I2 + I3 + I4 + I5; it += C.ngw) {
        int r = it;
        if (r < I0) { const int j = r / 768; p0_transpose_item(P.attn_w_in + (size_t)j * 1024 * 1536, 1024, 1536, P.wt_ain + (size_t)j * 1536 * 1024, scr, r % 768, C.lane); continue; } r -= I0;
        if (r < I1) { const int j = r / 512; p0_transpose_item(P.attn_w_out + (size_t)j * 1024 * 1024, 1024, 1024, P.wt_aout + (size_t)j * 1024 * 1024, scr, r % 512, C.lane); continue; } r -= I1;
        if (r < I2) { const int j = r / 2064; p0_transpose_item(P.dn_w_in + (size_t)j * 1024 * DNIN, 1024, DNIN, P.wt_din + (size_t)j * DNINP * 1024, scr, r % 2064, C.lane); continue; } r -= I2;
        if (r < I3) { const int j = r / 512; p0_transpose_item(P.dn_w_out + (size_t)j * 1024 * 1024, 1024, 1024, P.wt_dout + (size_t)j * 1024 * 1024, scr, r % 512, C.lane); continue; } r -= I3;
        if (r < I4) { const int l = r / 2048; p0_transpose_item(P.mlp_w1 + (size_t)l * 1024 * 4096, 1024, 4096, P.wt_w1 + (size_t)l * 4096 * 1024, scr, r % 2048, C.lane); continue; } r -= I4;
        { const int l = r / 2048; p0_transpose_item(P.mlp_w2 + (size_t)l * 4096 * 1024, 4096, 1024, P.wt_w2 + (size_t)l * 1024 * 4096, scr, r % 2048, C.lane); }
    }
    const int gt = C.blk * 512 + C.tid, ngt = C.nblk * 512;
    for (int i = gt; i < 2 * 28672; i += ngt) { const int j = i / 28672, o = i % 28672;
        *(u32x4_t*)(P.wt_din + ((size_t)j * DNINP + DNIN) * 1024 + (size_t)o * 8) = (u32x4_t){0u, 0u, 0u, 0u}; }
    for (int i = gt; i < 1024 * 64; i += ngt) { const int t = i >> 6, a = (i >> 5) & 1, f = i & 31;
        const float inv = powf(10000.f, -(float)f / 32.f); const float ang = (float)(a ? (t & 63) : (t >> 6)) * inv;
        P.rope[2 * i] = cosf(ang); P.rope[2 * i + 1] = sinf(ang); }
}

__device__ __forceinline__ void phase_norm(Ctx& C, const float* src_ctx, const float* src_lat, const float* gain, const float* md0, bf16raw* H) {
    for (int row = C.gw; row < MTOK; row += C.ngw) {
        const float* xr = row < NCTX ? src_ctx + (size_t)row * D : src_lat + (size_t)(row - NCTX) * D;
        const float* md = md0 + cond_of(row) * 6144;
        f32x4_t v[4]; float ss = 0.f;
#pragma unroll
        for (int j = 0; j < 4; ++j) { v[j] = *(const f32x4_t*)(xr + 4 * C.lane + 256 * j); ss += (v[j].x * v[j].x + v[j].y * v[j].y) + (v[j].z * v[j].z + v[j].w * v[j].w); }
        const float rinv = rsqrtf(wave_sum(ss, C.lane) * (1.f / D) + EPS);
#pragma unroll
        for (int j = 0; j < 4; ++j) { const int c = 4 * C.lane + 256 * j;
            const f32x4_t g = *(const f32x4_t*)(gain + c), sh = *(const f32x4_t*)(md + c), sc = *(const f32x4_t*)(md + 1024 + c);
            const f32x4_t y = v[j] * rinv * g * (sc + 1.f) + sh;
            u32x2_t o; o.x = pk2(y.x, y.y); o.y = pk2(y.z, y.w);
            *(u32x2_t*)(H + (size_t)row * D + c) = o; }
    }
}
__device__ __forceinline__ void phase_final(Ctx& C, const float* X, const float* final_norm, float* out) {
    for (int row = C.gw; row < MTOK; row += C.ngw) {
        const float* xr = X + (size_t)row * D;
        f32x4_t v[4]; float ss = 0.f;
#pragma unroll
        for (int j = 0; j < 4; ++j) { v[j] = *(const f32x4_t*)(xr + 4 * C.lane + 256 * j); ss += (v[j].x * v[j].x + v[j].y * v[j].y) + (v[j].z * v[j].z + v[j].w * v[j].w); }
        const float rinv = rsqrtf(wave_sum(ss, C.lane) * (1.f / D) + EPS);
#pragma unroll
        for (int j = 0; j < 4; ++j) { const int c = 4 * C.lane + 256 * j; const f32x4_t g = *(const f32x4_t*)(final_norm + c);
            *(f32x4_t*)(out + O_Y + (size_t)row * D + c) = v[j] * rinv * g; }
    }
}

struct QknPtrs { const bf16raw* PROJ; bf16raw *QB, *KB, *VB; const float *qg, *kg, *rope, *cache_k, *cache_v; float* out; };
__device__ __forceinline__ void phase_qkn(Ctx& C, const QknPtrs& P, int j) {
    const unsigned* P32 = (const unsigned*)P.PROJ; unsigned* Q32 = (unsigned*)P.QB; unsigned* K32 = (unsigned*)P.KB; unsigned* V32 = (unsigned*)P.VB;
    const float* qg = P.qg; const float* kg = P.kg;
    const int lane = C.lane;
    const f32x2_t gq = *(const f32x2_t*)(qg + 2 * lane), gk = *(const f32x2_t*)(kg + 2 * lane);
    for (int row = C.gw; row < MTOK; row += C.ngw) {
        const bool lat = row >= NCTX;
        const int b = lat ? (row - NCTX) >> 10 : row >> 8, t = lat ? (row - NCTX) & 1023 : row & 255;
        const int krow = lat ? 8192 + b * 1280 + 256 + t : row;
        f32x4_t rp = (f32x4_t){1.f, 0.f, 1.f, 0.f};
        if (lat) rp = *(const f32x4_t*)(P.rope + ((size_t)t * 64 + (lane >> 5) * 32 + 2 * (lane & 15)) * 2);
        const bool ph = (lane >> 4) & 1;
#pragma unroll
        for (int slot = 0; slot < 12; ++slot) {
            const unsigned w = P32[(size_t)row * 768 + slot * 64 + lane];
            float v0 = bf_lo(w), v1 = bf_hi(w);
            if (slot < 10) {
                const float rinv = rsqrtf(wave_sum(v0 * v0 + v1 * v1, lane) * (1.f / 128.f) + EPS);
                const f32x2_t g = slot < 8 ? gq : gk;
                v0 = v0 * rinv * g.x; v1 = v1 * rinv * g.y;
                if (lat) { const float y0 = lane_xor_f(v0, lane, 16), y1 = lane_xor_f(v1, lane, 16);
                    v0 = v0 * rp.x + (ph ? y0 : -y0) * rp.y; v1 = v1 * rp.z + (ph ? y1 : -y1) * rp.w; }
            }
            const unsigned o = pk2(v0, v1);
            if (slot < 8) Q32[(size_t)row * 512 + slot * 64 + lane] = o;
            else if (slot < 10) K32[(size_t)krow * 128 + (slot - 8) * 64 + lane] = o;
            else V32[(size_t)krow * 128 + (slot - 10) * 64 + lane] = o;
            if (!lat && slot >= 8) { float* op = P.out + (slot < 10 ? O_CK : O_CV) + ((size_t)(b * 2 + j) * 256 + t) * 256 + (slot & 1) * 128 + 2 * lane;
                *(f32x2_t*)op = (f32x2_t){v0, v1}; }
        }
    }
    for (int it = C.gw; it < 2 * 256 * 2; it += C.ngw) {
        const int kv = it & 1, key = (it >> 1) & 255, b = it >> 9;
        const float* src = (kv ? P.cache_v : P.cache_k) + ((size_t)(b * 2 + j) * 256 + key) * 256 + 4 * lane;
        const f32x4_t v = *(const f32x4_t*)src;
        u32x2_t o; o.x = pk2(v.x, v.y); o.y = pk2(v.z, v.w);
        *(u32x2_t*)((kv ? P.VB : P.KB) + (size_t)(8192 + b * 1280 + key) * 256 + 4 * lane) = o;
    }
}

struct AttnPtrs { const bf16raw *QB, *KB, *VB; bf16raw* Y; };
__device__ __forceinline__ void phase_attn(Ctx& C, const AttnPtrs& P) {
    char* lds = (char*)C.lds;
    for (int r = 0; r * C.nblk < 320; ++r) {
        const int u = r * C.nblk + (C.blk + r * (C.nblk - 64)) % C.nblk;
        if (u >= 320) continue;
        int row0, krow0, hq, seq;
        if (u < 64) { const int b = u >> 5, qb = u & 3; hq = (u >> 2) & 7; row0 = NCTX + b * 1024 + qb * 256; krow0 = 8192 + b * 1280; seq = 1280; }
        else { const int c = u - 64, b = c >> 3; hq = c & 7; row0 = b * 256; krow0 = b * 256; seq = 256; }
        const int kvh = hq >> 2;
        if (r > 0) __syncthreads();
        attn::attn_dense_body<attn::bf16>((const attn::bf16*)(P.QB + (size_t)row0 * 1024 + hq * 128), (const attn::bf16*)(P.KB + (size_t)krow0 * 256 + kvh * 128),
                                          (const attn::bf16*)(P.VB + (size_t)krow0 * 256 + kvh * 128), P.Y + (size_t)row0 * 1024 + hq * 128, seq, lds, C.tid);
    }
}
struct GatePtrs { const bf16raw *OF, *OB, *PROJ; bf16raw* Y; const float* gain; };
__device__ __forceinline__ void phase_gate(Ctx& C, const GatePtrs& P) {
    const unsigned* F32 = (const unsigned*)P.OF; const unsigned* B32 = (const unsigned*)P.OB; const unsigned* P32 = (const unsigned*)P.PROJ; unsigned* Y32 = (unsigned*)P.Y;
    const int lane = C.lane;
    const f32x2_t g = *(const f32x2_t*)(P.gain + 2 * lane);
    for (int it = C.gw; it < MTOK * 8; it += C.ngw) {
        const int row = it >> 3, h = it & 7;
        const unsigned wf = F32[(size_t)row * 512 + h * 64 + lane], wb = B32[(size_t)row * 512 + h * 64 + lane], wz = P32[(size_t)row * 2048 + 1536 + h * 64 + lane];
        const float v0 = bf_lo(wf) + bf_lo(wb), v1 = bf_hi(wf) + bf_hi(wb);
        const float rinv = rsqrtf(wave_sum(v0 * v0 + v1 * v1, lane) * (1.f / 128.f) + EPS);
        Y32[(size_t)row * 512 + h * 64 + lane] = pk2(v0 * rinv * g.x * silu_f(bf_lo(wz)), v1 * rinv * g.y * silu_f(bf_hi(wz)));
    }
}
constexpr int REC_WN = 0, REC_QT = 16384, REC_KT = 32768, REC_QK = 49152, REC_U = 57344, REC_BYTES = 73728;
typedef short dn_bf16x8 __attribute__((ext_vector_type(8)));
typedef float dn_f32x16 __attribute__((ext_vector_type(16)));
__device__ __forceinline__ int dn_crow(int r, int hi) { return (r & 3) + 8 * (r >> 2) + 4 * hi; }
typedef __bf16 dn_bf16x2 __attribute__((ext_vector_type(2)));
__device__ __forceinline__ unsigned dn_cvt_pk(float lo, float hi) { const f32x2_t v = {lo, hi}; return __builtin_bit_cast(unsigned, __builtin_convertvector(v, dn_bf16x2)); }

struct DnLocalPtrs { const bf16raw* PROJ; const float *AB, *cw, *alog, *dtb; unsigned char* SOP; float* EGL; };

__device__ __forceinline__ void phase_dn_local(Ctx& C, const DnLocalPtrs& P) {
    constexpr int L_Q = 0, L_K = 17408, L_V = 34816, L_GC = 52224, L_BT = 52736, L_AM = 53248, L_QK = L_AM + 2 * 17408;
    LAS unsigned char* L = C.lds;
    const unsigned* P32 = (const unsigned*)P.PROJ;
    LAS float* gcs = (LAS float*)(L + L_GC); LAS float* bts = (LAS float*)(L + L_BT);
    for (int u = C.blk; u < 1280; u += C.nblk) {
        int tid = C.tid; asm volatile("" : "+v"(tid));
        const int lane = tid & 63, wid = __builtin_amdgcn_readfirstlane(tid >> 6), dir = wid >> 2, w4 = wid & 3, t256 = tid & 255, r32 = lane & 31, hi = lane >> 5;
        const int h = u & 7, cidx = u >> 3;
        int npr, N, T, base, cbase;
        if (cidx < 128) { const int seq = cidx >> 2; npr = cidx & 3; N = 4; T = 256; base = seq * 256; cbase = cidx - npr; }
        else { const int c2 = cidx - 128, sq = c2 >> 4; npr = c2 & 15; N = 16; T = 1024; base = NCTX + sq * 1024; cbase = cidx - npr; }
        if (wid < 2) {
            const int tau = wid ? 63 - lane : lane; const size_t row = (size_t)(base + 64 * npr + tau);
            const float a = P.AB[row * 32 + wid * 8 + h], b = P.AB[row * 32 + 16 + wid * 8 + h];
            const float x = a + P.dtb[wid * 8 + h]; const float sp = x > 20.f ? x : log1pf(expf(x));
            float g = -expf(P.alog[wid * 8 + h]) * sp;
#pragma unroll
            for (int o = 1; o < 64; o <<= 1) { const float t = __builtin_bit_cast(float, __builtin_amdgcn_ds_bpermute((lane - o) << 2, __builtin_bit_cast(int, g))); if (lane >= o) g += t; }
            gcs[wid * 64 + lane] = g; bts[wid * 64 + lane] = 1.f / (1.f + expf(-b));
        }
        {
            const int tau0 = 8 * wid;
#pragma unroll
            for (int X = 0; X < 3; ++X) {
                const int cb = X * 1024 + h * 128;
                float w0[12], w1[12];
#pragma unroll
                for (int i = 0; i < 12; ++i) { const int tt = 64 * npr + tau0 - 2 + i; unsigned w = 0u;
                    if (tt >= 0 && tt < T) w = P32[(size_t)(base + tt) * 2048 + (cb >> 1) + lane];
                    w0[i] = bf_lo(w); w1[i] = bf_hi(w); }
                f32x2_t cwv[5];
#pragma unroll
                for (int i = 0; i < 5; ++i) cwv[i] = *(const f32x2_t*)(P.cw + i * 3072 + cb + 2 * lane);
#pragma unroll
                for (int r = 0; r < 8; ++r) {
                    float a0 = 0.f, a1 = 0.f;
#pragma unroll
                    for (int i = 0; i < 5; ++i) { a0 += w0[r + i] * cwv[i].x; a1 += w1[r + i] * cwv[i].y; }
                    a0 = silu_f(a0); a1 = silu_f(a1);
                    if (X < 2) { const float rinv = rsqrtf(wave_sum(a0 * a0 + a1 * a1, lane) + EPS); a0 *= rinv; a1 *= rinv; }
                    *(LAS unsigned*)(L + (X == 0 ? L_Q : X == 1 ? L_K : L_V) + (tau0 + r) * 272 + lane * 4) = pk2(a0, a1);
                }
            }
        }
        __syncthreads();
        {
            const int ti = w4 >> 1, tj = w4 & 1;
            dn_f32x16 accK = {}, accQ = {};
            if (ti >= tj) {
                const int pa = 32 * ti + r32, pb = 32 * tj + r32;
                const int rowA = dir ? 63 - pa : pa, rowB = dir ? 63 - pb : pb;
#pragma unroll
                for (int s = 0; s < 8; ++s) {
                    const int co = (16 * s + 8 * hi) * 2;
                    const dn_bf16x8 Ak = *(const LAS dn_bf16x8*)(L + L_K + rowA * 272 + co), Aq = *(const LAS dn_bf16x8*)(L + L_Q + rowA * 272 + co), Bk = *(const LAS dn_bf16x8*)(L + L_K + rowB * 272 + co);
                    accK = __builtin_amdgcn_mfma_f32_32x32x16_bf16(Ak, Bk, accK, 0, 0, 0);
                    accQ = __builtin_amdgcn_mfma_f32_32x32x16_bf16(Aq, Bk, accQ, 0, 0, 0);
                }
            }
            const int pj = 32 * tj + r32; const float gcj = gcs[dir * 64 + pj];
#pragma unroll
            for (int reg = 0; reg < 16; ++reg) {
                const int pi = 32 * ti + dn_crow(reg, hi);
                const float dec = pi >= pj ? __expf(gcs[dir * 64 + pi] - gcj) : 0.f;
                const float am = pi > pj ? bts[dir * 64 + pi] * accK[reg] * dec : 0.f;
                const float qk = ATT_SCALE * accQ[reg] * dec;
                *(LAS float*)(L + L_AM + dir * 17408 + pi * 272 + pj * 4) = am;
                *(LAS bf16raw*)(L + L_QK + dir * 9216 + pi * 144 + pj * 2) = (bf16raw)f2bf(qk);
            }
        }
        __syncthreads();
        const int rec_n = dir ? N - 1 - npr : npr;
        const int recid = ((cbase + rec_n) * 8 + h) * 2 + dir;
        unsigned char* rec = P.SOP + (size_t)recid * REC_BYTES;
        float x[64];
        {
            const bool isK = w4 >= 2; const float kmask = isK ? 1.f : 0.f;
            const LAS unsigned char* src = L + (isK ? L_K : L_V) + (t256 & 127) * 2;
            const LAS unsigned char* am = L + L_AM + dir * 17408;
            f32x4_t nx[16];
            nx[0] = (f32x4_t){0.f, 0.f, 0.f, 0.f};
#pragma unroll
            for (int i = 0; i < 64; ++i) {
                f32x4_t cu[16];
#pragma unroll
                for (int j4 = 0; j4 < (i + 3) / 4; ++j4) cu[j4] = nx[j4];
                if (i + 1 < 64) {
#pragma unroll
                    for (int j4 = 0; j4 < (i + 4) / 4; ++j4) nx[j4] = *(const LAS f32x4_t*)(am + (i + 1) * 272 + j4 * 16);
                }
                const int tau = dir ? 63 - i : i;
                float rhs = bts[dir * 64 + i] * bf2f(*(const LAS bf16raw*)(src + tau * 272));
                rhs *= __expf(gcs[dir * 64 + i] * kmask);
                asm volatile("" ::: "memory");
                float acc = rhs;
#pragma unroll
                for (int j4 = 0; j4 < (i + 3) / 4; ++j4) {
                    if (4 * j4 + 0 < i) acc -= cu[j4].x * x[4 * j4 + 0];
                    if (4 * j4 + 1 < i) acc -= cu[j4].y * x[4 * j4 + 1];
                    if (4 * j4 + 2 < i) acc -= cu[j4].z * x[4 * j4 + 2];
                    if (4 * j4 + 3 < i) acc -= cu[j4].w * x[4 * j4 + 3];
                }
                x[i] = acc;
            }
            if (!isK) {
                const int c = t256;
#pragma unroll
                for (int mt = 0; mt < 2; ++mt)
#pragma unroll
                    for (int hh = 0; hh < 2; ++hh) {
                        u32x4_t o0, o1;
                        o0.x = dn_cvt_pk(x[32 * mt + dn_crow(0, hh)], x[32 * mt + dn_crow(1, hh)]); o0.y = dn_cvt_pk(x[32 * mt + dn_crow(2, hh)], x[32 * mt + dn_crow(3, hh)]);
                        o0.z = dn_cvt_pk(x[32 * mt + dn_crow(4, hh)], x[32 * mt + dn_crow(5, hh)]); o0.w = dn_cvt_pk(x[32 * mt + dn_crow(6, hh)], x[32 * mt + dn_crow(7, hh)]);
                        o1.x = dn_cvt_pk(x[32 * mt + dn_crow(8, hh)], x[32 * mt + dn_crow(9, hh)]); o1.y = dn_cvt_pk(x[32 * mt + dn_crow(10, hh)], x[32 * mt + dn_crow(11, hh)]);
                        o1.z = dn_cvt_pk(x[32 * mt + dn_crow(12, hh)], x[32 * mt + dn_crow(13, hh)]); o1.w = dn_cvt_pk(x[32 * mt + dn_crow(14, hh)], x[32 * mt + dn_crow(15, hh)]);
                        unsigned char* up = rec + REC_U + (size_t)(((mt * 4 + (c >> 5)) * 64 + (c & 31) + 32 * hh) * 32);
                        *(u32x4_t*)up = o0; *(u32x4_t*)(up + 16) = o1;
                    }
            }
        }
        __syncthreads();
        if (w4 >= 2) {
            LAS unsigned char* wt = L + L_AM + dir * 17408 + (t256 - 128) * 2;
#pragma unroll
            for (int i = 0; i < 64; ++i) *(LAS bf16raw*)(wt + i * 264) = (bf16raw)f2bf(-x[i]);
        }
        __syncthreads();
        {
            const LAS unsigned char* wt = L + L_AM + dir * 17408;
#pragma unroll
            for (int i = 0; i < 4; ++i) {
                const int id = t256 + 256 * i, mt = id >> 9, kt = (id >> 6) & 7, r = id & 31, hh = (id >> 5) & 1;
                const int p = 32 * mt + r, dk0 = 32 * (kt >> 1) + 16 * (kt & 1) + 4 * hh;
                const u32x2_t wl = *(const LAS u32x2_t*)(wt + p * 264 + dk0 * 2), wh = *(const LAS u32x2_t*)(wt + p * 264 + (dk0 + 8) * 2);
                *(u32x4_t*)(rec + REC_WN + (size_t)id * 16) = (u32x4_t){wl.x, wl.y, wh.x, wh.y};
                const int tau = dir ? 63 - p : p; const float sc = ATT_SCALE * __expf(gcs[dir * 64 + p]);
                const u32x2_t ql = *(const LAS u32x2_t*)(L + L_Q + tau * 272 + dk0 * 2), qh = *(const LAS u32x2_t*)(L + L_Q + tau * 272 + (dk0 + 8) * 2);
                u32x4_t qo; qo.x = dn_cvt_pk(bf_lo(ql.x) * sc, bf_hi(ql.x) * sc); qo.y = dn_cvt_pk(bf_lo(ql.y) * sc, bf_hi(ql.y) * sc);
                qo.z = dn_cvt_pk(bf_lo(qh.x) * sc, bf_hi(qh.x) * sc); qo.w = dn_cvt_pk(bf_lo(qh.y) * sc, bf_hi(qh.y) * sc);
                *(u32x4_t*)(rec + REC_QT + (size_t)id * 16) = qo;
            }
            const float glast = gcs[dir * 64 + 63];
#pragma unroll
            for (int i = 0; i < 4; ++i) {
                const int id = t256 + 256 * i, mt = id >> 8, kt = (id >> 6) & 3, r = id & 31, hh = (id >> 5) & 1;
                const int c0 = 32 * (kt >> 1) + 16 * (kt & 1) + 4 * hh;
                float kv[8];
#pragma unroll
                for (int jj = 0; jj < 8; ++jj) { const int c = c0 + 8 * (jj >> 2) + (jj & 3); const int tau = dir ? 63 - c : c;
                    kv[jj] = bf2f(*(const LAS bf16raw*)(L + L_K + tau * 272 + (32 * mt + r) * 2)) * __expf(glast - gcs[dir * 64 + c]); }
                u32x4_t ko; ko.x = dn_cvt_pk(kv[0], kv[1]); ko.y = dn_cvt_pk(kv[2], kv[3]); ko.z = dn_cvt_pk(kv[4], kv[5]); ko.w = dn_cvt_pk(kv[6], kv[7]);
                *(u32x4_t*)(rec + REC_KT + (size_t)id * 16) = ko;
            }
#pragma unroll
            for (int i = 0; i < 2; ++i) {
                const int id = t256 + 256 * i, mt = id >> 8, kt = (id >> 6) & 3, r = id & 31, hh = (id >> 5) & 1;
                const int c0 = 32 * (kt >> 1) + 16 * (kt & 1) + 4 * hh;
                const LAS unsigned char* qp = L + L_QK + dir * 9216 + (32 * mt + r) * 144;
                const u32x2_t a = *(const LAS u32x2_t*)(qp + c0 * 2), b = *(const LAS u32x2_t*)(qp + (c0 + 8) * 2);
                *(u32x4_t*)(rec + REC_QK + (size_t)id * 16) = (u32x4_t){a.x, a.y, b.x, b.y};
            }
            if (t256 == 0) P.EGL[recid] = __expf(glast);
        }
        __syncthreads();
    }
}

struct DnScanPtrs { const unsigned char* SOP; const float *EGL, *state_delta; bf16raw *OF, *OB; float* out; };

__device__ __forceinline__ dn_bf16x8 dn_acc_frag(const dn_f32x16& a, int s) {
    u32x4_t w;
    if (s == 0) { w.x = dn_cvt_pk(a[0], a[1]); w.y = dn_cvt_pk(a[2], a[3]); w.z = dn_cvt_pk(a[4], a[5]); w.w = dn_cvt_pk(a[6], a[7]); }
    else { w.x = dn_cvt_pk(a[8], a[9]); w.y = dn_cvt_pk(a[10], a[11]); w.z = dn_cvt_pk(a[12], a[13]); w.w = dn_cvt_pk(a[14], a[15]); }
    return __builtin_bit_cast(dn_bf16x8, w);
}

__device__ __forceinline__ void phase_dn_scan(Ctx& C, const DnScanPtrs& P, int j) {
    const int slot = C.wid * C.nblk + C.blk, nslot = C.ngw;
    for (int r = 0; r * nslot < 2176; ++r) {
        const int u = r * nslot + (slot + r * (nslot - 128)) % nslot;
        if (u >= 2176) continue;
        int lane = C.lane; asm volatile("" : "+v"(lane));
        const int r32 = lane & 31, hi = lane >> 5;
        int seq, h, dir, sl, N, T, base, cbase; bool lat = u < 128;
        if (lat) { seq = 32 + (u >> 6); h = (u >> 3) & 7; dir = (u >> 2) & 1; sl = u & 3; N = 16; T = 1024; base = NCTX + (seq - 32) * 1024; cbase = 128 + 16 * (seq - 32); }
        else { const int c = u - 128; seq = c >> 6; h = (c >> 3) & 7; dir = (c >> 2) & 1; sl = c & 3; N = 4; T = 256; base = seq * 256; cbase = 4 * seq; }
        dn_f32x16 S[4];
        if (lat) { const float* sp = P.state_delta + ((((size_t)(seq - 32) * 2 + j) * 2 + dir) * 8 + h) * 16384 + 32 * sl + r32;
#pragma unroll
            for (int t4 = 0; t4 < 4; ++t4)
#pragma unroll
                for (int reg = 0; reg < 16; ++reg) S[t4][reg] = sp[(size_t)(32 * t4 + dn_crow(reg, hi)) * 128]; }
        else {
#pragma unroll
            for (int t4 = 0; t4 < 4; ++t4) S[t4] = (dn_f32x16){}; }
        bf16raw* Od = (dir ? P.OB : P.OF) + (size_t)base * 1024 + h * 128 + 32 * sl + r32;
        for (int n = 0; n < N; ++n) {
            const int recid = ((cbase + n) * 8 + h) * 2 + dir;
            const unsigned char* rec = P.SOP + (size_t)recid * REC_BYTES + lane * 16;
            const float eg = P.EGL[recid];
            dn_bf16x8 Sb[8];
#pragma unroll
            for (int kt = 0; kt < 8; ++kt) Sb[kt] = dn_acc_frag(S[kt >> 1], kt & 1);
#define DN_FENCE() asm volatile("" ::: "memory")
#define DN_LD8(F, off) do { _Pragma("unroll") for (int q_ = 0; q_ < 8; ++q_) F[q_] = *(const dn_bf16x8*)(rec + (off) + q_ * 1024); } while (0)
            dn_bf16x8 F[8];
            dn_f32x16 av[2];
#pragma unroll
            for (int mt = 0; mt < 2; ++mt) {
                const unsigned char* up = P.SOP + (size_t)recid * REC_BYTES + REC_U + (size_t)(((mt * 4 + sl) * 64 + lane) * 32);
                const u32x4_t u0 = *(const u32x4_t*)up, u1 = *(const u32x4_t*)(up + 16);
                DN_LD8(F, REC_WN + mt * 8192);
                DN_FENCE();
                dn_f32x16 a;
                a[0] = bf_lo(u0.x); a[1] = bf_hi(u0.x); a[2] = bf_lo(u0.y); a[3] = bf_hi(u0.y); a[4] = bf_lo(u0.z); a[5] = bf_hi(u0.z); a[6] = bf_lo(u0.w); a[7] = bf_hi(u0.w);
                a[8] = bf_lo(u1.x); a[9] = bf_hi(u1.x); a[10] = bf_lo(u1.y); a[11] = bf_hi(u1.y); a[12] = bf_lo(u1.z); a[13] = bf_hi(u1.z); a[14] = bf_lo(u1.w); a[15] = bf_hi(u1.w);
#pragma unroll
                for (int kt = 0; kt < 8; ++kt) a = __builtin_amdgcn_mfma_f32_32x32x16_bf16(F[kt], Sb[kt], a, 0, 0, 0);
                av[mt] = a;
                DN_FENCE();
            }
            dn_bf16x8 vb[4];
#pragma unroll
            for (int kt = 0; kt < 4; ++kt) vb[kt] = dn_acc_frag(av[kt >> 1], kt & 1);
            dn_f32x16 ao[2];
#pragma unroll
            for (int mt = 0; mt < 2; ++mt) {
                DN_LD8(F, REC_QT + mt * 8192);
                DN_FENCE();
                dn_f32x16 a = {};
#pragma unroll
                for (int kt = 0; kt < 8; ++kt) a = __builtin_amdgcn_mfma_f32_32x32x16_bf16(F[kt], Sb[kt], a, 0, 0, 0);
                ao[mt] = a;
                DN_FENCE();
            }
            DN_LD8(F, REC_QK);
            DN_FENCE();
#pragma unroll
            for (int mt = 0; mt < 2; ++mt) {
                dn_f32x16 a = ao[mt];
#pragma unroll
                for (int kt = 0; kt < 4; ++kt) a = __builtin_amdgcn_mfma_f32_32x32x16_bf16(F[mt * 4 + kt], vb[kt], a, 0, 0, 0);
#pragma unroll
                for (int reg = 0; reg < 16; ++reg) { const int p = 64 * n + 32 * mt + dn_crow(reg, hi); const int t = dir ? T - 1 - p : p;
                    Od[(size_t)t * 1024] = (bf16raw)f2bf(a[reg]); }
            }
            DN_FENCE();
#pragma unroll
            for (int t2 = 0; t2 < 2; ++t2) {
                DN_LD8(F, REC_KT + t2 * 8192);
                DN_FENCE();
#pragma unroll
                for (int tt = 0; tt < 2; ++tt) {
                    dn_f32x16 a = S[2 * t2 + tt] * eg;
#pragma unroll
                    for (int kt = 0; kt < 4; ++kt) a = __builtin_amdgcn_mfma_f32_32x32x16_bf16(F[tt * 4 + kt], vb[kt], a, 0, 0, 0);
                    S[2 * t2 + tt] = a;
                }
                DN_FENCE();
            }
#undef DN_FENCE
#undef DN_LD8
        }
        if (!lat) { float* sp = P.out + O_ST + ((((size_t)seq * 2 + j) * 2 + dir) * 8 + h) * 16384 + 32 * sl + r32;
#pragma unroll
            for (int t4 = 0; t4 < 4; ++t4)
#pragma unroll
                for (int reg = 0; reg < 16; ++reg) sp[(size_t)(32 * t4 + dn_crow(reg, hi)) * 128] = S[t4][reg]; }
    }
}
#define XB_TMO      128
#define XB_XCNT(j)  (256  + 64 * (j))
#define XB_XSUB(j)  (1280 + 64 * (j))
#define XB_XGEN(j)  (2304 + 64 * (j))
#define XB_TOP      3328
#define XB_TOPGEN   3392
#define XCD_BAR_WORDS 3456
#define XB_SPIN_CAP (1u << 18)

__device__ __forceinline__ unsigned xb_ld(unsigned* p)              { return __hip_atomic_load(p, __ATOMIC_RELAXED, __HIP_MEMORY_SCOPE_AGENT); }
__device__ __forceinline__ unsigned xb_add(unsigned* p, unsigned v) { return __hip_atomic_fetch_add(p, v, __ATOMIC_RELAXED, __HIP_MEMORY_SCOPE_AGENT); }
__device__ __forceinline__ unsigned xb_xcc_id() { return (unsigned)__builtin_amdgcn_s_getreg((3 << 11) | 20) & 0xFu; }
#define XB_SPIN(cond, bar) do { unsigned _sp = 0; while (cond) { __builtin_amdgcn_s_sleep(1); \
    if ((++_sp & 255u) == 0u) { if (xb_ld(&(bar)[XB_TMO])) break; if (_sp > XB_SPIN_CAP) { atomicAdd(&(bar)[XB_TMO], 1u); break; } } } } while (0)

struct XcdBarrier {
    unsigned* bar; unsigned x;
    volatile LAS unsigned* st;
};

__device__ __forceinline__ XcdBarrier xcd_barrier_post(unsigned* bar, volatile LAS unsigned* st) {
    XcdBarrier b; b.bar = bar; b.x = xb_xcc_id(); b.st = st;
    if (threadIdx.x == 0) (void)xb_add(&bar[XB_XCNT(b.x)], 1u);
    return b;
}
__device__ __forceinline__ void xcd_barrier_complete(unsigned* bar, unsigned x, unsigned& nloc, unsigned& nx) {
    const unsigned G = gridDim.x * gridDim.y * gridDim.z;
    unsigned sum, cnt, mine, sp = 0u;
    for (;;) {
        sum = 0u; cnt = 0u; mine = 0u;
#pragma unroll
        for (unsigned j = 0; j < 16; ++j) { const unsigned c = xb_ld(&bar[XB_XCNT(j)]); sum += c; cnt += (c > 0u) ? 1u : 0u; mine = (j == x) ? c : mine; }
        if (sum == G) break;
        __builtin_amdgcn_s_sleep(1);
        if ((++sp & 255u) == 0u) { if (xb_ld(&bar[XB_TMO])) break; if (sp > XB_SPIN_CAP) { atomicAdd(&bar[XB_TMO], 1u); break; } }
    }
    nloc = mine > 0u ? mine : 1u; nx = cnt > 0u ? cnt : 1u;
}

__device__ __forceinline__ void xcd_barrier(const XcdBarrier& b) {
    asm volatile("s_waitcnt vmcnt(0)" ::: "memory");
    __syncthreads();
    if (threadIdx.x == 0) {
        unsigned* bar = b.bar;
        __builtin_amdgcn_s_waitcnt(0);
        unsigned nloc = b.st[0], nx = b.st[1];
        if (nloc == 0u) { xcd_barrier_complete(bar, b.x, nloc, nx); b.st[0] = nloc; b.st[1] = nx; }
        const unsigned old = xb_add(&bar[XB_XSUB(b.x)], 1u);
        const unsigned gen = old / nloc;
        if (old + 1u == (gen + 1u) * nloc) {
            __builtin_amdgcn_fence(__ATOMIC_RELEASE, "agent");
            asm volatile("s_waitcnt vmcnt(0)" ::: "memory");
            const unsigned og = xb_add(&bar[XB_TOP], 1u);
            const unsigned tg = og / nx;
            if (og + 1u == (tg + 1u) * nx) xb_add(&bar[XB_TOPGEN], 1u);
            else XB_SPIN(xb_ld(&bar[XB_TOPGEN]) == tg, bar);
            __builtin_amdgcn_fence(__ATOMIC_ACQUIRE, "agent");
            xb_add(&bar[XB_XGEN(b.x)], 1u);
            asm volatile("s_waitcnt vmcnt(0)" ::: "memory");
        } else {
            XB_SPIN(xb_ld(&bar[XB_XGEN(b.x)]) == gen, bar);
            __builtin_amdgcn_fence(__ATOMIC_ACQUIRE, "agent");
            asm volatile("s_waitcnt vmcnt(0)" ::: "memory");
        }
    }
    __syncthreads();
}

constexpr int LDSCTL_OFF = 131072, MISC_OFF = LDSCTL_OFF + 320, CW_BAR = 4096;
struct Args { const float* in[24]; float* out; unsigned char* ws; int ph_lo, ph_hi; };
enum { I_XP = 0, I_XS, I_CK, I_CV, I_SD, I_C, I_CCTX, I_WMOD, I_BMOD, I_N1, I_N2, I_AWIN, I_AQG, I_AKG, I_AWOUT, I_DWIN, I_DCONV, I_DALOG, I_DDTB, I_DNORM, I_DWOUT, I_W1, I_W2, I_FN };

__global__ void __launch_bounds__(NWAVES * 64, 2) mk_fwd(Args args) {
    extern __shared__ __attribute__((aligned(16))) unsigned char lds_raw[];
    cg::grid_group grid = cg::this_grid();
    for (int u = threadIdx.x; u < (LDS_BYTES - LDSCTL_OFF) / 4; u += NWAVES * 64) ((LAS unsigned*)((LAS unsigned char*)lds_raw + LDSCTL_OFF))[u] = 0u;
    __syncthreads();
    const XcdBarrier bar = xcd_barrier_post((unsigned*)(args.ws + WS_CTL) + CW_BAR, (volatile LAS unsigned*)((LAS unsigned char*)lds_raw + MISC_OFF) + 8);

    const int lo = args.ph_lo, hi = args.ph_hi;
    int ph = 0;
#define PHASE_BEGIN() if (ph >= lo && ph < hi) { int z = 0; asm volatile("" : "+s"(z)); unsigned char* const ws = args.ws + z; (void)ws; \
    Ctx C; C.lds = (LAS unsigned char*)lds_raw + z; C.tid = threadIdx.x + z; C.lane = C.tid & 63; C.wid = __builtin_amdgcn_readfirstlane(C.tid >> 6); \
    C.nblk = gridDim.x + z; C.blk = blockIdx.x + z; C.gw = C.blk * NWAVES + C.wid; C.ngw = C.nblk * NWAVES;
#define PHASE_END() if (ph + 1 < hi) { if (ph == 0) grid.sync(); else xcd_barrier(bar); } } ++ph;
#define INP(i) (args.in[(i) + z])
#define WSF(off) ((float*)(ws + (off)))
#define WSB(off) ((bf16raw*)(ws + (off)))

    PHASE_BEGIN() {
        ProPtrs P{INP(I_C), INP(I_CCTX), INP(I_WMOD), INP(I_BMOD), INP(I_AWIN), INP(I_AWOUT), INP(I_DWIN), INP(I_DWOUT), INP(I_W1), INP(I_W2), WSF(WS_MODS), WSF(WS_ROPE),
                  WSB(WS_WT_AIN), WSB(WS_WT_AOUT), WSB(WS_WT_DIN), WSB(WS_WT_DOUT), WSB(WS_WT_W1), WSB(WS_WT_W2)};
        phase_prologue(C, P); } PHASE_END()
    for (int l = 0; l < 4; ++l) {
        const int j = l >> 1;
        PHASE_BEGIN() { const float* mods_l = WSF(WS_MODS) + (size_t)l * 3 * 6144;
            const float* xs_ctx = l == 0 ? INP(I_XP) : WSF(WS_X); const float* xs_lat = l == 0 ? INP(I_XS) : WSF(WS_X) + (size_t)NCTX * D;
            phase_norm(C, xs_ctx, xs_lat, INP(I_N1) + l * D, mods_l, WSB(WS_H)); } PHASE_END()
        if ((l & 1) == 0) {
            PHASE_BEGIN() { pg8::Gemm g{WSB(WS_H), WSB(WS_WT_AIN) + (size_t)j * QKVW * D, MTOK, QKVW, D, z}; pg8::StaticOrder S; S.init(MTOK, QKVW, C.nblk, C.blk);
                pg8::EpiBf16<0> E{WSB(WS_PROJ), QKVW, nullptr, 0, 0, 1.f};
                pg8::gemm_phase<pg8::EpiBf16<0>, pg8::StaticOrder, true, true>(C.lds, g, S, E); } PHASE_END()
            PHASE_BEGIN() { QknPtrs P{WSB(WS_PROJ), WSB(WS_QB), WSB(WS_KB), WSB(WS_VB), INP(I_AQG) + j * 128, INP(I_AKG) + j * 128, WSF(WS_ROPE), INP(I_CK), INP(I_CV), args.out + z};
                phase_qkn(C, P, j); } PHASE_END()
            PHASE_BEGIN() { AttnPtrs P{WSB(WS_QB), WSB(WS_KB), WSB(WS_VB), WSB(WS_Y)}; phase_attn(C, P); } PHASE_END()
        } else {
            PHASE_BEGIN() { pg8::Gemm g{WSB(WS_H), WSB(WS_WT_DIN) + (size_t)j * DNINP * D, MTOK, DNINP, D, z}; pg8::StaticOrder S; S.init(MTOK, DNINP, C.nblk, C.blk);
                pg8::EpiDnIn E{WSB(WS_PROJ), WSF(WS_AB)};
                pg8::gemm_phase<pg8::EpiDnIn, pg8::StaticOrder, true, true>(C.lds, g, S, E); } PHASE_END()
            PHASE_BEGIN() { DnLocalPtrs P{WSB(WS_PROJ), WSF(WS_AB), INP(I_DCONV) + (size_t)j * 5 * 3072, INP(I_DALOG) + j * 16, INP(I_DDTB) + j * 16, ws + WS_SOP, WSF(WS_EGL)};
                phase_dn_local(C, P); } PHASE_END()
            PHASE_BEGIN() { DnScanPtrs P{ws + WS_SOP, WSF(WS_EGL), INP(I_SD), WSB(WS_OF), WSB(WS_OB), args.out + z}; phase_dn_scan(C, P, j); } PHASE_END()
            PHASE_BEGIN() { GatePtrs P{WSB(WS_OF), WSB(WS_OB), WSB(WS_PROJ), WSB(WS_Y), INP(I_DNORM) + j * 128}; phase_gate(C, P); } PHASE_END()
        }
        PHASE_BEGIN() { const float* mods_l = WSF(WS_MODS) + (size_t)l * 3 * 6144;
            const float* xs_ctx = l == 0 ? INP(I_XP) : WSF(WS_X); const float* xs_lat = l == 0 ? INP(I_XS) : WSF(WS_X) + (size_t)NCTX * D;
            pg8::Gemm g{WSB(WS_Y), ((l & 1) ? WSB(WS_WT_DOUT) : WSB(WS_WT_AOUT)) + (size_t)j * D * D, MTOK, D, D, z}; pg8::StaticOrder S; S.init(MTOK, D, C.nblk, C.blk);
            pg8::EpiRes E{xs_ctx, xs_lat, WSF(WS_X), mods_l + 2048};
            pg8::gemm_phase<pg8::EpiRes, pg8::StaticOrder, true, true>(C.lds, g, S, E); } PHASE_END()
        PHASE_BEGIN() { const float* mods_l = WSF(WS_MODS) + (size_t)l * 3 * 6144;
            phase_norm(C, WSF(WS_X), WSF(WS_X) + (size_t)NCTX * D, INP(I_N2) + l * D, mods_l + 3072, WSB(WS_H)); } PHASE_END()
        PHASE_BEGIN() { pg8::Gemm g{WSB(WS_H), WSB(WS_WT_W1) + (size_t)l * FF * D, MTOK, FF, D, z}; pg8::StaticOrder S; S.init(MTOK, FF, C.nblk, C.blk);
            pg8::EpiBf16<2> E{WSB(WS_PROJ), FF, nullptr, 0, 0, 1.f};
            pg8::gemm_phase<pg8::EpiBf16<2>, pg8::StaticOrder, true, true>(C.lds, g, S, E); } PHASE_END()
        PHASE_BEGIN() { const float* mods_l = WSF(WS_MODS) + (size_t)l * 3 * 6144;
            pg8::Gemm g{WSB(WS_PROJ), WSB(WS_WT_W2) + (size_t)l * D * FF, MTOK, D, FF, z}; pg8::StaticOrder S; S.init(MTOK, D, C.nblk, C.blk);
            pg8::EpiRes E{WSF(WS_X), WSF(WS_X) + (size_t)NCTX * D, WSF(WS_X), mods_l + 5120};
            pg8::gemm_phase<pg8::EpiRes, pg8::StaticOrder, true, true>(C.lds, g, S, E); } PHASE_END()
    }
    PHASE_BEGIN() { phase_final(C, WSF(WS_X), INP(I_FN), args.out + z); } PHASE_END()
#undef PHASE_BEGIN
#undef PHASE_END
}

extern "C" void kernel_launch(void* const* d_in, const int* in_sizes, int n_in, void* d_out, int out_size, void* d_ws, size_t ws_size, hipStream_t stream) {
    static int grid = 0;
    if (grid == 0) {
        if (n_in != 24 || ws_size < WS_END) { fprintf(stderr, "kernel_launch: unexpected n_in %d / ws %zu\n", n_in, ws_size); grid = -1; return; }
        int dev = 0, cus = 0, per_cu = 0;
        if (hipGetDevice(&dev) != hipSuccess || hipDeviceGetAttribute(&cus, hipDeviceAttributeMultiprocessorCount, dev) != hipSuccess) { grid = -1; return; }
        if (hipFuncSetAttribute((const void*)mk_fwd, hipFuncAttributeMaxDynamicSharedMemorySize, LDS_BYTES) != hipSuccess) { fprintf(stderr, "kernel_launch: hipFuncSetAttribute failed\n"); grid = -1; return; }
        if (hipOccupancyMaxActiveBlocksPerMultiprocessor(&per_cu, (const void*)mk_fwd, NWAVES * 64, LDS_BYTES) != hipSuccess || per_cu < 1) { fprintf(stderr, "kernel_launch: occupancy query failed (%d)\n", per_cu); (void)hipGetLastError(); grid = -1; return; }
        grid = cus * 1;
    }
    if (grid < 0) return;
    (void)hipMemsetAsync((char*)d_ws + WS_CTL, 0, CTL_ZERO_BYTES, stream);
    Args a; memset(&a, 0, sizeof(a));
    for (int i = 0; i < 24; ++i) a.in[i] = (const float*)d_in[i];
    a.out = (float*)d_out; a.ws = (unsigned char*)d_ws; a.ph_lo = 0; a.ph_hi = 1000;
    void* kargs[] = {&a};
    hipError_t e = hipLaunchCooperativeKernel((const void*)mk_fwd, dim3(grid), dim3(NWAVES * 64), kargs, LDS_BYTES, stream);
    if (e != hipSuccess) fprintf(stderr, "kernel_launch: cooperative launch failed: %s (grid %d)\n", hipGetErrorString(e), grid);
}
```

```cpp
#include <hip/hip_runtime.h>
#include <hip/hip_cooperative_groups.h>
#include <cstdio>
#include <cstdint>
#include <cstring>
namespace cg = cooperative_groups;

constexpr int D = 1024, NCTX = 8192, NLAT = 2048, MTOK = 10240, FF = 4096;
constexpr int QKVW = 1536, DNIN = 4128, DNINP = 4352, PROJW = 4096;
constexpr int KVROWS = 8192 + 2 * 1280;
constexpr float EPS = 1e-6f;
constexpr float ATT_SCALE = 0.08838834764831845f;
constexpr size_t O_Y = 0, O_CK = (size_t)MTOK * D, O_CV = O_CK + 4194304, O_ST = O_CV + 4194304;

typedef unsigned short bf16raw;
typedef float f32x4_t __attribute__((ext_vector_type(4)));
typedef float f32x2_t __attribute__((ext_vector_type(2)));
typedef unsigned u32x4_t __attribute__((ext_vector_type(4)));
typedef unsigned u32x2_t __attribute__((ext_vector_type(2)));

__device__ __forceinline__ unsigned f2bf(float f) { unsigned u = __builtin_bit_cast(unsigned, f); return (u + 0x7fffu + ((u >> 16) & 1u)) >> 16; }
__device__ __forceinline__ unsigned pk2(float lo, float hi) { return f2bf(lo) | (f2bf(hi) << 16); }
__device__ __forceinline__ float bf_lo(unsigned w) { return __builtin_bit_cast(float, w << 16); }
__device__ __forceinline__ float bf_hi(unsigned w) { return __builtin_bit_cast(float, w & 0xffff0000u); }
__device__ __forceinline__ float bf2f(bf16raw h) { return __builtin_bit_cast(float, (unsigned)h << 16); }
__device__ __forceinline__ float silu_f(float x) { return x / (1.f + __expf(-x)); }
__device__ __forceinline__ int cond_of(int row) { return row < NCTX ? 0 : 1 + ((row - NCTX) >> 10); }
__device__ __forceinline__ float lane_xor_f(float v, int lane, int k) { return __builtin_bit_cast(float, __builtin_amdgcn_ds_bpermute((lane ^ k) << 2, __builtin_bit_cast(int, v))); }
__device__ __forceinline__ float wave_sum(float v, int lane) {
#pragma unroll
    for (int o = 1; o < 64; o <<= 1) v += lane_xor_f(v, lane, o);
    return v;
}
__device__ __forceinline__ float wave_max(float v, int lane) {
#pragma unroll
    for (int o = 1; o < 64; o <<= 1) v = fmaxf(v, lane_xor_f(v, lane, o));
    return v;
}
namespace pg8 {
#define PG8_LAS __attribute__((address_space(3)))
typedef unsigned short bf16_t;
typedef short bf16x8 __attribute__((ext_vector_type(8)));
typedef float f32x4 __attribute__((ext_vector_type(4)));
typedef unsigned u32x4 __attribute__((ext_vector_type(4)));
constexpr int BM = 256, BK = 64, HALF = 128, HTB = HALF * BK * 2  , STAGE_BYTES = 8 * HTB, NXCD = 8, WGM = 8;

__host__ __device__ __forceinline__ int lds_byte(int r, int c) { const int st = (r >> 4) * 2 + (c >> 5), rr = r & 15, cc = c & 31, ob = rr * 64 + cc * 2; return st * 1024 + (ob ^ (((ob >> 9) & 1) << 5)); }
__host__ __device__ __forceinline__ void stage_rc(int b, int& R, int& C) { const int st = b / 1024, sb = b % 1024, swz = sb ^ (((sb >> 9) & 1) << 5); R = (st >> 1) * 16 + swz / 64; C = (st & 1) * 32 + (swz % 64) / 2; }
__host__ __device__ __forceinline__ int perm32(int rho) { const int n = rho >> 4, i = rho & 15; return 8 * (i >> 2) + 4 * n + (i & 3); }

struct Unit { int pm, pn; };
struct Gemm { const bf16_t* A; const bf16_t* Bt; int M, N, K; int z; };

struct StaticOrder {
    int nM, nN, nwg, G, c;
    __host__ __device__ void init(int M, int N, int G_, int c_) { nM = M / BM; nN = N / BM; nwg = nM * nN; G = G_; c = c_; }
    __host__ __device__ bool next(int i, Unit& u) const {
        const long L = (long)i * G + c; if (L >= nwg) return false;
        int wgid = (int)L; { const int q = nwg / NXCD, r = nwg % NXCD, xcd = wgid % NXCD, off = wgid / NXCD; wgid = (xcd < r ? xcd * (q + 1) : r * (q + 1) + (xcd - r) * q) + off; }
        const int nig = WGM * nN, gid = wgid / nig, fm = gid * WGM, gsz = (nM - fm) < WGM ? (nM - fm) : WGM;
        u.pm = fm + ((wgid % nig) % gsz); u.pn = (wgid % nig) / gsz; return true;
    }
    __device__ __forceinline__ void a_ready(const Unit&) const {}
    __device__ __forceinline__ void done(const Unit&) const {}
};

__device__ __forceinline__ unsigned cvt_pk_bf16(float lo, float hi) { unsigned r; asm volatile("v_cvt_pk_bf16_f32 %0, %1, %2" : "=v"(r) : "v"(lo), "v"(hi)); return r; }
typedef float f32x2 __attribute__((ext_vector_type(2)));
__device__ __forceinline__ f32x2 gelu_pk(f32x2 v) {
    const f32x2 av = __builtin_elementwise_abs(v), d = av * 0.2316418882f + 1.0f;
    f32x2 t; t.x = __builtin_amdgcn_rcpf(d.x); t.y = __builtin_amdgcn_rcpf(d.y);
    f32x2 q = t * 0.5307027145f + (-0.7265760135f); q = q * t + 0.7107068705f; q = q * t + (-0.142248368f); q = q * t + 0.127414796f; q = q * t;
    const f32x2 s = (v * v) * (-0.72134752044f);
    f32x2 e; e.x = __builtin_amdgcn_exp2f(s.x); e.y = __builtin_amdgcn_exp2f(s.y);
    const f32x2 m = v * (q * e), r = v - m;
    f32x2 o; o.x = v.x < 0.f ? m.x : r.x; o.y = v.y < 0.f ? m.y : r.y; return o;
}

template <int ACT  > struct EpiBf16 {
    static constexpr bool PERM = true, AFTER_DRAIN = false; static_assert(ACT >= 0 && ACT <= 2, "EpiBf16: ACT is 0 (none), 1 (gelu_pk) or 2 (squared relu)");
    bf16_t* O; int ldc; const float* bias; int split_cols; size_t split_stride; float scale0;
    __device__ __forceinline__ void operator()(const f32x4 (&acc)[2][2][4][2], const Unit& u, int wr, int wc, int fr, int fq) const {
        const int row0 = u.pm * BM + wr * 64 + fr; int colt = u.pn * BM; bf16_t* base = O;
        float sc = 1.f; if (split_cols) { const int t = colt / split_cols; base += (size_t)t * split_stride; colt -= t * split_cols; if (t == 0) sc = scale0; }
        const int col0 = colt + wc * 32 + 8 * fq, bcol0 = u.pn * BM + wc * 32 + 8 * fq;
        f32x4 bv[2][2];
#pragma unroll
        for (int bj = 0; bj < 2; ++bj)
#pragma unroll
            for (int n = 0; n < 2; ++n) bv[bj][n] = bias ? *(const f32x4*)(bias + bcol0 + bj * HALF + 4 * n) : (f32x4){0.f, 0.f, 0.f, 0.f};
#pragma unroll
        for (int ai = 0; ai < 2; ++ai)
#pragma unroll
            for (int m = 0; m < 4; ++m) { bf16_t* rowp = base + (size_t)(row0 + ai * HALF + m * 16) * ldc + col0;
#pragma unroll
                for (int bj = 0; bj < 2; ++bj) { f32x4 v0 = acc[ai][bj][m][0] + bv[bj][0], v1 = acc[ai][bj][m][1] + bv[bj][1];
                    if (ACT == 1) { f32x2 a = gelu_pk((f32x2){v0[0], v0[1]}), b = gelu_pk((f32x2){v0[2], v0[3]}), c = gelu_pk((f32x2){v1[0], v1[1]}), d = gelu_pk((f32x2){v1[2], v1[3]});
                        v0 = (f32x4){a.x, a.y, b.x, b.y}; v1 = (f32x4){c.x, c.y, d.x, d.y}; }
                    if (ACT == 2) { v0 = __builtin_elementwise_max(v0, (f32x4){0.f, 0.f, 0.f, 0.f}); v1 = __builtin_elementwise_max(v1, (f32x4){0.f, 0.f, 0.f, 0.f}); v0 = v0 * v0; v1 = v1 * v1; }
                    v0 = v0 * sc; v1 = v1 * sc; u32x4 w; w.x = cvt_pk_bf16(v0[0], v0[1]); w.y = cvt_pk_bf16(v0[2], v0[3]); w.z = cvt_pk_bf16(v1[0], v1[1]); w.w = cvt_pk_bf16(v1[2], v1[3]);
                    *(u32x4*)(rowp + bj * HALF) = w; } }
    }
};

struct PanelStats {
    unsigned* xbuf;
    unsigned* cnt;
    unsigned* tmo;
    int ntn; float eps;
    unsigned code;
    __device__ __forceinline__ bool run(const f32x4 (&v)[2][2][4][2], const Unit& u, int wr, int wc, int fr, int fq, PG8_LAS unsigned char* lds, int wid, int lane) const {
        typedef float f32x2v __attribute__((ext_vector_type(2)));
        PG8_LAS f32x2v* P = (PG8_LAS f32x2v*)lds;
        PG8_LAS f32x2v* S = (PG8_LAS f32x2v*)(lds + 8192);
        PG8_LAS unsigned* flag = (PG8_LAS unsigned*)(lds + 8192 + 2048);
#pragma unroll
        for (int ai = 0; ai < 2; ++ai)
#pragma unroll
            for (int m = 0; m < 4; ++m) {
                float s = 0.f;
#pragma unroll
                for (int bj = 0; bj < 2; ++bj)
#pragma unroll
                    for (int n = 0; n < 2; ++n) { const f32x4 x = v[ai][bj][m][n]; s += (x[0] + x[1]) + (x[2] + x[3]); }
                s += __shfl_xor(s, 16); s += __shfl_xor(s, 32);
                const float mw = s * (1.0f / 64.0f); float q = 0.f;
#pragma unroll
                for (int bj = 0; bj < 2; ++bj)
#pragma unroll
                    for (int n = 0; n < 2; ++n) { const f32x4 d = v[ai][bj][m][n] - mw; q += (d[0] * d[0] + d[1] * d[1]) + (d[2] * d[2] + d[3] * d[3]); }
                q += __shfl_xor(q, 16); q += __shfl_xor(q, 32);
                if (fq == 0) P[(ai * HALF + wr * 64 + m * 16 + fr) * 4 + wc] = (f32x2v){mw, q};
            }
        asm volatile("s_waitcnt lgkmcnt(0)" ::: "memory"); __builtin_amdgcn_s_barrier(); asm volatile("" ::: "memory");
#if defined(BROKEN_EXCHANGE_NO_WAIT)
#warning BROKEN CONTROL BUILD: the row-statistics exchange does not wait; results are wrong by design
        if (blockIdx.x >= 64) { const long long t0_ = clock64(); while (clock64() - t0_ < 60000) __builtin_amdgcn_s_sleep(8); }
#endif
        const int row = wid * 32 + (lane & 31);
        if (lane < 32) {
            const f32x2v a = P[row * 4 + 0], b = P[row * 4 + 1], c = P[row * 4 + 2], d = P[row * 4 + 3];
            const float mt = (a.x + b.x + c.x + d.x) * 0.25f;
            const float da = a.x - mt, db = b.x - mt, dc = c.x - mt, dd = d.x - mt;
            const float m2 = (a.y + b.y) + (c.y + d.y) + 64.0f * ((da * da + db * db) + (dc * dc + dd * dd));
            unsigned long long* slot = (unsigned long long*)xbuf + ((size_t)(u.pm * BM + row) * 4 + u.pn);
            __hip_atomic_store(slot, ((unsigned long long)__float_as_uint(m2) << 32) | __float_as_uint(mt), __ATOMIC_RELAXED, __HIP_MEMORY_SCOPE_AGENT);
        }
        asm volatile("s_waitcnt vmcnt(0)" ::: "memory");
        if (lane == 0) __hip_atomic_fetch_add(cnt + 64 * u.pm, 1u, __ATOMIC_RELAXED, __HIP_MEMORY_SCOPE_AGENT);
        if (wid == 0) {
            bool dead = false; const unsigned long long t0 = __builtin_amdgcn_s_memrealtime(); const unsigned want = 8u * (unsigned)ntn;
            for (;;) {
#if defined(BROKEN_EXCHANGE_NO_WAIT)
                break;
#endif
                if ((unsigned)__builtin_amdgcn_readfirstlane(__hip_atomic_load(cnt + 64 * u.pm, __ATOMIC_RELAXED, __HIP_MEMORY_SCOPE_AGENT)) >= want) break;
                if (__builtin_amdgcn_s_memrealtime() - t0 > 2000000ull) {
                    if (lane == 0) { unsigned expect = 0u; __hip_atomic_compare_exchange_strong(tmo + 1, &expect, code | (unsigned)(u.pm & 0xff), __ATOMIC_RELAXED, __ATOMIC_RELAXED, __HIP_MEMORY_SCOPE_AGENT);
                                     __hip_atomic_store(tmo, 1u, __ATOMIC_RELAXED, __HIP_MEMORY_SCOPE_AGENT); }
                    dead = true; break; }
                __builtin_amdgcn_s_sleep(2);
            }
            __builtin_amdgcn_fence(__ATOMIC_ACQUIRE, "agent");
            if (lane == 0) flag[0] = dead ? 1u : 0u;
        }
        asm volatile("s_waitcnt vmcnt(0) lgkmcnt(0)" ::: "memory"); __builtin_amdgcn_s_barrier(); asm volatile("" ::: "memory");
        const bool bad = flag[0] != 0u;
        if (lane < 32) {
            const unsigned long long* slot = (const unsigned long long*)xbuf + (size_t)(u.pm * BM + row) * 4; float mt[4], m2[4]; float ms = 0.f;
#pragma unroll
            for (int t = 0; t < 4; ++t) { if (t < ntn) { const unsigned long long w = __hip_atomic_load(slot + t, __ATOMIC_RELAXED, __HIP_MEMORY_SCOPE_AGENT); mt[t] = __uint_as_float((unsigned)w); m2[t] = __uint_as_float((unsigned)(w >> 32)); } else { mt[t] = 0.f; m2[t] = 0.f; } ms += mt[t]; }
            const float mean = ms / (float)ntn; float q = 0.f;
#pragma unroll
            for (int t = 0; t < 4; ++t) if (t < ntn) { const float dm = mt[t] - mean; q += m2[t] + 256.0f * dm * dm; }
            S[row] = (f32x2v){mean, 1.0f / sqrtf(q / (256.0f * (float)ntn) + eps)};
        }
        asm volatile("s_waitcnt lgkmcnt(0)" ::: "memory"); __builtin_amdgcn_s_barrier(); asm volatile("" ::: "memory");
        return bad;
    }
};
struct EpiLnRes {
    static constexpr bool PERM = false, AFTER_DRAIN = true;
    const float* base; float* out; int ldc; const float* bias; PanelStats st; unsigned poison;
    __device__ __forceinline__ void fused(f32x4 (&acc)[2][2][4][2], const Unit& u, int wr, int wc, int fr, int fq, PG8_LAS unsigned char* lds, int wid, int lane) const {
        typedef float f32x2v __attribute__((ext_vector_type(2)));
        const PG8_LAS f32x2v* S = (const PG8_LAS f32x2v*)(lds + 8192);
        const int col0 = u.pn * BM + wc * 32 + 4 * fq;
#pragma unroll
        for (int bj = 0; bj < 2; ++bj)
#pragma unroll
            for (int n = 0; n < 2; ++n) { const f32x4 bv = bias ? *(const f32x4*)(bias + col0 + bj * HALF + n * 16) : (f32x4){0.f, 0.f, 0.f, 0.f};
#pragma unroll
                for (int ai = 0; ai < 2; ++ai)
#pragma unroll
                    for (int m = 0; m < 4; ++m) acc[ai][bj][m][n] += bv; }
        f32x4 pre[4][2][2];
#pragma unroll
        for (int m = 0; m < 4; ++m) { const size_t off = (size_t)(u.pm * BM + wr * 64 + m * 16 + fr) * ldc + col0;
#pragma unroll
            for (int bj = 0; bj < 2; ++bj)
#pragma unroll
                for (int n = 0; n < 2; ++n) pre[m][bj][n] = *(const f32x4*)(base + off + bj * HALF + n * 16); }
        const bool bad = st.run(acc, u, wr, wc, fr, fq, lds, wid, lane) || poison != 0u;
        const float qnan = __builtin_nanf("");
#pragma unroll
        for (int ai = 0; ai < 2; ++ai)
#pragma unroll
            for (int m = 0; m < 4; ++m) { const int r = ai * HALF + wr * 64 + m * 16 + fr; const f32x2v sr = S[r]; const size_t off = (size_t)(u.pm * BM + r) * ldc + col0;
#pragma unroll
                for (int bj = 0; bj < 2; ++bj)
#pragma unroll
                    for (int n = 0; n < 2; ++n) { const f32x4 bs = ai == 0 ? pre[m][bj][n] : *(const f32x4*)(base + off + bj * HALF + n * 16); f32x4 o = bs + (acc[ai][bj][m][n] - sr.x) * sr.y;
                        if (bad) o = (f32x4){qnan, qnan, qnan, qnan}; *(f32x4*)(out + off + bj * HALF + n * 16) = o; }
                if (m & 1) asm volatile("" ::: "memory"); }
    }
};
struct EpiLnResLn {
    static constexpr bool PERM = false, AFTER_DRAIN = true;
    const float* base; float* out; bf16_t* xn; int ldc; const float* bias; PanelStats st1, st2; unsigned poison;
    __device__ __forceinline__ void fused(f32x4 (&acc)[2][2][4][2], const Unit& u, int wr, int wc, int fr, int fq, PG8_LAS unsigned char* lds, int wid, int lane) const {
        typedef float f32x2v __attribute__((ext_vector_type(2))); typedef unsigned u32x2v __attribute__((ext_vector_type(2)));
        const PG8_LAS f32x2v* S = (const PG8_LAS f32x2v*)(lds + 8192);
        const int col0 = u.pn * BM + wc * 32 + 4 * fq;
#pragma unroll
        for (int bj = 0; bj < 2; ++bj)
#pragma unroll
            for (int n = 0; n < 2; ++n) { const f32x4 bv = bias ? *(const f32x4*)(bias + col0 + bj * HALF + n * 16) : (f32x4){0.f, 0.f, 0.f, 0.f};
#pragma unroll
                for (int ai = 0; ai < 2; ++ai)
#pragma unroll
                    for (int m = 0; m < 4; ++m) acc[ai][bj][m][n] += bv; }
        bool bad = st1.run(acc, u, wr, wc, fr, fq, lds, wid, lane) || poison != 0u;
        const float qnan = __builtin_nanf("");
#pragma unroll
        for (int ai = 0; ai < 2; ++ai)
#pragma unroll
            for (int m = 0; m < 4; ++m) { const int r = ai * HALF + wr * 64 + m * 16 + fr; const f32x2v sr = S[r]; const size_t off = (size_t)(u.pm * BM + r) * ldc + col0;
#pragma unroll
                for (int bj = 0; bj < 2; ++bj)
#pragma unroll
                    for (int n = 0; n < 2; ++n) { const f32x4 bs = *(const f32x4*)(base + off + bj * HALF + n * 16); acc[ai][bj][m][n] = bs + (acc[ai][bj][m][n] - sr.x) * sr.y; }
                asm volatile("" : "+v"(acc[ai][0][m][0]), "+v"(acc[ai][0][m][1]), "+v"(acc[ai][1][m][0]), "+v"(acc[ai][1][m][1]));
                if (m & 1) asm volatile("" ::: "memory"); }
        const bool bad1 = bad;
        bad = st2.run(acc, u, wr, wc, fr, fq, lds, wid, lane) || bad;
#pragma unroll
        for (int ai = 0; ai < 2; ++ai)
#pragma unroll
            for (int m = 0; m < 4; ++m) { const int r = ai * HALF + wr * 64 + m * 16 + fr; const f32x2v sr = S[r]; const size_t off = (size_t)(u.pm * BM + r) * ldc + col0;
#pragma unroll
                for (int bj = 0; bj < 2; ++bj)
#pragma unroll
                    for (int n = 0; n < 2; ++n) { const f32x4 x1 = acc[ai][bj][m][n]; *(f32x4*)(out + off + bj * HALF + n * 16) = bad1 ? (f32x4){qnan, qnan, qnan, qnan} : x1;
                        const f32x4 o = (x1 - sr.x) * sr.y; u32x2v w; w.x = cvt_pk_bf16(o[0], o[1]); w.y = cvt_pk_bf16(o[2], o[3]);
                        if (bad) { w.x = 0x7fc07fc0u; w.y = 0x7fc07fc0u; } *(u32x2v*)(xn + off + bj * HALF + n * 16) = w; }
                asm volatile("" ::: "memory"); }
    }
};

template <class Epi, class Sched, bool ALIGN_EPI = false, bool SP2 = false>
__device__ __forceinline__ void gemm_phase(PG8_LAS unsigned char* lds, const Gemm g, const Sched& S, const Epi& E) {
    const int tid = threadIdx.x + g.z, wid = __builtin_amdgcn_readfirstlane(tid >> 6), lane = tid & 63, wr = wid >> 2, wc = wid & 3, fr = lane & 15, fq = lane >> 4;
    const int K = g.K, nt = K / BK;
    unsigned voffA[2], voffB[2];
#pragma unroll
    for (int i = 0; i < 2; ++i) { int R, C; stage_rc(tid * 16 + i * 8192, R, C); const int Rb = Epi::PERM ? ((R & ~31) + perm32(R & 31)) : R;
        voffA[i] = (unsigned)(R * K + C) * 2u; voffB[i] = (unsigned)(Rb * K + C) * 2u; }
    const size_t kstep = (size_t)(BK * 2);
    const size_t hstep = (size_t)HALF * K * 2;
    const size_t tstep = 2 * hstep;
    const unsigned ldsw = (unsigned)wid * 1024u;
    const int aoff = lds_byte(wr * 64 + fr, fq * 8), boff = lds_byte(wc * 32 + fr, fq * 8);
#define PG8_SA(b, h) (((b) * 2 + (h)) * HTB)
#define PG8_SB(b, h) ((4 + (b) * 2 + (h)) * HTB)
#define PG8_STAGE(bufoff, gbase, voff) do { _Pragma("unroll") for (int _i = 0; _i < 2; ++_i) \
        __builtin_amdgcn_global_load_lds((const unsigned*)((const char*)(gbase) + (voff)[_i]), (PG8_LAS unsigned*)(lds + (bufoff) + ldsw + _i * 8192), 16, 0, 0); } while (0)
#define PG8_LDA(dst, b, h) do { _Pragma("unroll") for (int m = 0; m < 4; ++m) _Pragma("unroll") for (int k = 0; k < 2; ++k) dst[m][k] = *(const PG8_LAS bf16x8*)(lds + PG8_SA(b, h) + aoff + m * 2048 + k * 1024); } while (0)
#define PG8_LDB(dst, b, h) do { _Pragma("unroll") for (int n = 0; n < 2; ++n) _Pragma("unroll") for (int k = 0; k < 2; ++k) dst[n][k] = *(const PG8_LAS bf16x8*)(lds + PG8_SB(b, h) + boff + n * 2048 + k * 1024); } while (0)
#define PG8_MMA(ai, bj, At, Bt) do { __builtin_amdgcn_s_setprio(1); _Pragma("unroll") for (int m = 0; m < 4; ++m) _Pragma("unroll") for (int n = 0; n < 2; ++n) _Pragma("unroll") for (int k = 0; k < 2; ++k) \
        acc[ai][bj][m][n] = __builtin_amdgcn_mfma_f32_16x16x32_bf16(Bt[n][k], At[m][k], acc[ai][bj][m][n], 0, 0, 0); __builtin_amdgcn_s_setprio(0); } while (0)
#define PG8_WAIT_V(n) asm volatile("s_waitcnt vmcnt(" #n ")" ::: "memory")
#define PG8_WAIT_L(n) asm volatile("s_waitcnt lgkmcnt(" #n ")" ::: "memory")
#define PG8_BAR __builtin_amdgcn_s_barrier()
#define PG8_SCHED __builtin_amdgcn_sched_barrier(0)
    Unit cur, nxt; int ui = 0;
    if (!S.next(0, cur)) return;
    f32x4 acc[2][2][4][2];
#pragma unroll
    for (int a = 0; a < 2; ++a)
#pragma unroll
        for (int b = 0; b < 2; ++b)
#pragma unroll
            for (int m = 0; m < 4; ++m)
#pragma unroll
                for (int n = 0; n < 2; ++n) acc[a][b][m][n] = (f32x4){0.f, 0.f, 0.f, 0.f};
    bf16x8 At[4][2], B0[2][2], B1[2][2];
    const char* cA = (const char*)g.A + (size_t)cur.pm * tstep; const char* cB = (const char*)g.Bt + (size_t)cur.pn * tstep;
    S.a_ready(cur);
    if constexpr (SP2) {
        PG8_STAGE(PG8_SB(0, 0), cB, voffB); PG8_STAGE(PG8_SB(0, 1), cB + hstep, voffB); PG8_STAGE(PG8_SA(0, 0), cA, voffA); PG8_STAGE(PG8_SA(0, 1), cA + hstep, voffA);
        if (wr == 1) PG8_BAR;
        PG8_WAIT_V(2); PG8_BAR;
        PG8_STAGE(PG8_SB(1, 0), cB + kstep, voffB); PG8_STAGE(PG8_SA(1, 0), cA + kstep, voffA); PG8_STAGE(PG8_SB(1, 1), cB + hstep + kstep, voffB);
        PG8_WAIT_V(6); PG8_BAR;
    } else {
        PG8_STAGE(PG8_SB(0, 0), cB, voffB); PG8_STAGE(PG8_SA(0, 0), cA, voffA); PG8_STAGE(PG8_SB(0, 1), cB + hstep, voffB); PG8_STAGE(PG8_SA(0, 1), cA + hstep, voffA);
        if (wr == 1) PG8_BAR;
        PG8_WAIT_V(4); PG8_BAR;
        PG8_STAGE(PG8_SB(1, 0), cB + kstep, voffB); PG8_STAGE(PG8_SA(1, 0), cA + kstep, voffA); PG8_STAGE(PG8_SB(1, 1), cB + hstep + kstep, voffB);
        PG8_WAIT_V(6); PG8_BAR;
    }
    for (;;) {
        const bool has_next = S.next(ui + 1, nxt);
        const char* nA = has_next ? (const char*)g.A + (size_t)nxt.pm * tstep : cA; const char* nB = has_next ? (const char*)g.Bt + (size_t)nxt.pn * tstep : cB;
        for (int t = 0; t < nt; t += 2) {
            const bool last = (t == nt - 2);
            const char* a1 = cA + (size_t)(t + 1) * kstep;
            const char* a2 = last ? nA : cA + (size_t)(t + 2) * kstep; const char* b2 = last ? nB : cB + (size_t)(t + 2) * kstep;
            const char* a3 = a2 + kstep; const char* b3 = b2 + kstep;
            if (last && has_next) S.a_ready(nxt);
            if constexpr (SP2) {
            PG8_LDB(B0, 0, 0); PG8_LDB(B1, 0, 1); PG8_SCHED; PG8_LDA(At, 0, 0); PG8_STAGE(PG8_SA(1, 1), a1 + hstep, voffA);
            PG8_WAIT_V(8); PG8_WAIT_L(0); PG8_BAR; PG8_MMA(0, 0, At, B0); PG8_MMA(0, 1, At, B1); PG8_BAR; PG8_SCHED;
            PG8_LDA(At, 0, 1); PG8_STAGE(PG8_SB(0, 0), b2, voffB); PG8_STAGE(PG8_SB(0, 1), b2 + hstep, voffB); PG8_STAGE(PG8_SA(0, 0), a2, voffA);
            PG8_WAIT_V(8); PG8_WAIT_L(0); PG8_BAR; PG8_MMA(1, 0, At, B0); PG8_MMA(1, 1, At, B1); PG8_BAR; PG8_SCHED;
            PG8_LDB(B0, 1, 0); PG8_LDB(B1, 1, 1); PG8_SCHED; PG8_LDA(At, 1, 0); PG8_STAGE(PG8_SA(0, 1), a2 + hstep, voffA);
            PG8_WAIT_V(8); PG8_WAIT_L(0); PG8_BAR; PG8_MMA(0, 0, At, B0); PG8_MMA(0, 1, At, B1); PG8_BAR; PG8_SCHED;
            PG8_LDA(At, 1, 1); PG8_STAGE(PG8_SB(1, 0), b3, voffB); PG8_STAGE(PG8_SB(1, 1), b3 + hstep, voffB); PG8_STAGE(PG8_SA(1, 0), a3, voffA);
            PG8_WAIT_V(8); PG8_WAIT_L(0); PG8_BAR; PG8_MMA(1, 0, At, B0); PG8_MMA(1, 1, At, B1); PG8_BAR; PG8_SCHED;
            } else {
            PG8_LDB(B0, 0, 0); PG8_SCHED; PG8_LDA(At, 0, 0); PG8_STAGE(PG8_SA(1, 1), a1 + hstep, voffA);
            PG8_WAIT_L(8); PG8_BAR; PG8_WAIT_L(0); PG8_MMA(0, 0, At, B0); PG8_BAR; PG8_SCHED;
            PG8_LDB(B1, 0, 1); PG8_STAGE(PG8_SB(0, 0), b2, voffB);
            PG8_BAR; PG8_WAIT_L(0); PG8_MMA(0, 1, At, B1); PG8_BAR;
            PG8_LDA(At, 0, 1); PG8_STAGE(PG8_SA(0, 0), a2, voffA);
            PG8_BAR; PG8_WAIT_L(0); PG8_MMA(1, 0, At, B0); PG8_BAR; PG8_SCHED;
            PG8_STAGE(PG8_SB(0, 1), b2 + hstep, voffB);
            PG8_WAIT_V(6); PG8_BAR; PG8_MMA(1, 1, At, B1); PG8_BAR;
            PG8_LDB(B0, 1, 0); PG8_SCHED; PG8_LDA(At, 1, 0); PG8_STAGE(PG8_SA(0, 1), a2 + hstep, voffA);
            PG8_WAIT_L(8); PG8_BAR; PG8_WAIT_L(0); PG8_MMA(0, 0, At, B0); PG8_BAR; PG8_SCHED;
            PG8_LDB(B1, 1, 1); PG8_STAGE(PG8_SB(1, 0), b3, voffB);
            PG8_BAR; PG8_WAIT_L(0); PG8_MMA(0, 1, At, B1); PG8_BAR;
            PG8_LDA(At, 1, 1); PG8_STAGE(PG8_SA(1, 0), a3, voffA);
            PG8_BAR; PG8_WAIT_L(0); PG8_MMA(1, 0, At, B0); PG8_BAR; PG8_SCHED;
            PG8_STAGE(PG8_SB(1, 1), b3 + hstep, voffB);
            PG8_WAIT_V(6); PG8_BAR; PG8_MMA(1, 1, At, B1); PG8_BAR;
            }
        }
        if constexpr (ALIGN_EPI) { if (wr == 0) PG8_BAR; }
        if constexpr (!Epi::AFTER_DRAIN) { E(acc, cur, wr, wc, fr, fq); S.done(cur); }
        if (!has_next) break;
#pragma unroll
        for (int a = 0; a < 2; ++a)
#pragma unroll
            for (int b = 0; b < 2; ++b)
#pragma unroll
                for (int m = 0; m < 4; ++m)
#pragma unroll
                    for (int n = 0; n < 2; ++n) acc[a][b][m][n] = (f32x4){0.f, 0.f, 0.f, 0.f};
        cur = nxt; cA = nA; cB = nB; ++ui;
        if constexpr (ALIGN_EPI) { if (wr == 1) PG8_BAR; }
    }
    PG8_WAIT_V(0);
    if constexpr (!ALIGN_EPI) { if (wr == 0) PG8_BAR; }
    PG8_BAR;
    if constexpr (Epi::AFTER_DRAIN) { E.fused(acc, cur, wr, wc, fr, fq, lds, wid, lane); S.done(cur); }
#undef PG8_SA
#undef PG8_SB
#undef PG8_STAGE
#undef PG8_LDA
#undef PG8_LDB
#undef PG8_MMA
#undef PG8_WAIT_V
#undef PG8_WAIT_L
#undef PG8_BAR
#undef PG8_SCHED
}
}

#ifndef PG8_SP2
#define PG8_SP2 true
#endif
#ifndef PG8_ALIGN
#define PG8_ALIGN true
#endif
namespace pg8 {
typedef __bf16 bf16x2v __attribute__((ext_vector_type(2))); typedef float f32x2v_ __attribute__((ext_vector_type(2)));
__device__ __forceinline__ unsigned cvt_pk_vis(float lo, float hi) { const f32x2v_ v = {lo, hi}; return __builtin_bit_cast(unsigned, __builtin_convertvector(v, bf16x2v)); }
struct EpiRes {
    static constexpr bool PERM = false, AFTER_DRAIN = false;
    const float* src_ctx; const float* src_lat; float* X; const float* gate;
    __device__ __forceinline__ void operator()(const f32x4 (&acc)[2][2][4][2], const Unit& u, int wr, int wc, int fr, int fq) const {
        const int cond = u.pm < 32 ? 0 : 1 + ((u.pm - 32) >> 2);
        const float* g = gate + cond * 6144;
        const float* sb = u.pm < 32 ? src_ctx + (size_t)u.pm * BM * 1024 : src_lat + (size_t)(u.pm - 32) * BM * 1024;
        float* xb = X + (size_t)u.pm * BM * 1024;
        const int col0 = u.pn * BM + wc * 32 + 4 * fq;
        f32x4 gv[2][2];
#pragma unroll
        for (int bj = 0; bj < 2; ++bj)
#pragma unroll
            for (int n = 0; n < 2; ++n) gv[bj][n] = *(const f32x4*)(g + col0 + bj * HALF + n * 16);
#pragma unroll
        for (int ai = 0; ai < 2; ++ai)
#pragma unroll
            for (int m = 0; m < 4; ++m) { const size_t off = (size_t)(ai * HALF + wr * 64 + m * 16 + fr) * 1024 + col0;
#pragma unroll
                for (int bj = 0; bj < 2; ++bj)
#pragma unroll
                    for (int n = 0; n < 2; ++n) { const f32x4 xv = *(const f32x4*)(sb + off + bj * HALF + n * 16);
                        *(f32x4*)(xb + off + bj * HALF + n * 16) = xv + gv[bj][n] * acc[ai][bj][m][n]; } }
    }
};
struct EpiDnIn {
    static constexpr bool PERM = true, AFTER_DRAIN = false;
    bf16_t* O; float* AB;
    __device__ __forceinline__ void operator()(const f32x4 (&acc)[2][2][4][2], const Unit& u, int wr, int wc, int fr, int fq) const {
        const int row0 = u.pm * BM + wr * 64 + fr;
        if (u.pn < 16) {
            const int col0 = u.pn * BM + wc * 32 + 8 * fq;
#pragma unroll
            for (int ai = 0; ai < 2; ++ai)
#pragma unroll
                for (int m = 0; m < 4; ++m) { bf16_t* rowp = O + (size_t)(row0 + ai * HALF + m * 16) * 4096 + col0;
#pragma unroll
                    for (int bj = 0; bj < 2; ++bj) { const f32x4 v0 = acc[ai][bj][m][0], v1 = acc[ai][bj][m][1];
                        u32x4 w; w.x = cvt_pk_vis(v0[0], v0[1]); w.y = cvt_pk_vis(v0[2], v0[3]); w.z = cvt_pk_vis(v1[0], v1[1]); w.w = cvt_pk_vis(v1[2], v1[3]);
                        *(u32x4*)(rowp + bj * HALF) = w; } }
        } else if (wc == 0) {
#pragma unroll
            for (int ai = 0; ai < 2; ++ai)
#pragma unroll
                for (int m = 0; m < 4; ++m) { float* rp = AB + (size_t)(row0 + ai * HALF + m * 16) * 32 + 8 * fq;
                    *(f32x4*)rp = acc[ai][0][m][0]; *(f32x4*)(rp + 4) = acc[ai][0][m][1]; }
        }
    }
};
}
#include <hip/hip_bf16.h>
namespace attn {
using bf16 = __hip_bfloat16;
constexpr int D = 128, NW = 8, QBLK = 32, KVBLK = 64;
constexpr float SCALE = 0.088388347648318440f;
constexpr float THR = 8.f;
constexpr int SDEPTH = 2;
constexpr int LDQ = 1024, LDK = 256, LDO = 1024;
constexpr size_t SHM_V = KVBLK * D * 2, SHM_K = KVBLK * D * 2, SHM_ATTN = 2 * SHM_V + 2 * SHM_K + NW * 64 * 4;
using bf16x8 = __attribute__((ext_vector_type(8))) short;
using s16x4  = __attribute__((ext_vector_type(4))) short;
using f32x16 = __attribute__((ext_vector_type(16))) float;
using f32x8  = __attribute__((ext_vector_type(8))) float;
using u32x4  = __attribute__((ext_vector_type(4))) unsigned;
#define KSWZ(row, colB) ((row) * 256 + ((colB) ^ (((row) & 7) << 4)))
#define SBAR() __builtin_amdgcn_sched_barrier(0)
__device__ __forceinline__ int crow(int r, int hi) { return (r & 3) + 8 * (r >> 2) + 4 * hi; }
__device__ __forceinline__ unsigned cvtpk(float lo, float hi) {
  unsigned r; asm volatile("v_cvt_pk_bf16_f32 %0, %1, %2" : "=v"(r) : "v"(lo), "v"(hi)); return r;
}
template <typename TIn> struct Stage;
template <> struct Stage<bf16>  { using T = bf16x8;
  __device__ static __forceinline__ T ld8(const bf16* p) { return *reinterpret_cast<const bf16x8*>(p); }
  __device__ static __forceinline__ bf16x8 tobf(T x) { return x; } };
template <> struct Stage<float> { using T = f32x8;
  __device__ static __forceinline__ T ld8(const float* p) { return *reinterpret_cast<const f32x8*>(p); }
  __device__ static __forceinline__ bf16x8 tobf(T x) {
    u32x4 w = {cvtpk(x[0], x[1]), cvtpk(x[2], x[3]), cvtpk(x[4], x[5]), cvtpk(x[6], x[7])}; return *reinterpret_cast<bf16x8*>(&w); } };

__device__ __forceinline__ void partialSM(f32x16& p0, f32x16& p1, float& m_reg, float& mn, float& alpha) {
  constexpr float C = SCALE * 1.4426950408889634f;
  float pmax = p0[0]; for (int r = 1; r < 16; ++r) pmax = fmaxf(pmax, p0[r]); for (int r = 0; r < 16; ++r) pmax = fmaxf(pmax, p1[r]);
  { auto rr = __builtin_amdgcn_permlane32_swap(__float_as_uint(pmax), __float_as_uint(pmax), false, false);
    pmax = fmaxf(__uint_as_float(rr[0]), __uint_as_float(rr[1])); }
  if (__builtin_expect(__all(pmax - m_reg <= THR / SCALE), 1)) { mn = m_reg; alpha = 1.f; }
  else { mn = fmaxf(m_reg, pmax); alpha = __builtin_amdgcn_exp2f((m_reg - mn) * C); m_reg = mn; }
  float mnC = -mn * C;
  for (int r = 0; r < 16; ++r) p0[r] = fmaf(p0[r], C, mnC); for (int r = 0; r < 16; ++r) p1[r] = fmaf(p1[r], C, mnC);
  for (int r = 0; r < 16; ++r) p0[r] = __builtin_amdgcn_exp2f(p0[r]);
}
__device__ __forceinline__ void finishSM(f32x16& p0, f32x16& p1, float alpha, float& l_reg, bf16x8& pa0, bf16x8& pa1, bf16x8& pa2, bf16x8& pa3) {
  for (int r = 0; r < 16; ++r) p1[r] = __builtin_amdgcn_exp2f(p1[r]);
  float ps = 0; for (int r = 0; r < 16; ++r) ps += p0[r]; for (int r = 0; r < 16; ++r) ps += p1[r];
  { auto rr = __builtin_amdgcn_permlane32_swap(__float_as_uint(ps), __float_as_uint(ps), false, false);
    ps = __uint_as_float(rr[0]) + __uint_as_float(rr[1]); }
  l_reg = l_reg * alpha + ps;
#define PK4(P, BASE, OUT) do { unsigned a0 = cvtpk(P[BASE + 0], P[BASE + 1]), a1 = cvtpk(P[BASE + 2], P[BASE + 3]);   \
    unsigned b0 = cvtpk(P[BASE + 4], P[BASE + 5]), b1 = cvtpk(P[BASE + 6], P[BASE + 7]);                              \
    auto r0 = __builtin_amdgcn_permlane32_swap(a0, b0, false, false); auto r1 = __builtin_amdgcn_permlane32_swap(a1, b1, false, false); \
    u32x4 w = {r0[0], r1[0], r0[1], r1[1]}; OUT = *reinterpret_cast<bf16x8*>(&w); } while (0)
  PK4(p0, 0, pa0); PK4(p0, 8, pa1); PK4(p1, 0, pa2); PK4(p1, 8, pa3);
#undef PK4
}
__device__ __forceinline__ void qkt(f32x16& p0, f32x16& p1, const bf16* Ks, const bf16x8* qr, int r32, int hi) {
  p0 = f32x16{}; p1 = f32x16{};
  for (int d0 = 0; d0 < 8; ++d0) { int cb = (d0 * 16 + hi * 8) * 2;
    bf16x8 b0 = *reinterpret_cast<const bf16x8*>((const char*)Ks + KSWZ(r32, cb));
    bf16x8 b1 = *reinterpret_cast<const bf16x8*>((const char*)Ks + KSWZ(32 + r32, cb));
    p0 = __builtin_amdgcn_mfma_f32_32x32x16_bf16(b0, qr[d0], p0, 0, 0, 0);
    p1 = __builtin_amdgcn_mfma_f32_32x32x16_bf16(b1, qr[d0], p1, 0, 0, 0); }
}
__device__ __forceinline__ int v_st(int k, int c) { const int kk = (k & ~0xC) | ((k & 4) << 1) | ((k & 8) >> 1); return ((kk >> 3) * 4 + (c >> 5)) * 512 + ((kk & 7) * 32 + (c & 31)) * 2; }
__device__ __forceinline__ int v_rd_base(int lane) { return ((lane & 3) << 3) | (((lane >> 2) & 3) << 6) | (((lane >> 4) & 1) << 5) | (((lane >> 5) & 1) << 8); }
constexpr int v_rd_off(int d0, int ks, int half) { return d0 * 512 + ks * 4096 + half * 2048; }
template <int OFF> __device__ __forceinline__ s16x4 tr_read(int vb) {
  s16x4 r; asm volatile("ds_read_b64_tr_b16 %0, %1 offset:%2" : "=&v"(r) : "v"(vb), "i"(OFF) : "memory"); return r;
}
template <int D0> __device__ __forceinline__ void pv_one(f32x16& od, int vb, bf16x8 pa0, bf16x8 pa1, bf16x8 pa2, bf16x8 pa3) {
  const s16x4 l0 = tr_read<v_rd_off(D0, 0, 0)>(vb), h0 = tr_read<v_rd_off(D0, 0, 1)>(vb), l1 = tr_read<v_rd_off(D0, 1, 0)>(vb), h1 = tr_read<v_rd_off(D0, 1, 1)>(vb);
  const s16x4 l2 = tr_read<v_rd_off(D0, 2, 0)>(vb), h2 = tr_read<v_rd_off(D0, 2, 1)>(vb), l3 = tr_read<v_rd_off(D0, 3, 0)>(vb), h3 = tr_read<v_rd_off(D0, 3, 1)>(vb);
  asm volatile("s_waitcnt lgkmcnt(0)" ::: "memory"); SBAR();
#define PK(L, H) (bf16x8){L[0], L[1], L[2], L[3], H[0], H[1], H[2], H[3]}
  od = __builtin_amdgcn_mfma_f32_32x32x16_bf16(pa0, PK(l0, h0), od, 0, 0, 0);
  od = __builtin_amdgcn_mfma_f32_32x32x16_bf16(pa1, PK(l1, h1), od, 0, 0, 0);
  od = __builtin_amdgcn_mfma_f32_32x32x16_bf16(pa2, PK(l2, h2), od, 0, 0, 0);
  od = __builtin_amdgcn_mfma_f32_32x32x16_bf16(pa3, PK(l3, h3), od, 0, 0, 0);
#undef PK
}
__device__ __forceinline__ void pv_d0(f32x16* o, int vb, bf16x8 pa0, bf16x8 pa1, bf16x8 pa2, bf16x8 pa3) {
  pv_one<0>(o[0], vb, pa0, pa1, pa2, pa3); pv_one<1>(o[1], vb, pa0, pa1, pa2, pa3); pv_one<2>(o[2], vb, pa0, pa1, pa2, pa3); pv_one<3>(o[3], vb, pa0, pa1, pa2, pa3);
}

template <typename TQ>
__device__ __forceinline__ void attn_dense_body(const TQ* __restrict__ Qb, const bf16* __restrict__ Kh, const bf16* __restrict__ Vh,
                                                unsigned short* __restrict__ Ob, int seq, char* lds, const int tid) {
  using St = Stage<bf16>; using SQ = Stage<TQ>;
  const int wid = tid >> 6, lane = tid & 63, r32 = lane & 31, hi = lane >> 5;
  bf16* V_lds = (bf16*)lds; bf16* K_lds = (bf16*)(lds + 2 * SHM_V);
  float* ws = (float*)(lds + 2 * SHM_V + 2 * SHM_K) + wid * 64; float* li_l = ws; float* al_l = ws + 32;
  float m_reg = -1e30f, l_reg = 0; f32x16 o[4] = {}; bf16x8 qr[8];
  const TQ* Qw = Qb + (int)(wid * QBLK + r32) * LDQ + hi * 8;
#pragma unroll
  for (int d0 = 0; d0 < 8; ++d0) qr[d0] = SQ::tobf(SQ::ld8(Qw + d0 * 16));
  const int sr = tid >> 4, sc = (tid & 15) * 8, vst0 = v_st(sr, sc), vst1 = v_st(32 + sr, sc);
  const int vb0 = (int)(uintptr_t)V_lds + v_rd_base(lane);
  struct { typename St::T vs0, vs1, ks0, ks1; } sr_[SDEPTH];
#define SLOAD(i, k0) do { sr_[i].vs0 = St::ld8(&Vh[(int)((k0) + sr) * LDK + sc]); sr_[i].vs1 = St::ld8(&Vh[(int)((k0) + 32 + sr) * LDK + sc]); \
    sr_[i].ks0 = St::ld8(&Kh[(int)((k0) + sr) * LDK + sc]); sr_[i].ks1 = St::ld8(&Kh[(int)((k0) + 32 + sr) * LDK + sc]); } while (0)
#define SWRITE(b, i) do { *(bf16x8*)((char*)V_lds + (b) * SHM_V + vst0) = St::tobf(sr_[i].vs0);          \
    *(bf16x8*)((char*)V_lds + (b) * SHM_V + vst1) = St::tobf(sr_[i].vs1); int kc = sc * 2;               \
    *(bf16x8*)((char*)K_lds + (b) * SHM_K + KSWZ(sr, kc)) = St::tobf(sr_[i].ks0);                       \
    *(bf16x8*)((char*)K_lds + (b) * SHM_K + KSWZ(32 + sr, kc)) = St::tobf(sr_[i].ks1); } while (0)
#define SWAIT() do { if constexpr (SDEPTH == 2) asm volatile("s_waitcnt vmcnt(4)" ::: "memory"); else asm volatile("s_waitcnt vmcnt(0)" ::: "memory"); } while (0)
#define RESC(a) do { if (__any((a) < 1.f)) { if (hi == 0) al_l[r32] = (a); asm volatile("s_waitcnt lgkmcnt(0)" ::: "memory"); \
    for (int d = 0; d < 4; ++d) for (int r = 0; r < 16; ++r) o[d][r] *= al_l[crow(r, hi)]; } } while (0)
  f32x16 pA0, pA1, pB0, pB1; float mnA, mnB, alA, alB; bf16x8 pa0, pa1, pa2, pa3; const int NT = seq / KVBLK;
  constexpr int SE = 0, SO = SDEPTH - 1;
  SLOAD(SE, 0); asm volatile("s_waitcnt vmcnt(0)" ::: "memory"); SWRITE(0, SE); __syncthreads();
  qkt(pA0, pA1, K_lds, qr, r32, hi); partialSM(pA0, pA1, m_reg, mnA, alA);
  SLOAD(SO, KVBLK); if constexpr (SDEPTH == 2) { if (2 < NT) SLOAD(SE, 2 * KVBLK); }
  SWAIT(); SWRITE(1, SO); __syncthreads();
  for (int j = 1; j + 1 < NT; j += 2) {
    SBAR(); qkt(pB0, pB1, (bf16*)((char*)K_lds + SHM_K), qr, r32, hi);
    finishSM(pA0, pA1, alA, l_reg, pa0, pa1, pa2, pa3); SBAR();
    SLOAD(SO, (j + SDEPTH) * KVBLK); SBAR();
    pv_d0(o, vb0, pa0, pa1, pa2, pa3); partialSM(pB0, pB1, m_reg, mnB, alB);
    __syncthreads(); SWAIT(); SWRITE(0, SE);
    RESC(alB); __syncthreads();
    SBAR(); qkt(pA0, pA1, K_lds, qr, r32, hi);
    finishSM(pB0, pB1, alB, l_reg, pa0, pa1, pa2, pa3); SBAR();
    if (SDEPTH == 1 || j + 3 < NT) SLOAD(SE, (j + 1 + SDEPTH) * KVBLK); SBAR();
    pv_d0(o, vb0 + (int)SHM_V, pa0, pa1, pa2, pa3); partialSM(pA0, pA1, m_reg, mnA, alA);
    __syncthreads(); SWAIT(); SWRITE(1, SO);
    RESC(alA); __syncthreads();
  }
  SBAR(); qkt(pB0, pB1, (bf16*)((char*)K_lds + SHM_K), qr, r32, hi);
  finishSM(pA0, pA1, alA, l_reg, pa0, pa1, pa2, pa3); SBAR();
  pv_d0(o, vb0, pa0, pa1, pa2, pa3); partialSM(pB0, pB1, m_reg, mnB, alB);
  __syncthreads(); RESC(alB);
  finishSM(pB0, pB1, alB, l_reg, pa0, pa1, pa2, pa3); SBAR();
  pv_d0(o, vb0 + (int)SHM_V, pa0, pa1, pa2, pa3);
  if (hi == 0) li_l[r32] = l_reg; asm volatile("s_waitcnt lgkmcnt(0)" ::: "memory");
  float rli[16];
#pragma unroll
  for (int r = 0; r < 16; ++r) rli[r] = __builtin_amdgcn_rcpf(li_l[crow(r, hi)]);
  unsigned short* Ow = Ob + (int)(wid * QBLK) * LDO;
#pragma unroll
  for (int r = 0; r < 16; ++r) { int orow = crow(r, hi);
    for (int d0 = 0; d0 < 4; ++d0) Ow[(int)orow * LDO + d0 * 32 + r32] = (unsigned short)f2bf(o[d0][r] * rli[r]); }
#undef SLOAD
#undef SWRITE
#undef SWAIT
#undef RESC
}

#undef KSWZ
#undef SBAR
}
#define LAS __attribute__((address_space(3)))
constexpr int NWAVES = 8;
constexpr int LDS_BYTES = 147456;
constexpr size_t MiB = (size_t)1 << 20;
constexpr size_t WS_CTL = 0, CTL_ZERO_BYTES = 1 * MiB;
constexpr size_t WS_MODS = 1 * MiB, WS_ROPE = WS_MODS + MiB / 2;
constexpr size_t WS_WT_AIN = 2 * MiB, WS_WT_AOUT = 8 * MiB, WS_WT_DIN = 12 * MiB, WS_WT_DOUT = 29 * MiB, WS_WT_W1 = 33 * MiB, WS_WT_W2 = 65 * MiB;
constexpr size_t WS_X = 97 * MiB, WS_H = 137 * MiB, WS_Y = 157 * MiB, WS_PROJ = 177 * MiB, WS_AB = 257 * MiB;
constexpr size_t WS_SOP = 291 * MiB, WS_QB = 291 * MiB, WS_KB = 311 * MiB, WS_VB = 317 * MiB;
constexpr size_t WS_EGL = 471 * MiB, WS_OF = 472 * MiB, WS_OB = 492 * MiB, WS_END = 512 * MiB;
static_assert(WS_SOP + (size_t)2560 * 73728 <= WS_EGL, "operand records");

struct Ctx {
    LAS unsigned char* lds;
    int tid, lane, wid, gw, ngw, nblk, blk;
};
struct ProPtrs { const float *c, *c_ctx, *w_mod, *b_mod, *attn_w_in, *attn_w_out, *dn_w_in, *dn_w_out, *mlp_w1, *mlp_w2; float *mods, *rope; bf16raw *wt_ain, *wt_aout, *wt_din, *wt_dout, *wt_w1, *wt_w2; };

#define LDS_WAIT() asm volatile("s_waitcnt lgkmcnt(0)" ::: "memory")

__device__ __forceinline__ void p0_transpose_item(const float* W, int K, int N, bf16raw* WT, LAS float* scr, int item, int lane) {
    const int nblk = N / 32, kb = item / nblk, nb = item % nblk, k0 = 64 * kb, n0 = 32 * nb;
#pragma unroll 8
    for (int i = 0; i < 32; ++i) { const int kk = 2 * i + (lane >> 5); scr[kk * 33 + (lane & 31)] = W[(size_t)(k0 + kk) * N + n0 + (lane & 31)]; }
    LDS_WAIT(); asm volatile("" ::: "memory");
    const int c = lane & 7;
#pragma unroll
    for (int j = 0; j < 4; ++j) { const int n = (lane >> 3) + 8 * j; const LAS float* s = scr + (8 * c) * 33 + n;
        u32x4_t o; o.x = pk2(s[0 * 33], s[1 * 33]); o.y = pk2(s[2 * 33], s[3 * 33]); o.z = pk2(s[4 * 33], s[5 * 33]); o.w = pk2(s[6 * 33], s[7 * 33]);
        *(u32x4_t*)(WT + (size_t)(n0 + n) * K + k0 + 8 * c) = o; }
    LDS_WAIT(); asm volatile("" ::: "memory");
}

__device__ __forceinline__ void phase_prologue(Ctx& C, const ProPtrs& P) {
    LAS float* sc = (LAS float*)C.lds;
    LAS float* red = (LAS float*)(C.lds + 12288);
    for (int k = C.tid; k < 1024; k += 512) { sc[k] = silu_f(P.c_ctx[k]); sc[1024 + k] = silu_f(P.c[k]); sc[2048 + k] = silu_f(P.c[1024 + k]); }
    __syncthreads();
    for (int u = C.blk; u < 4 * 96; u += C.nblk) {
        const int l = u / 96, n0 = (u % 96) * 64;
        const float* w = P.w_mod + ((size_t)l * 1024 + C.wid * 128) * 6144 + n0 + C.lane;
        float a0 = 0.f, a1 = 0.f, a2 = 0.f;
#pragma unroll 8
        for (int k = 0; k < 128; ++k) { const float wv = w[(size_t)k * 6144]; const int kk = C.wid * 128 + k; a0 += sc[kk] * wv; a1 += sc[1024 + kk] * wv; a2 += sc[2048 + kk] * wv; }
        red[(C.wid * 3 + 0) * 64 + C.lane] = a0; red[(C.wid * 3 + 1) * 64 + C.lane] = a1; red[(C.wid * 3 + 2) * 64 + C.lane] = a2;
        __syncthreads();
        if (C.tid < 192) { const int s = C.tid >> 6, ln = C.tid & 63; float t = 0.f;
#pragma unroll
            for (int w8 = 0; w8 < 8; ++w8) t += red[(w8 * 3 + s) * 64 + ln];
            P.mods[(size_t)(l * 3 + s) * 6144 + n0 + ln] = t + P.b_mod[l * 6144 + n0 + ln]; }
        __syncthreads();
    }
    __syncthreads();
    LAS float* scr = (LAS float*)(C.lds + C.wid * 16384);
    constexpr int I0 = 2 * 768, I1 = 2 * 512, I2 = 2 * 2064, I3 = 2 * 512, I4 = 4 * 2048, I5 = 4 * 2048;
    for (int it = C.gw; it < I0 + I1 + I2 + I3 + I4 + I5; it += C.ngw) {
        int r = it;
        if (r < I0) { const int j = r / 768; p0_transpose_item(P.attn_w_in + (size_t)j * 1024 * 1536, 1024, 1536, P.wt_ain + (size_t)j * 1536 * 1024, scr, r % 768, C.lane); continue; } r -= I0;
        if (r < I1) { const int j = r / 512; p0_transpose_item(P.attn_w_out + (size_t)j * 1024 * 1024, 1024, 1024, P.wt_aout + (size_t)j * 1024 * 1024, scr, r % 512, C.lane); continue; } r -= I1;
        if (r < I2) { const int j = r / 2064; p0_transpose_item(P.dn_w_in + (size_t)j * 1024 * DNIN, 1024, DNIN, P.wt_din + (size_t)j * DNINP * 1024, scr, r % 2064, C.lane); continue; } r -= I2;
        if (r < I3) { const int j = r / 512; p0_transpose_item(P.dn_w_out + (size_t)j * 1024 * 1024, 1024, 1024, P.wt_dout + (size_t)j * 1024 * 1024, scr, r % 512, C.lane); continue; } r -= I3;
        if (r < I4) { const int l = r / 2048; p0_transpose_item(P.mlp_w1 + (size_t)l * 1024 * 4096, 1024, 4096, P.wt_w1 + (size_t)l * 4096 * 1024, scr, r % 2048, C.lane); continue; } r -= I4;
        { const int l = r / 2048; p0_transpose_item(P.mlp_w2 + (size_t)l * 4096 * 1024, 4096, 1024, P.wt_w2 + (size_t)l * 1024 * 4096, scr, r % 2048, C.lane); }
    }
    const int gt = C.blk * 512 + C.tid, ngt = C.nblk * 512;
    for (int i = gt; i < 2 * 28672; i += ngt) { const int j = i / 28672, o = i % 28672;
        *(u32x4_t*)(P.wt_din + ((size_t)j * DNINP + DNIN) * 1024 + (size_t)o * 8) = (u32x4_t){0u, 0u, 0u, 0u}; }
    for (int i = gt; i < 1024 * 64; i += ngt) { const int t = i >> 6, a = (i >> 5) & 1, f = i & 31;
        const float inv = powf(10000.f, -(float)f / 32.f); const float ang = (float)(a ? (t & 63) : (t >> 6)) * inv;
        P.rope[2 * i] = cosf(ang); P.rope[2 * i + 1] = sinf(ang); }
}

__device__ __forceinline__ void phase_norm(Ctx& C, const float* src_ctx, const float* src_lat, const float* gain, const float* md0, bf16raw* H) {
    for (int row = C.gw; row < MTOK; row += C.ngw) {
        const float* xr = row < NCTX ? src_ctx + (size_t)row * D : src_lat + (size_t)(row - NCTX) * D;
        const float* md = md0 + cond_of(row) * 6144;
        f32x4_t v[4]; float ss = 0.f;
#pragma unroll
        for (int j = 0; j < 4; ++j) { v[j] = *(const f32x4_t*)(xr + 4 * C.lane + 256 * j); ss += (v[j].x * v[j].x + v[j].y * v[j].y) + (v[j].z * v[j].z + v[j].w * v[j].w); }
        const float rinv = rsqrtf(wave_sum(ss, C.lane) * (1.f / D) + EPS);
#pragma unroll
        for (int j = 0; j < 4; ++j) { const int c = 4 * C.lane + 256 * j;
            const f32x4_t g = *(const f32x4_t*)(gain + c), sh = *(const f32x4_t*)(md + c), sc = *(const f32x4_t*)(md + 1024 + c);
            const f32x4_t y = v[j] * rinv * g * (sc + 1.f) + sh;
            u32x2_t o; o.x = pk2(y.x, y.y); o.y = pk2(y.z, y.w);
            *(u32x2_t*)(H + (size_t)row * D + c) = o; }
    }
}
__device__ __forceinline__ void phase_final(Ctx& C, const float* X, const float* final_norm, float* out) {
    for (int row = C.gw; row < MTOK; row += C.ngw) {
        const float* xr = X + (size_t)row * D;
        f32x4_t v[4]; float ss = 0.f;
#pragma unroll
        for (int j = 0; j < 4; ++j) { v[j] = *(const f32x4_t*)(xr + 4 * C.lane + 256 * j); ss += (v[j].x * v[j].x + v[j].y * v[j].y) + (v[j].z * v[j].z + v[j].w * v[j].w); }
        const float rinv = rsqrtf(wave_sum(ss, C.lane) * (1.f / D) + EPS);
#pragma unroll
        for (int j = 0; j < 4; ++j) { const int c = 4 * C.lane + 256 * j; const f32x4_t g = *(const f32x4_t*)(final_norm + c);
            *(f32x4_t*)(out + O_Y + (size_t)row * D + c) = v[j] * rinv * g; }
    }
}

struct QknPtrs { const bf16raw* PROJ; bf16raw *QB, *KB, *VB; const float *qg, *kg, *rope, *cache_k, *cache_v; float* out; };
__device__ __forceinline__ void phase_qkn(Ctx& C, const QknPtrs& P, int j) {
    const unsigned* P32 = (const unsigned*)P.PROJ; unsigned* Q32 = (unsigned*)P.QB; unsigned* K32 = (unsigned*)P.KB; unsigned* V32 = (unsigned*)P.VB;
    const float* qg = P.qg; const float* kg = P.kg;
    const int lane = C.lane;
    const f32x2_t gq = *(const f32x2_t*)(qg + 2 * lane), gk = *(const f32x2_t*)(kg + 2 * lane);
    for (int row = C.gw; row < MTOK; row += C.ngw) {
        const bool lat = row >= NCTX;
        const int b = lat ? (row - NCTX) >> 10 : row >> 8, t = lat ? (row - NCTX) & 1023 : row & 255;
        const int krow = lat ? 8192 + b * 1280 + 256 + t : row;
        f32x4_t rp = (f32x4_t){1.f, 0.f, 1.f, 0.f};
        if (lat) rp = *(const f32x4_t*)(P.rope + ((size_t)t * 64 + (lane >> 5) * 32 + 2 * (lane & 15)) * 2);
        const bool ph = (lane >> 4) & 1;
#pragma unroll
        for (int slot = 0; slot < 12; ++slot) {
            const unsigned w = P32[(size_t)row * 768 + slot * 64 + lane];
            float v0 = bf_lo(w), v1 = bf_hi(w);
            if (slot < 10) {
                const float rinv = rsqrtf(wave_sum(v0 * v0 + v1 * v1, lane) * (1.f / 128.f) + EPS);
                const f32x2_t g = slot < 8 ? gq : gk;
                v0 = v0 * rinv * g.x; v1 = v1 * rinv * g.y;
                if (lat) { const float y0 = lane_xor_f(v0, lane, 16), y1 = lane_xor_f(v1, lane, 16);
                    v0 = v0 * rp.x + (ph ? y0 : -y0) * rp.y; v1 = v1 * rp.z + (ph ? y1 : -y1) * rp.w; }
            }
            const unsigned o = pk2(v0, v1);
            if (slot < 8) Q32[(size_t)row * 512 + slot * 64 + lane] = o;
            else if (slot < 10) K32[(size_t)krow * 128 + (slot - 8) * 64 + lane] = o;
            else V32[(size_t)krow * 128 + (slot - 10) * 64 + lane] = o;
            if (!lat && slot >= 8) { float* op = P.out + (slot < 10 ? O_CK : O_CV) + ((size_t)(b * 2 + j) * 256 + t) * 256 + (slot & 1) * 128 + 2 * lane;
                *(f32x2_t*)op = (f32x2_t){v0, v1}; }
        }
    }
    for (int it = C.gw; it < 2 * 256 * 2; it += C.ngw) {
        const int kv = it & 1, key = (it >> 1) & 255, b = it >> 9;
        const float* src = (kv ? P.cache_v : P.cache_k) + ((size_t)(b * 2 + j) * 256 + key) * 256 + 4 * lane;
        const f32x4_t v = *(const f32x4_t*)src;
        u32x2_t o; o.x = pk2(v.x, v.y); o.y = pk2(v.z, v.w);
        *(u32x2_t*)((kv ? P.VB : P.KB) + (size_t)(8192 + b * 1280 + key) * 256 + 4 * lane) = o;
    }
}

struct AttnPtrs { const bf16raw *QB, *KB, *VB; bf16raw* Y; };
__device__ __forceinline__ void phase_attn(Ctx& C, const AttnPtrs& P) {
    char* lds = (char*)C.lds;
    for (int r = 0; r * C.nblk < 320; ++r) {
        const int u = r * C.nblk + (C.blk + r * (C.nblk - 64)) % C.nblk;
        if (u >= 320) continue;
        int row0, krow0, hq, seq;
        if (u < 64) { const int b = u >> 5, qb = u & 3; hq = (u >> 2) & 7; row0 = NCTX + b * 1024 + qb * 256; krow0 = 8192 + b * 1280; seq = 1280; }
        else { const int c = u - 64, b = c >> 3; hq = c & 7; row0 = b * 256; krow0 = b * 256; seq = 256; }
        const int kvh = hq >> 2;
        if (r > 0) __syncthreads();
        attn::attn_dense_body<attn::bf16>((const attn::bf16*)(P.QB + (size_t)row0 * 1024 + hq * 128), (const attn::bf16*)(P.KB + (size_t)krow0 * 256 + kvh * 128),
                                          (const attn::bf16*)(P.VB + (size_t)krow0 * 256 + kvh * 128), P.Y + (size_t)row0 * 1024 + hq * 128, seq, lds, C.tid);
    }
}
struct GatePtrs { const bf16raw *OF, *OB, *PROJ; bf16raw* Y; const float* gain; };
__device__ __forceinline__ void phase_gate(Ctx& C, const GatePtrs& P) {
    const unsigned* F32 = (const unsigned*)P.OF; const unsigned* B32 = (const unsigned*)P.OB; const unsigned* P32 = (const unsigned*)P.PROJ; unsigned* Y32 = (unsigned*)P.Y;
    const int lane = C.lane;
    const f32x2_t g = *(const f32x2_t*)(P.gain + 2 * lane);
    for (int it = C.gw; it < MTOK * 8; it += C.ngw) {
        const int row = it >> 3, h = it & 7;
        const unsigned wf = F32[(size_t)row * 512 + h * 64 + lane], wb = B32[(size_t)row * 512 + h * 64 + lane], wz = P32[(size_t)row * 2048 + 1536 + h * 64 + lane];
        const float v0 = bf_lo(wf) + bf_lo(wb), v1 = bf_hi(wf) + bf_hi(wb);
        const float rinv = rsqrtf(wave_sum(v0 * v0 + v1 * v1, lane) * (1.f / 128.f) + EPS);
        Y32[(size_t)row * 512 + h * 64 + lane] = pk2(v0 * rinv * g.x * silu_f(bf_lo(wz)), v1 * rinv * g.y * silu_f(bf_hi(wz)));
    }
}
constexpr int REC_U = 0, REC_WN = 16384, REC_QT = 32768, REC_QK = 49152, REC_KT = 57344, REC_BYTES = 73728;
typedef short dn_bf16x8 __attribute__((ext_vector_type(8)));
typedef float dn_f32x16 __attribute__((ext_vector_type(16)));
__device__ __forceinline__ int dn_crow(int r, int hi) { return (r & 3) + 8 * (r >> 2) + 4 * hi; }
typedef __bf16 dn_bf16x2 __attribute__((ext_vector_type(2)));
__device__ __forceinline__ unsigned dn_cvt_pk(float lo, float hi) { const f32x2_t v = {lo, hi}; return __builtin_bit_cast(unsigned, __builtin_convertvector(v, dn_bf16x2)); }

struct DnLocalPtrs { const bf16raw* PROJ; const float *AB, *cw, *alog, *dtb; unsigned char* SOP; float* EGL; };

__device__ __forceinline__ void phase_dn_local(Ctx& C, const DnLocalPtrs& P) {
    constexpr int L_Q = 0, L_K = 17408, L_V = 34816, L_GC = 52224, L_BT = 52736, L_AM = 53248, L_QK = L_AM + 2 * 17408;
    LAS unsigned char* L = C.lds;
    const unsigned* P32 = (const unsigned*)P.PROJ;
    LAS float* gcs = (LAS float*)(L + L_GC); LAS float* bts = (LAS float*)(L + L_BT);
    for (int u = C.blk; u < 1280; u += C.nblk) {
        int tid = C.tid; asm volatile("" : "+v"(tid));
        const int lane = tid & 63, wid = __builtin_amdgcn_readfirstlane(tid >> 6), dir = wid >> 2, w4 = wid & 3, t256 = tid & 255, r32 = lane & 31, hi = lane >> 5;
        const int h = u & 7, cidx = u >> 3;
        int npr, N, T, base, cbase;
        if (cidx < 128) { const int seq = cidx >> 2; npr = cidx & 3; N = 4; T = 256; base = seq * 256; cbase = cidx - npr; }
        else { const int c2 = cidx - 128, sq = c2 >> 4; npr = c2 & 15; N = 16; T = 1024; base = NCTX + sq * 1024; cbase = cidx - npr; }
        if (wid < 2) {
            const int tau = wid ? 63 - lane : lane; const size_t row = (size_t)(base + 64 * npr + tau);
            const float a = P.AB[row * 32 + wid * 8 + h], b = P.AB[row * 32 + 16 + wid * 8 + h];
            const float x = a + P.dtb[wid * 8 + h]; const float sp = x > 20.f ? x : log1pf(expf(x));
            float g = -expf(P.alog[wid * 8 + h]) * sp;
#pragma unroll
            for (int o = 1; o < 64; o <<= 1) { const float t = __builtin_bit_cast(float, __builtin_amdgcn_ds_bpermute((lane - o) << 2, __builtin_bit_cast(int, g))); if (lane >= o) g += t; }
            gcs[wid * 64 + lane] = g; bts[wid * 64 + lane] = 1.f / (1.f + expf(-b));
        }
        {
            const int tau0 = 8 * wid;
#pragma unroll
            for (int X = 0; X < 3; ++X) {
                const int cb = X * 1024 + h * 128;
                float w0[12], w1[12];
#pragma unroll
                for (int i = 0; i < 12; ++i) { const int tt = 64 * npr + tau0 - 2 + i; unsigned w = 0u;
                    if (tt >= 0 && tt < T) w = P32[(size_t)(base + tt) * 2048 + (cb >> 1) + lane];
                    w0[i] = bf_lo(w); w1[i] = bf_hi(w); }
                f32x2_t cwv[5];
#pragma unroll
                for (int i = 0; i < 5; ++i) cwv[i] = *(const f32x2_t*)(P.cw + i * 3072 + cb + 2 * lane);
#pragma unroll
                for (int r = 0; r < 8; ++r) {
                    float a0 = 0.f, a1 = 0.f;
#pragma unroll
                    for (int i = 0; i < 5; ++i) { a0 += w0[r + i] * cwv[i].x; a1 += w1[r + i] * cwv[i].y; }
                    a0 = silu_f(a0); a1 = silu_f(a1);
                    if (X < 2) { const float rinv = rsqrtf(wave_sum(a0 * a0 + a1 * a1, lane) + EPS); a0 *= rinv; a1 *= rinv; }
                    *(LAS unsigned*)(L + (X == 0 ? L_Q : X == 1 ? L_K : L_V) + (tau0 + r) * 272 + lane * 4) = pk2(a0, a1);
                }
            }
        }
        __syncthreads();
        {
            const int ti = w4 >> 1, tj = w4 & 1;
            dn_f32x16 accK = {}, accQ = {};
            if (ti >= tj) {
                const int pa = 32 * ti + r32, pb = 32 * tj + r32;
                const int rowA = dir ? 63 - pa : pa, rowB = dir ? 63 - pb : pb;
#pragma unroll
                for (int s = 0; s < 8; ++s) {
                    const int co = (16 * s + 8 * hi) * 2;
                    const dn_bf16x8 Ak = *(const LAS dn_bf16x8*)(L + L_K + rowA * 272 + co), Aq = *(const LAS dn_bf16x8*)(L + L_Q + rowA * 272 + co), Bk = *(const LAS dn_bf16x8*)(L + L_K + rowB * 272 + co);
                    accK = __builtin_amdgcn_mfma_f32_32x32x16_bf16(Ak, Bk, accK, 0, 0, 0);
                    accQ = __builtin_amdgcn_mfma_f32_32x32x16_bf16(Aq, Bk, accQ, 0, 0, 0);
                }
            }
            const int pj = 32 * tj + r32; const float gcj = gcs[dir * 64 + pj];
#pragma unroll
            for (int reg = 0; reg < 16; ++reg) {
                const int pi = 32 * ti + dn_crow(reg, hi);
                const float dec = pi >= pj ? __expf(gcs[dir * 64 + pi] - gcj) : 0.f;
                const float am = pi > pj ? bts[dir * 64 + pi] * accK[reg] * dec : 0.f;
                const float qk = ATT_SCALE * accQ[reg] * dec;
                *(LAS float*)(L + L_AM + dir * 17408 + pi * 272 + pj * 4) = am;
                *(LAS bf16raw*)(L + L_QK + dir * 9216 + pi * 144 + pj * 2) = (bf16raw)f2bf(qk);
            }
        }
        __syncthreads();
        const int rec_n = dir ? N - 1 - npr : npr;
        const int recid = ((cbase + rec_n) * 8 + h) * 2 + dir;
        unsigned char* rec = P.SOP + (size_t)recid * REC_BYTES;
        float x[64];
        {
            const bool isK = w4 >= 2; const float kmask = isK ? 1.f : 0.f;
            const LAS unsigned char* src = L + (isK ? L_K : L_V) + (t256 & 127) * 2;
            const LAS unsigned char* am = L + L_AM + dir * 17408;
            f32x4_t nx[16];
            nx[0] = (f32x4_t){0.f, 0.f, 0.f, 0.f};
#pragma unroll
            for (int i = 0; i < 64; ++i) {
                f32x4_t cu[16];
#pragma unroll
                for (int j4 = 0; j4 < (i + 3) / 4; ++j4) cu[j4] = nx[j4];
                if (i + 1 < 64) {
#pragma unroll
                    for (int j4 = 0; j4 < (i + 4) / 4; ++j4) nx[j4] = *(const LAS f32x4_t*)(am + (i + 1) * 272 + j4 * 16);
                }
                const int tau = dir ? 63 - i : i;
                float rhs = bts[dir * 64 + i] * bf2f(*(const LAS bf16raw*)(src + tau * 272));
                rhs *= __expf(gcs[dir * 64 + i] * kmask);
                asm volatile("" ::: "memory");
                float acc = rhs;
#pragma unroll
                for (int j4 = 0; j4 < (i + 3) / 4; ++j4) {
                    if (4 * j4 + 0 < i) acc -= cu[j4].x * x[4 * j4 + 0];
                    if (4 * j4 + 1 < i) acc -= cu[j4].y * x[4 * j4 + 1];
                    if (4 * j4 + 2 < i) acc -= cu[j4].z * x[4 * j4 + 2];
                    if (4 * j4 + 3 < i) acc -= cu[j4].w * x[4 * j4 + 3];
                }
                x[i] = acc;
            }
            if (!isK) {
                const int c = t256;
#pragma unroll
                for (int mt = 0; mt < 2; ++mt)
#pragma unroll
                    for (int hh = 0; hh < 2; ++hh) {
                        u32x4_t o0, o1;
                        o0.x = dn_cvt_pk(x[32 * mt + dn_crow(0, hh)], x[32 * mt + dn_crow(1, hh)]); o0.y = dn_cvt_pk(x[32 * mt + dn_crow(2, hh)], x[32 * mt + dn_crow(3, hh)]);
                        o0.z = dn_cvt_pk(x[32 * mt + dn_crow(4, hh)], x[32 * mt + dn_crow(5, hh)]); o0.w = dn_cvt_pk(x[32 * mt + dn_crow(6, hh)], x[32 * mt + dn_crow(7, hh)]);
                        o1.x = dn_cvt_pk(x[32 * mt + dn_crow(8, hh)], x[32 * mt + dn_crow(9, hh)]); o1.y = dn_cvt_pk(x[32 * mt + dn_crow(10, hh)], x[32 * mt + dn_crow(11, hh)]);
                        o1.z = dn_cvt_pk(x[32 * mt + dn_crow(12, hh)], x[32 * mt + dn_crow(13, hh)]); o1.w = dn_cvt_pk(x[32 * mt + dn_crow(14, hh)], x[32 * mt + dn_crow(15, hh)]);
                        unsigned char* up = rec + REC_U + (size_t)(((mt * 4 + (c >> 5)) * 64 + (c & 31) + 32 * hh) * 32);
                        *(u32x4_t*)up = o0; *(u32x4_t*)(up + 16) = o1;
                    }
            }
        }
        __syncthreads();
        if (w4 >= 2) {
            LAS unsigned char* wt = L + L_AM + dir * 17408 + (t256 - 128) * 2;
#pragma unroll
            for (int i = 0; i < 64; ++i) *(LAS bf16raw*)(wt + i * 264) = (bf16raw)f2bf(-x[i]);
        }
        __syncthreads();
        {
            const LAS unsigned char* wt = L + L_AM + dir * 17408;
#pragma unroll
            for (int i = 0; i < 4; ++i) {
                const int id = t256 + 256 * i, mt = id >> 9, kt = (id >> 6) & 7, r = id & 31, hh = (id >> 5) & 1;
                const int p = 32 * mt + r, dk0 = 32 * (kt >> 1) + 16 * (kt & 1) + 4 * hh;
                const u32x2_t wl = *(const LAS u32x2_t*)(wt + p * 264 + dk0 * 2), wh = *(const LAS u32x2_t*)(wt + p * 264 + (dk0 + 8) * 2);
                *(u32x4_t*)(rec + REC_WN + (size_t)id * 16) = (u32x4_t){wl.x, wl.y, wh.x, wh.y};
                const int tau = dir ? 63 - p : p; const float sc = ATT_SCALE * __expf(gcs[dir * 64 + p]);
                const u32x2_t ql = *(const LAS u32x2_t*)(L + L_Q + tau * 272 + dk0 * 2), qh = *(const LAS u32x2_t*)(L + L_Q + tau * 272 + (dk0 + 8) * 2);
                u32x4_t qo; qo.x = dn_cvt_pk(bf_lo(ql.x) * sc, bf_hi(ql.x) * sc); qo.y = dn_cvt_pk(bf_lo(ql.y) * sc, bf_hi(ql.y) * sc);
                qo.z = dn_cvt_pk(bf_lo(qh.x) * sc, bf_hi(qh.x) * sc); qo.w = dn_cvt_pk(bf_lo(qh.y) * sc, bf_hi(qh.y) * sc);
                *(u32x4_t*)(rec + REC_QT + (size_t)id * 16) = qo;
            }
            const float glast = gcs[dir * 64 + 63];
#pragma unroll
            for (int i = 0; i < 4; ++i) {
                const int id = t256 + 256 * i, mt = id >> 8, kt = (id >> 6) & 3, r = id & 31, hh = (id >> 5) & 1;
                const int c0 = 32 * (kt >> 1) + 16 * (kt & 1) + 4 * hh;
                float kv[8];
#pragma unroll
                for (int jj = 0; jj < 8; ++jj) { const int c = c0 + 8 * (jj >> 2) + (jj & 3); const int tau = dir ? 63 - c : c;
                    kv[jj] = bf2f(*(const LAS bf16raw*)(L + L_K + tau * 272 + (32 * mt + r) * 2)) * __expf(glast - gcs[dir * 64 + c]); }
                u32x4_t ko; ko.x = dn_cvt_pk(kv[0], kv[1]); ko.y = dn_cvt_pk(kv[2], kv[3]); ko.z = dn_cvt_pk(kv[4], kv[5]); ko.w = dn_cvt_pk(kv[6], kv[7]);
                *(u32x4_t*)(rec + REC_KT + (size_t)id * 16) = ko;
            }
#pragma unroll
            for (int i = 0; i < 2; ++i) {
                const int id = t256 + 256 * i, mt = id >> 8, kt = (id >> 6) & 3, r = id & 31, hh = (id >> 5) & 1;
                const int c0 = 32 * (kt >> 1) + 16 * (kt & 1) + 4 * hh;
                const LAS unsigned char* qp = L + L_QK + dir * 9216 + (32 * mt + r) * 144;
                const u32x2_t a = *(const LAS u32x2_t*)(qp + c0 * 2), b = *(const LAS u32x2_t*)(qp + (c0 + 8) * 2);
                *(u32x4_t*)(rec + REC_QK + (size_t)id * 16) = (u32x4_t){a.x, a.y, b.x, b.y};
            }
            if (t256 == 0) P.EGL[recid] = __expf(glast);
        }
        __syncthreads();
    }
}

struct DnScanPtrs { const unsigned char* SOP; const float *EGL, *state_delta; bf16raw *OF, *OB; float* out; };

__device__ __forceinline__ dn_bf16x8 dn_acc_frag(const dn_f32x16& a, int s) {
    u32x4_t w;
    if (s == 0) { w.x = dn_cvt_pk(a[0], a[1]); w.y = dn_cvt_pk(a[2], a[3]); w.z = dn_cvt_pk(a[4], a[5]); w.w = dn_cvt_pk(a[6], a[7]); }
    else { w.x = dn_cvt_pk(a[8], a[9]); w.y = dn_cvt_pk(a[10], a[11]); w.z = dn_cvt_pk(a[12], a[13]); w.w = dn_cvt_pk(a[14], a[15]); }
    return __builtin_bit_cast(dn_bf16x8, w);
}

__device__ __forceinline__ void phase_dn_scan(Ctx& C, const DnScanPtrs& P, int j) {
    const int slot = C.wid * C.nblk + C.blk, nslot = C.ngw;
    for (int r = 0; r * nslot < 2176; ++r) {
        const int u = r * nslot + (slot + r * (nslot - 128)) % nslot;
        if (u >= 2176) continue;
        int lane = C.lane; asm volatile("" : "+v"(lane));
        const int r32 = lane & 31, hi = lane >> 5;
        int seq, h, dir, sl, N, T, base, cbase; bool lat = u < 128;
        if (lat) { seq = 32 + (u >> 6); h = (u >> 3) & 7; dir = (u >> 2) & 1; sl = u & 3; N = 16; T = 1024; base = NCTX + (seq - 32) * 1024; cbase = 128 + 16 * (seq - 32); }
        else { const int c = u - 128; seq = c >> 6; h = (c >> 3) & 7; dir = (c >> 2) & 1; sl = c & 3; N = 4; T = 256; base = seq * 256; cbase = 4 * seq; }
        dn_f32x16 S[4];
        if (lat) { const float* sp = P.state_delta + ((((size_t)(seq - 32) * 2 + j) * 2 + dir) * 8 + h) * 16384 + 32 * sl + r32;
#pragma unroll
            for (int t4 = 0; t4 < 4; ++t4)
#pragma unroll
                for (int reg = 0; reg < 16; ++reg) S[t4][reg] = sp[(size_t)(32 * t4 + dn_crow(reg, hi)) * 128]; }
        else {
#pragma unroll
            for (int t4 = 0; t4 < 4; ++t4) S[t4] = (dn_f32x16){}; }
        bf16raw* Od = (dir ? P.OB : P.OF) + (size_t)base * 1024 + h * 128 + 32 * sl + r32;
        for (int n = 0; n < N; ++n) {
            const int recid = ((cbase + n) * 8 + h) * 2 + dir;
            const unsigned char* rec = P.SOP + (size_t)recid * REC_BYTES + lane * 16;
            const float eg = P.EGL[recid];
            dn_bf16x8 Sb[8];
#pragma unroll
            for (int kt = 0; kt < 8; ++kt) Sb[kt] = dn_acc_frag(S[kt >> 1], kt & 1);
#define DN_FENCE() asm volatile("" ::: "memory")
#define DN_LD8(F, off) do { _Pragma("unroll") for (int q_ = 0; q_ < 8; ++q_) F[q_] = *(const dn_bf16x8*)(rec + (off) + q_ * 1024); } while (0)
            dn_bf16x8 F[8];
            dn_f32x16 av[2];
#pragma unroll
            for (int mt = 0; mt < 2; ++mt) {
                const unsigned char* up = P.SOP + (size_t)recid * REC_BYTES + REC_U + (size_t)(((mt * 4 + sl) * 64 + lane) * 32);
                const u32x4_t u0 = *(const u32x4_t*)up, u1 = *(const u32x4_t*)(up + 16);
                DN_LD8(F, REC_WN + mt * 8192);
                DN_FENCE();
                dn_f32x16 a;
                a[0] = bf_lo(u0.x); a[1] = bf_hi(u0.x); a[2] = bf_lo(u0.y); a[3] = bf_hi(u0.y); a[4] = bf_lo(u0.z); a[5] = bf_hi(u0.z); a[6] = bf_lo(u0.w); a[7] = bf_hi(u0.w);
                a[8] = bf_lo(u1.x); a[9] = bf_hi(u1.x); a[10] = bf_lo(u1.y); a[11] = bf_hi(u1.y); a[12] = bf_lo(u1.z); a[13] = bf_hi(u1.z); a[14] = bf_lo(u1.w); a[15] = bf_hi(u1.w);
#pragma unroll
                for (int kt = 0; kt < 8; ++kt) a = __builtin_amdgcn_mfma_f32_32x32x16_bf16(F[kt], Sb[kt], a, 0, 0, 0);
                av[mt] = a;
                DN_FENCE();
            }
            dn_bf16x8 vb[4];
#pragma unroll
            for (int kt = 0; kt < 4; ++kt) vb[kt] = dn_acc_frag(av[kt >> 1], kt & 1);
            dn_f32x16 ao[2];
#pragma unroll
            for (int mt = 0; mt < 2; ++mt) {
                DN_LD8(F, REC_QT + mt * 8192);
                DN_FENCE();
                dn_f32x16 a = {};
#pragma unroll
                for (int kt = 0; kt < 8; ++kt) a = __builtin_amdgcn_mfma_f32_32x32x16_bf16(F[kt], Sb[kt], a, 0, 0, 0);
                ao[mt] = a;
                DN_FENCE();
            }
            DN_LD8(F, REC_QK);
            DN_FENCE();
#pragma unroll
            for (int mt = 0; mt < 2; ++mt) {
                dn_f32x16 a = ao[mt];
#pragma unroll
                for (int kt = 0; kt < 4; ++kt) a = __builtin_amdgcn_mfma_f32_32x32x16_bf16(F[mt * 4 + kt], vb[kt], a, 0, 0, 0);
#pragma unroll
                for (int reg = 0; reg < 16; ++reg) { const int p = 64 * n + 32 * mt + dn_crow(reg, hi); const int t = dir ? T - 1 - p : p;
                    Od[(size_t)t * 1024] = (bf16raw)f2bf(a[reg]); }
            }
            DN_FENCE();
#pragma unroll
            for (int t2 = 0; t2 < 2; ++t2) {
                DN_LD8(F, REC_KT + t2 * 8192);
                DN_FENCE();
#pragma unroll
                for (int tt = 0; tt < 2; ++tt) {
                    dn_f32x16 a = S[2 * t2 + tt] * eg;
#pragma unroll
                    for (int kt = 0; kt < 4; ++kt) a = __builtin_amdgcn_mfma_f32_32x32x16_bf16(F[tt * 4 + kt], vb[kt], a, 0, 0, 0);
                    S[2 * t2 + tt] = a;
                }
                DN_FENCE();
            }
#undef DN_FENCE
#undef DN_LD8
        }
        if (!lat) { float* sp = P.out + O_ST + ((((size_t)seq * 2 + j) * 2 + dir) * 8 + h) * 16384 + 32 * sl + r32;
#pragma unroll
            for (int t4 = 0; t4 < 4; ++t4)
#pragma unroll
                for (int reg = 0; reg < 16; ++reg) sp[(size_t)(32 * t4 + dn_crow(reg, hi)) * 128] = S[t4][reg]; }
    }
}

__device__ __forceinline__ void phase_dn_scan2(Ctx& C, const DnScanPtrs& P, int j) {
    LAS unsigned char* L = C.lds;
    const int wid = C.wid; const bool consumer = wid < 4; const int sl = wid & 3;
    const int nun = C.nblk == 256 ? (C.blk < 32 ? 1 : 3) : (544 + C.nblk - 1) / C.nblk;
    for (int ui = 0; ui < nun; ++ui) {
        int sid;
        if (C.nblk == 256) { if (C.blk < 32) sid = C.blk; else { const int c = (C.blk - 32) + 224 * ui; if (c >= 512) break; sid = 32 + c; } }
        else { sid = C.blk + ui * C.nblk; if (sid >= 544) break; }
        int lane = C.lane; asm volatile("" : "+v"(lane));
        const int r32 = lane & 31, hi = lane >> 5;
        int seq, h, dir, N, T, base, cbase; const bool lat = sid < 32;
        if (lat) { seq = 32 + (sid >> 4); h = (sid >> 1) & 7; dir = sid & 1; N = 16; T = 1024; base = NCTX + (seq - 32) * 1024; cbase = 128 + 16 * (seq - 32); }
        else { const int c = sid - 32; seq = c >> 4; h = (c >> 1) & 7; dir = c & 1; N = 4; T = 256; base = seq * 256; cbase = 4 * seq; }
        const int rec0 = (cbase * 8 + h) * 2 + dir;
        const unsigned char* rbase = P.SOP + (size_t)rec0 * REC_BYTES;
        constexpr size_t RSTRIDE = (size_t)16 * REC_BYTES;
#define DN2_BAR() __builtin_amdgcn_s_barrier()
        if (consumer) {
            dn_f32x16 S[4];
            if (lat) { const float* sp = P.state_delta + ((((size_t)(seq - 32) * 2 + j) * 2 + dir) * 8 + h) * 16384 + 32 * sl + r32;
#pragma unroll
                for (int t4 = 0; t4 < 4; ++t4)
#pragma unroll
                    for (int reg = 0; reg < 16; ++reg) S[t4][reg] = sp[(size_t)(32 * t4 + dn_crow(reg, hi)) * 128]; }
            else {
#pragma unroll
                for (int t4 = 0; t4 < 4; ++t4) S[t4] = (dn_f32x16){}; }
            bf16raw* Od = (dir ? P.OB : P.OF) + (size_t)base * 1024 + h * 128 + 32 * sl + r32;
            u32x4_t ua[2][2];
#pragma unroll
            for (int mt = 0; mt < 2; ++mt) { const unsigned char* up = rbase + REC_U + (size_t)(((mt * 4 + sl) * 64 + lane) * 32); ua[mt][0] = *(const u32x4_t*)up; ua[mt][1] = *(const u32x4_t*)(up + 16); }
            int g = 0;
#define DN2_CSYNC() do { asm volatile("s_waitcnt lgkmcnt(0)" ::: "memory"); DN2_BAR(); asm volatile("" ::: "memory"); } while (0)
#define DN2_RD8(F) do { const LAS unsigned char* sp_ = L + (g & 15) * 8192 + lane * 16; _Pragma("unroll") for (int q_ = 0; q_ < 8; ++q_) F[q_] = *(const LAS dn_bf16x8*)(sp_ + q_ * 1024); ++g; } while (0)
            for (int n = 0; n < N; ++n) {
                const float eg = P.EGL[rec0 + 16 * n];
                dn_bf16x8 Sb[8];
#pragma unroll
                for (int kt = 0; kt < 8; ++kt) Sb[kt] = dn_acc_frag(S[kt >> 1], kt & 1);
                dn_bf16x8 F[8];
                dn_f32x16 av[2];
#pragma unroll
                for (int mt = 0; mt < 2; ++mt) {
                    DN2_CSYNC(); DN2_RD8(F);
                    const u32x4_t u0 = ua[mt][0], u1 = ua[mt][1];
                    dn_f32x16 a;
                    a[0] = bf_lo(u0.x); a[1] = bf_hi(u0.x); a[2] = bf_lo(u0.y); a[3] = bf_hi(u0.y); a[4] = bf_lo(u0.z); a[5] = bf_hi(u0.z); a[6] = bf_lo(u0.w); a[7] = bf_hi(u0.w);
                    a[8] = bf_lo(u1.x); a[9] = bf_hi(u1.x); a[10] = bf_lo(u1.y); a[11] = bf_hi(u1.y); a[12] = bf_lo(u1.z); a[13] = bf_hi(u1.z); a[14] = bf_lo(u1.w); a[15] = bf_hi(u1.w);
#pragma unroll
                    for (int kt = 0; kt < 8; ++kt) a = __builtin_amdgcn_mfma_f32_32x32x16_bf16(F[kt], Sb[kt], a, 0, 0, 0);
                    av[mt] = a;
                }
                if (n + 1 < N) {
#pragma unroll
                    for (int mt = 0; mt < 2; ++mt) { const unsigned char* up = rbase + (size_t)(n + 1) * RSTRIDE + REC_U + (size_t)(((mt * 4 + sl) * 64 + lane) * 32); ua[mt][0] = *(const u32x4_t*)up; ua[mt][1] = *(const u32x4_t*)(up + 16); }
                }
                dn_bf16x8 vb[4];
#pragma unroll
                for (int kt = 0; kt < 4; ++kt) vb[kt] = dn_acc_frag(av[kt >> 1], kt & 1);
                dn_f32x16 ao[2];
#pragma unroll
                for (int mt = 0; mt < 2; ++mt) {
                    DN2_CSYNC(); DN2_RD8(F);
                    dn_f32x16 a = {};
#pragma unroll
                    for (int kt = 0; kt < 8; ++kt) a = __builtin_amdgcn_mfma_f32_32x32x16_bf16(F[kt], Sb[kt], a, 0, 0, 0);
                    ao[mt] = a;
                }
                DN2_CSYNC(); DN2_RD8(F);
#pragma unroll
                for (int mt = 0; mt < 2; ++mt) {
                    dn_f32x16 a = ao[mt];
#pragma unroll
                    for (int kt = 0; kt < 4; ++kt) a = __builtin_amdgcn_mfma_f32_32x32x16_bf16(F[mt * 4 + kt], vb[kt], a, 0, 0, 0);
#pragma unroll
                    for (int reg = 0; reg < 16; ++reg) { const int p = 64 * n + 32 * mt + dn_crow(reg, hi); const int t = dir ? T - 1 - p : p;
                        Od[(size_t)t * 1024] = (bf16raw)f2bf(a[reg]); }
                }
#pragma unroll
                for (int t2 = 0; t2 < 2; ++t2) {
                    DN2_CSYNC(); DN2_RD8(F);
#pragma unroll
                    for (int tt = 0; tt < 2; ++tt) {
                        dn_f32x16 a = S[2 * t2 + tt] * eg;
#pragma unroll
                        for (int kt = 0; kt < 4; ++kt) a = __builtin_amdgcn_mfma_f32_32x32x16_bf16(F[tt * 4 + kt], vb[kt], a, 0, 0, 0);
                        S[2 * t2 + tt] = a;
                    }
                }
            }
            DN2_CSYNC();
            if (!lat) { float* sp = P.out + O_ST + ((((size_t)seq * 2 + j) * 2 + dir) * 8 + h) * 16384 + 32 * sl + r32;
#pragma unroll
                for (int t4 = 0; t4 < 4; ++t4)
#pragma unroll
                    for (int reg = 0; reg < 16; ++reg) sp[(size_t)(32 * t4 + dn_crow(reg, hi)) * 128] = S[t4][reg]; }
#undef DN2_CSYNC
#undef DN2_RD8
        } else {
            const int ld = wid - 4;
            int ln = 0, ls = 0;
            const unsigned char* gsrc = rbase + REC_WN + (size_t)(2 * ld) * 1024 + lane * 16;
#define DN2_ISSUE(slot) do { const unsigned char* s_ = gsrc + (size_t)ln * RSTRIDE + ls * 8192; LAS unsigned char* d_ = L + (slot) * 8192 + (2 * ld) * 1024; \
        __builtin_amdgcn_global_load_lds((const unsigned*)s_, (LAS unsigned*)d_, 16, 0, 0); __builtin_amdgcn_global_load_lds((const unsigned*)(s_ + 1024), (LAS unsigned*)(d_ + 1024), 16, 0, 0); \
        if (++ls == 7) { ls = 0; if (ln < N - 1) ++ln; } } while (0)
            for (int q = 0; q < 15; ++q) DN2_ISSUE(q);
            const int G = 7 * N;
            for (int g = 0; g < G; ++g) {
                asm volatile("s_waitcnt vmcnt(28)" ::: "memory");
                DN2_BAR();
                DN2_ISSUE((g + 15) & 15);
            }
            asm volatile("s_waitcnt vmcnt(0)" ::: "memory");
            DN2_BAR();
#undef DN2_ISSUE
        }
#undef DN2_BAR
    }
}
#define XB_TMO      128
#define XB_XCNT(j)  (256  + 64 * (j))
#define XB_XSUB(j)  (1280 + 64 * (j))
#define XB_XGEN(j)  (2304 + 64 * (j))
#define XB_TOP      3328
#define XB_TOPGEN   3392
#define XCD_BAR_WORDS 3456
#define XB_SPIN_CAP (1u << 18)

__device__ __forceinline__ unsigned xb_ld(unsigned* p)              { return __hip_atomic_load(p, __ATOMIC_RELAXED, __HIP_MEMORY_SCOPE_AGENT); }
__device__ __forceinline__ unsigned xb_add(unsigned* p, unsigned v) { return __hip_atomic_fetch_add(p, v, __ATOMIC_RELAXED, __HIP_MEMORY_SCOPE_AGENT); }
__device__ __forceinline__ unsigned xb_xcc_id() { return (unsigned)__builtin_amdgcn_s_getreg((3 << 11) | 20) & 0xFu; }
#define XB_SPIN(cond, bar) do { unsigned _sp = 0; while (cond) { __builtin_amdgcn_s_sleep(1); \
    if ((++_sp & 255u) == 0u) { if (xb_ld(&(bar)[XB_TMO])) break; if (_sp > XB_SPIN_CAP) { atomicAdd(&(bar)[XB_TMO], 1u); break; } } } } while (0)

struct XcdBarrier {
    unsigned* bar; unsigned x;
    volatile LAS unsigned* st;
};

__device__ __forceinline__ XcdBarrier xcd_barrier_post(unsigned* bar, volatile LAS unsigned* st) {
    XcdBarrier b; b.bar = bar; b.x = xb_xcc_id(); b.st = st;
    if (threadIdx.x == 0) (void)xb_add(&bar[XB_XCNT(b.x)], 1u);
    return b;
}
__device__ __forceinline__ void xcd_barrier_complete(unsigned* bar, unsigned x, unsigned& nloc, unsigned& nx) {
    const unsigned G = gridDim.x * gridDim.y * gridDim.z;
    unsigned sum, cnt, mine, sp = 0u;
    for (;;) {
        sum = 0u; cnt = 0u; mine = 0u;
#pragma unroll
        for (unsigned j = 0; j < 16; ++j) { const unsigned c = xb_ld(&bar[XB_XCNT(j)]); sum += c; cnt += (c > 0u) ? 1u : 0u; mine = (j == x) ? c : mine; }
        if (sum == G) break;
        __builtin_amdgcn_s_sleep(1);
        if ((++sp & 255u) == 0u) { if (xb_ld(&bar[XB_TMO])) break; if (sp > XB_SPIN_CAP) { atomicAdd(&bar[XB_TMO], 1u); break; } }
    }
    nloc = mine > 0u ? mine : 1u; nx = cnt > 0u ? cnt : 1u;
}

__device__ __forceinline__ void xcd_barrier(const XcdBarrier& b) {
    asm volatile("s_waitcnt vmcnt(0)" ::: "memory");
    __syncthreads();
    if (threadIdx.x == 0) {
        unsigned* bar = b.bar;
        __builtin_amdgcn_s_waitcnt(0);
        unsigned nloc = b.st[0], nx = b.st[1];
        if (nloc == 0u) { xcd_barrier_complete(bar, b.x, nloc, nx); b.st[0] = nloc; b.st[1] = nx; }
        const unsigned old = xb_add(&bar[XB_XSUB(b.x)], 1u);
        const unsigned gen = old / nloc;
        if (old + 1u == (gen + 1u) * nloc) {
            __builtin_amdgcn_fence(__ATOMIC_RELEASE, "agent");
            asm volatile("s_waitcnt vmcnt(0)" ::: "memory");
            const unsigned og = xb_add(&bar[XB_TOP], 1u);
            const unsigned tg = og / nx;
            if (og + 1u == (tg + 1u) * nx) xb_add(&bar[XB_TOPGEN], 1u);
            else XB_SPIN(xb_ld(&bar[XB_TOPGEN]) == tg, bar);
            __builtin_amdgcn_fence(__ATOMIC_ACQUIRE, "agent");
            xb_add(&bar[XB_XGEN(b.x)], 1u);
            asm volatile("s_waitcnt vmcnt(0)" ::: "memory");
        } else {
            XB_SPIN(xb_ld(&bar[XB_XGEN(b.x)]) == gen, bar);
            __builtin_amdgcn_fence(__ATOMIC_ACQUIRE, "agent");
            asm volatile("s_waitcnt vmcnt(0)" ::: "memory");
        }
    }
    __syncthreads();
}

constexpr int LDSCTL_OFF = 131072, MISC_OFF = LDSCTL_OFF + 320, CW_BAR = 4096;
struct Args { const float* in[24]; float* out; unsigned char* ws; int ph_lo, ph_hi; };
enum { I_XP = 0, I_XS, I_CK, I_CV, I_SD, I_C, I_CCTX, I_WMOD, I_BMOD, I_N1, I_N2, I_AWIN, I_AQG, I_AKG, I_AWOUT, I_DWIN, I_DCONV, I_DALOG, I_DDTB, I_DNORM, I_DWOUT, I_W1, I_W2, I_FN };

__global__ void __launch_bounds__(NWAVES * 64, 2) mk_fwd(Args args) {
    extern __shared__ __attribute__((aligned(16))) unsigned char lds_raw[];
    cg::grid_group grid = cg::this_grid();
    for (int u = threadIdx.x; u < (LDS_BYTES - LDSCTL_OFF) / 4; u += NWAVES * 64) ((LAS unsigned*)((LAS unsigned char*)lds_raw + LDSCTL_OFF))[u] = 0u;
    __syncthreads();
    const XcdBarrier bar = xcd_barrier_post((unsigned*)(args.ws + WS_CTL) + CW_BAR, (volatile LAS unsigned*)((LAS unsigned char*)lds_raw + MISC_OFF) + 8);

    const int lo = args.ph_lo, hi = args.ph_hi;
    int ph = 0;
#define PHASE_BEGIN() if (ph >= lo && ph < hi) { int z = 0; asm volatile("" : "+s"(z)); unsigned char* const ws = args.ws + z; (void)ws; \
    Ctx C; C.lds = (LAS unsigned char*)lds_raw + z; C.tid = threadIdx.x + z; C.lane = C.tid & 63; C.wid = __builtin_amdgcn_readfirstlane(C.tid >> 6); \
    C.nblk = gridDim.x + z; C.blk = blockIdx.x + z; C.gw = C.blk * NWAVES + C.wid; C.ngw = C.nblk * NWAVES;
#ifndef REP_KIND
#define REP_KIND -1
#endif
#define PHASE_END() if (ph + 1 < hi) { if (ph == 0) grid.sync(); else xcd_barrier(bar); } } ++ph;
#define INP(i) (args.in[(i) + z])
#define WSF(off) ((float*)(ws + (off)))
#define WSB(off) ((bf16raw*)(ws + (off)))

    PHASE_BEGIN() {
        ProPtrs P{INP(I_C), INP(I_CCTX), INP(I_WMOD), INP(I_BMOD), INP(I_AWIN), INP(I_AWOUT), INP(I_DWIN), INP(I_DWOUT), INP(I_W1), INP(I_W2), WSF(WS_MODS), WSF(WS_ROPE),
                  WSB(WS_WT_AIN), WSB(WS_WT_AOUT), WSB(WS_WT_DIN), WSB(WS_WT_DOUT), WSB(WS_WT_W1), WSB(WS_WT_W2)};
        phase_prologue(C, P); } PHASE_END()
    for (int l = 0; l < 4; ++l) {
        const int j = l >> 1;
        PHASE_BEGIN() { const float* mods_l = WSF(WS_MODS) + (size_t)l * 3 * 6144;
            const float* xs_ctx = l == 0 ? INP(I_XP) : WSF(WS_X); const float* xs_lat = l == 0 ? INP(I_XS) : WSF(WS_X) + (size_t)NCTX * D;
            phase_norm(C, xs_ctx, xs_lat, INP(I_N1) + l * D, mods_l, WSB(WS_H)); } PHASE_END()
        if ((l & 1) == 0) {
            PHASE_BEGIN() { pg8::Gemm g{WSB(WS_H), WSB(WS_WT_AIN) + (size_t)j * QKVW * D, MTOK, QKVW, D, z}; pg8::StaticOrder S; S.init(MTOK, QKVW, C.nblk, C.blk);
                pg8::EpiBf16<0> E{WSB(WS_PROJ), QKVW, nullptr, 0, 0, 1.f};
                pg8::gemm_phase<pg8::EpiBf16<0>, pg8::StaticOrder, true, true>(C.lds, g, S, E); } PHASE_END()
            PHASE_BEGIN() { QknPtrs P{WSB(WS_PROJ), WSB(WS_QB), WSB(WS_KB), WSB(WS_VB), INP(I_AQG) + j * 128, INP(I_AKG) + j * 128, WSF(WS_ROPE), INP(I_CK), INP(I_CV), args.out + z};
                phase_qkn(C, P, j); if (REP_KIND == 3) { xcd_barrier(bar); phase_qkn(C, P, j); } } PHASE_END()
            PHASE_BEGIN() { AttnPtrs P{WSB(WS_QB), WSB(WS_KB), WSB(WS_VB), WSB(WS_Y)}; phase_attn(C, P); if (REP_KIND == 4) { xcd_barrier(bar); phase_attn(C, P); } } PHASE_END()
        } else {
            PHASE_BEGIN() { pg8::Gemm g{WSB(WS_H), WSB(WS_WT_DIN) + (size_t)j * DNINP * D, MTOK, DNINP, D, z}; pg8::StaticOrder S; S.init(MTOK, DNINP, C.nblk, C.blk);
                pg8::EpiDnIn E{WSB(WS_PROJ), WSF(WS_AB)};
                pg8::gemm_phase<pg8::EpiDnIn, pg8::StaticOrder, true, true>(C.lds, g, S, E); } PHASE_END()
            PHASE_BEGIN() { DnLocalPtrs P{WSB(WS_PROJ), WSF(WS_AB), INP(I_DCONV) + (size_t)j * 5 * 3072, INP(I_DALOG) + j * 16, INP(I_DDTB) + j * 16, ws + WS_SOP, WSF(WS_EGL)};
                phase_dn_local(C, P); if (REP_KIND == 6) { xcd_barrier(bar); phase_dn_local(C, P); } } PHASE_END()
            PHASE_BEGIN() { DnScanPtrs P{ws + WS_SOP, WSF(WS_EGL), INP(I_SD), WSB(WS_OF), WSB(WS_OB), args.out + z}; phase_dn_scan2(C, P, j); } PHASE_END()
            PHASE_BEGIN() { GatePtrs P{WSB(WS_OF), WSB(WS_OB), WSB(WS_PROJ), WSB(WS_Y), INP(I_DNORM) + j * 128}; phase_gate(C, P); if (REP_KIND == 8) { xcd_barrier(bar); phase_gate(C, P); } } PHASE_END()
        }
        PHASE_BEGIN() { const float* mods_l = WSF(WS_MODS) + (size_t)l * 3 * 6144;
            const float* xs_ctx = l == 0 ? INP(I_XP) : WSF(WS_X); const float* xs_lat = l == 0 ? INP(I_XS) : WSF(WS_X) + (size_t)NCTX * D;
            pg8::Gemm g{WSB(WS_Y), ((l & 1) ? WSB(WS_WT_DOUT) : WSB(WS_WT_AOUT)) + (size_t)j * D * D, MTOK, D, D, z}; pg8::StaticOrder S; S.init(MTOK, D, C.nblk, C.blk);
            pg8::EpiRes E{xs_ctx, xs_lat, WSF(WS_X), mods_l + 2048};
            pg8::gemm_phase<pg8::EpiRes, pg8::StaticOrder, true, true>(C.lds, g, S, E); } PHASE_END()
        PHASE_BEGIN() { const float* mods_l = WSF(WS_MODS) + (size_t)l * 3 * 6144;
            phase_norm(C, WSF(WS_X), WSF(WS_X) + (size_t)NCTX * D, INP(I_N2) + l * D, mods_l + 3072, WSB(WS_H)); } PHASE_END()
        PHASE_BEGIN() { pg8::Gemm g{WSB(WS_H), WSB(WS_WT_W1) + (size_t)l * FF * D, MTOK, FF, D, z}; pg8::StaticOrder S; S.init(MTOK, FF, C.nblk, C.blk);
            pg8::EpiBf16<2> E{WSB(WS_PROJ), FF, nullptr, 0, 0, 1.f};
            pg8::gemm_phase<pg8::EpiBf16<2>, pg8::StaticOrder, true, true>(C.lds, g, S, E); } PHASE_END()
        PHASE_BEGIN() { const float* mods_l = WSF(WS_MODS) + (size_t)l * 3 * 6144;
            pg8::Gemm g{WSB(WS_PROJ), WSB(WS_WT_W2) + (size_t)l * D * FF, MTOK, D, FF, z}; pg8::StaticOrder S; S.init(MTOK, D, C.nblk, C.blk);
            pg8::EpiRes E{WSF(WS_X), WSF(WS_X) + (size_t)NCTX * D, WSF(WS_X), mods_l + 5120};
            pg8::gemm_phase<pg8::EpiRes, pg8::StaticOrder, true, true>(C.lds, g, S, E); } PHASE_END()
    }
    PHASE_BEGIN() { phase_final(C, WSF(WS_X), INP(I_FN), args.out + z); } PHASE_END()
#undef PHASE_BEGIN
#undef PHASE_END
}

extern "C" void kernel_launch(void* const* d_in, const int* in_sizes, int n_in, void* d_out, int out_size, void* d_ws, size_t ws_size, hipStream_t stream) {
    static int grid = 0;
    if (grid == 0) {
        if (n_in != 24 || ws_size < WS_END) { fprintf(stderr, "kernel_launch: unexpected n_in %d / ws %zu\n", n_in, ws_size); grid = -1; return; }
        int dev = 0, cus = 0, per_cu = 0;
        if (hipGetDevice(&dev) != hipSuccess || hipDeviceGetAttribute(&cus, hipDeviceAttributeMultiprocessorCount, dev) != hipSuccess) { grid = -1; return; }
        if (hipFuncSetAttribute((const void*)mk_fwd, hipFuncAttributeMaxDynamicSharedMemorySize, LDS_BYTES) != hipSuccess) { fprintf(stderr, "kernel_launch: hipFuncSetAttribute failed\n"); grid = -1; return; }
        if (hipOccupancyMaxActiveBlocksPerMultiprocessor(&per_cu, (const void*)mk_fwd, NWAVES * 64, LDS_BYTES) != hipSuccess || per_cu < 1) { fprintf(stderr, "kernel_launch: occupancy query failed (%d)\n", per_cu); (void)hipGetLastError(); grid = -1; return; }
        grid = cus * 1;
    }
    if (grid < 0) return;
    (void)hipMemsetAsync((char*)d_ws + WS_CTL, 0, CTL_ZERO_BYTES, stream);
    Args a; memset(&a, 0, sizeof(a));
    for (int i = 0; i < 24; ++i) a.in[i] = (const float*)d_in[i];
    a.out = (float*)d_out; a.ws = (unsigned char*)d_ws; a.ph_lo = 0; a.ph_hi = 1000;
    void* kargs[] = {&a};
    hipError_t e = hipLaunchCooperativeKernel((const void*)mk_fwd, dim3(grid), dim3(NWAVES * 64), kargs, LDS_BYTES, stream);
    if (e != hipSuccess) fprintf(stderr, "kernel_launch: cooperative launch failed: %s (grid %d)\n", hipGetErrorString(e), grid);
}
```

```cpp
#include <hip/hip_runtime.h>
#include <hip/hip_cooperative_groups.h>
#include <cstdio>
#include <cstdint>
#include <cstring>
namespace cg = cooperative_groups;

constexpr int D = 1024, NCTX = 8192, NLAT = 2048, MTOK = 10240, FF = 4096;
constexpr int QKVW = 1536, DNIN = 4128, DNINP = 4352, PROJW = 4096;
constexpr int KVROWS = 8192 + 2 * 1280;
constexpr float EPS = 1e-6f;
constexpr float ATT_SCALE = 0.08838834764831845f;
constexpr size_t O_Y = 0, O_CK = (size_t)MTOK * D, O_CV = O_CK + 4194304, O_ST = O_CV + 4194304;

typedef unsigned short bf16raw;
typedef float f32x4_t __attribute__((ext_vector_type(4)));
typedef float f32x2_t __attribute__((ext_vector_type(2)));
typedef unsigned u32x4_t __attribute__((ext_vector_type(4)));
typedef unsigned u32x2_t __attribute__((ext_vector_type(2)));

__device__ __forceinline__ unsigned f2bf(float f) { unsigned u = __builtin_bit_cast(unsigned, f); return (u + 0x7fffu + ((u >> 16) & 1u)) >> 16; }
__device__ __forceinline__ unsigned pk2(float lo, float hi) { return f2bf(lo) | (f2bf(hi) << 16); }
__device__ __forceinline__ float bf_lo(unsigned w) { return __builtin_bit_cast(float, w << 16); }
__device__ __forceinline__ float bf_hi(unsigned w) { return __builtin_bit_cast(float, w & 0xffff0000u); }
__device__ __forceinline__ float bf2f(bf16raw h) { return __builtin_bit_cast(float, (unsigned)h << 16); }
__device__ __forceinline__ float silu_f(float x) { return x / (1.f + __expf(-x)); }
__device__ __forceinline__ int cond_of(int row) { return row < NCTX ? 0 : 1 + ((row - NCTX) >> 10); }
__device__ __forceinline__ float lane_xor_f(float v, int lane, int k) { return __builtin_bit_cast(float, __builtin_amdgcn_ds_bpermute((lane ^ k) << 2, __builtin_bit_cast(int, v))); }
__device__ __forceinline__ float wave_sum(float v, int lane) {
#pragma unroll
    for (int o = 1; o < 64; o <<= 1) v += lane_xor_f(v, lane, o);
    return v;
}
__device__ __forceinline__ float wave_max(float v, int lane) {
#pragma unroll
    for (int o = 1; o < 64; o <<= 1) v = fmaxf(v, lane_xor_f(v, lane, o));
    return v;
}
__device__ __forceinline__ float dpp_xadd(float v, const int ctrl_tag) { return v; }
#define DPP_ADD(v, ctrl) ((v) + __builtin_bit_cast(float, __builtin_amdgcn_update_dpp(0, __builtin_bit_cast(int, (v)), (ctrl), 0xf, 0xf, true)))
__device__ __forceinline__ float wave_sum_dpp(float v) {
    v = DPP_ADD(v, 0xB1); v = DPP_ADD(v, 0x4E); v = DPP_ADD(v, 0x141); v = DPP_ADD(v, 0x140);
    const int iv = __builtin_bit_cast(int, v);
    return (__builtin_bit_cast(float, __builtin_amdgcn_readlane(iv, 0)) + __builtin_bit_cast(float, __builtin_amdgcn_readlane(iv, 16))) +
           (__builtin_bit_cast(float, __builtin_amdgcn_readlane(iv, 32)) + __builtin_bit_cast(float, __builtin_amdgcn_readlane(iv, 48)));
}
namespace pg8 {
#define PG8_LAS __attribute__((address_space(3)))
typedef unsigned short bf16_t;
typedef short bf16x8 __attribute__((ext_vector_type(8)));
typedef float f32x4 __attribute__((ext_vector_type(4)));
typedef unsigned u32x4 __attribute__((ext_vector_type(4)));
constexpr int BM = 256, BK = 64, HALF = 128, HTB = HALF * BK * 2  , STAGE_BYTES = 8 * HTB, NXCD = 8, WGM = 8;

__host__ __device__ __forceinline__ int lds_byte(int r, int c) { const int st = (r >> 4) * 2 + (c >> 5), rr = r & 15, cc = c & 31, ob = rr * 64 + cc * 2; return st * 1024 + (ob ^ (((ob >> 9) & 1) << 5)); }
__host__ __device__ __forceinline__ void stage_rc(int b, int& R, int& C) { const int st = b / 1024, sb = b % 1024, swz = sb ^ (((sb >> 9) & 1) << 5); R = (st >> 1) * 16 + swz / 64; C = (st & 1) * 32 + (swz % 64) / 2; }
__host__ __device__ __forceinline__ int perm32(int rho) { const int n = rho >> 4, i = rho & 15; return 8 * (i >> 2) + 4 * n + (i & 3); }

struct Unit { int pm, pn; };
struct Gemm { const bf16_t* A; const bf16_t* Bt; int M, N, K; int z; };

struct StaticOrder {
    int nM, nN, nwg, G, c;
    __host__ __device__ void init(int M, int N, int G_, int c_) { nM = M / BM; nN = N / BM; nwg = nM * nN; G = G_; c = c_; }
    __host__ __device__ bool next(int i, Unit& u) const {
        const long L = (long)i * G + c; if (L >= nwg) return false;
        int wgid = (int)L; { const int q = nwg / NXCD, r = nwg % NXCD, xcd = wgid % NXCD, off = wgid / NXCD; wgid = (xcd < r ? xcd * (q + 1) : r * (q + 1) + (xcd - r) * q) + off; }
        const int nig = WGM * nN, gid = wgid / nig, fm = gid * WGM, gsz = (nM - fm) < WGM ? (nM - fm) : WGM;
        u.pm = fm + ((wgid % nig) % gsz); u.pn = (wgid % nig) / gsz; return true;
    }
    __device__ __forceinline__ void a_ready(const Unit&) const {}
    __device__ __forceinline__ void done(const Unit&) const {}
};

__device__ __forceinline__ unsigned cvt_pk_bf16(float lo, float hi) { unsigned r; asm volatile("v_cvt_pk_bf16_f32 %0, %1, %2" : "=v"(r) : "v"(lo), "v"(hi)); return r; }
typedef float f32x2 __attribute__((ext_vector_type(2)));
__device__ __forceinline__ f32x2 gelu_pk(f32x2 v) {
    const f32x2 av = __builtin_elementwise_abs(v), d = av * 0.2316418882f + 1.0f;
    f32x2 t; t.x = __builtin_amdgcn_rcpf(d.x); t.y = __builtin_amdgcn_rcpf(d.y);
    f32x2 q = t * 0.5307027145f + (-0.7265760135f); q = q * t + 0.7107068705f; q = q * t + (-0.142248368f); q = q * t + 0.127414796f; q = q * t;
    const f32x2 s = (v * v) * (-0.72134752044f);
    f32x2 e; e.x = __builtin_amdgcn_exp2f(s.x); e.y = __builtin_amdgcn_exp2f(s.y);
    const f32x2 m = v * (q * e), r = v - m;
    f32x2 o; o.x = v.x < 0.f ? m.x : r.x; o.y = v.y < 0.f ? m.y : r.y; return o;
}

template <int ACT  > struct EpiBf16 {
    static constexpr bool PERM = true, AFTER_DRAIN = false; static_assert(ACT >= 0 && ACT <= 2, "EpiBf16: ACT is 0 (none), 1 (gelu_pk) or 2 (squared relu)");
    bf16_t* O; int ldc; const float* bias; int split_cols; size_t split_stride; float scale0;
    __device__ __forceinline__ void operator()(const f32x4 (&acc)[2][2][4][2], const Unit& u, int wr, int wc, int fr, int fq) const {
        const int row0 = u.pm * BM + wr * 64 + fr; int colt = u.pn * BM; bf16_t* base = O;
        float sc = 1.f; if (split_cols) { const int t = colt / split_cols; base += (size_t)t * split_stride; colt -= t * split_cols; if (t == 0) sc = scale0; }
        const int col0 = colt + wc * 32 + 8 * fq, bcol0 = u.pn * BM + wc * 32 + 8 * fq;
        f32x4 bv[2][2];
#pragma unroll
        for (int bj = 0; bj < 2; ++bj)
#pragma unroll
            for (int n = 0; n < 2; ++n) bv[bj][n] = bias ? *(const f32x4*)(bias + bcol0 + bj * HALF + 4 * n) : (f32x4){0.f, 0.f, 0.f, 0.f};
#pragma unroll
        for (int ai = 0; ai < 2; ++ai)
#pragma unroll
            for (int m = 0; m < 4; ++m) { bf16_t* rowp = base + (size_t)(row0 + ai * HALF + m * 16) * ldc + col0;
#pragma unroll
                for (int bj = 0; bj < 2; ++bj) { f32x4 v0 = acc[ai][bj][m][0] + bv[bj][0], v1 = acc[ai][bj][m][1] + bv[bj][1];
                    if (ACT == 1) { f32x2 a = gelu_pk((f32x2){v0[0], v0[1]}), b = gelu_pk((f32x2){v0[2], v0[3]}), c = gelu_pk((f32x2){v1[0], v1[1]}), d = gelu_pk((f32x2){v1[2], v1[3]});
                        v0 = (f32x4){a.x, a.y, b.x, b.y}; v1 = (f32x4){c.x, c.y, d.x, d.y}; }
                    if (ACT == 2) { v0 = __builtin_elementwise_max(v0, (f32x4){0.f, 0.f, 0.f, 0.f}); v1 = __builtin_elementwise_max(v1, (f32x4){0.f, 0.f, 0.f, 0.f}); v0 = v0 * v0; v1 = v1 * v1; }
                    v0 = v0 * sc; v1 = v1 * sc; u32x4 w; w.x = cvt_pk_bf16(v0[0], v0[1]); w.y = cvt_pk_bf16(v0[2], v0[3]); w.z = cvt_pk_bf16(v1[0], v1[1]); w.w = cvt_pk_bf16(v1[2], v1[3]);
                    *(u32x4*)(rowp + bj * HALF) = w; } }
    }
};

struct PanelStats {
    unsigned* xbuf;
    unsigned* cnt;
    unsigned* tmo;
    int ntn; float eps;
    unsigned code;
    __device__ __forceinline__ bool run(const f32x4 (&v)[2][2][4][2], const Unit& u, int wr, int wc, int fr, int fq, PG8_LAS unsigned char* lds, int wid, int lane) const {
        typedef float f32x2v __attribute__((ext_vector_type(2)));
        PG8_LAS f32x2v* P = (PG8_LAS f32x2v*)lds;
        PG8_LAS f32x2v* S = (PG8_LAS f32x2v*)(lds + 8192);
        PG8_LAS unsigned* flag = (PG8_LAS unsigned*)(lds + 8192 + 2048);
#pragma unroll
        for (int ai = 0; ai < 2; ++ai)
#pragma unroll
            for (int m = 0; m < 4; ++m) {
                float s = 0.f;
#pragma unroll
                for (int bj = 0; bj < 2; ++bj)
#pragma unroll
                    for (int n = 0; n < 2; ++n) { const f32x4 x = v[ai][bj][m][n]; s += (x[0] + x[1]) + (x[2] + x[3]); }
                s += __shfl_xor(s, 16); s += __shfl_xor(s, 32);
                const float mw = s * (1.0f / 64.0f); float q = 0.f;
#pragma unroll
                for (int bj = 0; bj < 2; ++bj)
#pragma unroll
                    for (int n = 0; n < 2; ++n) { const f32x4 d = v[ai][bj][m][n] - mw; q += (d[0] * d[0] + d[1] * d[1]) + (d[2] * d[2] + d[3] * d[3]); }
                q += __shfl_xor(q, 16); q += __shfl_xor(q, 32);
                if (fq == 0) P[(ai * HALF + wr * 64 + m * 16 + fr) * 4 + wc] = (f32x2v){mw, q};
            }
        asm volatile("s_waitcnt lgkmcnt(0)" ::: "memory"); __builtin_amdgcn_s_barrier(); asm volatile("" ::: "memory");
#if defined(BROKEN_EXCHANGE_NO_WAIT)
#warning BROKEN CONTROL BUILD: the row-statistics exchange does not wait; results are wrong by design
        if (blockIdx.x >= 64) { const long long t0_ = clock64(); while (clock64() - t0_ < 60000) __builtin_amdgcn_s_sleep(8); }
#endif
        const int row = wid * 32 + (lane & 31);
        if (lane < 32) {
            const f32x2v a = P[row * 4 + 0], b = P[row * 4 + 1], c = P[row * 4 + 2], d = P[row * 4 + 3];
            const float mt = (a.x + b.x + c.x + d.x) * 0.25f;
            const float da = a.x - mt, db = b.x - mt, dc = c.x - mt, dd = d.x - mt;
            const float m2 = (a.y + b.y) + (c.y + d.y) + 64.0f * ((da * da + db * db) + (dc * dc + dd * dd));
            unsigned long long* slot = (unsigned long long*)xbuf + ((size_t)(u.pm * BM + row) * 4 + u.pn);
            __hip_atomic_store(slot, ((unsigned long long)__float_as_uint(m2) << 32) | __float_as_uint(mt), __ATOMIC_RELAXED, __HIP_MEMORY_SCOPE_AGENT);
        }
        asm volatile("s_waitcnt vmcnt(0)" ::: "memory");
        if (lane == 0) __hip_atomic_fetch_add(cnt + 64 * u.pm, 1u, __ATOMIC_RELAXED, __HIP_MEMORY_SCOPE_AGENT);
        if (wid == 0) {
            bool dead = false; const unsigned long long t0 = __builtin_amdgcn_s_memrealtime(); const unsigned want = 8u * (unsigned)ntn;
            for (;;) {
#if defined(BROKEN_EXCHANGE_NO_WAIT)
                break;
#endif
                if ((unsigned)__builtin_amdgcn_readfirstlane(__hip_atomic_load(cnt + 64 * u.pm, __ATOMIC_RELAXED, __HIP_MEMORY_SCOPE_AGENT)) >= want) break;
                if (__builtin_amdgcn_s_memrealtime() - t0 > 2000000ull) {
                    if (lane == 0) { unsigned expect = 0u; __hip_atomic_compare_exchange_strong(tmo + 1, &expect, code | (unsigned)(u.pm & 0xff), __ATOMIC_RELAXED, __ATOMIC_RELAXED, __HIP_MEMORY_SCOPE_AGENT);
                                     __hip_atomic_store(tmo, 1u, __ATOMIC_RELAXED, __HIP_MEMORY_SCOPE_AGENT); }
                    dead = true; break; }
                __builtin_amdgcn_s_sleep(2);
            }
            __builtin_amdgcn_fence(__ATOMIC_ACQUIRE, "agent");
            if (lane == 0) flag[0] = dead ? 1u : 0u;
        }
        asm volatile("s_waitcnt vmcnt(0) lgkmcnt(0)" ::: "memory"); __builtin_amdgcn_s_barrier(); asm volatile("" ::: "memory");
        const bool bad = flag[0] != 0u;
        if (lane < 32) {
            const unsigned long long* slot = (const unsigned long long*)xbuf + (size_t)(u.pm * BM + row) * 4; float mt[4], m2[4]; float ms = 0.f;
#pragma unroll
            for (int t = 0; t < 4; ++t) { if (t < ntn) { const unsigned long long w = __hip_atomic_load(slot + t, __ATOMIC_RELAXED, __HIP_MEMORY_SCOPE_AGENT); mt[t] = __uint_as_float((unsigned)w); m2[t] = __uint_as_float((unsigned)(w >> 32)); } else { mt[t] = 0.f; m2[t] = 0.f; } ms += mt[t]; }
            const float mean = ms / (float)ntn; float q = 0.f;
#pragma unroll
            for (int t = 0; t < 4; ++t) if (t < ntn) { const float dm = mt[t] - mean; q += m2[t] + 256.0f * dm * dm; }
            S[row] = (f32x2v){mean, 1.0f / sqrtf(q / (256.0f * (float)ntn) + eps)};
        }
        asm volatile("s_waitcnt lgkmcnt(0)" ::: "memory"); __builtin_amdgcn_s_barrier(); asm volatile("" ::: "memory");
        return bad;
    }
};
struct EpiLnRes {
    static constexpr bool PERM = false, AFTER_DRAIN = true;
    const float* base; float* out; int ldc; const float* bias; PanelStats st; unsigned poison;
    __device__ __forceinline__ void fused(f32x4 (&acc)[2][2][4][2], const Unit& u, int wr, int wc, int fr, int fq, PG8_LAS unsigned char* lds, int wid, int lane) const {
        typedef float f32x2v __attribute__((ext_vector_type(2)));
        const PG8_LAS f32x2v* S = (const PG8_LAS f32x2v*)(lds + 8192);
        const int col0 = u.pn * BM + wc * 32 + 4 * fq;
#pragma unroll
        for (int bj = 0; bj < 2; ++bj)
#pragma unroll
            for (int n = 0; n < 2; ++n) { const f32x4 bv = bias ? *(const f32x4*)(bias + col0 + bj * HALF + n * 16) : (f32x4){0.f, 0.f, 0.f, 0.f};
#pragma unroll
                for (int ai = 0; ai < 2; ++ai)
#pragma unroll
                    for (int m = 0; m < 4; ++m) acc[ai][bj][m][n] += bv; }
        f32x4 pre[4][2][2];
#pragma unroll
        for (int m = 0; m < 4; ++m) { const size_t off = (size_t)(u.pm * BM + wr * 64 + m * 16 + fr) * ldc + col0;
#pragma unroll
            for (int bj = 0; bj < 2; ++bj)
#pragma unroll
                for (int n = 0; n < 2; ++n) pre[m][bj][n] = *(const f32x4*)(base + off + bj * HALF + n * 16); }
        const bool bad = st.run(acc, u, wr, wc, fr, fq, lds, wid, lane) || poison != 0u;
        const float qnan = __builtin_nanf("");
#pragma unroll
        for (int ai = 0; ai < 2; ++ai)
#pragma unroll
            for (int m = 0; m < 4; ++m) { const int r = ai * HALF + wr * 64 + m * 16 + fr; const f32x2v sr = S[r]; const size_t off = (size_t)(u.pm * BM + r) * ldc + col0;
#pragma unroll
                for (int bj = 0; bj < 2; ++bj)
#pragma unroll
                    for (int n = 0; n < 2; ++n) { const f32x4 bs = ai == 0 ? pre[m][bj][n] : *(const f32x4*)(base + off + bj * HALF + n * 16); f32x4 o = bs + (acc[ai][bj][m][n] - sr.x) * sr.y;
                        if (bad) o = (f32x4){qnan, qnan, qnan, qnan}; *(f32x4*)(out + off + bj * HALF + n * 16) = o; }
                if (m & 1) asm volatile("" ::: "memory"); }
    }
};
struct EpiLnResLn {
    static constexpr bool PERM = false, AFTER_DRAIN = true;
    const float* base; float* out; bf16_t* xn; int ldc; const float* bias; PanelStats st1, st2; unsigned poison;
    __device__ __forceinline__ void fused(f32x4 (&acc)[2][2][4][2], const Unit& u, int wr, int wc, int fr, int fq, PG8_LAS unsigned char* lds, int wid, int lane) const {
        typedef float f32x2v __attribute__((ext_vector_type(2))); typedef unsigned u32x2v __attribute__((ext_vector_type(2)));
        const PG8_LAS f32x2v* S = (const PG8_LAS f32x2v*)(lds + 8192);
        const int col0 = u.pn * BM + wc * 32 + 4 * fq;
#pragma unroll
        for (int bj = 0; bj < 2; ++bj)
#pragma unroll
            for (int n = 0; n < 2; ++n) { const f32x4 bv = bias ? *(const f32x4*)(bias + col0 + bj * HALF + n * 16) : (f32x4){0.f, 0.f, 0.f, 0.f};
#pragma unroll
                for (int ai = 0; ai < 2; ++ai)
#pragma unroll
                    for (int m = 0; m < 4; ++m) acc[ai][bj][m][n] += bv; }
        bool bad = st1.run(acc, u, wr, wc, fr, fq, lds, wid, lane) || poison != 0u;
        const float qnan = __builtin_nanf("");
#pragma unroll
        for (int ai = 0; ai < 2; ++ai)
#pragma unroll
            for (int m = 0; m < 4; ++m) { const int r = ai * HALF + wr * 64 + m * 16 + fr; const f32x2v sr = S[r]; const size_t off = (size_t)(u.pm * BM + r) * ldc + col0;
#pragma unroll
                for (int bj = 0; bj < 2; ++bj)
#pragma unroll
                    for (int n = 0; n < 2; ++n) { const f32x4 bs = *(const f32x4*)(base + off + bj * HALF + n * 16); acc[ai][bj][m][n] = bs + (acc[ai][bj][m][n] - sr.x) * sr.y; }
                asm volatile("" : "+v"(acc[ai][0][m][0]), "+v"(acc[ai][0][m][1]), "+v"(acc[ai][1][m][0]), "+v"(acc[ai][1][m][1]));
                if (m & 1) asm volatile("" ::: "memory"); }
        const bool bad1 = bad;
        bad = st2.run(acc, u, wr, wc, fr, fq, lds, wid, lane) || bad;
#pragma unroll
        for (int ai = 0; ai < 2; ++ai)
#pragma unroll
            for (int m = 0; m < 4; ++m) { const int r = ai * HALF + wr * 64 + m * 16 + fr; const f32x2v sr = S[r]; const size_t off = (size_t)(u.pm * BM + r) * ldc + col0;
#pragma unroll
                for (int bj = 0; bj < 2; ++bj)
#pragma unroll
                    for (int n = 0; n < 2; ++n) { const f32x4 x1 = acc[ai][bj][m][n]; *(f32x4*)(out + off + bj * HALF + n * 16) = bad1 ? (f32x4){qnan, qnan, qnan, qnan} : x1;
                        const f32x4 o = (x1 - sr.x) * sr.y; u32x2v w; w.x = cvt_pk_bf16(o[0], o[1]); w.y = cvt_pk_bf16(o[2], o[3]);
                        if (bad) { w.x = 0x7fc07fc0u; w.y = 0x7fc07fc0u; } *(u32x2v*)(xn + off + bj * HALF + n * 16) = w; }
                asm volatile("" ::: "memory"); }
    }
};

template <class Epi, class Sched, bool ALIGN_EPI = false, bool SP2 = false, bool T160 = false>
__device__ __forceinline__ void gemm_phase(PG8_LAS unsigned char* lds, const Gemm g, const Sched& S, const Epi& E, const int row1 = 0) {
    static_assert(!T160 || SP2, "T160 is implemented on the SP2 loop only");
    const int tid = threadIdx.x + g.z, wid = __builtin_amdgcn_readfirstlane(tid >> 6), lane = tid & 63, wr = wid >> 2, wc = wid & 3, fr = lane & 15, fq = lane >> 4;
    const int K = g.K, nt = K / BK;
    unsigned voffA[2], voffB[2], voffA1[2];
#pragma unroll
    for (int i = 0; i < 2; ++i) { int R, C; stage_rc(tid * 16 + i * 8192, R, C); const int Rb = Epi::PERM ? ((R & ~31) + perm32(R & 31)) : R;
        voffA[i] = (unsigned)(R * K + C) * 2u; voffB[i] = (unsigned)(Rb * K + C) * 2u; voffA1[i] = T160 ? (unsigned)((R & 31) * K + C) * 2u : voffA[i]; }
    const size_t kstep = (size_t)(BK * 2);
    const size_t hstep = (size_t)HALF * K * 2;
    const size_t tstep = 2 * hstep;
    const size_t tstepA = T160 ? hstep : tstep;
    const size_t t1step = (size_t)32 * K * 2;
    const unsigned ldsw = (unsigned)wid * 1024u;
    const int aoff = lds_byte(wr * 64 + fr, fq * 8), boff = lds_byte(wc * 32 + fr, fq * 8), aoff1 = lds_byte(wr * 16 + fr, fq * 8);
#define PG8_SA(b, h) (((b) * 2 + (h)) * HTB)
#define PG8_SB(b, h) ((4 + (b) * 2 + (h)) * HTB)
#define PG8_STAGE(bufoff, gbase, voff) do { _Pragma("unroll") for (int _i = 0; _i < 2; ++_i) \
        __builtin_amdgcn_global_load_lds((const unsigned*)((const char*)(gbase) + (voff)[_i]), (PG8_LAS unsigned*)(lds + (bufoff) + ldsw + _i * 8192), 16, 0, 0); } while (0)
#define PG8_LDA(dst, b, h) do { _Pragma("unroll") for (int m = 0; m < 4; ++m) _Pragma("unroll") for (int k = 0; k < 2; ++k) dst[m][k] = *(const PG8_LAS bf16x8*)(lds + PG8_SA(b, h) + aoff + m * 2048 + k * 1024); } while (0)
#define PG8_LDB(dst, b, h) do { _Pragma("unroll") for (int n = 0; n < 2; ++n) _Pragma("unroll") for (int k = 0; k < 2; ++k) dst[n][k] = *(const PG8_LAS bf16x8*)(lds + PG8_SB(b, h) + boff + n * 2048 + k * 1024); } while (0)
#define PG8_MMA(ai, bj, At, Bt) do { __builtin_amdgcn_s_setprio(1); _Pragma("unroll") for (int m = 0; m < 4; ++m) _Pragma("unroll") for (int n = 0; n < 2; ++n) _Pragma("unroll") for (int k = 0; k < 2; ++k) \
        acc[ai][bj][m][n] = __builtin_amdgcn_mfma_f32_16x16x32_bf16(Bt[n][k], At[m][k], acc[ai][bj][m][n], 0, 0, 0); __builtin_amdgcn_s_setprio(0); } while (0)
#define PG8_LDA1(dst, b) do { if constexpr (T160) { _Pragma("unroll") for (int k = 0; k < 2; ++k) dst[0][k] = *(const PG8_LAS bf16x8*)(lds + PG8_SA(b, 1) + aoff1 + k * 1024); } else { PG8_LDA(dst, b, 1); } } while (0)
#define PG8_MMA1(bj, At, Bt) do { if constexpr (T160) { __builtin_amdgcn_s_setprio(1); _Pragma("unroll") for (int n = 0; n < 2; ++n) _Pragma("unroll") for (int k = 0; k < 2; ++k) \
        acc[1][bj][0][n] = __builtin_amdgcn_mfma_f32_16x16x32_bf16(Bt[n][k], At[0][k], acc[1][bj][0][n], 0, 0, 0); __builtin_amdgcn_s_setprio(0); } else { PG8_MMA(1, bj, At, Bt); } } while (0)
#define PG8_WAIT_V(n) asm volatile("s_waitcnt vmcnt(" #n ")" ::: "memory")
#define PG8_WAIT_L(n) asm volatile("s_waitcnt lgkmcnt(" #n ")" ::: "memory")
#define PG8_BAR __builtin_amdgcn_s_barrier()
#define PG8_SCHED __builtin_amdgcn_sched_barrier(0)
    Unit cur, nxt; int ui = 0;
    if (!S.next(0, cur)) return;
    f32x4 acc[2][2][4][2];
#pragma unroll
    for (int a = 0; a < 2; ++a)
#pragma unroll
        for (int b = 0; b < 2; ++b)
#pragma unroll
            for (int m = 0; m < 4; ++m)
#pragma unroll
                for (int n = 0; n < 2; ++n) acc[a][b][m][n] = (f32x4){0.f, 0.f, 0.f, 0.f};
    bf16x8 At[4][2], B0[2][2], B1[2][2];
    const char* cA = (const char*)g.A + (size_t)cur.pm * tstepA; const char* cB = (const char*)g.Bt + (size_t)cur.pn * tstep;
#define PG8_DA(pm_) (T160 ? (ptrdiff_t)((size_t)row1 * K * 2 + (size_t)(pm_) * t1step) - (ptrdiff_t)((size_t)(pm_) * tstepA) : (ptrdiff_t)hstep)
    ptrdiff_t dA = PG8_DA(cur.pm), dAn = dA;
    S.a_ready(cur);
    if constexpr (SP2) {
        PG8_STAGE(PG8_SB(0, 0), cB, voffB); PG8_STAGE(PG8_SB(0, 1), cB + hstep, voffB); PG8_STAGE(PG8_SA(0, 0), cA, voffA); PG8_STAGE(PG8_SA(0, 1), cA + dA, voffA1);
        if (wr == 1) PG8_BAR;
        PG8_WAIT_V(2); PG8_BAR;
        PG8_STAGE(PG8_SB(1, 0), cB + kstep, voffB); PG8_STAGE(PG8_SA(1, 0), cA + kstep, voffA); PG8_STAGE(PG8_SB(1, 1), cB + hstep + kstep, voffB);
        PG8_WAIT_V(6); PG8_BAR;
    } else {
        PG8_STAGE(PG8_SB(0, 0), cB, voffB); PG8_STAGE(PG8_SA(0, 0), cA, voffA); PG8_STAGE(PG8_SB(0, 1), cB + hstep, voffB); PG8_STAGE(PG8_SA(0, 1), cA + hstep, voffA);
        if (wr == 1) PG8_BAR;
        PG8_WAIT_V(4); PG8_BAR;
        PG8_STAGE(PG8_SB(1, 0), cB + kstep, voffB); PG8_STAGE(PG8_SA(1, 0), cA + kstep, voffA); PG8_STAGE(PG8_SB(1, 1), cB + hstep + kstep, voffB);
        PG8_WAIT_V(6); PG8_BAR;
    }
    for (;;) {
        const bool has_next = S.next(ui + 1, nxt);
        const char* nA = has_next ? (const char*)g.A + (size_t)nxt.pm * tstepA : cA; const char* nB = has_next ? (const char*)g.Bt + (size_t)nxt.pn * tstep : cB;
        dAn = has_next ? PG8_DA(nxt.pm) : dA;
        for (int t = 0; t < nt; t += 2) {
            const bool last = (t == nt - 2);
            const char* a1 = cA + (size_t)(t + 1) * kstep;
            const char* a2 = last ? nA : cA + (size_t)(t + 2) * kstep; const char* b2 = last ? nB : cB + (size_t)(t + 2) * kstep;
            const char* a3 = a2 + kstep; const char* b3 = b2 + kstep;
            const ptrdiff_t d2 = last ? dAn : dA;
            if (last && has_next) S.a_ready(nxt);
            if constexpr (SP2) {
            PG8_LDB(B0, 0, 0); PG8_LDB(B1, 0, 1); PG8_SCHED; PG8_LDA(At, 0, 0); PG8_STAGE(PG8_SA(1, 1), a1 + dA, voffA1);
            PG8_WAIT_V(8); PG8_WAIT_L(0); PG8_BAR; PG8_MMA(0, 0, At, B0); PG8_MMA(0, 1, At, B1); PG8_BAR; PG8_SCHED;
            PG8_LDA1(At, 0); PG8_STAGE(PG8_SB(0, 0), b2, voffB); PG8_STAGE(PG8_SB(0, 1), b2 + hstep, voffB); PG8_STAGE(PG8_SA(0, 0), a2, voffA);
            PG8_WAIT_V(8); PG8_WAIT_L(0); PG8_BAR; PG8_MMA1(0, At, B0); PG8_MMA1(1, At, B1); PG8_BAR; PG8_SCHED;
            PG8_LDB(B0, 1, 0); PG8_LDB(B1, 1, 1); PG8_SCHED; PG8_LDA(At, 1, 0); PG8_STAGE(PG8_SA(0, 1), a2 + d2, voffA1);
            PG8_WAIT_V(8); PG8_WAIT_L(0); PG8_BAR; PG8_MMA(0, 0, At, B0); PG8_MMA(0, 1, At, B1); PG8_BAR; PG8_SCHED;
            PG8_LDA1(At, 1); PG8_STAGE(PG8_SB(1, 0), b3, voffB); PG8_STAGE(PG8_SB(1, 1), b3 + hstep, voffB); PG8_STAGE(PG8_SA(1, 0), a3, voffA);
            PG8_WAIT_V(8); PG8_WAIT_L(0); PG8_BAR; PG8_MMA1(0, At, B0); PG8_MMA1(1, At, B1); PG8_BAR; PG8_SCHED;
            } else {
            PG8_LDB(B0, 0, 0); PG8_SCHED; PG8_LDA(At, 0, 0); PG8_STAGE(PG8_SA(1, 1), a1 + hstep, voffA);
            PG8_WAIT_L(8); PG8_BAR; PG8_WAIT_L(0); PG8_MMA(0, 0, At, B0); PG8_BAR; PG8_SCHED;
            PG8_LDB(B1, 0, 1); PG8_STAGE(PG8_SB(0, 0), b2, voffB);
            PG8_BAR; PG8_WAIT_L(0); PG8_MMA(0, 1, At, B1); PG8_BAR;
            PG8_LDA(At, 0, 1); PG8_STAGE(PG8_SA(0, 0), a2, voffA);
            PG8_BAR; PG8_WAIT_L(0); PG8_MMA(1, 0, At, B0); PG8_BAR; PG8_SCHED;
            PG8_STAGE(PG8_SB(0, 1), b2 + hstep, voffB);
            PG8_WAIT_V(6); PG8_BAR; PG8_MMA(1, 1, At, B1); PG8_BAR;
            PG8_LDB(B0, 1, 0); PG8_SCHED; PG8_LDA(At, 1, 0); PG8_STAGE(PG8_SA(0, 1), a2 + hstep, voffA);
            PG8_WAIT_L(8); PG8_BAR; PG8_WAIT_L(0); PG8_MMA(0, 0, At, B0); PG8_BAR; PG8_SCHED;
            PG8_LDB(B1, 1, 1); PG8_STAGE(PG8_SB(1, 0), b3, voffB);
            PG8_BAR; PG8_WAIT_L(0); PG8_MMA(0, 1, At, B1); PG8_BAR;
            PG8_LDA(At, 1, 1); PG8_STAGE(PG8_SA(1, 0), a3, voffA);
            PG8_BAR; PG8_WAIT_L(0); PG8_MMA(1, 0, At, B0); PG8_BAR; PG8_SCHED;
            PG8_STAGE(PG8_SB(1, 1), b3 + hstep, voffB);
            PG8_WAIT_V(6); PG8_BAR; PG8_MMA(1, 1, At, B1); PG8_BAR;
            }
        }
        if constexpr (ALIGN_EPI) { if (wr == 0) PG8_BAR; }
        if constexpr (!Epi::AFTER_DRAIN) { E(acc, cur, wr, wc, fr, fq); S.done(cur); }
        if (!has_next) break;
#pragma unroll
        for (int a = 0; a < 2; ++a)
#pragma unroll
            for (int b = 0; b < 2; ++b)
#pragma unroll
                for (int m = 0; m < 4; ++m)
#pragma unroll
                    for (int n = 0; n < 2; ++n) acc[a][b][m][n] = (f32x4){0.f, 0.f, 0.f, 0.f};
        cur = nxt; cA = nA; cB = nB; dA = dAn; ++ui;
        if constexpr (ALIGN_EPI) { if (wr == 1) PG8_BAR; }
    }
    PG8_WAIT_V(0);
    if constexpr (!ALIGN_EPI) { if (wr == 0) PG8_BAR; }
    PG8_BAR;
    if constexpr (Epi::AFTER_DRAIN) { E.fused(acc, cur, wr, wc, fr, fq, lds, wid, lane); S.done(cur); }
#undef PG8_SA
#undef PG8_SB
#undef PG8_STAGE
#undef PG8_LDA
#undef PG8_LDB
#undef PG8_MMA
#undef PG8_WAIT_V
#undef PG8_LDA1
#undef PG8_MMA1
#undef PG8_DA
#undef PG8_WAIT_L
#undef PG8_BAR
#undef PG8_SCHED
}
}

#ifndef PG8_SP2
#define PG8_SP2 true
#endif
#ifndef PG8_ALIGN
#define PG8_ALIGN true
#endif
namespace pg8 {
typedef __bf16 bf16x2v __attribute__((ext_vector_type(2))); typedef float f32x2v_ __attribute__((ext_vector_type(2)));
__device__ __forceinline__ unsigned cvt_pk_vis(float lo, float hi) { const f32x2v_ v = {lo, hi}; return __builtin_bit_cast(unsigned, __builtin_convertvector(v, bf16x2v)); }
struct EpiRes {
    static constexpr bool PERM = false, AFTER_DRAIN = false;
    const float* src_ctx; const float* src_lat; float* X; const float* gate;
    __device__ __forceinline__ void operator()(const f32x4 (&acc)[2][2][4][2], const Unit& u, int wr, int wc, int fr, int fq) const {
        const int cond = u.pm < 32 ? 0 : 1 + ((u.pm - 32) >> 2);
        const float* g = gate + cond * 6144;
        const float* sb = u.pm < 32 ? src_ctx + (size_t)u.pm * BM * 1024 : src_lat + (size_t)(u.pm - 32) * BM * 1024;
        float* xb = X + (size_t)u.pm * BM * 1024;
        const int col0 = u.pn * BM + wc * 32 + 4 * fq;
        f32x4 gv[2][2];
#pragma unroll
        for (int bj = 0; bj < 2; ++bj)
#pragma unroll
            for (int n = 0; n < 2; ++n) gv[bj][n] = *(const f32x4*)(g + col0 + bj * HALF + n * 16);
#pragma unroll
        for (int ai = 0; ai < 2; ++ai)
#pragma unroll
            for (int m = 0; m < 4; ++m) { const size_t off = (size_t)(ai * HALF + wr * 64 + m * 16 + fr) * 1024 + col0;
#pragma unroll
                for (int bj = 0; bj < 2; ++bj)
#pragma unroll
                    for (int n = 0; n < 2; ++n) { const f32x4 xv = *(const f32x4*)(sb + off + bj * HALF + n * 16);
                        *(f32x4*)(xb + off + bj * HALF + n * 16) = xv + gv[bj][n] * acc[ai][bj][m][n]; } }
    }
};
struct EpiRes160 {
    static constexpr bool PERM = false, AFTER_DRAIN = false;
    const float* src_ctx; const float* src_lat; float* X; const float* gate;
    __device__ __forceinline__ void operator()(const f32x4 (&acc)[2][2][4][2], const Unit& u, int wr, int wc, int fr, int fq) const {
        const int col0 = u.pn * BM + wc * 32 + 4 * fq;
        {
            const float* sb = src_ctx + (size_t)u.pm * 128 * 1024; float* xb = X + (size_t)u.pm * 128 * 1024;
            f32x4 gv[2][2];
#pragma unroll
            for (int bj = 0; bj < 2; ++bj)
#pragma unroll
                for (int n = 0; n < 2; ++n) gv[bj][n] = *(const f32x4*)(gate + col0 + bj * HALF + n * 16);
#pragma unroll
            for (int m = 0; m < 4; ++m) { const size_t off = (size_t)(wr * 64 + m * 16 + fr) * 1024 + col0;
#pragma unroll
                for (int bj = 0; bj < 2; ++bj)
#pragma unroll
                    for (int n = 0; n < 2; ++n) { const f32x4 xv = *(const f32x4*)(sb + off + bj * HALF + n * 16);
                        *(f32x4*)(xb + off + bj * HALF + n * 16) = xv + gv[bj][n] * acc[0][bj][m][n]; } }
        }
        {
            const float* g = gate + (1 + (u.pm >> 5)) * 6144;
            const float* sb = src_lat + (size_t)u.pm * 32 * 1024; float* xb = X + (size_t)(NCTX + 32 * u.pm) * 1024;
            const size_t off = (size_t)(wr * 16 + fr) * 1024 + col0;
#pragma unroll
            for (int bj = 0; bj < 2; ++bj)
#pragma unroll
                for (int n = 0; n < 2; ++n) { const f32x4 gv = *(const f32x4*)(g + col0 + bj * HALF + n * 16); const f32x4 xv = *(const f32x4*)(sb + off + bj * HALF + n * 16);
                    *(f32x4*)(xb + off + bj * HALF + n * 16) = xv + gv * acc[1][bj][0][n]; }
        }
    }
};
struct EpiDnIn {
    static constexpr bool PERM = true, AFTER_DRAIN = false;
    bf16_t* O; float* AB;
    __device__ __forceinline__ void operator()(const f32x4 (&acc)[2][2][4][2], const Unit& u, int wr, int wc, int fr, int fq) const {
        const int row0 = u.pm * BM + wr * 64 + fr;
        if (u.pn < 16) {
            const int col0 = u.pn * BM + wc * 32 + 8 * fq;
#pragma unroll
            for (int ai = 0; ai < 2; ++ai)
#pragma unroll
                for (int m = 0; m < 4; ++m) { bf16_t* rowp = O + (size_t)(row0 + ai * HALF + m * 16) * 4096 + col0;
#pragma unroll
                    for (int bj = 0; bj < 2; ++bj) { const f32x4 v0 = acc[ai][bj][m][0], v1 = acc[ai][bj][m][1];
                        u32x4 w; w.x = cvt_pk_vis(v0[0], v0[1]); w.y = cvt_pk_vis(v0[2], v0[3]); w.z = cvt_pk_vis(v1[0], v1[1]); w.w = cvt_pk_vis(v1[2], v1[3]);
                        *(u32x4*)(rowp + bj * HALF) = w; } }
        } else if (wc == 0) {
#pragma unroll
            for (int ai = 0; ai < 2; ++ai)
#pragma unroll
                for (int m = 0; m < 4; ++m) { float* rp = AB + (size_t)(row0 + ai * HALF + m * 16) * 32 + 8 * fq;
                    *(f32x4*)rp = acc[ai][0][m][0]; *(f32x4*)(rp + 4) = acc[ai][0][m][1]; }
        }
    }
};
}
#include <hip/hip_bf16.h>
namespace attn {
using bf16 = __hip_bfloat16;
constexpr int D = 128, NW = 8, QBLK = 32, KVBLK = 64;
constexpr float SCALE = 0.088388347648318440f;
constexpr float THR = 8.f;
constexpr int SDEPTH = 2;
constexpr int LDQ = 1024, LDK = 256, LDO = 1024;
constexpr size_t SHM_V = KVBLK * D * 2, SHM_K = KVBLK * D * 2, SHM_ATTN = 2 * SHM_V + 2 * SHM_K + NW * 64 * 4;
using bf16x8 = __attribute__((ext_vector_type(8))) short;
using s16x4  = __attribute__((ext_vector_type(4))) short;
using f32x16 = __attribute__((ext_vector_type(16))) float;
using f32x8  = __attribute__((ext_vector_type(8))) float;
using u32x4  = __attribute__((ext_vector_type(4))) unsigned;
#define KSWZ(row, colB) ((row) * 256 + ((colB) ^ (((row) & 7) << 4)))
#define SBAR() __builtin_amdgcn_sched_barrier(0)
__device__ __forceinline__ int crow(int r, int hi) { return (r & 3) + 8 * (r >> 2) + 4 * hi; }
__device__ __forceinline__ unsigned cvtpk(float lo, float hi) {
  unsigned r; asm volatile("v_cvt_pk_bf16_f32 %0, %1, %2" : "=v"(r) : "v"(lo), "v"(hi)); return r;
}
template <typename TIn> struct Stage;
template <> struct Stage<bf16>  { using T = bf16x8;
  __device__ static __forceinline__ T ld8(const bf16* p) { return *reinterpret_cast<const bf16x8*>(p); }
  __device__ static __forceinline__ bf16x8 tobf(T x) { return x; } };
template <> struct Stage<float> { using T = f32x8;
  __device__ static __forceinline__ T ld8(const float* p) { return *reinterpret_cast<const f32x8*>(p); }
  __device__ static __forceinline__ bf16x8 tobf(T x) {
    u32x4 w = {cvtpk(x[0], x[1]), cvtpk(x[2], x[3]), cvtpk(x[4], x[5]), cvtpk(x[6], x[7])}; return *reinterpret_cast<bf16x8*>(&w); } };

__device__ __forceinline__ void partialSM(f32x16& p0, f32x16& p1, float& m_reg, float& mn, float& alpha) {
  constexpr float C = SCALE * 1.4426950408889634f;
  float pmax = p0[0]; for (int r = 1; r < 16; ++r) pmax = fmaxf(pmax, p0[r]); for (int r = 0; r < 16; ++r) pmax = fmaxf(pmax, p1[r]);
  { auto rr = __builtin_amdgcn_permlane32_swap(__float_as_uint(pmax), __float_as_uint(pmax), false, false);
    pmax = fmaxf(__uint_as_float(rr[0]), __uint_as_float(rr[1])); }
  if (__builtin_expect(__all(pmax - m_reg <= THR / SCALE), 1)) { mn = m_reg; alpha = 1.f; }
  else { mn = fmaxf(m_reg, pmax); alpha = __builtin_amdgcn_exp2f((m_reg - mn) * C); m_reg = mn; }
  float mnC = -mn * C;
  for (int r = 0; r < 16; ++r) p0[r] = fmaf(p0[r], C, mnC); for (int r = 0; r < 16; ++r) p1[r] = fmaf(p1[r], C, mnC);
  for (int r = 0; r < 16; ++r) p0[r] = __builtin_amdgcn_exp2f(p0[r]);
}
__device__ __forceinline__ void finishSM(f32x16& p0, f32x16& p1, float alpha, float& l_reg, bf16x8& pa0, bf16x8& pa1, bf16x8& pa2, bf16x8& pa3) {
  for (int r = 0; r < 16; ++r) p1[r] = __builtin_amdgcn_exp2f(p1[r]);
  float ps = 0; for (int r = 0; r < 16; ++r) ps += p0[r]; for (int r = 0; r < 16; ++r) ps += p1[r];
  { auto rr = __builtin_amdgcn_permlane32_swap(__float_as_uint(ps), __float_as_uint(ps), false, false);
    ps = __uint_as_float(rr[0]) + __uint_as_float(rr[1]); }
  l_reg = l_reg * alpha + ps;
#define PK4(P, BASE, OUT) do { unsigned a0 = cvtpk(P[BASE + 0], P[BASE + 1]), a1 = cvtpk(P[BASE + 2], P[BASE + 3]);   \
    unsigned b0 = cvtpk(P[BASE + 4], P[BASE + 5]), b1 = cvtpk(P[BASE + 6], P[BASE + 7]);                              \
    auto r0 = __builtin_amdgcn_permlane32_swap(a0, b0, false, false); auto r1 = __builtin_amdgcn_permlane32_swap(a1, b1, false, false); \
    u32x4 w = {r0[0], r1[0], r0[1], r1[1]}; OUT = *reinterpret_cast<bf16x8*>(&w); } while (0)
  PK4(p0, 0, pa0); PK4(p0, 8, pa1); PK4(p1, 0, pa2); PK4(p1, 8, pa3);
#undef PK4
}
__device__ __forceinline__ void qkt(f32x16& p0, f32x16& p1, const bf16* Ks, const bf16x8* qr, int r32, int hi) {
  p0 = f32x16{}; p1 = f32x16{};
  for (int d0 = 0; d0 < 8; ++d0) { int cb = (d0 * 16 + hi * 8) * 2;
    bf16x8 b0 = *reinterpret_cast<const bf16x8*>((const char*)Ks + KSWZ(r32, cb));
    bf16x8 b1 = *reinterpret_cast<const bf16x8*>((const char*)Ks + KSWZ(32 + r32, cb));
    p0 = __builtin_amdgcn_mfma_f32_32x32x16_bf16(b0, qr[d0], p0, 0, 0, 0);
    p1 = __builtin_amdgcn_mfma_f32_32x32x16_bf16(b1, qr[d0], p1, 0, 0, 0); }
}
__device__ __forceinline__ int v_st(int k, int c) { const int kk = (k & ~0xC) | ((k & 4) << 1) | ((k & 8) >> 1); return ((kk >> 3) * 4 + (c >> 5)) * 512 + ((kk & 7) * 32 + (c & 31)) * 2; }
__device__ __forceinline__ int v_rd_base(int lane) { return ((lane & 3) << 3) | (((lane >> 2) & 3) << 6) | (((lane >> 4) & 1) << 5) | (((lane >> 5) & 1) << 8); }
constexpr int v_rd_off(int d0, int ks, int half) { return d0 * 512 + ks * 4096 + half * 2048; }
template <int OFF> __device__ __forceinline__ s16x4 tr_read(int vb) {
  s16x4 r; asm volatile("ds_read_b64_tr_b16 %0, %1 offset:%2" : "=&v"(r) : "v"(vb), "i"(OFF) : "memory"); return r;
}
template <int D0> __device__ __forceinline__ void pv_one(f32x16& od, int vb, bf16x8 pa0, bf16x8 pa1, bf16x8 pa2, bf16x8 pa3) {
  const s16x4 l0 = tr_read<v_rd_off(D0, 0, 0)>(vb), h0 = tr_read<v_rd_off(D0, 0, 1)>(vb), l1 = tr_read<v_rd_off(D0, 1, 0)>(vb), h1 = tr_read<v_rd_off(D0, 1, 1)>(vb);
  const s16x4 l2 = tr_read<v_rd_off(D0, 2, 0)>(vb), h2 = tr_read<v_rd_off(D0, 2, 1)>(vb), l3 = tr_read<v_rd_off(D0, 3, 0)>(vb), h3 = tr_read<v_rd_off(D0, 3, 1)>(vb);
  asm volatile("s_waitcnt lgkmcnt(0)" ::: "memory"); SBAR();
#define PK(L, H) (bf16x8){L[0], L[1], L[2], L[3], H[0], H[1], H[2], H[3]}
  od = __builtin_amdgcn_mfma_f32_32x32x16_bf16(pa0, PK(l0, h0), od, 0, 0, 0);
  od = __builtin_amdgcn_mfma_f32_32x32x16_bf16(pa1, PK(l1, h1), od, 0, 0, 0);
  od = __builtin_amdgcn_mfma_f32_32x32x16_bf16(pa2, PK(l2, h2), od, 0, 0, 0);
  od = __builtin_amdgcn_mfma_f32_32x32x16_bf16(pa3, PK(l3, h3), od, 0, 0, 0);
#undef PK
}
__device__ __forceinline__ void pv_d0(f32x16* o, int vb, bf16x8 pa0, bf16x8 pa1, bf16x8 pa2, bf16x8 pa3) {
  pv_one<0>(o[0], vb, pa0, pa1, pa2, pa3); pv_one<1>(o[1], vb, pa0, pa1, pa2, pa3); pv_one<2>(o[2], vb, pa0, pa1, pa2, pa3); pv_one<3>(o[3], vb, pa0, pa1, pa2, pa3);
}

template <typename TQ>
__device__ __forceinline__ void attn_dense_body(const TQ* __restrict__ Qb, const bf16* __restrict__ Kh, const bf16* __restrict__ Vh,
                                                unsigned short* __restrict__ Ob, int seq, char* lds, const int tid) {
  using St = Stage<bf16>; using SQ = Stage<TQ>;
  const int wid = tid >> 6, lane = tid & 63, r32 = lane & 31, hi = lane >> 5;
  bf16* V_lds = (bf16*)lds; bf16* K_lds = (bf16*)(lds + 2 * SHM_V);
  float* ws = (float*)(lds + 2 * SHM_V + 2 * SHM_K) + wid * 64; float* li_l = ws; float* al_l = ws + 32;
  float m_reg = -1e30f, l_reg = 0; f32x16 o[4] = {}; bf16x8 qr[8];
  const TQ* Qw = Qb + (int)(wid * QBLK + r32) * LDQ + hi * 8;
#pragma unroll
  for (int d0 = 0; d0 < 8; ++d0) qr[d0] = SQ::tobf(SQ::ld8(Qw + d0 * 16));
  const int sr = tid >> 4, sc = (tid & 15) * 8, vst0 = v_st(sr, sc), vst1 = v_st(32 + sr, sc);
  const int vb0 = (int)(uintptr_t)V_lds + v_rd_base(lane);
  struct { typename St::T vs0, vs1, ks0, ks1; } sr_[SDEPTH];
#define SLOAD(i, k0) do { sr_[i].vs0 = St::ld8(&Vh[(int)((k0) + sr) * LDK + sc]); sr_[i].vs1 = St::ld8(&Vh[(int)((k0) + 32 + sr) * LDK + sc]); \
    sr_[i].ks0 = St::ld8(&Kh[(int)((k0) + sr) * LDK + sc]); sr_[i].ks1 = St::ld8(&Kh[(int)((k0) + 32 + sr) * LDK + sc]); } while (0)
#define SWRITE(b, i) do { *(bf16x8*)((char*)V_lds + (b) * SHM_V + vst0) = St::tobf(sr_[i].vs0);          \
    *(bf16x8*)((char*)V_lds + (b) * SHM_V + vst1) = St::tobf(sr_[i].vs1); int kc = sc * 2;               \
    *(bf16x8*)((char*)K_lds + (b) * SHM_K + KSWZ(sr, kc)) = St::tobf(sr_[i].ks0);                       \
    *(bf16x8*)((char*)K_lds + (b) * SHM_K + KSWZ(32 + sr, kc)) = St::tobf(sr_[i].ks1); } while (0)
#define SWAIT() do { if constexpr (SDEPTH == 2) asm volatile("s_waitcnt vmcnt(4)" ::: "memory"); else asm volatile("s_waitcnt vmcnt(0)" ::: "memory"); } while (0)
#define RESC(a) do { if (__any((a) < 1.f)) { if (hi == 0) al_l[r32] = (a); asm volatile("s_waitcnt lgkmcnt(0)" ::: "memory"); \
    for (int d = 0; d < 4; ++d) for (int r = 0; r < 16; ++r) o[d][r] *= al_l[crow(r, hi)]; } } while (0)
  f32x16 pA0, pA1, pB0, pB1; float mnA, mnB, alA, alB; bf16x8 pa0, pa1, pa2, pa3; const int NT = seq / KVBLK;
  constexpr int SE = 0, SO = SDEPTH - 1;
  SLOAD(SE, 0); asm volatile("s_waitcnt vmcnt(0)" ::: "memory"); SWRITE(0, SE); __syncthreads();
  qkt(pA0, pA1, K_lds, qr, r32, hi); partialSM(pA0, pA1, m_reg, mnA, alA);
  SLOAD(SO, KVBLK); if constexpr (SDEPTH == 2) { if (2 < NT) SLOAD(SE, 2 * KVBLK); }
  SWAIT(); SWRITE(1, SO); __syncthreads();
  for (int j = 1; j + 1 < NT; j += 2) {
    SBAR(); qkt(pB0, pB1, (bf16*)((char*)K_lds + SHM_K), qr, r32, hi);
    finishSM(pA0, pA1, alA, l_reg, pa0, pa1, pa2, pa3); SBAR();
    SLOAD(SO, (j + SDEPTH) * KVBLK); SBAR();
    pv_d0(o, vb0, pa0, pa1, pa2, pa3); partialSM(pB0, pB1, m_reg, mnB, alB);
    __syncthreads(); SWAIT(); SWRITE(0, SE);
    RESC(alB); __syncthreads();
    SBAR(); qkt(pA0, pA1, K_lds, qr, r32, hi);
    finishSM(pB0, pB1, alB, l_reg, pa0, pa1, pa2, pa3); SBAR();
    if (SDEPTH == 1 || j + 3 < NT) SLOAD(SE, (j + 1 + SDEPTH) * KVBLK); SBAR();
    pv_d0(o, vb0 + (int)SHM_V, pa0, pa1, pa2, pa3); partialSM(pA0, pA1, m_reg, mnA, alA);
    __syncthreads(); SWAIT(); SWRITE(1, SO);
    RESC(alA); __syncthreads();
  }
  SBAR(); qkt(pB0, pB1, (bf16*)((char*)K_lds + SHM_K), qr, r32, hi);
  finishSM(pA0, pA1, alA, l_reg, pa0, pa1, pa2, pa3); SBAR();
  pv_d0(o, vb0, pa0, pa1, pa2, pa3); partialSM(pB0, pB1, m_reg, mnB, alB);
  __syncthreads(); RESC(alB);
  finishSM(pB0, pB1, alB, l_reg, pa0, pa1, pa2, pa3); SBAR();
  pv_d0(o, vb0 + (int)SHM_V, pa0, pa1, pa2, pa3);
  if (hi == 0) li_l[r32] = l_reg; asm volatile("s_waitcnt lgkmcnt(0)" ::: "memory");
  float rli[16];
#pragma unroll
  for (int r = 0; r < 16; ++r) rli[r] = __builtin_amdgcn_rcpf(li_l[crow(r, hi)]);
  unsigned short* Ow = Ob + (int)(wid * QBLK) * LDO;
#pragma unroll
  for (int r = 0; r < 16; ++r) { int orow = crow(r, hi);
    for (int d0 = 0; d0 < 4; ++d0) Ow[(int)orow * LDO + d0 * 32 + r32] = (unsigned short)f2bf(o[d0][r] * rli[r]); }
#undef SLOAD
#undef SWRITE
#undef SWAIT
#undef RESC
}

#undef KSWZ
#undef SBAR
}
#define LAS __attribute__((address_space(3)))
constexpr int NWAVES = 8;
constexpr int LDS_BYTES = 147456;
constexpr size_t MiB = (size_t)1 << 20;
constexpr size_t WS_CTL = 0, CTL_ZERO_BYTES = 1 * MiB;
constexpr size_t WS_MODS = 1 * MiB, WS_ROPE = WS_MODS + MiB / 2;
constexpr size_t WS_WT_AIN = 2 * MiB, WS_WT_AOUT = 8 * MiB, WS_WT_DIN = 12 * MiB, WS_WT_DOUT = 29 * MiB, WS_WT_W1 = 33 * MiB, WS_WT_W2 = 65 * MiB;
constexpr size_t WS_X = 97 * MiB, WS_H = 137 * MiB, WS_Y = 157 * MiB, WS_PROJ = 177 * MiB, WS_AB = 257 * MiB;
constexpr size_t WS_SOP = 291 * MiB, WS_QB = 291 * MiB, WS_KB = 311 * MiB, WS_VB = 317 * MiB;
constexpr size_t WS_EGL = 471 * MiB, WS_OF = 472 * MiB, WS_OB = 492 * MiB, WS_END = 512 * MiB;
static_assert(WS_SOP + (size_t)2560 * 73728 <= WS_EGL, "operand records");

struct Ctx {
    LAS unsigned char* lds;
    int tid, lane, wid, gw, ngw, nblk, blk;
};
struct ProPtrs { const float *c, *c_ctx, *w_mod, *b_mod, *attn_w_in, *attn_w_out, *dn_w_in, *dn_w_out, *mlp_w1, *mlp_w2; float *mods, *rope; bf16raw *wt_ain, *wt_aout, *wt_din, *wt_dout, *wt_w1, *wt_w2; };

#define LDS_WAIT() asm volatile("s_waitcnt lgkmcnt(0)" ::: "memory")

__device__ __forceinline__ void p0_transpose_item(const float* W, int K, int N, bf16raw* WT, LAS float* scr, int item, int lane) {
    const int nblk = N / 32, kb = item / nblk, nb = item % nblk, k0 = 64 * kb, n0 = 32 * nb;
#pragma unroll 8
    for (int i = 0; i < 32; ++i) { const int kk = 2 * i + (lane >> 5); scr[kk * 33 + (lane & 31)] = W[(size_t)(k0 + kk) * N + n0 + (lane & 31)]; }
    LDS_WAIT(); asm volatile("" ::: "memory");
    const int c = lane & 7;
#pragma unroll
    for (int j = 0; j < 4; ++j) { const int n = (lane >> 3) + 8 * j; const LAS float* s = scr + (8 * c) * 33 + n;
        u32x4_t o; o.x = pk2(s[0 * 33], s[1 * 33]); o.y = pk2(s[2 * 33], s[3 * 33]); o.z = pk2(s[4 * 33], s[5 * 33]); o.w = pk2(s[6 * 33], s[7 * 33]);
        *(u32x4_t*)(WT + (size_t)(n0 + n) * K + k0 + 8 * c) = o; }
    LDS_WAIT(); asm volatile("" ::: "memory");
}

__device__ __forceinline__ void phase_prologue(Ctx& C, const ProPtrs& P) {
    LAS float* sc = (LAS float*)C.lds;
    LAS float* red = (LAS float*)(C.lds + 12288);
    for (int k = C.tid; k < 1024; k += 512) { sc[k] = silu_f(P.c_ctx[k]); sc[1024 + k] = silu_f(P.c[k]); sc[2048 + k] = silu_f(P.c[1024 + k]); }
    __syncthreads();
    for (int u = C.blk; u < 4 * 96; u += C.nblk) {
        const int l = u / 96, n0 = (u % 96) * 64;
        const float* w = P.w_mod + ((size_t)l * 1024 + C.wid * 128) * 6144 + n0 + C.lane;
        float a0 = 0.f, a1 = 0.f, a2 = 0.f;
#pragma unroll 8
        for (int k = 0; k < 128; ++k) { const float wv = w[(size_t)k * 6144]; const int kk = C.wid * 128 + k; a0 += sc[kk] * wv; a1 += sc[1024 + kk] * wv; a2 += sc[2048 + kk] * wv; }
        red[(C.wid * 3 + 0) * 64 + C.lane] = a0; red[(C.wid * 3 + 1) * 64 + C.lane] = a1; red[(C.wid * 3 + 2) * 64 + C.lane] = a2;
        __syncthreads();
        if (C.tid < 192) { const int s = C.tid >> 6, ln = C.tid & 63; float t = 0.f;
#pragma unroll
            for (int w8 = 0; w8 < 8; ++w8) t += red[(w8 * 3 + s) * 64 + ln];
            P.mods[(size_t)(l * 3 + s) * 6144 + n0 + ln] = t + P.b_mod[l * 6144 + n0 + ln]; }
        __syncthreads();
    }
    __syncthreads();
    LAS float* scr = (LAS float*)(C.lds + C.wid * 16384);
    constexpr int I0 = 2 * 768, I1 = 2 * 512, I2 = 2 * 2064, I3 = 2 * 512, I4 = 4 * 2048, I5 = 4 * 2048;
    for (int it = C.gw; it < I0 + I1 + I2 + I3 + I4 + I5; it += C.ngw) {
        int r = it;
        if (r < I0) { const int j = r / 768; p0_transpose_item(P.attn_w_in + (size_t)j * 1024 * 1536, 1024, 1536, P.wt_ain + (size_t)j * 1536 * 1024, scr, r % 768, C.lane); continue; } r -= I0;
        if (r < I1) { const int j = r / 512; p0_transpose_item(P.attn_w_out + (size_t)j * 1024 * 1024, 1024, 1024, P.wt_aout + (size_t)j * 1024 * 1024, scr, r % 512, C.lane); continue; } r -= I1;
        if (r < I2) { const int j = r / 2064; p0_transpose_item(P.dn_w_in + (size_t)j * 1024 * DNIN, 1024, DNIN, P.wt_din + (size_t)j * DNINP * 1024, scr, r % 2064, C.lane); continue; } r -= I2;
        if (r < I3) { const int j = r / 512; p0_transpose_item(P.dn_w_out + (size_t)j * 1024 * 1024, 1024, 1024, P.wt_dout + (size_t)j * 1024 * 1024, scr, r % 512, C.lane); continue; } r -= I3;
        if (r < I4) { const int l = r / 2048; p0_transpose_item(P.mlp_w1 + (size_t)l * 1024 * 4096, 1024, 4096, P.wt_w1 + (size_t)l * 4096 * 1024, scr, r % 2048, C.lane); continue; } r -= I4;
        { const int l = r / 2048; p0_transpose_item(P.mlp_w2 + (size_t)l * 4096 * 1024, 4096, 1024, P.wt_w2 + (size_t)l * 1024 * 4096, scr, r % 2048, C.lane); }
    }
    const int gt = C.blk * 512 + C.tid, ngt = C.nblk * 512;
    for (int i = gt; i < 2 * 28672; i += ngt) { const int j = i / 28672, o = i % 28672;
        *(u32x4_t*)(P.wt_din + ((size_t)j * DNINP + DNIN) * 1024 + (size_t)o * 8) = (u32x4_t){0u, 0u, 0u, 0u}; }
    for (int i = gt; i < 1024 * 64; i += ngt) { const int t = i >> 6, a = (i >> 5) & 1, f = i & 31;
        const float inv = powf(10000.f, -(float)f / 32.f); const float ang = (float)(a ? (t & 63) : (t >> 6)) * inv;
        P.rope[2 * i] = cosf(ang); P.rope[2 * i + 1] = sinf(ang); }
}

__device__ __forceinline__ void phase_norm(Ctx& C, const float* src_ctx, const float* src_lat, const float* gain, const float* md0, bf16raw* H) {
    for (int row = C.gw; row < MTOK; row += C.ngw) {
        const float* xr = row < NCTX ? src_ctx + (size_t)row * D : src_lat + (size_t)(row - NCTX) * D;
        const float* md = md0 + cond_of(row) * 6144;
        f32x4_t v[4]; float ss = 0.f;
#pragma unroll
        for (int j = 0; j < 4; ++j) { v[j] = *(const f32x4_t*)(xr + 4 * C.lane + 256 * j); ss += (v[j].x * v[j].x + v[j].y * v[j].y) + (v[j].z * v[j].z + v[j].w * v[j].w); }
        const float rinv = rsqrtf(wave_sum(ss, C.lane) * (1.f / D) + EPS);
#pragma unroll
        for (int j = 0; j < 4; ++j) { const int c = 4 * C.lane + 256 * j;
            const f32x4_t g = *(const f32x4_t*)(gain + c), sh = *(const f32x4_t*)(md + c), sc = *(const f32x4_t*)(md + 1024 + c);
            const f32x4_t y = v[j] * rinv * g * (sc + 1.f) + sh;
            u32x2_t o; o.x = pk2(y.x, y.y); o.y = pk2(y.z, y.w);
            *(u32x2_t*)(H + (size_t)row * D + c) = o; }
    }
}
__device__ __forceinline__ void phase_final(Ctx& C, const float* X, const float* final_norm, float* out) {
    for (int row = C.gw; row < MTOK; row += C.ngw) {
        const float* xr = X + (size_t)row * D;
        f32x4_t v[4]; float ss = 0.f;
#pragma unroll
        for (int j = 0; j < 4; ++j) { v[j] = *(const f32x4_t*)(xr + 4 * C.lane + 256 * j); ss += (v[j].x * v[j].x + v[j].y * v[j].y) + (v[j].z * v[j].z + v[j].w * v[j].w); }
        const float rinv = rsqrtf(wave_sum(ss, C.lane) * (1.f / D) + EPS);
#pragma unroll
        for (int j = 0; j < 4; ++j) { const int c = 4 * C.lane + 256 * j; const f32x4_t g = *(const f32x4_t*)(final_norm + c);
            *(f32x4_t*)(out + O_Y + (size_t)row * D + c) = v[j] * rinv * g; }
    }
}

struct QknPtrs { const bf16raw* PROJ; bf16raw *QB, *KB, *VB; const float *qg, *kg, *rope, *cache_k, *cache_v; float* out; };
__device__ __forceinline__ void phase_qkn(Ctx& C, const QknPtrs& P, int j) {
    const unsigned* P32 = (const unsigned*)P.PROJ; unsigned* Q32 = (unsigned*)P.QB; unsigned* K32 = (unsigned*)P.KB; unsigned* V32 = (unsigned*)P.VB;
    const float* qg = P.qg; const float* kg = P.kg;
    const int lane = C.lane;
    const f32x2_t gq = *(const f32x2_t*)(qg + 2 * lane), gk = *(const f32x2_t*)(kg + 2 * lane);
    for (int row = C.gw; row < MTOK; row += C.ngw) {
        const bool lat = row >= NCTX;
        const int b = lat ? (row - NCTX) >> 10 : row >> 8, t = lat ? (row - NCTX) & 1023 : row & 255;
        const int krow = lat ? 8192 + b * 1280 + 256 + t : row;
        f32x4_t rp = (f32x4_t){1.f, 0.f, 1.f, 0.f};
        if (lat) rp = *(const f32x4_t*)(P.rope + ((size_t)t * 64 + (lane >> 5) * 32 + 2 * (lane & 15)) * 2);
        const bool ph = (lane >> 4) & 1;
#pragma unroll
        for (int slot = 0; slot < 12; ++slot) {
            const unsigned w = P32[(size_t)row * 768 + slot * 64 + lane];
            float v0 = bf_lo(w), v1 = bf_hi(w);
            if (slot < 10) {
                const float rinv = rsqrtf(wave_sum(v0 * v0 + v1 * v1, lane) * (1.f / 128.f) + EPS);
                const f32x2_t g = slot < 8 ? gq : gk;
                v0 = v0 * rinv * g.x; v1 = v1 * rinv * g.y;
                if (lat) { const float y0 = lane_xor_f(v0, lane, 16), y1 = lane_xor_f(v1, lane, 16);
                    v0 = v0 * rp.x + (ph ? y0 : -y0) * rp.y; v1 = v1 * rp.z + (ph ? y1 : -y1) * rp.w; }
            }
            const unsigned o = pk2(v0, v1);
            if (slot < 8) Q32[(size_t)row * 512 + slot * 64 + lane] = o;
            else if (slot < 10) K32[(size_t)krow * 128 + (slot - 8) * 64 + lane] = o;
            else V32[(size_t)krow * 128 + (slot - 10) * 64 + lane] = o;
            if (!lat && slot >= 8) { float* op = P.out + (slot < 10 ? O_CK : O_CV) + ((size_t)(b * 2 + j) * 256 + t) * 256 + (slot & 1) * 128 + 2 * lane;
                *(f32x2_t*)op = (f32x2_t){v0, v1}; }
        }
    }
    for (int it = C.gw; it < 2 * 256 * 2; it += C.ngw) {
        const int kv = it & 1, key = (it >> 1) & 255, b = it >> 9;
        const float* src = (kv ? P.cache_v : P.cache_k) + ((size_t)(b * 2 + j) * 256 + key) * 256 + 4 * lane;
        const f32x4_t v = *(const f32x4_t*)src;
        u32x2_t o; o.x = pk2(v.x, v.y); o.y = pk2(v.z, v.w);
        *(u32x2_t*)((kv ? P.VB : P.KB) + (size_t)(8192 + b * 1280 + key) * 256 + 4 * lane) = o;
    }
}

struct AttnPtrs { const bf16raw *QB, *KB, *VB; bf16raw* Y; };
__device__ __forceinline__ void phase_attn(Ctx& C, const AttnPtrs& P) {
    char* lds = (char*)C.lds;
    for (int r = 0; r * C.nblk < 320; ++r) {
        const int u = r * C.nblk + (C.blk + r * (C.nblk - 64)) % C.nblk;
        if (u >= 320) continue;
        int row0, krow0, hq, seq;
        if (u < 64) { const int b = u >> 5, qb = u & 3; hq = (u >> 2) & 7; row0 = NCTX + b * 1024 + qb * 256; krow0 = 8192 + b * 1280; seq = 1280; }
        else { const int c = u - 64, b = c >> 3; hq = c & 7; row0 = b * 256; krow0 = b * 256; seq = 256; }
        const int kvh = hq >> 2;
        if (r > 0) __syncthreads();
        attn::attn_dense_body<attn::bf16>((const attn::bf16*)(P.QB + (size_t)row0 * 1024 + hq * 128), (const attn::bf16*)(P.KB + (size_t)krow0 * 256 + kvh * 128),
                                          (const attn::bf16*)(P.VB + (size_t)krow0 * 256 + kvh * 128), P.Y + (size_t)row0 * 1024 + hq * 128, seq, lds, C.tid);
    }
}
struct GatePtrs { const bf16raw *OF, *OB, *PROJ; bf16raw* Y; const float* gain; };
__device__ __forceinline__ void phase_gate(Ctx& C, const GatePtrs& P) {
    const unsigned* F32 = (const unsigned*)P.OF; const unsigned* B32 = (const unsigned*)P.OB; const unsigned* P32 = (const unsigned*)P.PROJ; unsigned* Y32 = (unsigned*)P.Y;
    const int lane = C.lane;
    const f32x2_t g = *(const f32x2_t*)(P.gain + 2 * lane);
    for (int it = C.gw; it < MTOK * 8; it += C.ngw) {
        const int row = it >> 3, h = it & 7;
        const unsigned wf = F32[(size_t)row * 512 + h * 64 + lane], wb = B32[(size_t)row * 512 + h * 64 + lane], wz = P32[(size_t)row * 2048 + 1536 + h * 64 + lane];
        const float v0 = bf_lo(wf) + bf_lo(wb), v1 = bf_hi(wf) + bf_hi(wb);
        const float rinv = rsqrtf(wave_sum(v0 * v0 + v1 * v1, lane) * (1.f / 128.f) + EPS);
        Y32[(size_t)row * 512 + h * 64 + lane] = pk2(v0 * rinv * g.x * silu_f(bf_lo(wz)), v1 * rinv * g.y * silu_f(bf_hi(wz)));
    }
}
constexpr int REC_U = 0, REC_WN = 16384, REC_QT = 32768, REC_QK = 49152, REC_KT = 57344, REC_BYTES = 73728;
typedef short dn_bf16x8 __attribute__((ext_vector_type(8)));
typedef float dn_f32x16 __attribute__((ext_vector_type(16)));
__device__ __forceinline__ int dn_crow(int r, int hi) { return (r & 3) + 8 * (r >> 2) + 4 * hi; }
typedef __bf16 dn_bf16x2 __attribute__((ext_vector_type(2)));
__device__ __forceinline__ unsigned dn_cvt_pk(float lo, float hi) { const f32x2_t v = {lo, hi}; return __builtin_bit_cast(unsigned, __builtin_convertvector(v, dn_bf16x2)); }

struct DnLocalPtrs { const bf16raw* PROJ; const float *AB, *cw, *alog, *dtb; unsigned char* SOP; float* EGL; };

__device__ __forceinline__ void phase_dn_local(Ctx& C, const DnLocalPtrs& P) {
    constexpr int L_Q = 0, L_K = 17408, L_V = 34816, L_GC = 52224, L_BT = 52736, L_AM = 53248, L_QK = L_AM + 2 * 17408, L_TB = L_QK + 2 * 9216;
    LAS unsigned char* L = C.lds;
    const unsigned* P32 = (const unsigned*)P.PROJ;
    LAS float* gcs = (LAS float*)(L + L_GC); LAS float* bts = (LAS float*)(L + L_BT);
    for (int u = C.blk; u < 1280; u += C.nblk) {
        int tid = C.tid; asm volatile("" : "+v"(tid));
        const int lane = tid & 63, wid = __builtin_amdgcn_readfirstlane(tid >> 6), dir = wid >> 2, w4 = wid & 3, t256 = tid & 255, r32 = lane & 31, hi = lane >> 5;
        const int h = u & 7, cidx = u >> 3;
        int npr, N, T, base, cbase;
        if (cidx < 128) { const int seq = cidx >> 2; npr = cidx & 3; N = 4; T = 256; base = seq * 256; cbase = cidx - npr; }
        else { const int c2 = cidx - 128, sq = c2 >> 4; npr = c2 & 15; N = 16; T = 1024; base = NCTX + sq * 1024; cbase = cidx - npr; }
        if (wid < 2) {
            const int tau = wid ? 63 - lane : lane; const size_t row = (size_t)(base + 64 * npr + tau);
            const float a = P.AB[row * 32 + wid * 8 + h], b = P.AB[row * 32 + 16 + wid * 8 + h];
            const float x = a + P.dtb[wid * 8 + h]; const float sp = x > 20.f ? x : log1pf(expf(x));
            float g = -expf(P.alog[wid * 8 + h]) * sp;
#pragma unroll
            for (int o = 1; o < 64; o <<= 1) { const float t = __builtin_bit_cast(float, __builtin_amdgcn_ds_bpermute((lane - o) << 2, __builtin_bit_cast(int, g))); if (lane >= o) g += t; }
            gcs[wid * 64 + lane] = g; bts[wid * 64 + lane] = 1.f / (1.f + expf(-b));
        }
        {
            const int tau0 = 8 * wid;
#pragma unroll
            for (int X = 0; X < 3; ++X) {
                const int cb = X * 1024 + h * 128;
                float w0[12], w1[12];
#pragma unroll
                for (int i = 0; i < 12; ++i) { const int tt = 64 * npr + tau0 - 2 + i; unsigned w = 0u;
                    if (tt >= 0 && tt < T) w = P32[(size_t)(base + tt) * 2048 + (cb >> 1) + lane];
                    w0[i] = bf_lo(w); w1[i] = bf_hi(w); }
                f32x2_t cwv[5];
#pragma unroll
                for (int i = 0; i < 5; ++i) cwv[i] = *(const f32x2_t*)(P.cw + i * 3072 + cb + 2 * lane);
#pragma unroll
                for (int r = 0; r < 8; ++r) {
                    float a0 = 0.f, a1 = 0.f;
#pragma unroll
                    for (int i = 0; i < 5; ++i) { a0 += w0[r + i] * cwv[i].x; a1 += w1[r + i] * cwv[i].y; }
                    a0 = silu_f(a0); a1 = silu_f(a1);
                    if (X < 2) { const float rinv = rsqrtf(wave_sum_dpp(a0 * a0 + a1 * a1) + EPS); a0 *= rinv; a1 *= rinv; }
                    *(LAS unsigned*)(L + (X == 0 ? L_Q : X == 1 ? L_K : L_V) + (tau0 + r) * 272 + lane * 4) = pk2(a0, a1);
                }
            }
        }
        __syncthreads();
        {
            const int ti = w4 >> 1, tj = w4 & 1;
            dn_f32x16 accK = {}, accQ = {};
            if (ti >= tj) {
                const int pa = 32 * ti + r32, pb = 32 * tj + r32;
                const int rowA = dir ? 63 - pa : pa, rowB = dir ? 63 - pb : pb;
#pragma unroll
                for (int s = 0; s < 8; ++s) {
                    const int co = (16 * s + 8 * hi) * 2;
                    const dn_bf16x8 Ak = *(const LAS dn_bf16x8*)(L + L_K + rowA * 272 + co), Aq = *(const LAS dn_bf16x8*)(L + L_Q + rowA * 272 + co), Bk = *(const LAS dn_bf16x8*)(L + L_K + rowB * 272 + co);
                    accK = __builtin_amdgcn_mfma_f32_32x32x16_bf16(Ak, Bk, accK, 0, 0, 0);
                    accQ = __builtin_amdgcn_mfma_f32_32x32x16_bf16(Aq, Bk, accQ, 0, 0, 0);
                }
            }
            const int pj = 32 * tj + r32; const float gcj = gcs[dir * 64 + pj];
#pragma unroll
            for (int reg = 0; reg < 16; ++reg) {
                const int pi = 32 * ti + dn_crow(reg, hi);
                const float dec = pi >= pj ? __expf(gcs[dir * 64 + pi] - gcj) : 0.f;
                const float am = pi > pj ? bts[dir * 64 + pi] * accK[reg] * dec : 0.f;
                const float qk = ATT_SCALE * accQ[reg] * dec;
                *(LAS float*)(L + L_AM + dir * 17408 + pi * 272 + pj * 4) = am;
                *(LAS bf16raw*)(L + L_QK + dir * 9216 + pi * 144 + pj * 2) = (bf16raw)f2bf(qk);
            }
        }
        __syncthreads();
        const int rec_n = dir ? N - 1 - npr : npr;
        const int recid = ((cbase + rec_n) * 8 + h) * 2 + dir;
        unsigned char* rec = P.SOP + (size_t)recid * REC_BYTES;
        if (w4 == 0) {
            const LAS unsigned char* am = L + L_AM + dir * 17408;
            float x[64];
            f32x4_t nx[16];
            nx[0] = (f32x4_t){0.f, 0.f, 0.f, 0.f};
#pragma unroll
            for (int i = 0; i < 64; ++i) {
                f32x4_t cu[16];
#pragma unroll
                for (int j4 = 0; j4 < (i + 3) / 4; ++j4) cu[j4] = nx[j4];
                if (i + 1 < 64) {
#pragma unroll
                    for (int j4 = 0; j4 < (i + 4) / 4; ++j4) nx[j4] = *(const LAS f32x4_t*)(am + (i + 1) * 272 + j4 * 16);
                }
                asm volatile("" ::: "memory");
                float acc0 = (i == lane) ? 1.f : 0.f, acc1 = 0.f;
#pragma unroll
                for (int j4 = 0; j4 < (i + 3) / 4; ++j4) {
                    if (4 * j4 + 0 < i) acc0 -= cu[j4].x * x[4 * j4 + 0];
                    if (4 * j4 + 1 < i) acc1 -= cu[j4].y * x[4 * j4 + 1];
                    if (4 * j4 + 2 < i) acc0 -= cu[j4].z * x[4 * j4 + 2];
                    if (4 * j4 + 3 < i) acc1 -= cu[j4].w * x[4 * j4 + 3];
                }
                x[i] = acc0 + acc1;
            }
            LAS unsigned char* tb = L + L_TB + dir * 9216 + lane * 2;
#pragma unroll
            for (int i = 0; i < 64; ++i) *(LAS bf16raw*)(tb + i * 144) = (bf16raw)f2bf(x[i]);
        } else {
            const int t192 = (w4 - 1) * 64 + lane;
            const float glast = gcs[dir * 64 + 63];
            for (int id = t192; id < 1024; id += 192) {
                const int mt = id >> 9, kt = (id >> 6) & 7, r = id & 31, hh = (id >> 5) & 1;
                const int p = 32 * mt + r, dk0 = 32 * (kt >> 1) + 16 * (kt & 1) + 4 * hh;
                const int tau = dir ? 63 - p : p; const float sc = ATT_SCALE * __expf(gcs[dir * 64 + p]);
                const u32x2_t ql = *(const LAS u32x2_t*)(L + L_Q + tau * 272 + dk0 * 2), qh = *(const LAS u32x2_t*)(L + L_Q + tau * 272 + (dk0 + 8) * 2);
                u32x4_t qo; qo.x = dn_cvt_pk(bf_lo(ql.x) * sc, bf_hi(ql.x) * sc); qo.y = dn_cvt_pk(bf_lo(ql.y) * sc, bf_hi(ql.y) * sc);
                qo.z = dn_cvt_pk(bf_lo(qh.x) * sc, bf_hi(qh.x) * sc); qo.w = dn_cvt_pk(bf_lo(qh.y) * sc, bf_hi(qh.y) * sc);
                *(u32x4_t*)(rec + REC_QT + (size_t)id * 16) = qo;
            }
            for (int id = t192; id < 1024; id += 192) {
                const int mt = id >> 8, kt = (id >> 6) & 3, r = id & 31, hh = (id >> 5) & 1;
                const int c0 = 32 * (kt >> 1) + 16 * (kt & 1) + 4 * hh;
                float kv[8];
#pragma unroll
                for (int jj = 0; jj < 8; ++jj) { const int c = c0 + 8 * (jj >> 2) + (jj & 3); const int tau = dir ? 63 - c : c;
                    kv[jj] = bf2f(*(const LAS bf16raw*)(L + L_K + tau * 272 + (32 * mt + r) * 2)) * __expf(glast - gcs[dir * 64 + c]); }
                u32x4_t ko; ko.x = dn_cvt_pk(kv[0], kv[1]); ko.y = dn_cvt_pk(kv[2], kv[3]); ko.z = dn_cvt_pk(kv[4], kv[5]); ko.w = dn_cvt_pk(kv[6], kv[7]);
                *(u32x4_t*)(rec + REC_KT + (size_t)id * 16) = ko;
            }
            for (int id = t192; id < 512; id += 192) {
                const int mt = id >> 8, kt = (id >> 6) & 3, r = id & 31, hh = (id >> 5) & 1;
                const int c0 = 32 * (kt >> 1) + 16 * (kt & 1) + 4 * hh;
                const LAS unsigned char* qp = L + L_QK + dir * 9216 + (32 * mt + r) * 144;
                const u32x2_t qa = *(const LAS u32x2_t*)(qp + c0 * 2), qb = *(const LAS u32x2_t*)(qp + (c0 + 8) * 2);
                *(u32x4_t*)(rec + REC_QK + (size_t)id * 16) = (u32x4_t){qa.x, qa.y, qb.x, qb.y};
            }
            if (t192 == 0) P.EGL[recid] = __expf(glast);
        }
        __syncthreads();
        {
            const bool isK = w4 >= 2;
            const LAS unsigned char* srcb = L + (isK ? L_K : L_V);
            dn_f32x16 acc[2][2] = {};
#pragma unroll
            for (int ks = 0; ks < 4; ++ks) {
                dn_bf16x8 At[2];
#pragma unroll
                for (int mt = 0; mt < 2; ++mt) At[mt] = *(const LAS dn_bf16x8*)(L + L_TB + dir * 9216 + (32 * mt + r32) * 144 + (16 * ks + 8 * hi) * 2);
                float bt[8], eg8[8];
#pragma unroll
                for (int jj = 0; jj < 8; ++jj) { const int jrow = 16 * ks + 8 * hi + jj; bt[jj] = bts[dir * 64 + jrow]; eg8[jj] = isK ? __expf(gcs[dir * 64 + jrow]) : 1.f; }
#pragma unroll
                for (int nl = 0; nl < 2; ++nl) {
                    const int col = (32 * (2 * w4 + nl) + r32) & 127;
                    float rv[8];
#pragma unroll
                    for (int jj = 0; jj < 8; ++jj) { const int jrow = 16 * ks + 8 * hi + jj; const int tau = dir ? 63 - jrow : jrow;
                        rv[jj] = bf2f(*(const LAS bf16raw*)(srcb + tau * 272 + col * 2)) * bt[jj] * eg8[jj]; }
                    u32x4_t bw; bw.x = dn_cvt_pk(rv[0], rv[1]); bw.y = dn_cvt_pk(rv[2], rv[3]); bw.z = dn_cvt_pk(rv[4], rv[5]); bw.w = dn_cvt_pk(rv[6], rv[7]);
                    const dn_bf16x8 Bf = __builtin_bit_cast(dn_bf16x8, bw);
#pragma unroll
                    for (int mt = 0; mt < 2; ++mt) acc[mt][nl] = __builtin_amdgcn_mfma_f32_32x32x16_bf16(At[mt], Bf, acc[mt][nl], 0, 0, 0);
                }
            }
            if (!isK) {
#pragma unroll
                for (int mt = 0; mt < 2; ++mt)
#pragma unroll
                    for (int nl = 0; nl < 2; ++nl) { const dn_f32x16 a = acc[mt][nl];
                        u32x4_t o0, o1; o0.x = dn_cvt_pk(a[0], a[1]); o0.y = dn_cvt_pk(a[2], a[3]); o0.z = dn_cvt_pk(a[4], a[5]); o0.w = dn_cvt_pk(a[6], a[7]);
                        o1.x = dn_cvt_pk(a[8], a[9]); o1.y = dn_cvt_pk(a[10], a[11]); o1.z = dn_cvt_pk(a[12], a[13]); o1.w = dn_cvt_pk(a[14], a[15]);
                        unsigned char* up = rec + REC_U + (size_t)(((mt * 4 + 2 * w4 + nl) * 64 + lane) * 32);
                        *(u32x4_t*)up = o0; *(u32x4_t*)(up + 16) = o1; }
            } else {
#pragma unroll
                for (int mt = 0; mt < 2; ++mt)
#pragma unroll
                    for (int nl = 0; nl < 2; ++nl) { const int dk = 32 * (2 * (w4 - 2) + nl) + r32;
#pragma unroll
                        for (int reg = 0; reg < 16; ++reg) *(LAS bf16raw*)(L + L_AM + dir * 17408 + (32 * mt + dn_crow(reg, hi)) * 264 + dk * 2) = (bf16raw)f2bf(-acc[mt][nl][reg]); }
            }
        }
        __syncthreads();
        {
            const LAS unsigned char* wt = L + L_AM + dir * 17408;
#pragma unroll
            for (int i = 0; i < 4; ++i) {
                const int id = t256 + 256 * i, mt = id >> 9, kt = (id >> 6) & 7, r = id & 31, hh = (id >> 5) & 1;
                const int p = 32 * mt + r, dk0 = 32 * (kt >> 1) + 16 * (kt & 1) + 4 * hh;
                const u32x2_t wl = *(const LAS u32x2_t*)(wt + p * 264 + dk0 * 2), wh = *(const LAS u32x2_t*)(wt + p * 264 + (dk0 + 8) * 2);
                *(u32x4_t*)(rec + REC_WN + (size_t)id * 16) = (u32x4_t){wl.x, wl.y, wh.x, wh.y};
            }
        }
        __syncthreads();
    }
}

struct DnScanPtrs { const unsigned char* SOP; const float *EGL, *state_delta; bf16raw *OF, *OB; float* out; };

__device__ __forceinline__ dn_bf16x8 dn_acc_frag(const dn_f32x16& a, int s) {
    u32x4_t w;
    if (s == 0) { w.x = dn_cvt_pk(a[0], a[1]); w.y = dn_cvt_pk(a[2], a[3]); w.z = dn_cvt_pk(a[4], a[5]); w.w = dn_cvt_pk(a[6], a[7]); }
    else { w.x = dn_cvt_pk(a[8], a[9]); w.y = dn_cvt_pk(a[10], a[11]); w.z = dn_cvt_pk(a[12], a[13]); w.w = dn_cvt_pk(a[14], a[15]); }
    return __builtin_bit_cast(dn_bf16x8, w);
}

__device__ __forceinline__ void phase_dn_scan(Ctx& C, const DnScanPtrs& P, int j) {
    const int slot = C.wid * C.nblk + C.blk, nslot = C.ngw;
    for (int r = 0; r * nslot < 2176; ++r) {
        const int u = r * nslot + (slot + r * (nslot - 128)) % nslot;
        if (u >= 2176) continue;
        int lane = C.lane; asm volatile("" : "+v"(lane));
        const int r32 = lane & 31, hi = lane >> 5;
        int seq, h, dir, sl, N, T, base, cbase; bool lat = u < 128;
        if (lat) { seq = 32 + (u >> 6); h = (u >> 3) & 7; dir = (u >> 2) & 1; sl = u & 3; N = 16; T = 1024; base = NCTX + (seq - 32) * 1024; cbase = 128 + 16 * (seq - 32); }
        else { const int c = u - 128; seq = c >> 6; h = (c >> 3) & 7; dir = (c >> 2) & 1; sl = c & 3; N = 4; T = 256; base = seq * 256; cbase = 4 * seq; }
        dn_f32x16 S[4];
        if (lat) { const float* sp = P.state_delta + ((((size_t)(seq - 32) * 2 + j) * 2 + dir) * 8 + h) * 16384 + 32 * sl + r32;
#pragma unroll
            for (int t4 = 0; t4 < 4; ++t4)
#pragma unroll
                for (int reg = 0; reg < 16; ++reg) S[t4][reg] = sp[(size_t)(32 * t4 + dn_crow(reg, hi)) * 128]; }
        else {
#pragma unroll
            for (int t4 = 0; t4 < 4; ++t4) S[t4] = (dn_f32x16){}; }
        bf16raw* Od = (dir ? P.OB : P.OF) + (size_t)base * 1024 + h * 128 + 32 * sl + r32;
        for (int n = 0; n < N; ++n) {
            const int recid = ((cbase + n) * 8 + h) * 2 + dir;
            const unsigned char* rec = P.SOP + (size_t)recid * REC_BYTES + lane * 16;
            const float eg = P.EGL[recid];
            dn_bf16x8 Sb[8];
#pragma unroll
            for (int kt = 0; kt < 8; ++kt) Sb[kt] = dn_acc_frag(S[kt >> 1], kt & 1);
#define DN_FENCE() asm volatile("" ::: "memory")
#define DN_LD8(F, off) do { _Pragma("unroll") for (int q_ = 0; q_ < 8; ++q_) F[q_] = *(const dn_bf16x8*)(rec + (off) + q_ * 1024); } while (0)
            dn_bf16x8 F[8];
            dn_f32x16 av[2];
#pragma unroll
            for (int mt = 0; mt < 2; ++mt) {
                const unsigned char* up = P.SOP + (size_t)recid * REC_BYTES + REC_U + (size_t)(((mt * 4 + sl) * 64 + lane) * 32);
                const u32x4_t u0 = *(const u32x4_t*)up, u1 = *(const u32x4_t*)(up + 16);
                DN_LD8(F, REC_WN + mt * 8192);
                DN_FENCE();
                dn_f32x16 a;
                a[0] = bf_lo(u0.x); a[1] = bf_hi(u0.x); a[2] = bf_lo(u0.y); a[3] = bf_hi(u0.y); a[4] = bf_lo(u0.z); a[5] = bf_hi(u0.z); a[6] = bf_lo(u0.w); a[7] = bf_hi(u0.w);
                a[8] = bf_lo(u1.x); a[9] = bf_hi(u1.x); a[10] = bf_lo(u1.y); a[11] = bf_hi(u1.y); a[12] = bf_lo(u1.z); a[13] = bf_hi(u1.z); a[14] = bf_lo(u1.w); a[15] = bf_hi(u1.w);
#pragma unroll
                for (int kt = 0; kt < 8; ++kt) a = __builtin_amdgcn_mfma_f32_32x32x16_bf16(F[kt], Sb[kt], a, 0, 0, 0);
                av[mt] = a;
                DN_FENCE();
            }
            dn_bf16x8 vb[4];
#pragma unroll
            for (int kt = 0; kt < 4; ++kt) vb[kt] = dn_acc_frag(av[kt >> 1], kt & 1);
            dn_f32x16 ao[2];
#pragma unroll
            for (int mt = 0; mt < 2; ++mt) {
                DN_LD8(F, REC_QT + mt * 8192);
                DN_FENCE();
                dn_f32x16 a = {};
#pragma unroll
                for (int kt = 0; kt < 8; ++kt) a = __builtin_amdgcn_mfma_f32_32x32x16_bf16(F[kt], Sb[kt], a, 0, 0, 0);
                ao[mt] = a;
                DN_FENCE();
            }
            DN_LD8(F, REC_QK);
            DN_FENCE();
#pragma unroll
            for (int mt = 0; mt < 2; ++mt) {
                dn_f32x16 a = ao[mt];
#pragma unroll
                for (int kt = 0; kt < 4; ++kt) a = __builtin_amdgcn_mfma_f32_32x32x16_bf16(F[mt * 4 + kt], vb[kt], a, 0, 0, 0);
#pragma unroll
                for (int reg = 0; reg < 16; ++reg) { const int p = 64 * n + 32 * mt + dn_crow(reg, hi); const int t = dir ? T - 1 - p : p;
                    Od[(size_t)t * 1024] = (bf16raw)f2bf(a[reg]); }
            }
            DN_FENCE();
#pragma unroll
            for (int t2 = 0; t2 < 2; ++t2) {
                DN_LD8(F, REC_KT + t2 * 8192);
                DN_FENCE();
#pragma unroll
                for (int tt = 0; tt < 2; ++tt) {
                    dn_f32x16 a = S[2 * t2 + tt] * eg;
#pragma unroll
                    for (int kt = 0; kt < 4; ++kt) a = __builtin_amdgcn_mfma_f32_32x32x16_bf16(F[tt * 4 + kt], vb[kt], a, 0, 0, 0);
                    S[2 * t2 + tt] = a;
                }
                DN_FENCE();
            }
#undef DN_FENCE
#undef DN_LD8
        }
        if (!lat) { float* sp = P.out + O_ST + ((((size_t)seq * 2 + j) * 2 + dir) * 8 + h) * 16384 + 32 * sl + r32;
#pragma unroll
            for (int t4 = 0; t4 < 4; ++t4)
#pragma unroll
                for (int reg = 0; reg < 16; ++reg) sp[(size_t)(32 * t4 + dn_crow(reg, hi)) * 128] = S[t4][reg]; }
    }
}

__device__ __forceinline__ void phase_dn_scan2(Ctx& C, const DnScanPtrs& P, int j) {
    LAS unsigned char* L = C.lds;
    const int wid = C.wid; const bool consumer = wid < 4; const int sl = wid & 3;
    const int nun = C.nblk == 256 ? (C.blk < 32 ? 1 : 3) : (544 + C.nblk - 1) / C.nblk;
    for (int ui = 0; ui < nun; ++ui) {
        int sid;
        if (C.nblk == 256) { if (C.blk < 32) sid = C.blk; else { const int c = (C.blk - 32) + 224 * ui; if (c >= 512) break; sid = 32 + c; } }
        else { sid = C.blk + ui * C.nblk; if (sid >= 544) break; }
        int lane = C.lane; asm volatile("" : "+v"(lane));
        const int r32 = lane & 31, hi = lane >> 5;
        int seq, h, dir, N, T, base, cbase; const bool lat = sid < 32;
        if (lat) { seq = 32 + (sid >> 4); h = (sid >> 1) & 7; dir = sid & 1; N = 16; T = 1024; base = NCTX + (seq - 32) * 1024; cbase = 128 + 16 * (seq - 32); }
        else { const int c = sid - 32; seq = c >> 4; h = (c >> 1) & 7; dir = c & 1; N = 4; T = 256; base = seq * 256; cbase = 4 * seq; }
        const int rec0 = (cbase * 8 + h) * 2 + dir;
        const unsigned char* rbase = P.SOP + (size_t)rec0 * REC_BYTES;
        constexpr size_t RSTRIDE = (size_t)16 * REC_BYTES;
#define DN2_BAR() __builtin_amdgcn_s_barrier()
        if (consumer) {
            dn_f32x16 S[4];
            if (lat) { const float* sp = P.state_delta + ((((size_t)(seq - 32) * 2 + j) * 2 + dir) * 8 + h) * 16384 + 32 * sl + r32;
#pragma unroll
                for (int t4 = 0; t4 < 4; ++t4)
#pragma unroll
                    for (int reg = 0; reg < 16; ++reg) S[t4][reg] = sp[(size_t)(32 * t4 + dn_crow(reg, hi)) * 128]; }
            else {
#pragma unroll
                for (int t4 = 0; t4 < 4; ++t4) S[t4] = (dn_f32x16){}; }
            bf16raw* Od = (dir ? P.OB : P.OF) + (size_t)base * 1024 + h * 128 + 32 * sl + r32;
            u32x4_t ua[2][2];
#pragma unroll
            for (int mt = 0; mt < 2; ++mt) { const unsigned char* up = rbase + REC_U + (size_t)(((mt * 4 + sl) * 64 + lane) * 32); ua[mt][0] = *(const u32x4_t*)up; ua[mt][1] = *(const u32x4_t*)(up + 16); }
            int g = 0;
#define DN2_CSYNC() do { asm volatile("s_waitcnt lgkmcnt(0)" ::: "memory"); DN2_BAR(); asm volatile("" ::: "memory"); } while (0)
#define DN2_RD8(F) do { const LAS unsigned char* sp_ = L + (g & 15) * 8192 + lane * 16; _Pragma("unroll") for (int q_ = 0; q_ < 8; ++q_) F[q_] = *(const LAS dn_bf16x8*)(sp_ + q_ * 1024); ++g; } while (0)
            for (int n = 0; n < N; ++n) {
                const float eg = P.EGL[rec0 + 16 * n];
                dn_bf16x8 Sb[8];
#pragma unroll
                for (int kt = 0; kt < 8; ++kt) Sb[kt] = dn_acc_frag(S[kt >> 1], kt & 1);
                dn_bf16x8 F[8];
                dn_f32x16 av[2];
#pragma unroll
                for (int mt = 0; mt < 2; ++mt) {
                    DN2_CSYNC(); DN2_RD8(F);
                    const u32x4_t u0 = ua[mt][0], u1 = ua[mt][1];
                    dn_f32x16 a;
                    a[0] = bf_lo(u0.x); a[1] = bf_hi(u0.x); a[2] = bf_lo(u0.y); a[3] = bf_hi(u0.y); a[4] = bf_lo(u0.z); a[5] = bf_hi(u0.z); a[6] = bf_lo(u0.w); a[7] = bf_hi(u0.w);
                    a[8] = bf_lo(u1.x); a[9] = bf_hi(u1.x); a[10] = bf_lo(u1.y); a[11] = bf_hi(u1.y); a[12] = bf_lo(u1.z); a[13] = bf_hi(u1.z); a[14] = bf_lo(u1.w); a[15] = bf_hi(u1.w);
#pragma unroll
                    for (int kt = 0; kt < 8; ++kt) a = __builtin_amdgcn_mfma_f32_32x32x16_bf16(F[kt], Sb[kt], a, 0, 0, 0);
                    av[mt] = a;
                }
                if (n + 1 < N) {
#pragma unroll
                    for (int mt = 0; mt < 2; ++mt) { const unsigned char* up = rbase + (size_t)(n + 1) * RSTRIDE + REC_U + (size_t)(((mt * 4 + sl) * 64 + lane) * 32); ua[mt][0] = *(const u32x4_t*)up; ua[mt][1] = *(const u32x4_t*)(up + 16); }
                }
                dn_bf16x8 vb[4];
#pragma unroll
                for (int kt = 0; kt < 4; ++kt) vb[kt] = dn_acc_frag(av[kt >> 1], kt & 1);
                dn_f32x16 ao[2];
#pragma unroll
                for (int mt = 0; mt < 2; ++mt) {
                    DN2_CSYNC(); DN2_RD8(F);
                    dn_f32x16 a = {};
#pragma unroll
                    for (int kt = 0; kt < 8; ++kt) a = __builtin_amdgcn_mfma_f32_32x32x16_bf16(F[kt], Sb[kt], a, 0, 0, 0);
                    ao[mt] = a;
                }
                DN2_CSYNC(); DN2_RD8(F);
#pragma unroll
                for (int mt = 0; mt < 2; ++mt) {
                    dn_f32x16 a = ao[mt];
#pragma unroll
                    for (int kt = 0; kt < 4; ++kt) a = __builtin_amdgcn_mfma_f32_32x32x16_bf16(F[mt * 4 + kt], vb[kt], a, 0, 0, 0);
#pragma unroll
                    for (int reg = 0; reg < 16; ++reg) { const int p = 64 * n + 32 * mt + dn_crow(reg, hi); const int t = dir ? T - 1 - p : p;
                        Od[(size_t)t * 1024] = (bf16raw)f2bf(a[reg]); }
                }
#pragma unroll
                for (int t2 = 0; t2 < 2; ++t2) {
                    DN2_CSYNC(); DN2_RD8(F);
#pragma unroll
                    for (int tt = 0; tt < 2; ++tt) {
                        dn_f32x16 a = S[2 * t2 + tt] * eg;
#pragma unroll
                        for (int kt = 0; kt < 4; ++kt) a = __builtin_amdgcn_mfma_f32_32x32x16_bf16(F[tt * 4 + kt], vb[kt], a, 0, 0, 0);
                        S[2 * t2 + tt] = a;
                    }
                }
            }
            DN2_CSYNC();
            if (!lat) { float* sp = P.out + O_ST + ((((size_t)seq * 2 + j) * 2 + dir) * 8 + h) * 16384 + 32 * sl + r32;
#pragma unroll
                for (int t4 = 0; t4 < 4; ++t4)
#pragma unroll
                    for (int reg = 0; reg < 16; ++reg) sp[(size_t)(32 * t4 + dn_crow(reg, hi)) * 128] = S[t4][reg]; }
#undef DN2_CSYNC
#undef DN2_RD8
        } else {
            const int ld = wid - 4;
            int ln = 0, ls = 0;
            const unsigned char* gsrc = rbase + REC_WN + (size_t)(2 * ld) * 1024 + lane * 16;
#define DN2_ISSUE(slot) do { const unsigned char* s_ = gsrc + (size_t)ln * RSTRIDE + ls * 8192; LAS unsigned char* d_ = L + (slot) * 8192 + (2 * ld) * 1024; \
        __builtin_amdgcn_global_load_lds((const unsigned*)s_, (LAS unsigned*)d_, 16, 0, 0); __builtin_amdgcn_global_load_lds((const unsigned*)(s_ + 1024), (LAS unsigned*)(d_ + 1024), 16, 0, 0); \
        if (++ls == 7) { ls = 0; if (ln < N - 1) ++ln; } } while (0)
            for (int q = 0; q < 15; ++q) DN2_ISSUE(q);
            const int G = 7 * N;
            for (int g = 0; g < G; ++g) {
                asm volatile("s_waitcnt vmcnt(28)" ::: "memory");
                DN2_BAR();
                DN2_ISSUE((g + 15) & 15);
            }
            asm volatile("s_waitcnt vmcnt(0)" ::: "memory");
            DN2_BAR();
#undef DN2_ISSUE
        }
#undef DN2_BAR
    }
}
#define XB_TMO      128
#define XB_XCNT(j)  (256  + 64 * (j))
#define XB_XSUB(j)  (1280 + 64 * (j))
#define XB_XGEN(j)  (2304 + 64 * (j))
#define XB_TOP      3328
#define XB_TOPGEN   3392
#define XCD_BAR_WORDS 3456
#define XB_SPIN_CAP (1u << 18)

__device__ __forceinline__ unsigned xb_ld(unsigned* p)              { return __hip_atomic_load(p, __ATOMIC_RELAXED, __HIP_MEMORY_SCOPE_AGENT); }
__device__ __forceinline__ unsigned xb_add(unsigned* p, unsigned v) { return __hip_atomic_fetch_add(p, v, __ATOMIC_RELAXED, __HIP_MEMORY_SCOPE_AGENT); }
__device__ __forceinline__ unsigned xb_xcc_id() { return (unsigned)__builtin_amdgcn_s_getreg((3 << 11) | 20) & 0xFu; }
#define XB_SPIN(cond, bar) do { unsigned _sp = 0; while (cond) { __builtin_amdgcn_s_sleep(1); \
    if ((++_sp & 255u) == 0u) { if (xb_ld(&(bar)[XB_TMO])) break; if (_sp > XB_SPIN_CAP) { atomicAdd(&(bar)[XB_TMO], 1u); break; } } } } while (0)

struct XcdBarrier {
    unsigned* bar; unsigned x;
    volatile LAS unsigned* st;
};

__device__ __forceinline__ XcdBarrier xcd_barrier_post(unsigned* bar, volatile LAS unsigned* st) {
    XcdBarrier b; b.bar = bar; b.x = xb_xcc_id(); b.st = st;
    if (threadIdx.x == 0) (void)xb_add(&bar[XB_XCNT(b.x)], 1u);
    return b;
}
__device__ __forceinline__ void xcd_barrier_complete(unsigned* bar, unsigned x, unsigned& nloc, unsigned& nx) {
    const unsigned G = gridDim.x * gridDim.y * gridDim.z;
    unsigned sum, cnt, mine, sp = 0u;
    for (;;) {
        sum = 0u; cnt = 0u; mine = 0u;
#pragma unroll
        for (unsigned j = 0; j < 16; ++j) { const unsigned c = xb_ld(&bar[XB_XCNT(j)]); sum += c; cnt += (c > 0u) ? 1u : 0u; mine = (j == x) ? c : mine; }
        if (sum == G) break;
        __builtin_amdgcn_s_sleep(1);
        if ((++sp & 255u) == 0u) { if (xb_ld(&bar[XB_TMO])) break; if (sp > XB_SPIN_CAP) { atomicAdd(&bar[XB_TMO], 1u); break; } }
    }
    nloc = mine > 0u ? mine : 1u; nx = cnt > 0u ? cnt : 1u;
}

__device__ __forceinline__ void xcd_barrier(const XcdBarrier& b) {
    asm volatile("s_waitcnt vmcnt(0)" ::: "memory");
    __syncthreads();
    if (threadIdx.x == 0) {
        unsigned* bar = b.bar;
        __builtin_amdgcn_s_waitcnt(0);
        unsigned nloc = b.st[0], nx = b.st[1];
        if (nloc == 0u) { xcd_barrier_complete(bar, b.x, nloc, nx); b.st[0] = nloc; b.st[1] = nx; }
        const unsigned old = xb_add(&bar[XB_XSUB(b.x)], 1u);
        const unsigned gen = old / nloc;
        if (old + 1u == (gen + 1u) * nloc) {
            __builtin_amdgcn_fence(__ATOMIC_RELEASE, "agent");
            asm volatile("s_waitcnt vmcnt(0)" ::: "memory");
            const unsigned og = xb_add(&bar[XB_TOP], 1u);
            const unsigned tg = og / nx;
            if (og + 1u == (tg + 1u) * nx) xb_add(&bar[XB_TOPGEN], 1u);
            else XB_SPIN(xb_ld(&bar[XB_TOPGEN]) == tg, bar);
            __builtin_amdgcn_fence(__ATOMIC_ACQUIRE, "agent");
            xb_add(&bar[XB_XGEN(b.x)], 1u);
            asm volatile("s_waitcnt vmcnt(0)" ::: "memory");
        } else {
            XB_SPIN(xb_ld(&bar[XB_XGEN(b.x)]) == gen, bar);
            __builtin_amdgcn_fence(__ATOMIC_ACQUIRE, "agent");
            asm volatile("s_waitcnt vmcnt(0)" ::: "memory");
        }
    }
    __syncthreads();
}

constexpr int LDSCTL_OFF = 131072, MISC_OFF = LDSCTL_OFF + 320, CW_BAR = 4096;
struct Args { const float* in[24]; float* out; unsigned char* ws; int ph_lo, ph_hi; };
enum { I_XP = 0, I_XS, I_CK, I_CV, I_SD, I_C, I_CCTX, I_WMOD, I_BMOD, I_N1, I_N2, I_AWIN, I_AQG, I_AKG, I_AWOUT, I_DWIN, I_DCONV, I_DALOG, I_DDTB, I_DNORM, I_DWOUT, I_W1, I_W2, I_FN };

__global__ void __launch_bounds__(NWAVES * 64, 2) mk_fwd(Args args) {
    extern __shared__ __attribute__((aligned(16))) unsigned char lds_raw[];
    cg::grid_group grid = cg::this_grid();
    for (int u = threadIdx.x; u < (LDS_BYTES - LDSCTL_OFF) / 4; u += NWAVES * 64) ((LAS unsigned*)((LAS unsigned char*)lds_raw + LDSCTL_OFF))[u] = 0u;
    __syncthreads();
    const XcdBarrier bar = xcd_barrier_post((unsigned*)(args.ws + WS_CTL) + CW_BAR, (volatile LAS unsigned*)((LAS unsigned char*)lds_raw + MISC_OFF) + 8);

    const int lo = args.ph_lo, hi = args.ph_hi;
    int ph = 0;
#define PHASE_BEGIN() if (ph >= lo && ph < hi) { int z = 0; asm volatile("" : "+s"(z)); unsigned char* const ws = args.ws + z; (void)ws; \
    Ctx C; C.lds = (LAS unsigned char*)lds_raw + z; C.tid = threadIdx.x + z; C.lane = C.tid & 63; C.wid = __builtin_amdgcn_readfirstlane(C.tid >> 6); \
    C.nblk = gridDim.x + z; C.blk = blockIdx.x + z; C.gw = C.blk * NWAVES + C.wid; C.ngw = C.nblk * NWAVES;
#ifndef REP_KIND
#define REP_KIND -1
#endif
#define PHASE_END() if (ph + 1 < hi) { if (ph == 0) grid.sync(); else xcd_barrier(bar); } } ++ph;
#define INP(i) (args.in[(i) + z])
#define WSF(off) ((float*)(ws + (off)))
#define WSB(off) ((bf16raw*)(ws + (off)))

    PHASE_BEGIN() {
        ProPtrs P{INP(I_C), INP(I_CCTX), INP(I_WMOD), INP(I_BMOD), INP(I_AWIN), INP(I_AWOUT), INP(I_DWIN), INP(I_DWOUT), INP(I_W1), INP(I_W2), WSF(WS_MODS), WSF(WS_ROPE),
                  WSB(WS_WT_AIN), WSB(WS_WT_AOUT), WSB(WS_WT_DIN), WSB(WS_WT_DOUT), WSB(WS_WT_W1), WSB(WS_WT_W2)};
        phase_prologue(C, P); } PHASE_END()
    for (int l = 0; l < 4; ++l) {
        const int j = l >> 1;
        PHASE_BEGIN() { const float* mods_l = WSF(WS_MODS) + (size_t)l * 3 * 6144;
            const float* xs_ctx = l == 0 ? INP(I_XP) : WSF(WS_X); const float* xs_lat = l == 0 ? INP(I_XS) : WSF(WS_X) + (size_t)NCTX * D;
            phase_norm(C, xs_ctx, xs_lat, INP(I_N1) + l * D, mods_l, WSB(WS_H)); } PHASE_END()
        if ((l & 1) == 0) {
            PHASE_BEGIN() { pg8::Gemm g{WSB(WS_H), WSB(WS_WT_AIN) + (size_t)j * QKVW * D, MTOK, QKVW, D, z}; pg8::StaticOrder S; S.init(MTOK, QKVW, C.nblk, C.blk);
                pg8::EpiBf16<0> E{WSB(WS_PROJ), QKVW, nullptr, 0, 0, 1.f};
                pg8::gemm_phase<pg8::EpiBf16<0>, pg8::StaticOrder, true, true>(C.lds, g, S, E); } PHASE_END()
            PHASE_BEGIN() { QknPtrs P{WSB(WS_PROJ), WSB(WS_QB), WSB(WS_KB), WSB(WS_VB), INP(I_AQG) + j * 128, INP(I_AKG) + j * 128, WSF(WS_ROPE), INP(I_CK), INP(I_CV), args.out + z};
                phase_qkn(C, P, j); if (REP_KIND == 3) { xcd_barrier(bar); phase_qkn(C, P, j); } } PHASE_END()
            PHASE_BEGIN() { AttnPtrs P{WSB(WS_QB), WSB(WS_KB), WSB(WS_VB), WSB(WS_Y)}; phase_attn(C, P); if (REP_KIND == 4) { xcd_barrier(bar); phase_attn(C, P); } } PHASE_END()
        } else {
            PHASE_BEGIN() { pg8::Gemm g{WSB(WS_H), WSB(WS_WT_DIN) + (size_t)j * DNINP * D, MTOK, DNINP, D, z}; pg8::StaticOrder S; S.init(MTOK, DNINP, C.nblk, C.blk);
                pg8::EpiDnIn E{WSB(WS_PROJ), WSF(WS_AB)};
                pg8::gemm_phase<pg8::EpiDnIn, pg8::StaticOrder, true, true>(C.lds, g, S, E); } PHASE_END()
            PHASE_BEGIN() { DnLocalPtrs P{WSB(WS_PROJ), WSF(WS_AB), INP(I_DCONV) + (size_t)j * 5 * 3072, INP(I_DALOG) + j * 16, INP(I_DDTB) + j * 16, ws + WS_SOP, WSF(WS_EGL)};
                phase_dn_local(C, P); if (REP_KIND == 6) { xcd_barrier(bar); phase_dn_local(C, P); } } PHASE_END()
            PHASE_BEGIN() { DnScanPtrs P{ws + WS_SOP, WSF(WS_EGL), INP(I_SD), WSB(WS_OF), WSB(WS_OB), args.out + z}; phase_dn_scan2(C, P, j); } PHASE_END()
            PHASE_BEGIN() { GatePtrs P{WSB(WS_OF), WSB(WS_OB), WSB(WS_PROJ), WSB(WS_Y), INP(I_DNORM) + j * 128}; phase_gate(C, P); if (REP_KIND == 8) { xcd_barrier(bar); phase_gate(C, P); } } PHASE_END()
        }
        PHASE_BEGIN() { const float* mods_l = WSF(WS_MODS) + (size_t)l * 3 * 6144;
            const float* xs_ctx = l == 0 ? INP(I_XP) : WSF(WS_X); const float* xs_lat = l == 0 ? INP(I_XS) : WSF(WS_X) + (size_t)NCTX * D;
            pg8::Gemm g{WSB(WS_Y), ((l & 1) ? WSB(WS_WT_DOUT) : WSB(WS_WT_AOUT)) + (size_t)j * D * D, MTOK, D, D, z}; pg8::StaticOrder S; S.init(64 * 256, D, C.nblk, C.blk);
            pg8::EpiRes160 E{xs_ctx, xs_lat, WSF(WS_X), mods_l + 2048};
            pg8::gemm_phase<pg8::EpiRes160, pg8::StaticOrder, true, true, true>(C.lds, g, S, E, NCTX); } PHASE_END()
        PHASE_BEGIN() { const float* mods_l = WSF(WS_MODS) + (size_t)l * 3 * 6144;
            phase_norm(C, WSF(WS_X), WSF(WS_X) + (size_t)NCTX * D, INP(I_N2) + l * D, mods_l + 3072, WSB(WS_H)); } PHASE_END()
        PHASE_BEGIN() { pg8::Gemm g{WSB(WS_H), WSB(WS_WT_W1) + (size_t)l * FF * D, MTOK, FF, D, z}; pg8::StaticOrder S; S.init(MTOK, FF, C.nblk, C.blk);
            pg8::EpiBf16<2> E{WSB(WS_PROJ), FF, nullptr, 0, 0, 1.f};
            pg8::gemm_phase<pg8::EpiBf16<2>, pg8::StaticOrder, true, true>(C.lds, g, S, E); } PHASE_END()
        PHASE_BEGIN() { const float* mods_l = WSF(WS_MODS) + (size_t)l * 3 * 6144;
            pg8::Gemm g{WSB(WS_PROJ), WSB(WS_WT_W2) + (size_t)l * D * FF, MTOK, D, FF, z}; pg8::StaticOrder S; S.init(64 * 256, D, C.nblk, C.blk);
            pg8::EpiRes160 E{WSF(WS_X), WSF(WS_X) + (size_t)NCTX * D, WSF(WS_X), mods_l + 5120};
            pg8::gemm_phase<pg8::EpiRes160, pg8::StaticOrder, true, true, true>(C.lds, g, S, E, NCTX); } PHASE_END()
    }
    PHASE_BEGIN() { phase_final(C, WSF(WS_X), INP(I_FN), args.out + z); } PHASE_END()
#undef PHASE_BEGIN
#undef PHASE_END
}

extern "C" void kernel_launch(void* const* d_in, const int* in_sizes, int n_in, void* d_out, int out_size, void* d_ws, size_t ws_size, hipStream_t stream) {
    static int grid = 0;
    if (grid == 0) {
        if (n_in != 24 || ws_size < WS_END) { fprintf(stderr, "kernel_launch: unexpected n_in %d / ws %zu\n", n_in, ws_size); grid = -1; return; }
        int dev = 0, cus = 0, per_cu = 0;
        if (hipGetDevice(&dev) != hipSuccess || hipDeviceGetAttribute(&cus, hipDeviceAttributeMultiprocessorCount, dev) != hipSuccess) { grid = -1; return; }
        if (hipFuncSetAttribute((const void*)mk_fwd, hipFuncAttributeMaxDynamicSharedMemorySize, LDS_BYTES) != hipSuccess) { fprintf(stderr, "kernel_launch: hipFuncSetAttribute failed\n"); grid = -1; return; }
        if (hipOccupancyMaxActiveBlocksPerMultiprocessor(&per_cu, (const void*)mk_fwd, NWAVES * 64, LDS_BYTES) != hipSuccess || per_cu < 1) { fprintf(stderr, "kernel_launch: occupancy query failed (%d)\n", per_cu); (void)hipGetLastError(); grid = -1; return; }
        grid = cus * 1;
    }
    if (grid < 0) return;
    (void)hipMemsetAsync((char*)d_ws + WS_CTL, 0, CTL_ZERO_BYTES, stream);
    Args a; memset(&a, 0, sizeof(a));
    for (int i = 0; i < 24; ++i) a.in[i] = (const float*)d_in[i];
    a.out = (float*)d_out; a.ws = (unsigned char*)d_ws; a.ph_lo = 0; a.ph_hi = 1000;
    void* kargs[] = {&a};
    hipError_t e = hipLaunchCooperativeKernel((const void*)mk_fwd, dim3(grid), dim3(NWAVES * 64), kargs, LDS_BYTES, stream);
    if (e != hipSuccess) fprintf(stderr, "kernel_launch: cooperative launch failed: %s (grid %d)\n", hipGetErrorString(e), grid);
}
```

```cpp
#include <hip/hip_runtime.h>
#include <hip/hip_cooperative_groups.h>
#include <cstdio>
#include <cstdint>
#include <cstring>
namespace cg = cooperative_groups;

constexpr int D = 1024, NCTX = 8192, NLAT = 2048, MTOK = 10240, FF = 4096;
constexpr int QKVW = 1536, DNIN = 4128, DNINP = 4352, PROJW = 4096;
constexpr int KVROWS = 8192 + 2 * 1280;
constexpr float EPS = 1e-6f;
constexpr float ATT_SCALE = 0.08838834764831845f;
constexpr size_t O_Y = 0, O_CK = (size_t)MTOK * D, O_CV = O_CK + 4194304, O_ST = O_CV + 4194304;

typedef unsigned short bf16raw;
typedef float f32x4_t __attribute__((ext_vector_type(4)));
typedef float f32x2_t __attribute__((ext_vector_type(2)));
typedef unsigned u32x4_t __attribute__((ext_vector_type(4)));
typedef unsigned u32x2_t __attribute__((ext_vector_type(2)));

__device__ __forceinline__ unsigned f2bf(float f) { unsigned u = __builtin_bit_cast(unsigned, f); return (u + 0x7fffu + ((u >> 16) & 1u)) >> 16; }
__device__ __forceinline__ unsigned pk2(float lo, float hi) { return f2bf(lo) | (f2bf(hi) << 16); }
__device__ __forceinline__ float bf_lo(unsigned w) { return __builtin_bit_cast(float, w << 16); }
__device__ __forceinline__ float bf_hi(unsigned w) { return __builtin_bit_cast(float, w & 0xffff0000u); }
__device__ __forceinline__ float bf2f(bf16raw h) { return __builtin_bit_cast(float, (unsigned)h << 16); }
__device__ __forceinline__ float silu_f(float x) { return x / (1.f + __expf(-x)); }
__device__ __forceinline__ int cond_of(int row) { return row < NCTX ? 0 : 1 + ((row - NCTX) >> 10); }
__device__ __forceinline__ float lane_xor_f(float v, int lane, int k) { return __builtin_bit_cast(float, __builtin_amdgcn_ds_bpermute((lane ^ k) << 2, __builtin_bit_cast(int, v))); }
__device__ __forceinline__ float wave_sum(float v, int lane) {
#pragma unroll
    for (int o = 1; o < 64; o <<= 1) v += lane_xor_f(v, lane, o);
    return v;
}
__device__ __forceinline__ float wave_max(float v, int lane) {
#pragma unroll
    for (int o = 1; o < 64; o <<= 1) v = fmaxf(v, lane_xor_f(v, lane, o));
    return v;
}
__device__ __forceinline__ float dpp_xadd(float v, const int ctrl_tag) { return v; }
#define DPP_ADD(v, ctrl) ((v) + __builtin_bit_cast(float, __builtin_amdgcn_update_dpp(0, __builtin_bit_cast(int, (v)), (ctrl), 0xf, 0xf, true)))
__device__ __forceinline__ float wave_sum_dpp(float v) {
    v = DPP_ADD(v, 0xB1); v = DPP_ADD(v, 0x4E); v = DPP_ADD(v, 0x141); v = DPP_ADD(v, 0x140);
    const int iv = __builtin_bit_cast(int, v);
    return (__builtin_bit_cast(float, __builtin_amdgcn_readlane(iv, 0)) + __builtin_bit_cast(float, __builtin_amdgcn_readlane(iv, 16))) +
           (__builtin_bit_cast(float, __builtin_amdgcn_readlane(iv, 32)) + __builtin_bit_cast(float, __builtin_amdgcn_readlane(iv, 48)));
}
namespace pg8 {
#define PG8_LAS __attribute__((address_space(3)))
typedef unsigned short bf16_t;
typedef short bf16x8 __attribute__((ext_vector_type(8)));
typedef float f32x4 __attribute__((ext_vector_type(4)));
typedef unsigned u32x4 __attribute__((ext_vector_type(4)));
constexpr int BM = 256, BK = 64, HALF = 128, HTB = HALF * BK * 2  , STAGE_BYTES = 8 * HTB, NXCD = 8, WGM = 8;

__host__ __device__ __forceinline__ int lds_byte(int r, int c) { const int st = (r >> 4) * 2 + (c >> 5), rr = r & 15, cc = c & 31, ob = rr * 64 + cc * 2; return st * 1024 + (ob ^ (((ob >> 9) & 1) << 5)); }
__host__ __device__ __forceinline__ void stage_rc(int b, int& R, int& C) { const int st = b / 1024, sb = b % 1024, swz = sb ^ (((sb >> 9) & 1) << 5); R = (st >> 1) * 16 + swz / 64; C = (st & 1) * 32 + (swz % 64) / 2; }
__host__ __device__ __forceinline__ int perm32(int rho) { const int n = rho >> 4, i = rho & 15; return 8 * (i >> 2) + 4 * n + (i & 3); }

struct Unit { int pm, pn; };
struct Gemm { const bf16_t* A; const bf16_t* Bt; int M, N, K; int z; };

struct StaticOrder {
    int nM, nN, nwg, G, c;
    __host__ __device__ void init(int M, int N, int G_, int c_) { nM = M / BM; nN = N / BM; nwg = nM * nN; G = G_; c = c_; }
    __host__ __device__ bool next(int i, Unit& u) const {
        const long L = (long)i * G + c; if (L >= nwg) return false;
        int wgid = (int)L; { const int q = nwg / NXCD, r = nwg % NXCD, xcd = wgid % NXCD, off = wgid / NXCD; wgid = (xcd < r ? xcd * (q + 1) : r * (q + 1) + (xcd - r) * q) + off; }
        const int nig = WGM * nN, gid = wgid / nig, fm = gid * WGM, gsz = (nM - fm) < WGM ? (nM - fm) : WGM;
        u.pm = fm + ((wgid % nig) % gsz); u.pn = (wgid % nig) / gsz; return true;
    }
    __device__ __forceinline__ void a_ready(const Unit&) const {}
    __device__ __forceinline__ void done(const Unit&) const {}
};

__device__ __forceinline__ unsigned cvt_pk_bf16(float lo, float hi) { unsigned r; asm volatile("v_cvt_pk_bf16_f32 %0, %1, %2" : "=v"(r) : "v"(lo), "v"(hi)); return r; }
typedef float f32x2 __attribute__((ext_vector_type(2)));
__device__ __forceinline__ f32x2 gelu_pk(f32x2 v) {
    const f32x2 av = __builtin_elementwise_abs(v), d = av * 0.2316418882f + 1.0f;
    f32x2 t; t.x = __builtin_amdgcn_rcpf(d.x); t.y = __builtin_amdgcn_rcpf(d.y);
    f32x2 q = t * 0.5307027145f + (-0.7265760135f); q = q * t + 0.7107068705f; q = q * t + (-0.142248368f); q = q * t + 0.127414796f; q = q * t;
    const f32x2 s = (v * v) * (-0.72134752044f);
    f32x2 e; e.x = __builtin_amdgcn_exp2f(s.x); e.y = __builtin_amdgcn_exp2f(s.y);
    const f32x2 m = v * (q * e), r = v - m;
    f32x2 o; o.x = v.x < 0.f ? m.x : r.x; o.y = v.y < 0.f ? m.y : r.y; return o;
}

template <int ACT  > struct EpiBf16 {
    static constexpr bool PERM = true, AFTER_DRAIN = false; static_assert(ACT >= 0 && ACT <= 2, "EpiBf16: ACT is 0 (none), 1 (gelu_pk) or 2 (squared relu)");
    bf16_t* O; int ldc; const float* bias; int split_cols; size_t split_stride; float scale0;
    __device__ __forceinline__ void operator()(const f32x4 (&acc)[2][2][4][2], const Unit& u, int wr, int wc, int fr, int fq) const {
        const int row0 = u.pm * BM + wr * 64 + fr; int colt = u.pn * BM; bf16_t* base = O;
        float sc = 1.f; if (split_cols) { const int t = colt / split_cols; base += (size_t)t * split_stride; colt -= t * split_cols; if (t == 0) sc = scale0; }
        const int col0 = colt + wc * 32 + 8 * fq, bcol0 = u.pn * BM + wc * 32 + 8 * fq;
        f32x4 bv[2][2];
#pragma unroll
        for (int bj = 0; bj < 2; ++bj)
#pragma unroll
            for (int n = 0; n < 2; ++n) bv[bj][n] = bias ? *(const f32x4*)(bias + bcol0 + bj * HALF + 4 * n) : (f32x4){0.f, 0.f, 0.f, 0.f};
#pragma unroll
        for (int ai = 0; ai < 2; ++ai)
#pragma unroll
            for (int m = 0; m < 4; ++m) { bf16_t* rowp = base + (size_t)(row0 + ai * HALF + m * 16) * ldc + col0;
#pragma unroll
                for (int bj = 0; bj < 2; ++bj) { f32x4 v0 = acc[ai][bj][m][0] + bv[bj][0], v1 = acc[ai][bj][m][1] + bv[bj][1];
                    if (ACT == 1) { f32x2 a = gelu_pk((f32x2){v0[0], v0[1]}), b = gelu_pk((f32x2){v0[2], v0[3]}), c = gelu_pk((f32x2){v1[0], v1[1]}), d = gelu_pk((f32x2){v1[2], v1[3]});
                        v0 = (f32x4){a.x, a.y, b.x, b.y}; v1 = (f32x4){c.x, c.y, d.x, d.y}; }
                    if (ACT == 2) { v0 = __builtin_elementwise_max(v0, (f32x4){0.f, 0.f, 0.f, 0.f}); v1 = __builtin_elementwise_max(v1, (f32x4){0.f, 0.f, 0.f, 0.f}); v0 = v0 * v0; v1 = v1 * v1; }
                    v0 = v0 * sc; v1 = v1 * sc; u32x4 w; w.x = cvt_pk_bf16(v0[0], v0[1]); w.y = cvt_pk_bf16(v0[2], v0[3]); w.z = cvt_pk_bf16(v1[0], v1[1]); w.w = cvt_pk_bf16(v1[2], v1[3]);
                    *(u32x4*)(rowp + bj * HALF) = w; } }
    }
};

struct PanelStats {
    unsigned* xbuf;
    unsigned* cnt;
    unsigned* tmo;
    int ntn; float eps;
    unsigned code;
    __device__ __forceinline__ bool run(const f32x4 (&v)[2][2][4][2], const Unit& u, int wr, int wc, int fr, int fq, PG8_LAS unsigned char* lds, int wid, int lane) const {
        typedef float f32x2v __attribute__((ext_vector_type(2)));
        PG8_LAS f32x2v* P = (PG8_LAS f32x2v*)lds;
        PG8_LAS f32x2v* S = (PG8_LAS f32x2v*)(lds + 8192);
        PG8_LAS unsigned* flag = (PG8_LAS unsigned*)(lds + 8192 + 2048);
#pragma unroll
        for (int ai = 0; ai < 2; ++ai)
#pragma unroll
            for (int m = 0; m < 4; ++m) {
                float s = 0.f;
#pragma unroll
                for (int bj = 0; bj < 2; ++bj)
#pragma unroll
                    for (int n = 0; n < 2; ++n) { const f32x4 x = v[ai][bj][m][n]; s += (x[0] + x[1]) + (x[2] + x[3]); }
                s += __shfl_xor(s, 16); s += __shfl_xor(s, 32);
                const float mw = s * (1.0f / 64.0f); float q = 0.f;
#pragma unroll
                for (int bj = 0; bj < 2; ++bj)
#pragma unroll
                    for (int n = 0; n < 2; ++n) { const f32x4 d = v[ai][bj][m][n] - mw; q += (d[0] * d[0] + d[1] * d[1]) + (d[2] * d[2] + d[3] * d[3]); }
                q += __shfl_xor(q, 16); q += __shfl_xor(q, 32);
                if (fq == 0) P[(ai * HALF + wr * 64 + m * 16 + fr) * 4 + wc] = (f32x2v){mw, q};
            }
        asm volatile("s_waitcnt lgkmcnt(0)" ::: "memory"); __builtin_amdgcn_s_barrier(); asm volatile("" ::: "memory");
#if defined(BROKEN_EXCHANGE_NO_WAIT)
#warning BROKEN CONTROL BUILD: the row-statistics exchange does not wait; results are wrong by design
        if (blockIdx.x >= 64) { const long long t0_ = clock64(); while (clock64() - t0_ < 60000) __builtin_amdgcn_s_sleep(8); }
#endif
        const int row = wid * 32 + (lane & 31);
        if (lane < 32) {
            const f32x2v a = P[row * 4 + 0], b = P[row * 4 + 1], c = P[row * 4 + 2], d = P[row * 4 + 3];
            const float mt = (a.x + b.x + c.x + d.x) * 0.25f;
            const float da = a.x - mt, db = b.x - mt, dc = c.x - mt, dd = d.x - mt;
            const float m2 = (a.y + b.y) + (c.y + d.y) + 64.0f * ((da * da + db * db) + (dc * dc + dd * dd));
            unsigned long long* slot = (unsigned long long*)xbuf + ((size_t)(u.pm * BM + row) * 4 + u.pn);
            __hip_atomic_store(slot, ((unsigned long long)__float_as_uint(m2) << 32) | __float_as_uint(mt), __ATOMIC_RELAXED, __HIP_MEMORY_SCOPE_AGENT);
        }
        asm volatile("s_waitcnt vmcnt(0)" ::: "memory");
        if (lane == 0) __hip_atomic_fetch_add(cnt + 64 * u.pm, 1u, __ATOMIC_RELAXED, __HIP_MEMORY_SCOPE_AGENT);
        if (wid == 0) {
            bool dead = false; const unsigned long long t0 = __builtin_amdgcn_s_memrealtime(); const unsigned want = 8u * (unsigned)ntn;
            for (;;) {
#if defined(BROKEN_EXCHANGE_NO_WAIT)
                break;
#endif
                if ((unsigned)__builtin_amdgcn_readfirstlane(__hip_atomic_load(cnt + 64 * u.pm, __ATOMIC_RELAXED, __HIP_MEMORY_SCOPE_AGENT)) >= want) break;
                if (__builtin_amdgcn_s_memrealtime() - t0 > 2000000ull) {
                    if (lane == 0) { unsigned expect = 0u; __hip_atomic_compare_exchange_strong(tmo + 1, &expect, code | (unsigned)(u.pm & 0xff), __ATOMIC_RELAXED, __ATOMIC_RELAXED, __HIP_MEMORY_SCOPE_AGENT);
                                     __hip_atomic_store(tmo, 1u, __ATOMIC_RELAXED, __HIP_MEMORY_SCOPE_AGENT); }
                    dead = true; break; }
                __builtin_amdgcn_s_sleep(2);
            }
            __builtin_amdgcn_fence(__ATOMIC_ACQUIRE, "agent");
            if (lane == 0) flag[0] = dead ? 1u : 0u;
        }
        asm volatile("s_waitcnt vmcnt(0) lgkmcnt(0)" ::: "memory"); __builtin_amdgcn_s_barrier(); asm volatile("" ::: "memory");
        const bool bad = flag[0] != 0u;
        if (lane < 32) {
            const unsigned long long* slot = (const unsigned long long*)xbuf + (size_t)(u.pm * BM + row) * 4; float mt[4], m2[4]; float ms = 0.f;
#pragma unroll
            for (int t = 0; t < 4; ++t) { if (t < ntn) { const unsigned long long w = __hip_atomic_load(slot + t, __ATOMIC_RELAXED, __HIP_MEMORY_SCOPE_AGENT); mt[t] = __uint_as_float((unsigned)w); m2[t] = __uint_as_float((unsigned)(w >> 32)); } else { mt[t] = 0.f; m2[t] = 0.f; } ms += mt[t]; }
            const float mean = ms / (float)ntn; float q = 0.f;
#pragma unroll
            for (int t = 0; t < 4; ++t) if (t < ntn) { const float dm = mt[t] - mean; q += m2[t] + 256.0f * dm * dm; }
            S[row] = (f32x2v){mean, 1.0f / sqrtf(q / (256.0f * (float)ntn) + eps)};
        }
        asm volatile("s_waitcnt lgkmcnt(0)" ::: "memory"); __builtin_amdgcn_s_barrier(); asm volatile("" ::: "memory");
        return bad;
    }
};
struct EpiLnRes {
    static constexpr bool PERM = false, AFTER_DRAIN = true;
    const float* base; float* out; int ldc; const float* bias; PanelStats st; unsigned poison;
    __device__ __forceinline__ void fused(f32x4 (&acc)[2][2][4][2], const Unit& u, int wr, int wc, int fr, int fq, PG8_LAS unsigned char* lds, int wid, int lane) const {
        typedef float f32x2v __attribute__((ext_vector_type(2)));
        const PG8_LAS f32x2v* S = (const PG8_LAS f32x2v*)(lds + 8192);
        const int col0 = u.pn * BM + wc * 32 + 4 * fq;
#pragma unroll
        for (int bj = 0; bj < 2; ++bj)
#pragma unroll
            for (int n = 0; n < 2; ++n) { const f32x4 bv = bias ? *(const f32x4*)(bias + col0 + bj * HALF + n * 16) : (f32x4){0.f, 0.f, 0.f, 0.f};
#pragma unroll
                for (int ai = 0; ai < 2; ++ai)
#pragma unroll
                    for (int m = 0; m < 4; ++m) acc[ai][bj][m][n] += bv; }
        f32x4 pre[4][2][2];
#pragma unroll
        for (int m = 0; m < 4; ++m) { const size_t off = (size_t)(u.pm * BM + wr * 64 + m * 16 + fr) * ldc + col0;
#pragma unroll
            for (int bj = 0; bj < 2; ++bj)
#pragma unroll
                for (int n = 0; n < 2; ++n) pre[m][bj][n] = *(const f32x4*)(base + off + bj * HALF + n * 16); }
        const bool bad = st.run(acc, u, wr, wc, fr, fq, lds, wid, lane) || poison != 0u;
        const float qnan = __builtin_nanf("");
#pragma unroll
        for (int ai = 0; ai < 2; ++ai)
#pragma unroll
            for (int m = 0; m < 4; ++m) { const int r = ai * HALF + wr * 64 + m * 16 + fr; const f32x2v sr = S[r]; const size_t off = (size_t)(u.pm * BM + r) * ldc + col0;
#pragma unroll
                for (int bj = 0; bj < 2; ++bj)
#pragma unroll
                    for (int n = 0; n < 2; ++n) { const f32x4 bs = ai == 0 ? pre[m][bj][n] : *(const f32x4*)(base + off + bj * HALF + n * 16); f32x4 o = bs + (acc[ai][bj][m][n] - sr.x) * sr.y;
                        if (bad) o = (f32x4){qnan, qnan, qnan, qnan}; *(f32x4*)(out + off + bj * HALF + n * 16) = o; }
                if (m & 1) asm volatile("" ::: "memory"); }
    }
};
struct EpiLnResLn {
    static constexpr bool PERM = false, AFTER_DRAIN = true;
    const float* base; float* out; bf16_t* xn; int ldc; const float* bias; PanelStats st1, st2; unsigned poison;
    __device__ __forceinline__ void fused(f32x4 (&acc)[2][2][4][2], const Unit& u, int wr, int wc, int fr, int fq, PG8_LAS unsigned char* lds, int wid, int lane) const {
        typedef float f32x2v __attribute__((ext_vector_type(2))); typedef unsigned u32x2v __attribute__((ext_vector_type(2)));
        const PG8_LAS f32x2v* S = (const PG8_LAS f32x2v*)(lds + 8192);
        const int col0 = u.pn * BM + wc * 32 + 4 * fq;
#pragma unroll
        for (int bj = 0; bj < 2; ++bj)
#pragma unroll
            for (int n = 0; n < 2; ++n) { const f32x4 bv = bias ? *(const f32x4*)(bias + col0 + bj * HALF + n * 16) : (f32x4){0.f, 0.f, 0.f, 0.f};
#pragma unroll
                for (int ai = 0; ai < 2; ++ai)
#pragma unroll
                    for (int m = 0; m < 4; ++m) acc[ai][bj][m][n] += bv; }
        bool bad = st1.run(acc, u, wr, wc, fr, fq, lds, wid, lane) || poison != 0u;
        const float qnan = __builtin_nanf("");
#pragma unroll
        for (int ai = 0; ai < 2; ++ai)
#pragma unroll
            for (int m = 0; m < 4; ++m) { const int r = ai * HALF + wr * 64 + m * 16 + fr; const f32x2v sr = S[r]; const size_t off = (size_t)(u.pm * BM + r) * ldc + col0;
#pragma unroll
                for (int bj = 0; bj < 2; ++bj)
#pragma unroll
                    for (int n = 0; n < 2; ++n) { const f32x4 bs = *(const f32x4*)(base + off + bj * HALF + n * 16); acc[ai][bj][m][n] = bs + (acc[ai][bj][m][n] - sr.x) * sr.y; }
                asm volatile("" : "+v"(acc[ai][0][m][0]), "+v"(acc[ai][0][m][1]), "+v"(acc[ai][1][m][0]), "+v"(acc[ai][1][m][1]));
                if (m & 1) asm volatile("" ::: "memory"); }
        const bool bad1 = bad;
        bad = st2.run(acc, u, wr, wc, fr, fq, lds, wid, lane) || bad;
#pragma unroll
        for (int ai = 0; ai < 2; ++ai)
#pragma unroll
            for (int m = 0; m < 4; ++m) { const int r = ai * HALF + wr * 64 + m * 16 + fr; const f32x2v sr = S[r]; const size_t off = (size_t)(u.pm * BM + r) * ldc + col0;
#pragma unroll
                for (int bj = 0; bj < 2; ++bj)
#pragma unroll
                    for (int n = 0; n < 2; ++n) { const f32x4 x1 = acc[ai][bj][m][n]; *(f32x4*)(out + off + bj * HALF + n * 16) = bad1 ? (f32x4){qnan, qnan, qnan, qnan} : x1;
                        const f32x4 o = (x1 - sr.x) * sr.y; u32x2v w; w.x = cvt_pk_bf16(o[0], o[1]); w.y = cvt_pk_bf16(o[2], o[3]);
                        if (bad) { w.x = 0x7fc07fc0u; w.y = 0x7fc07fc0u; } *(u32x2v*)(xn + off + bj * HALF + n * 16) = w; }
                asm volatile("" ::: "memory"); }
    }
};

template <class Epi, class Sched, bool ALIGN_EPI = false, bool SP2 = false, bool T160 = false>
__device__ __forceinline__ void gemm_phase(PG8_LAS unsigned char* lds, const Gemm g, const Sched& S, const Epi& E, const int row1 = 0) {
    static_assert(!T160 || SP2, "T160 is implemented on the SP2 loop only");
    const int tid = threadIdx.x + g.z, wid = __builtin_amdgcn_readfirstlane(tid >> 6), lane = tid & 63, wr = wid >> 2, wc = wid & 3, fr = lane & 15, fq = lane >> 4;
    const int K = g.K, nt = K / BK;
    unsigned voffA[2], voffB[2], voffA1[2];
#pragma unroll
    for (int i = 0; i < 2; ++i) { int R, C; stage_rc(tid * 16 + i * 8192, R, C); const int Rb = Epi::PERM ? ((R & ~31) + perm32(R & 31)) : R;
        voffA[i] = (unsigned)(R * K + C) * 2u; voffB[i] = (unsigned)(Rb * K + C) * 2u; voffA1[i] = T160 ? (unsigned)((R & 31) * K + C) * 2u : voffA[i]; }
    const size_t kstep = (size_t)(BK * 2);
    const size_t hstep = (size_t)HALF * K * 2;
    const size_t tstep = 2 * hstep;
    const size_t tstepA = T160 ? hstep : tstep;
    const size_t t1step = (size_t)32 * K * 2;
    const unsigned ldsw = (unsigned)wid * 1024u;
    const int aoff = lds_byte(wr * 64 + fr, fq * 8), boff = lds_byte(wc * 32 + fr, fq * 8), aoff1 = lds_byte(wr * 16 + fr, fq * 8);
#define PG8_SA(b, h) (((b) * 2 + (h)) * HTB)
#define PG8_SB(b, h) ((4 + (b) * 2 + (h)) * HTB)
#define PG8_STAGE(bufoff, gbase, voff) do { _Pragma("unroll") for (int _i = 0; _i < 2; ++_i) \
        __builtin_amdgcn_global_load_lds((const unsigned*)((const char*)(gbase) + (voff)[_i]), (PG8_LAS unsigned*)(lds + (bufoff) + ldsw + _i * 8192), 16, 0, 0); } while (0)
#define PG8_LDA(dst, b, h) do { _Pragma("unroll") for (int m = 0; m < 4; ++m) _Pragma("unroll") for (int k = 0; k < 2; ++k) dst[m][k] = *(const PG8_LAS bf16x8*)(lds + PG8_SA(b, h) + aoff + m * 2048 + k * 1024); } while (0)
#define PG8_LDB(dst, b, h) do { _Pragma("unroll") for (int n = 0; n < 2; ++n) _Pragma("unroll") for (int k = 0; k < 2; ++k) dst[n][k] = *(const PG8_LAS bf16x8*)(lds + PG8_SB(b, h) + boff + n * 2048 + k * 1024); } while (0)
#define PG8_MMA(ai, bj, At, Bt) do { __builtin_amdgcn_s_setprio(1); _Pragma("unroll") for (int m = 0; m < 4; ++m) _Pragma("unroll") for (int n = 0; n < 2; ++n) _Pragma("unroll") for (int k = 0; k < 2; ++k) \
        acc[ai][bj][m][n] = __builtin_amdgcn_mfma_f32_16x16x32_bf16(Bt[n][k], At[m][k], acc[ai][bj][m][n], 0, 0, 0); __builtin_amdgcn_s_setprio(0); } while (0)
#define PG8_LDA1(dst, b) do { if constexpr (T160) { _Pragma("unroll") for (int k = 0; k < 2; ++k) dst[0][k] = *(const PG8_LAS bf16x8*)(lds + PG8_SA(b, 1) + aoff1 + k * 1024); } else { PG8_LDA(dst, b, 1); } } while (0)
#define PG8_MMA1(bj, At, Bt) do { if constexpr (T160) { __builtin_amdgcn_s_setprio(1); _Pragma("unroll") for (int n = 0; n < 2; ++n) _Pragma("unroll") for (int k = 0; k < 2; ++k) \
        acc[1][bj][0][n] = __builtin_amdgcn_mfma_f32_16x16x32_bf16(Bt[n][k], At[0][k], acc[1][bj][0][n], 0, 0, 0); __builtin_amdgcn_s_setprio(0); } else { PG8_MMA(1, bj, At, Bt); } } while (0)
#define PG8_WAIT_V(n) asm volatile("s_waitcnt vmcnt(" #n ")" ::: "memory")
#define PG8_WAIT_L(n) asm volatile("s_waitcnt lgkmcnt(" #n ")" ::: "memory")
#define PG8_BAR __builtin_amdgcn_s_barrier()
#define PG8_SCHED __builtin_amdgcn_sched_barrier(0)
    Unit cur, nxt; int ui = 0;
    if (!S.next(0, cur)) return;
    f32x4 acc[2][2][4][2];
#pragma unroll
    for (int a = 0; a < 2; ++a)
#pragma unroll
        for (int b = 0; b < 2; ++b)
#pragma unroll
            for (int m = 0; m < 4; ++m)
#pragma unroll
                for (int n = 0; n < 2; ++n) acc[a][b][m][n] = (f32x4){0.f, 0.f, 0.f, 0.f};
    bf16x8 At[4][2], B0[2][2], B1[2][2];
    const char* cA = (const char*)g.A + (size_t)cur.pm * tstepA; const char* cB = (const char*)g.Bt + (size_t)cur.pn * tstep;
#define PG8_DA(pm_) (T160 ? (ptrdiff_t)((size_t)row1 * K * 2 + (size_t)(pm_) * t1step) - (ptrdiff_t)((size_t)(pm_) * tstepA) : (ptrdiff_t)hstep)
    ptrdiff_t dA = PG8_DA(cur.pm), dAn = dA;
    S.a_ready(cur);
    if constexpr (SP2) {
        PG8_STAGE(PG8_SB(0, 0), cB, voffB); PG8_STAGE(PG8_SB(0, 1), cB + hstep, voffB); PG8_STAGE(PG8_SA(0, 0), cA, voffA); PG8_STAGE(PG8_SA(0, 1), cA + dA, voffA1);
        if (wr == 1) PG8_BAR;
        PG8_WAIT_V(2); PG8_BAR;
        PG8_STAGE(PG8_SB(1, 0), cB + kstep, voffB); PG8_STAGE(PG8_SA(1, 0), cA + kstep, voffA); PG8_STAGE(PG8_SB(1, 1), cB + hstep + kstep, voffB);
        PG8_WAIT_V(6); PG8_BAR;
    } else {
        PG8_STAGE(PG8_SB(0, 0), cB, voffB); PG8_STAGE(PG8_SA(0, 0), cA, voffA); PG8_STAGE(PG8_SB(0, 1), cB + hstep, voffB); PG8_STAGE(PG8_SA(0, 1), cA + hstep, voffA);
        if (wr == 1) PG8_BAR;
        PG8_WAIT_V(4); PG8_BAR;
        PG8_STAGE(PG8_SB(1, 0), cB + kstep, voffB); PG8_STAGE(PG8_SA(1, 0), cA + kstep, voffA); PG8_STAGE(PG8_SB(1, 1), cB + hstep + kstep, voffB);
        PG8_WAIT_V(6); PG8_BAR;
    }
    for (;;) {
        const bool has_next = S.next(ui + 1, nxt);
        const char* nA = has_next ? (const char*)g.A + (size_t)nxt.pm * tstepA : cA; const char* nB = has_next ? (const char*)g.Bt + (size_t)nxt.pn * tstep : cB;
        dAn = has_next ? PG8_DA(nxt.pm) : dA;
        for (int t = 0; t < nt; t += 2) {
            const bool last = (t == nt - 2);
            const char* a1 = cA + (size_t)(t + 1) * kstep;
            const char* a2 = last ? nA : cA + (size_t)(t + 2) * kstep; const char* b2 = last ? nB : cB + (size_t)(t + 2) * kstep;
            const char* a3 = a2 + kstep; const char* b3 = b2 + kstep;
            const ptrdiff_t d2 = last ? dAn : dA;
            if (last && has_next) S.a_ready(nxt);
            if constexpr (SP2) {
            PG8_LDB(B0, 0, 0); PG8_LDB(B1, 0, 1); PG8_SCHED; PG8_LDA(At, 0, 0); PG8_STAGE(PG8_SA(1, 1), a1 + dA, voffA1);
            PG8_WAIT_V(8); PG8_WAIT_L(0); PG8_BAR; PG8_MMA(0, 0, At, B0); PG8_MMA(0, 1, At, B1); PG8_BAR; PG8_SCHED;
            PG8_LDA1(At, 0); PG8_STAGE(PG8_SB(0, 0), b2, voffB); PG8_STAGE(PG8_SB(0, 1), b2 + hstep, voffB); PG8_STAGE(PG8_SA(0, 0), a2, voffA);
            PG8_WAIT_V(8); PG8_WAIT_L(0); PG8_BAR; PG8_MMA1(0, At, B0); PG8_MMA1(1, At, B1); PG8_BAR; PG8_SCHED;
            PG8_LDB(B0, 1, 0); PG8_LDB(B1, 1, 1); PG8_SCHED; PG8_LDA(At, 1, 0); PG8_STAGE(PG8_SA(0, 1), a2 + d2, voffA1);
            PG8_WAIT_V(8); PG8_WAIT_L(0); PG8_BAR; PG8_MMA(0, 0, At, B0); PG8_MMA(0, 1, At, B1); PG8_BAR; PG8_SCHED;
            PG8_LDA1(At, 1); PG8_STAGE(PG8_SB(1, 0), b3, voffB); PG8_STAGE(PG8_SB(1, 1), b3 + hstep, voffB); PG8_STAGE(PG8_SA(1, 0), a3, voffA);
            PG8_WAIT_V(8); PG8_WAIT_L(0); PG8_BAR; PG8_MMA1(0, At, B0); PG8_MMA1(1, At, B1); PG8_BAR; PG8_SCHED;
            } else {
            PG8_LDB(B0, 0, 0); PG8_SCHED; PG8_LDA(At, 0, 0); PG8_STAGE(PG8_SA(1, 1), a1 + hstep, voffA);
            PG8_WAIT_L(8); PG8_BAR; PG8_WAIT_L(0); PG8_MMA(0, 0, At, B0); PG8_BAR; PG8_SCHED;
            PG8_LDB(B1, 0, 1); PG8_STAGE(PG8_SB(0, 0), b2, voffB);
            PG8_BAR; PG8_WAIT_L(0); PG8_MMA(0, 1, At, B1); PG8_BAR;
            PG8_LDA(At, 0, 1); PG8_STAGE(PG8_SA(0, 0), a2, voffA);
            PG8_BAR; PG8_WAIT_L(0); PG8_MMA(1, 0, At, B0); PG8_BAR; PG8_SCHED;
            PG8_STAGE(PG8_SB(0, 1), b2 + hstep, voffB);
            PG8_WAIT_V(6); PG8_BAR; PG8_MMA(1, 1, At, B1); PG8_BAR;
            PG8_LDB(B0, 1, 0); PG8_SCHED; PG8_LDA(At, 1, 0); PG8_STAGE(PG8_SA(0, 1), a2 + hstep, voffA);
            PG8_WAIT_L(8); PG8_BAR; PG8_WAIT_L(0); PG8_MMA(0, 0, At, B0); PG8_BAR; PG8_SCHED;
            PG8_LDB(B1, 1, 1); PG8_STAGE(PG8_SB(1, 0), b3, voffB);
            PG8_BAR; PG8_WAIT_L(0); PG8_MMA(0, 1, At, B1); PG8_BAR;
            PG8_LDA(At, 1, 1); PG8_STAGE(PG8_SA(1, 0), a3, voffA);
            PG8_BAR; PG8_WAIT_L(0); PG8_MMA(1, 0, At, B0); PG8_BAR; PG8_SCHED;
            PG8_STAGE(PG8_SB(1, 1), b3 + hstep, voffB);
            PG8_WAIT_V(6); PG8_BAR; PG8_MMA(1, 1, At, B1); PG8_BAR;
            }
        }
        if constexpr (ALIGN_EPI) { if (wr == 0) PG8_BAR; }
        if constexpr (!Epi::AFTER_DRAIN) { E(acc, cur, wr, wc, fr, fq); S.done(cur); }
        if (!has_next) break;
#pragma unroll
        for (int a = 0; a < 2; ++a)
#pragma unroll
            for (int b = 0; b < 2; ++b)
#pragma unroll
                for (int m = 0; m < 4; ++m)
#pragma unroll
                    for (int n = 0; n < 2; ++n) acc[a][b][m][n] = (f32x4){0.f, 0.f, 0.f, 0.f};
        cur = nxt; cA = nA; cB = nB; dA = dAn; ++ui;
        if constexpr (ALIGN_EPI) { if (wr == 1) PG8_BAR; }
    }
    PG8_WAIT_V(0);
    if constexpr (!ALIGN_EPI) { if (wr == 0) PG8_BAR; }
    PG8_BAR;
    if constexpr (Epi::AFTER_DRAIN) { E.fused(acc, cur, wr, wc, fr, fq, lds, wid, lane); S.done(cur); }
#undef PG8_SA
#undef PG8_SB
#undef PG8_STAGE
#undef PG8_LDA
#undef PG8_LDB
#undef PG8_MMA
#undef PG8_WAIT_V
#undef PG8_LDA1
#undef PG8_MMA1
#undef PG8_DA
#undef PG8_WAIT_L
#undef PG8_BAR
#undef PG8_SCHED
}
}

#ifndef PG8_SP2
#define PG8_SP2 true
#endif
#ifndef PG8_ALIGN
#define PG8_ALIGN true
#endif
namespace pg8 {
typedef __bf16 bf16x2v __attribute__((ext_vector_type(2))); typedef float f32x2v_ __attribute__((ext_vector_type(2)));
__device__ __forceinline__ unsigned cvt_pk_vis(float lo, float hi) { const f32x2v_ v = {lo, hi}; return __builtin_bit_cast(unsigned, __builtin_convertvector(v, bf16x2v)); }
struct EpiRes {
    static constexpr bool PERM = false, AFTER_DRAIN = false;
    const float* src_ctx; const float* src_lat; float* X; const float* gate;
    __device__ __forceinline__ void operator()(const f32x4 (&acc)[2][2][4][2], const Unit& u, int wr, int wc, int fr, int fq) const {
        const int cond = u.pm < 32 ? 0 : 1 + ((u.pm - 32) >> 2);
        const float* g = gate + cond * 6144;
        const float* sb = u.pm < 32 ? src_ctx + (size_t)u.pm * BM * 1024 : src_lat + (size_t)(u.pm - 32) * BM * 1024;
        float* xb = X + (size_t)u.pm * BM * 1024;
        const int col0 = u.pn * BM + wc * 32 + 4 * fq;
        f32x4 gv[2][2];
#pragma unroll
        for (int bj = 0; bj < 2; ++bj)
#pragma unroll
            for (int n = 0; n < 2; ++n) gv[bj][n] = *(const f32x4*)(g + col0 + bj * HALF + n * 16);
#pragma unroll
        for (int ai = 0; ai < 2; ++ai)
#pragma unroll
            for (int m = 0; m < 4; ++m) { const size_t off = (size_t)(ai * HALF + wr * 64 + m * 16 + fr) * 1024 + col0;
#pragma unroll
                for (int bj = 0; bj < 2; ++bj)
#pragma unroll
                    for (int n = 0; n < 2; ++n) { const f32x4 xv = *(const f32x4*)(sb + off + bj * HALF + n * 16);
                        *(f32x4*)(xb + off + bj * HALF + n * 16) = xv + gv[bj][n] * acc[ai][bj][m][n]; } }
    }
};
struct EpiRes160 {
    static constexpr bool PERM = false, AFTER_DRAIN = false;
    const float* src_ctx; const float* src_lat; float* X; const float* gate;
    __device__ __forceinline__ void operator()(const f32x4 (&acc)[2][2][4][2], const Unit& u, int wr, int wc, int fr, int fq) const {
        const int col0 = u.pn * BM + wc * 32 + 4 * fq;
        {
            const float* sb = src_ctx + (size_t)u.pm * 128 * 1024; float* xb = X + (size_t)u.pm * 128 * 1024;
            f32x4 gv[2][2];
#pragma unroll
            for (int bj = 0; bj < 2; ++bj)
#pragma unroll
                for (int n = 0; n < 2; ++n) gv[bj][n] = *(const f32x4*)(gate + col0 + bj * HALF + n * 16);
#pragma unroll
            for (int m = 0; m < 4; ++m) { const size_t off = (size_t)(wr * 64 + m * 16 + fr) * 1024 + col0;
#pragma unroll
                for (int bj = 0; bj < 2; ++bj)
#pragma unroll
                    for (int n = 0; n < 2; ++n) { const f32x4 xv = *(const f32x4*)(sb + off + bj * HALF + n * 16);
                        *(f32x4*)(xb + off + bj * HALF + n * 16) = xv + gv[bj][n] * acc[0][bj][m][n]; } }
        }
        {
            const float* g = gate + (1 + (u.pm >> 5)) * 6144;
            const float* sb = src_lat + (size_t)u.pm * 32 * 1024; float* xb = X + (size_t)(NCTX + 32 * u.pm) * 1024;
            const size_t off = (size_t)(wr * 16 + fr) * 1024 + col0;
#pragma unroll
            for (int bj = 0; bj < 2; ++bj)
#pragma unroll
                for (int n = 0; n < 2; ++n) { const f32x4 gv = *(const f32x4*)(g + col0 + bj * HALF + n * 16); const f32x4 xv = *(const f32x4*)(sb + off + bj * HALF + n * 16);
                    *(f32x4*)(xb + off + bj * HALF + n * 16) = xv + gv * acc[1][bj][0][n]; }
        }
    }
};
struct EpiDnIn {
    static constexpr bool PERM = true, AFTER_DRAIN = false;
    bf16_t* O; float* AB;
    __device__ __forceinline__ void operator()(const f32x4 (&acc)[2][2][4][2], const Unit& u, int wr, int wc, int fr, int fq) const {
        const int row0 = u.pm * BM + wr * 64 + fr;
        if (u.pn < 16) {
            const int col0 = u.pn * BM + wc * 32 + 8 * fq;
#pragma unroll
            for (int ai = 0; ai < 2; ++ai)
#pragma unroll
                for (int m = 0; m < 4; ++m) { bf16_t* rowp = O + (size_t)(row0 + ai * HALF + m * 16) * 4096 + col0;
#pragma unroll
                    for (int bj = 0; bj < 2; ++bj) { const f32x4 v0 = acc[ai][bj][m][0], v1 = acc[ai][bj][m][1];
                        u32x4 w; w.x = cvt_pk_vis(v0[0], v0[1]); w.y = cvt_pk_vis(v0[2], v0[3]); w.z = cvt_pk_vis(v1[0], v1[1]); w.w = cvt_pk_vis(v1[2], v1[3]);
                        *(u32x4*)(rowp + bj * HALF) = w; } }
        } else if (wc == 0) {
#pragma unroll
            for (int ai = 0; ai < 2; ++ai)
#pragma unroll
                for (int m = 0; m < 4; ++m) { float* rp = AB + (size_t)(row0 + ai * HALF + m * 16) * 32 + 8 * fq;
                    *(f32x4*)rp = acc[ai][0][m][0]; *(f32x4*)(rp + 4) = acc[ai][0][m][1]; }
        }
    }
};
}
#include <hip/hip_bf16.h>
namespace attn {
using bf16 = __hip_bfloat16;
constexpr int D = 128, NW = 8, QBLK = 32, KVBLK = 64;
constexpr float SCALE = 0.088388347648318440f;
constexpr float THR = 8.f;
constexpr int SDEPTH = 2;
constexpr int LDQ = 1024, LDK = 256, LDO = 1024;
constexpr size_t SHM_V = KVBLK * D * 2, SHM_K = KVBLK * D * 2, SHM_ATTN = 2 * SHM_V + 2 * SHM_K + NW * 64 * 4;
using bf16x8 = __attribute__((ext_vector_type(8))) short;
using s16x4  = __attribute__((ext_vector_type(4))) short;
using f32x16 = __attribute__((ext_vector_type(16))) float;
using f32x8  = __attribute__((ext_vector_type(8))) float;
using u32x4  = __attribute__((ext_vector_type(4))) unsigned;
#define KSWZ(row, colB) ((row) * 256 + ((colB) ^ (((row) & 7) << 4)))
#define SBAR() __builtin_amdgcn_sched_barrier(0)
__device__ __forceinline__ int crow(int r, int hi) { return (r & 3) + 8 * (r >> 2) + 4 * hi; }
__device__ __forceinline__ unsigned cvtpk(float lo, float hi) {
  unsigned r; asm volatile("v_cvt_pk_bf16_f32 %0, %1, %2" : "=v"(r) : "v"(lo), "v"(hi)); return r;
}
template <typename TIn> struct Stage;
template <> struct Stage<bf16>  { using T = bf16x8;
  __device__ static __forceinline__ T ld8(const bf16* p) { return *reinterpret_cast<const bf16x8*>(p); }
  __device__ static __forceinline__ bf16x8 tobf(T x) { return x; } };
template <> struct Stage<float> { using T = f32x8;
  __device__ static __forceinline__ T ld8(const float* p) { return *reinterpret_cast<const f32x8*>(p); }
  __device__ static __forceinline__ bf16x8 tobf(T x) {
    u32x4 w = {cvtpk(x[0], x[1]), cvtpk(x[2], x[3]), cvtpk(x[4], x[5]), cvtpk(x[6], x[7])}; return *reinterpret_cast<bf16x8*>(&w); } };

__device__ __forceinline__ void partialSM(f32x16& p0, f32x16& p1, float& m_reg, float& mn, float& alpha) {
  constexpr float C = SCALE * 1.4426950408889634f;
  float pmax = p0[0]; for (int r = 1; r < 16; ++r) pmax = fmaxf(pmax, p0[r]); for (int r = 0; r < 16; ++r) pmax = fmaxf(pmax, p1[r]);
  { auto rr = __builtin_amdgcn_permlane32_swap(__float_as_uint(pmax), __float_as_uint(pmax), false, false);
    pmax = fmaxf(__uint_as_float(rr[0]), __uint_as_float(rr[1])); }
  if (__builtin_expect(__all(pmax - m_reg <= THR / SCALE), 1)) { mn = m_reg; alpha = 1.f; }
  else { mn = fmaxf(m_reg, pmax); alpha = __builtin_amdgcn_exp2f((m_reg - mn) * C); m_reg = mn; }
  float mnC = -mn * C;
  for (int r = 0; r < 16; ++r) p0[r] = fmaf(p0[r], C, mnC); for (int r = 0; r < 16; ++r) p1[r] = fmaf(p1[r], C, mnC);
  for (int r = 0; r < 16; ++r) p0[r] = __builtin_amdgcn_exp2f(p0[r]);
}
__device__ __forceinline__ void finishSM(f32x16& p0, f32x16& p1, float alpha, float& l_reg, bf16x8& pa0, bf16x8& pa1, bf16x8& pa2, bf16x8& pa3) {
  for (int r = 0; r < 16; ++r) p1[r] = __builtin_amdgcn_exp2f(p1[r]);
  float ps = 0; for (int r = 0; r < 16; ++r) ps += p0[r]; for (int r = 0; r < 16; ++r) ps += p1[r];
  { auto rr = __builtin_amdgcn_permlane32_swap(__float_as_uint(ps), __float_as_uint(ps), false, false);
    ps = __uint_as_float(rr[0]) + __uint_as_float(rr[1]); }
  l_reg = l_reg * alpha + ps;
#define PK4(P, BASE, OUT) do { unsigned a0 = cvtpk(P[BASE + 0], P[BASE + 1]), a1 = cvtpk(P[BASE + 2], P[BASE + 3]);   \
    unsigned b0 = cvtpk(P[BASE + 4], P[BASE + 5]), b1 = cvtpk(P[BASE + 6], P[BASE + 7]);                              \
    auto r0 = __builtin_amdgcn_permlane32_swap(a0, b0, false, false); auto r1 = __builtin_amdgcn_permlane32_swap(a1, b1, false, false); \
    u32x4 w = {r0[0], r1[0], r0[1], r1[1]}; OUT = *reinterpret_cast<bf16x8*>(&w); } while (0)
  PK4(p0, 0, pa0); PK4(p0, 8, pa1); PK4(p1, 0, pa2); PK4(p1, 8, pa3);
#undef PK4
}
__device__ __forceinline__ void qkt(f32x16& p0, f32x16& p1, const bf16* Ks, const bf16x8* qr, int r32, int hi) {
  p0 = f32x16{}; p1 = f32x16{};
  for (int d0 = 0; d0 < 8; ++d0) { int cb = (d0 * 16 + hi * 8) * 2;
    bf16x8 b0 = *reinterpret_cast<const bf16x8*>((const char*)Ks + KSWZ(r32, cb));
    bf16x8 b1 = *reinterpret_cast<const bf16x8*>((const char*)Ks + KSWZ(32 + r32, cb));
    p0 = __builtin_amdgcn_mfma_f32_32x32x16_bf16(b0, qr[d0], p0, 0, 0, 0);
    p1 = __builtin_amdgcn_mfma_f32_32x32x16_bf16(b1, qr[d0], p1, 0, 0, 0); }
}
__device__ __forceinline__ int v_st(int k, int c) { const int kk = (k & ~0xC) | ((k & 4) << 1) | ((k & 8) >> 1); return ((kk >> 3) * 4 + (c >> 5)) * 512 + ((kk & 7) * 32 + (c & 31)) * 2; }
__device__ __forceinline__ int v_rd_base(int lane) { return ((lane & 3) << 3) | (((lane >> 2) & 3) << 6) | (((lane >> 4) & 1) << 5) | (((lane >> 5) & 1) << 8); }
constexpr int v_rd_off(int d0, int ks, int half) { return d0 * 512 + ks * 4096 + half * 2048; }
template <int OFF> __device__ __forceinline__ s16x4 tr_read(int vb) {
  s16x4 r; asm volatile("ds_read_b64_tr_b16 %0, %1 offset:%2" : "=&v"(r) : "v"(vb), "i"(OFF) : "memory"); return r;
}
template <int D0> __device__ __forceinline__ void pv_one(f32x16& od, int vb, bf16x8 pa0, bf16x8 pa1, bf16x8 pa2, bf16x8 pa3) {
  const s16x4 l0 = tr_read<v_rd_off(D0, 0, 0)>(vb), h0 = tr_read<v_rd_off(D0, 0, 1)>(vb), l1 = tr_read<v_rd_off(D0, 1, 0)>(vb), h1 = tr_read<v_rd_off(D0, 1, 1)>(vb);
  const s16x4 l2 = tr_read<v_rd_off(D0, 2, 0)>(vb), h2 = tr_read<v_rd_off(D0, 2, 1)>(vb), l3 = tr_read<v_rd_off(D0, 3, 0)>(vb), h3 = tr_read<v_rd_off(D0, 3, 1)>(vb);
  asm volatile("s_waitcnt lgkmcnt(0)" ::: "memory"); SBAR();
#define PK(L, H) (bf16x8){L[0], L[1], L[2], L[3], H[0], H[1], H[2], H[3]}
  od = __builtin_amdgcn_mfma_f32_32x32x16_bf16(pa0, PK(l0, h0), od, 0, 0, 0);
  od = __builtin_amdgcn_mfma_f32_32x32x16_bf16(pa1, PK(l1, h1), od, 0, 0, 0);
  od = __builtin_amdgcn_mfma_f32_32x32x16_bf16(pa2, PK(l2, h2), od, 0, 0, 0);
  od = __builtin_amdgcn_mfma_f32_32x32x16_bf16(pa3, PK(l3, h3), od, 0, 0, 0);
#undef PK
}
__device__ __forceinline__ void pv_d0(f32x16* o, int vb, bf16x8 pa0, bf16x8 pa1, bf16x8 pa2, bf16x8 pa3) {
  pv_one<0>(o[0], vb, pa0, pa1, pa2, pa3); pv_one<1>(o[1], vb, pa0, pa1, pa2, pa3); pv_one<2>(o[2], vb, pa0, pa1, pa2, pa3); pv_one<3>(o[3], vb, pa0, pa1, pa2, pa3);
}

template <typename TQ>
__device__ __forceinline__ void attn_dense_body(const TQ* __restrict__ Qb, const bf16* __restrict__ Kh, const bf16* __restrict__ Vh,
                                                unsigned short* __restrict__ Ob, int seq, char* lds, const int tid) {
  using St = Stage<bf16>; using SQ = Stage<TQ>;
  const int wid = tid >> 6, lane = tid & 63, r32 = lane & 31, hi = lane >> 5;
  bf16* V_lds = (bf16*)lds; bf16* K_lds = (bf16*)(lds + 2 * SHM_V);
  float* ws = (float*)(lds + 2 * SHM_V + 2 * SHM_K) + wid * 64; float* li_l = ws; float* al_l = ws + 32;
  float m_reg = -1e30f, l_reg = 0; f32x16 o[4] = {}; bf16x8 qr[8];
  const TQ* Qw = Qb + (int)(wid * QBLK + r32) * LDQ + hi * 8;
#pragma unroll
  for (int d0 = 0; d0 < 8; ++d0) qr[d0] = SQ::tobf(SQ::ld8(Qw + d0 * 16));
  const int sr = tid >> 4, sc = (tid & 15) * 8, vst0 = v_st(sr, sc), vst1 = v_st(32 + sr, sc);
  const int vb0 = (int)(uintptr_t)V_lds + v_rd_base(lane);
  struct { typename St::T vs0, vs1, ks0, ks1; } sr_[SDEPTH];
#define SLOAD(i, k0) do { sr_[i].vs0 = St::ld8(&Vh[(int)((k0) + sr) * LDK + sc]); sr_[i].vs1 = St::ld8(&Vh[(int)((k0) + 32 + sr) * LDK + sc]); \
    sr_[i].ks0 = St::ld8(&Kh[(int)((k0) + sr) * LDK + sc]); sr_[i].ks1 = St::ld8(&Kh[(int)((k0) + 32 + sr) * LDK + sc]); } while (0)
#define SWRITE(b, i) do { *(bf16x8*)((char*)V_lds + (b) * SHM_V + vst0) = St::tobf(sr_[i].vs0);          \
    *(bf16x8*)((char*)V_lds + (b) * SHM_V + vst1) = St::tobf(sr_[i].vs1); int kc = sc * 2;               \
    *(bf16x8*)((char*)K_lds + (b) * SHM_K + KSWZ(sr, kc)) = St::tobf(sr_[i].ks0);                       \
    *(bf16x8*)((char*)K_lds + (b) * SHM_K + KSWZ(32 + sr, kc)) = St::tobf(sr_[i].ks1); } while (0)
#define SWAIT() do { if constexpr (SDEPTH == 2) asm volatile("s_waitcnt vmcnt(4)" ::: "memory"); else asm volatile("s_waitcnt vmcnt(0)" ::: "memory"); } while (0)
#define RESC(a) do { if (__any((a) < 1.f)) { if (hi == 0) al_l[r32] = (a); asm volatile("s_waitcnt lgkmcnt(0)" ::: "memory"); \
    for (int d = 0; d < 4; ++d) for (int r = 0; r < 16; ++r) o[d][r] *= al_l[crow(r, hi)]; } } while (0)
  f32x16 pA0, pA1, pB0, pB1; float mnA, mnB, alA, alB; bf16x8 pa0, pa1, pa2, pa3; const int NT = seq / KVBLK;
  constexpr int SE = 0, SO = SDEPTH - 1;
  SLOAD(SE, 0); asm volatile("s_waitcnt vmcnt(0)" ::: "memory"); SWRITE(0, SE); __syncthreads();
  qkt(pA0, pA1, K_lds, qr, r32, hi); partialSM(pA0, pA1, m_reg, mnA, alA);
  SLOAD(SO, KVBLK); if constexpr (SDEPTH == 2) { if (2 < NT) SLOAD(SE, 2 * KVBLK); }
  SWAIT(); SWRITE(1, SO); __syncthreads();
  for (int j = 1; j + 1 < NT; j += 2) {
    SBAR(); qkt(pB0, pB1, (bf16*)((char*)K_lds + SHM_K), qr, r32, hi);
    finishSM(pA0, pA1, alA, l_reg, pa0, pa1, pa2, pa3); SBAR();
    SLOAD(SO, (j + SDEPTH) * KVBLK); SBAR();
    pv_d0(o, vb0, pa0, pa1, pa2, pa3); partialSM(pB0, pB1, m_reg, mnB, alB);
    __syncthreads(); SWAIT(); SWRITE(0, SE);
    RESC(alB); __syncthreads();
    SBAR(); qkt(pA0, pA1, K_lds, qr, r32, hi);
    finishSM(pB0, pB1, alB, l_reg, pa0, pa1, pa2, pa3); SBAR();
    if (SDEPTH == 1 || j + 3 < NT) SLOAD(SE, (j + 1 + SDEPTH) * KVBLK); SBAR();
    pv_d0(o, vb0 + (int)SHM_V, pa0, pa1, pa2, pa3); partialSM(pA0, pA1, m_reg, mnA, alA);
    __syncthreads(); SWAIT(); SWRITE(1, SO);
    RESC(alA); __syncthreads();
  }
  SBAR(); qkt(pB0, pB1, (bf16*)((char*)K_lds + SHM_K), qr, r32, hi);
  finishSM(pA0, pA1, alA, l_reg, pa0, pa1, pa2, pa3); SBAR();
  pv_d0(o, vb0, pa0, pa1, pa2, pa3); partialSM(pB0, pB1, m_reg, mnB, alB);
  __syncthreads(); RESC(alB);
  finishSM(pB0, pB1, alB, l_reg, pa0, pa1, pa2, pa3); SBAR();
  pv_d0(o, vb0 + (int)SHM_V, pa0, pa1, pa2, pa3);
  if (hi == 0) li_l[r32] = l_reg; asm volatile("s_waitcnt lgkmcnt(0)" ::: "memory");
  float rli[16];
#pragma unroll
  for (int r = 0; r < 16; ++r) rli[r] = __builtin_amdgcn_rcpf(li_l[crow(r, hi)]);
  unsigned short* Ow = Ob + (int)(wid * QBLK) * LDO;
#pragma unroll
  for (int r = 0; r < 16; ++r) { int orow = crow(r, hi);
    for (int d0 = 0; d0 < 4; ++d0) Ow[(int)orow * LDO + d0 * 32 + r32] = (unsigned short)f2bf(o[d0][r] * rli[r]); }
#undef SLOAD
#undef SWRITE
#undef SWAIT
#undef RESC
}

#undef KSWZ
#undef SBAR
}
#define LAS __attribute__((address_space(3)))
constexpr int NWAVES = 8;
constexpr int LDS_BYTES = 147456;
constexpr size_t MiB = (size_t)1 << 20;
constexpr size_t WS_CTL = 0, CTL_ZERO_BYTES = 1 * MiB;
constexpr size_t WS_MODS = 1 * MiB, WS_ROPE = WS_MODS + MiB / 2;
constexpr size_t WS_WT_AIN = 2 * MiB, WS_WT_AOUT = 8 * MiB, WS_WT_DIN = 12 * MiB, WS_WT_DOUT = 29 * MiB, WS_WT_W1 = 33 * MiB, WS_WT_W2 = 65 * MiB;
constexpr size_t WS_X = 97 * MiB, WS_H = 137 * MiB, WS_Y = 157 * MiB, WS_PROJ = 177 * MiB, WS_AB = 257 * MiB;
constexpr size_t WS_SOP = 291 * MiB, WS_QB = 291 * MiB, WS_KB = 311 * MiB, WS_VB = 317 * MiB;
constexpr size_t WS_EGL = 471 * MiB, WS_OF = 472 * MiB, WS_OB = 492 * MiB, WS_END = 512 * MiB;
static_assert(WS_SOP + (size_t)2560 * 73728 <= WS_EGL, "operand records");

struct Ctx {
    LAS unsigned char* lds;
    int tid, lane, wid, gw, ngw, nblk, blk;
};
struct ProPtrs { const float *c, *c_ctx, *w_mod, *b_mod, *attn_w_in, *attn_w_out, *dn_w_in, *dn_w_out, *mlp_w1, *mlp_w2; float *mods, *rope; bf16raw *wt_ain, *wt_aout, *wt_din, *wt_dout, *wt_w1, *wt_w2; };

#define LDS_WAIT() asm volatile("s_waitcnt lgkmcnt(0)" ::: "memory")

__device__ __forceinline__ void p0_transpose_item(const float* W, int K, int N, bf16raw* WT, LAS float* scr, int item, int lane) {
    const int nblk = N / 32, kb = item / nblk, nb = item % nblk, k0 = 64 * kb, n0 = 32 * nb;
#pragma unroll 8
    for (int i = 0; i < 32; ++i) { const int kk = 2 * i + (lane >> 5); scr[kk * 33 + (lane & 31)] = W[(size_t)(k0 + kk) * N + n0 + (lane & 31)]; }
    LDS_WAIT(); asm volatile("" ::: "memory");
    const int c = lane & 7;
#pragma unroll
    for (int j = 0; j < 4; ++j) { const int n = (lane >> 3) + 8 * j; const LAS float* s = scr + (8 * c) * 33 + n;
        u32x4_t o; o.x = pk2(s[0 * 33], s[1 * 33]); o.y = pk2(s[2 * 33], s[3 * 33]); o.z = pk2(s[4 * 33], s[5 * 33]); o.w = pk2(s[6 * 33], s[7 * 33]);
        *(u32x4_t*)(WT + (size_t)(n0 + n) * K + k0 + 8 * c) = o; }
    LDS_WAIT(); asm volatile("" ::: "memory");
}

__device__ __forceinline__ void convert_group(Ctx& C, const ProPtrs& P, int grp, int blk0, int nb) {
    LAS float* scr = (LAS float*)(C.lds + C.wid * 16384);
    const int w = (C.blk - blk0) * NWAVES + C.wid, nw = nb * NWAVES;
    if (grp == 0) {
        constexpr int A = 768, B = 512, W = 2048;
        for (int it = w; it < 2 * (A + B + 2 * W); it += nw) {
            const int jj = it / (A + B + 2 * W), l = 2 * jj; int r = it % (A + B + 2 * W);
            if (r < A) { p0_transpose_item(P.attn_w_in + (size_t)jj * 1024 * 1536, 1024, 1536, P.wt_ain + (size_t)jj * 1536 * 1024, scr, r, C.lane); continue; } r -= A;
            if (r < B) { p0_transpose_item(P.attn_w_out + (size_t)jj * 1024 * 1024, 1024, 1024, P.wt_aout + (size_t)jj * 1024 * 1024, scr, r, C.lane); continue; } r -= B;
            if (r < W) { p0_transpose_item(P.mlp_w1 + (size_t)l * 1024 * 4096, 1024, 4096, P.wt_w1 + (size_t)l * 4096 * 1024, scr, r, C.lane); continue; } r -= W;
            p0_transpose_item(P.mlp_w2 + (size_t)l * 4096 * 1024, 4096, 1024, P.wt_w2 + (size_t)l * 1024 * 4096, scr, r, C.lane);
        }
    } else {
        constexpr int A = 2064, B = 512, W = 2048;
        const int jj = grp - 1, l = 2 * jj + 1;
        for (int it = w; it < A + B + 2 * W; it += nw) {
            int r = it;
            if (r < A) { p0_transpose_item(P.dn_w_in + (size_t)jj * 1024 * DNIN, 1024, DNIN, P.wt_din + (size_t)jj * DNINP * 1024, scr, r, C.lane); continue; } r -= A;
            if (r < B) { p0_transpose_item(P.dn_w_out + (size_t)jj * 1024 * 1024, 1024, 1024, P.wt_dout + (size_t)jj * 1024 * 1024, scr, r, C.lane); continue; } r -= B;
            if (r < W) { p0_transpose_item(P.mlp_w1 + (size_t)l * 1024 * 4096, 1024, 4096, P.wt_w1 + (size_t)l * 4096 * 1024, scr, r, C.lane); continue; } r -= W;
            p0_transpose_item(P.mlp_w2 + (size_t)l * 4096 * 1024, 4096, 1024, P.wt_w2 + (size_t)l * 1024 * 4096, scr, r, C.lane);
        }
    }
}

__device__ __forceinline__ void phase_prologue(Ctx& C, const ProPtrs& P) {
    LAS float* sc = (LAS float*)C.lds;
    LAS float* red = (LAS float*)(C.lds + 12288);
    for (int k = C.tid; k < 1024; k += 512) { sc[k] = silu_f(P.c_ctx[k]); sc[1024 + k] = silu_f(P.c[k]); sc[2048 + k] = silu_f(P.c[1024 + k]); }
    __syncthreads();
    for (int u = C.blk; u < 4 * 96; u += C.nblk) {
        const int l = u / 96, n0 = (u % 96) * 64;
        const float* w = P.w_mod + ((size_t)l * 1024 + C.wid * 128) * 6144 + n0 + C.lane;
        float a0 = 0.f, a1 = 0.f, a2 = 0.f;
#pragma unroll 8
        for (int k = 0; k < 128; ++k) { const float wv = w[(size_t)k * 6144]; const int kk = C.wid * 128 + k; a0 += sc[kk] * wv; a1 += sc[1024 + kk] * wv; a2 += sc[2048 + kk] * wv; }
        red[(C.wid * 3 + 0) * 64 + C.lane] = a0; red[(C.wid * 3 + 1) * 64 + C.lane] = a1; red[(C.wid * 3 + 2) * 64 + C.lane] = a2;
        __syncthreads();
        if (C.tid < 192) { const int s = C.tid >> 6, ln = C.tid & 63; float t = 0.f;
#pragma unroll
            for (int w8 = 0; w8 < 8; ++w8) t += red[(w8 * 3 + s) * 64 + ln];
            P.mods[(size_t)(l * 3 + s) * 6144 + n0 + ln] = t + P.b_mod[l * 6144 + n0 + ln]; }
        __syncthreads();
    }
    __syncthreads();
    convert_group(C, P, 0, 0, C.nblk);
    const int gt = C.blk * 512 + C.tid, ngt = C.nblk * 512;
    for (int i = gt; i < 2 * 28672; i += ngt) { const int j = i / 28672, o = i % 28672;
        *(u32x4_t*)(P.wt_din + ((size_t)j * DNINP + DNIN) * 1024 + (size_t)o * 8) = (u32x4_t){0u, 0u, 0u, 0u}; }
    for (int i = gt; i < 1024 * 64; i += ngt) { const int t = i >> 6, a = (i >> 5) & 1, f = i & 31;
        const float inv = exp2f(-(float)f * (13.287712379549449f / 32.f)); const float ang = (float)(a ? (t & 63) : (t >> 6)) * inv;
        P.rope[2 * i] = __cosf(ang); P.rope[2 * i + 1] = __sinf(ang); }
}

__device__ __forceinline__ void phase_norm(Ctx& C, const float* src_ctx, const float* src_lat, const float* gain, const float* md0, bf16raw* H) {
    for (int row = C.gw; row < MTOK; row += C.ngw) {
        const float* xr = row < NCTX ? src_ctx + (size_t)row * D : src_lat + (size_t)(row - NCTX) * D;
        const float* md = md0 + cond_of(row) * 6144;
        f32x4_t v[4]; float ss = 0.f;
#pragma unroll
        for (int j = 0; j < 4; ++j) { v[j] = *(const f32x4_t*)(xr + 4 * C.lane + 256 * j); ss += (v[j].x * v[j].x + v[j].y * v[j].y) + (v[j].z * v[j].z + v[j].w * v[j].w); }
        const float rinv = rsqrtf(wave_sum(ss, C.lane) * (1.f / D) + EPS);
#pragma unroll
        for (int j = 0; j < 4; ++j) { const int c = 4 * C.lane + 256 * j;
            const f32x4_t g = *(const f32x4_t*)(gain + c), sh = *(const f32x4_t*)(md + c), sc = *(const f32x4_t*)(md + 1024 + c);
            const f32x4_t y = v[j] * rinv * g * (sc + 1.f) + sh;
            u32x2_t o; o.x = pk2(y.x, y.y); o.y = pk2(y.z, y.w);
            *(u32x2_t*)(H + (size_t)row * D + c) = o; }
    }
}
__device__ __forceinline__ void phase_final(Ctx& C, const float* X, const float* final_norm, float* out) {
    for (int row = C.gw; row < MTOK; row += C.ngw) {
        const float* xr = X + (size_t)row * D;
        f32x4_t v[4]; float ss = 0.f;
#pragma unroll
        for (int j = 0; j < 4; ++j) { v[j] = *(const f32x4_t*)(xr + 4 * C.lane + 256 * j); ss += (v[j].x * v[j].x + v[j].y * v[j].y) + (v[j].z * v[j].z + v[j].w * v[j].w); }
        const float rinv = rsqrtf(wave_sum(ss, C.lane) * (1.f / D) + EPS);
#pragma unroll
        for (int j = 0; j < 4; ++j) { const int c = 4 * C.lane + 256 * j; const f32x4_t g = *(const f32x4_t*)(final_norm + c);
            *(f32x4_t*)(out + O_Y + (size_t)row * D + c) = v[j] * rinv * g; }
    }
}

struct QknPtrs { const bf16raw* PROJ; bf16raw *QB, *KB, *VB; const float *qg, *kg, *rope, *cache_k, *cache_v; float* out; };
__device__ __forceinline__ void phase_qkn(Ctx& C, const QknPtrs& P, int j) {
    const unsigned* P32 = (const unsigned*)P.PROJ; unsigned* Q32 = (unsigned*)P.QB; unsigned* K32 = (unsigned*)P.KB; unsigned* V32 = (unsigned*)P.VB;
    const float* qg = P.qg; const float* kg = P.kg;
    const int lane = C.lane;
    const f32x2_t gq = *(const f32x2_t*)(qg + 2 * lane), gk = *(const f32x2_t*)(kg + 2 * lane);
    for (int row = C.gw; row < MTOK; row += C.ngw) {
        const bool lat = row >= NCTX;
        const int b = lat ? (row - NCTX) >> 10 : row >> 8, t = lat ? (row - NCTX) & 1023 : row & 255;
        const int krow = lat ? 8192 + b * 1280 + 256 + t : row;
        f32x4_t rp = (f32x4_t){1.f, 0.f, 1.f, 0.f};
        if (lat) rp = *(const f32x4_t*)(P.rope + ((size_t)t * 64 + (lane >> 5) * 32 + 2 * (lane & 15)) * 2);
        const bool ph = (lane >> 4) & 1;
#pragma unroll
        for (int slot = 0; slot < 12; ++slot) {
            const unsigned w = P32[(size_t)row * 768 + slot * 64 + lane];
            float v0 = bf_lo(w), v1 = bf_hi(w);
            if (slot < 10) {
                const float rinv = rsqrtf(wave_sum(v0 * v0 + v1 * v1, lane) * (1.f / 128.f) + EPS);
                const f32x2_t g = slot < 8 ? gq : gk;
                v0 = v0 * rinv * g.x; v1 = v1 * rinv * g.y;
                if (lat) { const float y0 = lane_xor_f(v0, lane, 16), y1 = lane_xor_f(v1, lane, 16);
                    v0 = v0 * rp.x + (ph ? y0 : -y0) * rp.y; v1 = v1 * rp.z + (ph ? y1 : -y1) * rp.w; }
            }
            const unsigned o = pk2(v0, v1);
            if (slot < 8) Q32[(size_t)row * 512 + slot * 64 + lane] = o;
            else if (slot < 10) K32[(size_t)krow * 128 + (slot - 8) * 64 + lane] = o;
            else V32[(size_t)krow * 128 + (slot - 10) * 64 + lane] = o;
            if (!lat && slot >= 8) { float* op = P.out + (slot < 10 ? O_CK : O_CV) + ((size_t)(b * 2 + j) * 256 + t) * 256 + (slot & 1) * 128 + 2 * lane;
                *(f32x2_t*)op = (f32x2_t){v0, v1}; }
        }
    }
    for (int it = C.gw; it < 2 * 256 * 2; it += C.ngw) {
        const int kv = it & 1, key = (it >> 1) & 255, b = it >> 9;
        const float* src = (kv ? P.cache_v : P.cache_k) + ((size_t)(b * 2 + j) * 256 + key) * 256 + 4 * lane;
        const f32x4_t v = *(const f32x4_t*)src;
        u32x2_t o; o.x = pk2(v.x, v.y); o.y = pk2(v.z, v.w);
        *(u32x2_t*)((kv ? P.VB : P.KB) + (size_t)(8192 + b * 1280 + key) * 256 + 4 * lane) = o;
    }
}

struct AttnPtrs { const bf16raw *QB, *KB, *VB; bf16raw* Y; };
__device__ __forceinline__ void phase_attn(Ctx& C, const AttnPtrs& P) {
    char* lds = (char*)C.lds;
    for (int r = 0; r * C.nblk < 320; ++r) {
        const int u = r * C.nblk + (C.blk + r * (C.nblk - 64)) % C.nblk;
        if (u >= 320) continue;
        int row0, krow0, hq, seq;
        if (u < 64) { const int b = u >> 5, qb = u & 3; hq = (u >> 2) & 7; row0 = NCTX + b * 1024 + qb * 256; krow0 = 8192 + b * 1280; seq = 1280; }
        else { const int c = u - 64, b = c >> 3; hq = c & 7; row0 = b * 256; krow0 = b * 256; seq = 256; }
        const int kvh = hq >> 2;
        if (r > 0) __syncthreads();
        attn::attn_dense_body<attn::bf16>((const attn::bf16*)(P.QB + (size_t)row0 * 1024 + hq * 128), (const attn::bf16*)(P.KB + (size_t)krow0 * 256 + kvh * 128),
                                          (const attn::bf16*)(P.VB + (size_t)krow0 * 256 + kvh * 128), P.Y + (size_t)row0 * 1024 + hq * 128, seq, lds, C.tid);
    }
}
__device__ __forceinline__ void phase_attn_tail(Ctx& C, const ProPtrs& W, int grp) {
    if (C.nblk == 256) { if (C.blk >= 128) { __syncthreads(); convert_group(C, W, grp, 128, 128); } }
    else { __syncthreads(); convert_group(C, W, grp, 0, C.nblk); }
}
struct GatePtrs { const bf16raw *OF, *OB, *PROJ; bf16raw* Y; const float* gain; };
__device__ __forceinline__ void phase_gate(Ctx& C, const GatePtrs& P) {
    const unsigned* F32 = (const unsigned*)P.OF; const unsigned* B32 = (const unsigned*)P.OB; const unsigned* P32 = (const unsigned*)P.PROJ; unsigned* Y32 = (unsigned*)P.Y;
    const int lane = C.lane;
    const f32x2_t g = *(const f32x2_t*)(P.gain + 2 * lane);
    for (int it = C.gw; it < MTOK * 8; it += C.ngw) {
        const int row = it >> 3, h = it & 7;
        const unsigned wf = F32[(size_t)row * 512 + h * 64 + lane], wb = B32[(size_t)row * 512 + h * 64 + lane], wz = P32[(size_t)row * 2048 + 1536 + h * 64 + lane];
        const float v0 = bf_lo(wf) + bf_lo(wb), v1 = bf_hi(wf) + bf_hi(wb);
        const float rinv = rsqrtf(wave_sum(v0 * v0 + v1 * v1, lane) * (1.f / 128.f) + EPS);
        Y32[(size_t)row * 512 + h * 64 + lane] = pk2(v0 * rinv * g.x * silu_f(bf_lo(wz)), v1 * rinv * g.y * silu_f(bf_hi(wz)));
    }
}
constexpr int REC_U = 0, REC_WN = 16384, REC_QT = 32768, REC_QK = 49152, REC_KT = 57344, REC_BYTES = 73728;
typedef short dn_bf16x8 __attribute__((ext_vector_type(8)));
typedef float dn_f32x16 __attribute__((ext_vector_type(16)));
__device__ __forceinline__ int dn_crow(int r, int hi) { return (r & 3) + 8 * (r >> 2) + 4 * hi; }
typedef __bf16 dn_bf16x2 __attribute__((ext_vector_type(2)));
__device__ __forceinline__ unsigned dn_cvt_pk(float lo, float hi) { const f32x2_t v = {lo, hi}; return __builtin_bit_cast(unsigned, __builtin_convertvector(v, dn_bf16x2)); }

struct DnLocalPtrs { const bf16raw* PROJ; const float *AB, *cw, *alog, *dtb; unsigned char* SOP; float* EGL; };

__device__ __forceinline__ void phase_dn_local(Ctx& C, const DnLocalPtrs& P) {
    constexpr int L_Q = 0, L_K = 17408, L_V = 34816, L_GC = 52224, L_BT = 52736, L_AM = 53248, L_QK = L_AM + 2 * 17408, L_TB = L_QK + 2 * 9216;
    LAS unsigned char* L = C.lds;
    const unsigned* P32 = (const unsigned*)P.PROJ;
    LAS float* gcs = (LAS float*)(L + L_GC); LAS float* bts = (LAS float*)(L + L_BT);
    for (int u = C.blk; u < 1280; u += C.nblk) {
        int tid = C.tid; asm volatile("" : "+v"(tid));
        const int lane = tid & 63, wid = __builtin_amdgcn_readfirstlane(tid >> 6), dir = wid >> 2, w4 = wid & 3, t256 = tid & 255, r32 = lane & 31, hi = lane >> 5;
        const int h = u & 7, cidx = u >> 3;
        int npr, N, T, base, cbase;
        if (cidx < 128) { const int seq = cidx >> 2; npr = cidx & 3; N = 4; T = 256; base = seq * 256; cbase = cidx - npr; }
        else { const int c2 = cidx - 128, sq = c2 >> 4; npr = c2 & 15; N = 16; T = 1024; base = NCTX + sq * 1024; cbase = cidx - npr; }
        if (wid < 2) {
            const int tau = wid ? 63 - lane : lane; const size_t row = (size_t)(base + 64 * npr + tau);
            const float a = P.AB[row * 32 + wid * 8 + h], b = P.AB[row * 32 + 16 + wid * 8 + h];
            const float x = a + P.dtb[wid * 8 + h]; const float sp = fmaxf(x, 0.f) + __logf(1.f + __expf(-fabsf(x)));
            float g = -__expf(P.alog[wid * 8 + h]) * sp;
#pragma unroll
            for (int o = 1; o < 64; o <<= 1) { const float t = __builtin_bit_cast(float, __builtin_amdgcn_ds_bpermute((lane - o) << 2, __builtin_bit_cast(int, g))); if (lane >= o) g += t; }
            gcs[wid * 64 + lane] = g; bts[wid * 64 + lane] = 1.f / (1.f + __expf(-b));
        }
        {
            const int tau0 = 8 * wid;
#pragma unroll
            for (int X = 0; X < 3; ++X) {
                const int cb = X * 1024 + h * 128;
                float w0[12], w1[12];
#pragma unroll
                for (int i = 0; i < 12; ++i) { const int tt = 64 * npr + tau0 - 2 + i; unsigned w = 0u;
                    if (tt >= 0 && tt < T) w = P32[(size_t)(base + tt) * 2048 + (cb >> 1) + lane];
                    w0[i] = bf_lo(w); w1[i] = bf_hi(w); }
                f32x2_t cwv[5];
#pragma unroll
                for (int i = 0; i < 5; ++i) cwv[i] = *(const f32x2_t*)(P.cw + i * 3072 + cb + 2 * lane);
#pragma unroll
                for (int r = 0; r < 8; ++r) {
                    float a0 = 0.f, a1 = 0.f;
#pragma unroll
                    for (int i = 0; i < 5; ++i) { a0 += w0[r + i] * cwv[i].x; a1 += w1[r + i] * cwv[i].y; }
                    a0 = silu_f(a0); a1 = silu_f(a1);
                    if (X < 2) { const float rinv = rsqrtf(wave_sum_dpp(a0 * a0 + a1 * a1) + EPS); a0 *= rinv; a1 *= rinv; }
                    *(LAS unsigned*)(L + (X == 0 ? L_Q : X == 1 ? L_K : L_V) + (tau0 + r) * 272 + lane * 4) = pk2(a0, a1);
                }
            }
        }
        __syncthreads();
        {
            const int ti = w4 >> 1, tj = w4 & 1;
            dn_f32x16 accK = {}, accQ = {};
            if (ti >= tj) {
                const int pa = 32 * ti + r32, pb = 32 * tj + r32;
                const int rowA = dir ? 63 - pa : pa, rowB = dir ? 63 - pb : pb;
#pragma unroll
                for (int s = 0; s < 8; ++s) {
                    const int co = (16 * s + 8 * hi) * 2;
                    const dn_bf16x8 Ak = *(const LAS dn_bf16x8*)(L + L_K + rowA * 272 + co), Aq = *(const LAS dn_bf16x8*)(L + L_Q + rowA * 272 + co), Bk = *(const LAS dn_bf16x8*)(L + L_K + rowB * 272 + co);
                    accK = __builtin_amdgcn_mfma_f32_32x32x16_bf16(Ak, Bk, accK, 0, 0, 0);
                    accQ = __builtin_amdgcn_mfma_f32_32x32x16_bf16(Aq, Bk, accQ, 0, 0, 0);
                }
            }
            const int pj = 32 * tj + r32; const float gcj = gcs[dir * 64 + pj];
#pragma unroll
            for (int reg = 0; reg < 16; ++reg) {
                const int pi = 32 * ti + dn_crow(reg, hi);
                const float dec = pi >= pj ? __expf(gcs[dir * 64 + pi] - gcj) : 0.f;
                const float am = pi > pj ? bts[dir * 64 + pi] * accK[reg] * dec : 0.f;
                const float qk = ATT_SCALE * accQ[reg] * dec;
                *(LAS float*)(L + L_AM + dir * 17408 + pi * 272 + pj * 4) = am;
                *(LAS bf16raw*)(L + L_QK + dir * 9216 + pi * 144 + pj * 2) = (bf16raw)f2bf(qk);
            }
        }
        __syncthreads();
        const int rec_n = dir ? N - 1 - npr : npr;
        const int recid = ((cbase + rec_n) * 8 + h) * 2 + dir;
        unsigned char* rec = P.SOP + (size_t)recid * REC_BYTES;
        if (w4 == 0) {
            const LAS unsigned char* am = L + L_AM + dir * 17408;
            float x[64];
            f32x4_t nx[16];
            nx[0] = (f32x4_t){0.f, 0.f, 0.f, 0.f};
#pragma unroll
            for (int i = 0; i < 64; ++i) {
                f32x4_t cu[16];
#pragma unroll
                for (int j4 = 0; j4 < (i + 3) / 4; ++j4) cu[j4] = nx[j4];
                if (i + 1 < 64) {
#pragma unroll
                    for (int j4 = 0; j4 < (i + 4) / 4; ++j4) nx[j4] = *(const LAS f32x4_t*)(am + (i + 1) * 272 + j4 * 16);
                }
                asm volatile("" ::: "memory");
                float acc0 = (i == lane) ? 1.f : 0.f, acc1 = 0.f;
#pragma unroll
                for (int j4 = 0; j4 < (i + 3) / 4; ++j4) {
                    if (4 * j4 + 0 < i) acc0 -= cu[j4].x * x[4 * j4 + 0];
                    if (4 * j4 + 1 < i) acc1 -= cu[j4].y * x[4 * j4 + 1];
                    if (4 * j4 + 2 < i) acc0 -= cu[j4].z * x[4 * j4 + 2];
                    if (4 * j4 + 3 < i) acc1 -= cu[j4].w * x[4 * j4 + 3];
                }
                x[i] = acc0 + acc1;
            }
            LAS unsigned char* tb = L + L_TB + dir * 9216 + lane * 2;
#pragma unroll
            for (int i = 0; i < 64; ++i) *(LAS bf16raw*)(tb + i * 144) = (bf16raw)f2bf(x[i]);
        } else {
            const int t192 = (w4 - 1) * 64 + lane;
            const float glast = gcs[dir * 64 + 63];
            for (int id = t192; id < 1024; id += 192) {
                const int mt = id >> 9, kt = (id >> 6) & 7, r = id & 31, hh = (id >> 5) & 1;
                const int p = 32 * mt + r, dk0 = 32 * (kt >> 1) + 16 * (kt & 1) + 4 * hh;
                const int tau = dir ? 63 - p : p; const float sc = ATT_SCALE * __expf(gcs[dir * 64 + p]);
                const u32x2_t ql = *(const LAS u32x2_t*)(L + L_Q + tau * 272 + dk0 * 2), qh = *(const LAS u32x2_t*)(L + L_Q + tau * 272 + (dk0 + 8) * 2);
                u32x4_t qo; qo.x = dn_cvt_pk(bf_lo(ql.x) * sc, bf_hi(ql.x) * sc); qo.y = dn_cvt_pk(bf_lo(ql.y) * sc, bf_hi(ql.y) * sc);
                qo.z = dn_cvt_pk(bf_lo(qh.x) * sc, bf_hi(qh.x) * sc); qo.w = dn_cvt_pk(bf_lo(qh.y) * sc, bf_hi(qh.y) * sc);
                *(u32x4_t*)(rec + REC_QT + (size_t)id * 16) = qo;
            }
            for (int id = t192; id < 1024; id += 192) {
                const int mt = id >> 8, kt = (id >> 6) & 3, r = id & 31, hh = (id >> 5) & 1;
                const int c0 = 32 * (kt >> 1) + 16 * (kt & 1) + 4 * hh;
                float kv[8];
#pragma unroll
                for (int jj = 0; jj < 8; ++jj) { const int c = c0 + 8 * (jj >> 2) + (jj & 3); const int tau = dir ? 63 - c : c;
                    kv[jj] = bf2f(*(const LAS bf16raw*)(L + L_K + tau * 272 + (32 * mt + r) * 2)) * __expf(glast - gcs[dir * 64 + c]); }
                u32x4_t ko; ko.x = dn_cvt_pk(kv[0], kv[1]); ko.y = dn_cvt_pk(kv[2], kv[3]); ko.z = dn_cvt_pk(kv[4], kv[5]); ko.w = dn_cvt_pk(kv[6], kv[7]);
                *(u32x4_t*)(rec + REC_KT + (size_t)id * 16) = ko;
            }
            for (int id = t192; id < 512; id += 192) {
                const int mt = id >> 8, kt = (id >> 6) & 3, r = id & 31, hh = (id >> 5) & 1;
                const int c0 = 32 * (kt >> 1) + 16 * (kt & 1) + 4 * hh;
                const LAS unsigned char* qp = L + L_QK + dir * 9216 + (32 * mt + r) * 144;
                const u32x2_t qa = *(const LAS u32x2_t*)(qp + c0 * 2), qb = *(const LAS u32x2_t*)(qp + (c0 + 8) * 2);
                *(u32x4_t*)(rec + REC_QK + (size_t)id * 16) = (u32x4_t){qa.x, qa.y, qb.x, qb.y};
            }
            if (t192 == 0) P.EGL[recid] = __expf(glast);
        }
        __syncthreads();
        {
            const bool isK = w4 >= 2;
            const LAS unsigned char* srcb = L + (isK ? L_K : L_V);
            dn_f32x16 acc[2][2] = {};
#pragma unroll
            for (int ks = 0; ks < 4; ++ks) {
                dn_bf16x8 At[2];
#pragma unroll
                for (int mt = 0; mt < 2; ++mt) At[mt] = *(const LAS dn_bf16x8*)(L + L_TB + dir * 9216 + (32 * mt + r32) * 144 + (16 * ks + 8 * hi) * 2);
                float bt[8], eg8[8];
#pragma unroll
                for (int jj = 0; jj < 8; ++jj) { const int jrow = 16 * ks + 8 * hi + jj; bt[jj] = bts[dir * 64 + jrow]; eg8[jj] = isK ? __expf(gcs[dir * 64 + jrow]) : 1.f; }
#pragma unroll
                for (int nl = 0; nl < 2; ++nl) {
                    const int col = (32 * (2 * w4 + nl) + r32) & 127;
                    float rv[8];
#pragma unroll
                    for (int jj = 0; jj < 8; ++jj) { const int jrow = 16 * ks + 8 * hi + jj; const int tau = dir ? 63 - jrow : jrow;
                        rv[jj] = bf2f(*(const LAS bf16raw*)(srcb + tau * 272 + col * 2)) * bt[jj] * eg8[jj]; }
                    u32x4_t bw; bw.x = dn_cvt_pk(rv[0], rv[1]); bw.y = dn_cvt_pk(rv[2], rv[3]); bw.z = dn_cvt_pk(rv[4], rv[5]); bw.w = dn_cvt_pk(rv[6], rv[7]);
                    const dn_bf16x8 Bf = __builtin_bit_cast(dn_bf16x8, bw);
#pragma unroll
                    for (int mt = 0; mt < 2; ++mt) acc[mt][nl] = __builtin_amdgcn_mfma_f32_32x32x16_bf16(At[mt], Bf, acc[mt][nl], 0, 0, 0);
                }
            }
            if (!isK) {
#pragma unroll
                for (int mt = 0; mt < 2; ++mt)
#pragma unroll
                    for (int nl = 0; nl < 2; ++nl) { const dn_f32x16 a = acc[mt][nl];
                        u32x4_t o0, o1; o0.x = dn_cvt_pk(a[0], a[1]); o0.y = dn_cvt_pk(a[2], a[3]); o0.z = dn_cvt_pk(a[4], a[5]); o0.w = dn_cvt_pk(a[6], a[7]);
                        o1.x = dn_cvt_pk(a[8], a[9]); o1.y = dn_cvt_pk(a[10], a[11]); o1.z = dn_cvt_pk(a[12], a[13]); o1.w = dn_cvt_pk(a[14], a[15]);
                        unsigned char* up = rec + REC_U + (size_t)(((mt * 4 + 2 * w4 + nl) * 64 + lane) * 32);
                        *(u32x4_t*)up = o0; *(u32x4_t*)(up + 16) = o1; }
            } else {
#pragma unroll
                for (int mt = 0; mt < 2; ++mt)
#pragma unroll
                    for (int nl = 0; nl < 2; ++nl) { const int dk = 32 * (2 * (w4 - 2) + nl) + r32;
#pragma unroll
                        for (int reg = 0; reg < 16; ++reg) *(LAS bf16raw*)(L + L_AM + dir * 17408 + (32 * mt + dn_crow(reg, hi)) * 264 + dk * 2) = (bf16raw)f2bf(-acc[mt][nl][reg]); }
            }
        }
        __syncthreads();
        {
            const LAS unsigned char* wt = L + L_AM + dir * 17408;
#pragma unroll
            for (int i = 0; i < 4; ++i) {
                const int id = t256 + 256 * i, mt = id >> 9, kt = (id >> 6) & 7, r = id & 31, hh = (id >> 5) & 1;
                const int p = 32 * mt + r, dk0 = 32 * (kt >> 1) + 16 * (kt & 1) + 4 * hh;
                const u32x2_t wl = *(const LAS u32x2_t*)(wt + p * 264 + dk0 * 2), wh = *(const LAS u32x2_t*)(wt + p * 264 + (dk0 + 8) * 2);
                *(u32x4_t*)(rec + REC_WN + (size_t)id * 16) = (u32x4_t){wl.x, wl.y, wh.x, wh.y};
            }
        }
        __syncthreads();
    }
}

struct DnScanPtrs { const unsigned char* SOP; const float *EGL, *state_delta; bf16raw *OF, *OB; float* out; };

__device__ __forceinline__ dn_bf16x8 dn_acc_frag(const dn_f32x16& a, int s) {
    u32x4_t w;
    if (s == 0) { w.x = dn_cvt_pk(a[0], a[1]); w.y = dn_cvt_pk(a[2], a[3]); w.z = dn_cvt_pk(a[4], a[5]); w.w = dn_cvt_pk(a[6], a[7]); }
    else { w.x = dn_cvt_pk(a[8], a[9]); w.y = dn_cvt_pk(a[10], a[11]); w.z = dn_cvt_pk(a[12], a[13]); w.w = dn_cvt_pk(a[14], a[15]); }
    return __builtin_bit_cast(dn_bf16x8, w);
}

__device__ __forceinline__ void phase_dn_scan(Ctx& C, const DnScanPtrs& P, int j) {
    const int slot = C.wid * C.nblk + C.blk, nslot = C.ngw;
    for (int r = 0; r * nslot < 2176; ++r) {
        const int u = r * nslot + (slot + r * (nslot - 128)) % nslot;
        if (u >= 2176) continue;
        int lane = C.lane; asm volatile("" : "+v"(lane));
        const int r32 = lane & 31, hi = lane >> 5;
        int seq, h, dir, sl, N, T, base, cbase; bool lat = u < 128;
        if (lat) { seq = 32 + (u >> 6); h = (u >> 3) & 7; dir = (u >> 2) & 1; sl = u & 3; N = 16; T = 1024; base = NCTX + (seq - 32) * 1024; cbase = 128 + 16 * (seq - 32); }
        else { const int c = u - 128; seq = c >> 6; h = (c >> 3) & 7; dir = (c >> 2) & 1; sl = c & 3; N = 4; T = 256; base = seq * 256; cbase = 4 * seq; }
        dn_f32x16 S[4];
        if (lat) { const float* sp = P.state_delta + ((((size_t)(seq - 32) * 2 + j) * 2 + dir) * 8 + h) * 16384 + 32 * sl + r32;
#pragma unroll
            for (int t4 = 0; t4 < 4; ++t4)
#pragma unroll
                for (int reg = 0; reg < 16; ++reg) S[t4][reg] = sp[(size_t)(32 * t4 + dn_crow(reg, hi)) * 128]; }
        else {
#pragma unroll
            for (int t4 = 0; t4 < 4; ++t4) S[t4] = (dn_f32x16){}; }
        bf16raw* Od = (dir ? P.OB : P.OF) + (size_t)base * 1024 + h * 128 + 32 * sl + r32;
        for (int n = 0; n < N; ++n) {
            const int recid = ((cbase + n) * 8 + h) * 2 + dir;
            const unsigned char* rec = P.SOP + (size_t)recid * REC_BYTES + lane * 16;
            const float eg = P.EGL[recid];
            dn_bf16x8 Sb[8];
#pragma unroll
            for (int kt = 0; kt < 8; ++kt) Sb[kt] = dn_acc_frag(S[kt >> 1], kt & 1);
#define DN_FENCE() asm volatile("" ::: "memory")
#define DN_LD8(F, off) do { _Pragma("unroll") for (int q_ = 0; q_ < 8; ++q_) F[q_] = *(const dn_bf16x8*)(rec + (off) + q_ * 1024); } while (0)
            dn_bf16x8 F[8];
            dn_f32x16 av[2];
#pragma unroll
            for (int mt = 0; mt < 2; ++mt) {
                const unsigned char* up = P.SOP + (size_t)recid * REC_BYTES + REC_U + (size_t)(((mt * 4 + sl) * 64 + lane) * 32);
                const u32x4_t u0 = *(const u32x4_t*)up, u1 = *(const u32x4_t*)(up + 16);
                DN_LD8(F, REC_WN + mt * 8192);
                DN_FENCE();
                dn_f32x16 a;
                a[0] = bf_lo(u0.x); a[1] = bf_hi(u0.x); a[2] = bf_lo(u0.y); a[3] = bf_hi(u0.y); a[4] = bf_lo(u0.z); a[5] = bf_hi(u0.z); a[6] = bf_lo(u0.w); a[7] = bf_hi(u0.w);
                a[8] = bf_lo(u1.x); a[9] = bf_hi(u1.x); a[10] = bf_lo(u1.y); a[11] = bf_hi(u1.y); a[12] = bf_lo(u1.z); a[13] = bf_hi(u1.z); a[14] = bf_lo(u1.w); a[15] = bf_hi(u1.w);
#pragma unroll
                for (int kt = 0; kt < 8; ++kt) a = __builtin_amdgcn_mfma_f32_32x32x16_bf16(F[kt], Sb[kt], a, 0, 0, 0);
                av[mt] = a;
                DN_FENCE();
            }
            dn_bf16x8 vb[4];
#pragma unroll
            for (int kt = 0; kt < 4; ++kt) vb[kt] = dn_acc_frag(av[kt >> 1], kt & 1);
            dn_f32x16 ao[2];
#pragma unroll
            for (int mt = 0; mt < 2; ++mt) {
                DN_LD8(F, REC_QT + mt * 8192);
                DN_FENCE();
                dn_f32x16 a = {};
#pragma unroll
                for (int kt = 0; kt < 8; ++kt) a = __builtin_amdgcn_mfma_f32_32x32x16_bf16(F[kt], Sb[kt], a, 0, 0, 0);
                ao[mt] = a;
                DN_FENCE();
            }
            DN_LD8(F, REC_QK);
            DN_FENCE();
#pragma unroll
            for (int mt = 0; mt < 2; ++mt) {
                dn_f32x16 a = ao[mt];
#pragma unroll
                for (int kt = 0; kt < 4; ++kt) a = __builtin_amdgcn_mfma_f32_32x32x16_bf16(F[mt * 4 + kt], vb[kt], a, 0, 0, 0);
#pragma unroll
                for (int reg = 0; reg < 16; ++reg) { const int p = 64 * n + 32 * mt + dn_crow(reg, hi); const int t = dir ? T - 1 - p : p;
                    Od[(size_t)t * 1024] = (bf16raw)f2bf(a[reg]); }
            }
            DN_FENCE();
#pragma unroll
            for (int t2 = 0; t2 < 2; ++t2) {
                DN_LD8(F, REC_KT + t2 * 8192);
                DN_FENCE();
#pragma unroll
                for (int tt = 0; tt < 2; ++tt) {
                    dn_f32x16 a = S[2 * t2 + tt] * eg;
#pragma unroll
                    for (int kt = 0; kt < 4; ++kt) a = __builtin_amdgcn_mfma_f32_32x32x16_bf16(F[tt * 4 + kt], vb[kt], a, 0, 0, 0);
                    S[2 * t2 + tt] = a;
                }
                DN_FENCE();
            }
#undef DN_FENCE
#undef DN_LD8
        }
        if (!lat) { float* sp = P.out + O_ST + ((((size_t)seq * 2 + j) * 2 + dir) * 8 + h) * 16384 + 32 * sl + r32;
#pragma unroll
            for (int t4 = 0; t4 < 4; ++t4)
#pragma unroll
                for (int reg = 0; reg < 16; ++reg) sp[(size_t)(32 * t4 + dn_crow(reg, hi)) * 128] = S[t4][reg]; }
    }
}

__device__ __forceinline__ void phase_dn_scan2(Ctx& C, const DnScanPtrs& P, int j) {
    LAS unsigned char* L = C.lds;
    const int wid = C.wid; const bool consumer = wid < 4; const int sl = wid & 3;
    const int nun = C.nblk == 256 ? (C.blk < 32 ? 1 : 3) : (544 + C.nblk - 1) / C.nblk;
    for (int ui = 0; ui < nun; ++ui) {
        int sid;
        if (C.nblk == 256) { if (C.blk < 32) sid = C.blk; else { const int c = (C.blk - 32) + 224 * ui; if (c >= 512) break; sid = 32 + c; } }
        else { sid = C.blk + ui * C.nblk; if (sid >= 544) break; }
        int lane = C.lane; asm volatile("" : "+v"(lane));
        const int r32 = lane & 31, hi = lane >> 5;
        int seq, h, dir, N, T, base, cbase; const bool lat = sid < 32;
        if (lat) { seq = 32 + (sid >> 4); h = (sid >> 1) & 7; dir = sid & 1; N = 16; T = 1024; base = NCTX + (seq - 32) * 1024; cbase = 128 + 16 * (seq - 32); }
        else { const int c = sid - 32; seq = c >> 4; h = (c >> 1) & 7; dir = c & 1; N = 4; T = 256; base = seq * 256; cbase = 4 * seq; }
        const int rec0 = (cbase * 8 + h) * 2 + dir;
        const unsigned char* rbase = P.SOP + (size_t)rec0 * REC_BYTES;
        constexpr size_t RSTRIDE = (size_t)16 * REC_BYTES;
#define DN2_BAR() __builtin_amdgcn_s_barrier()
        if (consumer) {
            dn_f32x16 S[4];
            if (lat) { const float* sp = P.state_delta + ((((size_t)(seq - 32) * 2 + j) * 2 + dir) * 8 + h) * 16384 + 32 * sl + r32;
#pragma unroll
                for (int t4 = 0; t4 < 4; ++t4)
#pragma unroll
                    for (int reg = 0; reg < 16; ++reg) S[t4][reg] = sp[(size_t)(32 * t4 + dn_crow(reg, hi)) * 128]; }
            else {
#pragma unroll
                for (int t4 = 0; t4 < 4; ++t4) S[t4] = (dn_f32x16){}; }
            bf16raw* Od = (dir ? P.OB : P.OF) + (size_t)base * 1024 + h * 128 + 32 * sl + r32;
            u32x4_t ua[2][2];
#pragma unroll
            for (int mt = 0; mt < 2; ++mt) { const unsigned char* up = rbase + REC_U + (size_t)(((mt * 4 + sl) * 64 + lane) * 32); ua[mt][0] = *(const u32x4_t*)up; ua[mt][1] = *(const u32x4_t*)(up + 16); }
            int g = 0;
#define DN2_CSYNC() do { asm volatile("s_waitcnt lgkmcnt(0)" ::: "memory"); DN2_BAR(); asm volatile("" ::: "memory"); } while (0)
#define DN2_RD8(F) do { const LAS unsigned char* sp_ = L + (g & 15) * 8192 + lane * 16; _Pragma("unroll") for (int q_ = 0; q_ < 8; ++q_) F[q_] = *(const LAS dn_bf16x8*)(sp_ + q_ * 1024); ++g; } while (0)
            for (int n = 0; n < N; ++n) {
                const float eg = P.EGL[rec0 + 16 * n];
                dn_bf16x8 Sb[8];
#pragma unroll
                for (int kt = 0; kt < 8; ++kt) Sb[kt] = dn_acc_frag(S[kt >> 1], kt & 1);
                dn_bf16x8 F[8];
                dn_f32x16 av[2];
#pragma unroll
                for (int mt = 0; mt < 2; ++mt) {
                    DN2_CSYNC(); DN2_RD8(F);
                    const u32x4_t u0 = ua[mt][0], u1 = ua[mt][1];
                    dn_f32x16 a;
                    a[0] = bf_lo(u0.x); a[1] = bf_hi(u0.x); a[2] = bf_lo(u0.y); a[3] = bf_hi(u0.y); a[4] = bf_lo(u0.z); a[5] = bf_hi(u0.z); a[6] = bf_lo(u0.w); a[7] = bf_hi(u0.w);
                    a[8] = bf_lo(u1.x); a[9] = bf_hi(u1.x); a[10] = bf_lo(u1.y); a[11] = bf_hi(u1.y); a[12] = bf_lo(u1.z); a[13] = bf_hi(u1.z); a[14] = bf_lo(u1.w); a[15] = bf_hi(u1.w);
#pragma unroll
                    for (int kt = 0; kt < 8; ++kt) a = __builtin_amdgcn_mfma_f32_32x32x16_bf16(F[kt], Sb[kt], a, 0, 0, 0);
                    av[mt] = a;
                }
                if (n + 1 < N) {
#pragma unroll
                    for (int mt = 0; mt < 2; ++mt) { const unsigned char* up = rbase + (size_t)(n + 1) * RSTRIDE + REC_U + (size_t)(((mt * 4 + sl) * 64 + lane) * 32); ua[mt][0] = *(const u32x4_t*)up; ua[mt][1] = *(const u32x4_t*)(up + 16); }
                }
                dn_bf16x8 vb[4];
#pragma unroll
                for (int kt = 0; kt < 4; ++kt) vb[kt] = dn_acc_frag(av[kt >> 1], kt & 1);
                dn_f32x16 ao[2];
#pragma unroll
                for (int mt = 0; mt < 2; ++mt) {
                    DN2_CSYNC(); DN2_RD8(F);
                    dn_f32x16 a = {};
#pragma unroll
                    for (int kt = 0; kt < 8; ++kt) a = __builtin_amdgcn_mfma_f32_32x32x16_bf16(F[kt], Sb[kt], a, 0, 0, 0);
                    ao[mt] = a;
                }
                DN2_CSYNC(); DN2_RD8(F);
#pragma unroll
                for (int mt = 0; mt < 2; ++mt) {
                    dn_f32x16 a = ao[mt];
#pragma unroll
                    for (int kt = 0; kt < 4; ++kt) a = __builtin_amdgcn_mfma_f32_32x32x16_bf16(F[mt * 4 + kt], vb[kt], a, 0, 0, 0);
#pragma unroll
                    for (int reg = 0; reg < 16; ++reg) { const int p = 64 * n + 32 * mt + dn_crow(reg, hi); const int t = dir ? T - 1 - p : p;
                        Od[(size_t)t * 1024] = (bf16raw)f2bf(a[reg]); }
                }
#pragma unroll
                for (int t2 = 0; t2 < 2; ++t2) {
                    DN2_CSYNC(); DN2_RD8(F);
#pragma unroll
                    for (int tt = 0; tt < 2; ++tt) {
                        dn_f32x16 a = S[2 * t2 + tt] * eg;
#pragma unroll
                        for (int kt = 0; kt < 4; ++kt) a = __builtin_amdgcn_mfma_f32_32x32x16_bf16(F[tt * 4 + kt], vb[kt], a, 0, 0, 0);
                        S[2 * t2 + tt] = a;
                    }
                }
            }
            DN2_CSYNC();
            if (!lat) { float* sp = P.out + O_ST + ((((size_t)seq * 2 + j) * 2 + dir) * 8 + h) * 16384 + 32 * sl + r32;
#pragma unroll
                for (int t4 = 0; t4 < 4; ++t4)
#pragma unroll
                    for (int reg = 0; reg < 16; ++reg) sp[(size_t)(32 * t4 + dn_crow(reg, hi)) * 128] = S[t4][reg]; }
#undef DN2_CSYNC
#undef DN2_RD8
        } else {
            const int ld = wid - 4;
            int ln = 0, ls = 0;
            const unsigned char* gsrc = rbase + REC_WN + (size_t)(2 * ld) * 1024 + lane * 16;
#define DN2_ISSUE(slot) do { const unsigned char* s_ = gsrc + (size_t)ln * RSTRIDE + ls * 8192; LAS unsigned char* d_ = L + (slot) * 8192 + (2 * ld) * 1024; \
        __builtin_amdgcn_global_load_lds((const unsigned*)s_, (LAS unsigned*)d_, 16, 0, 0); __builtin_amdgcn_global_load_lds((const unsigned*)(s_ + 1024), (LAS unsigned*)(d_ + 1024), 16, 0, 0); \
        if (++ls == 7) { ls = 0; if (ln < N - 1) ++ln; } } while (0)
            for (int q = 0; q < 15; ++q) DN2_ISSUE(q);
            const int G = 7 * N;
            for (int g = 0; g < G; ++g) {
                asm volatile("s_waitcnt vmcnt(28)" ::: "memory");
                DN2_BAR();
                DN2_ISSUE((g + 15) & 15);
            }
            asm volatile("s_waitcnt vmcnt(0)" ::: "memory");
            DN2_BAR();
#undef DN2_ISSUE
        }
#undef DN2_BAR
    }
}
#define XB_TMO      128
#define XB_XCNT(j)  (256  + 64 * (j))
#define XB_XSUB(j)  (1280 + 64 * (j))
#define XB_XGEN(j)  (2304 + 64 * (j))
#define XB_TOP      3328
#define XB_TOPGEN   3392
#define XCD_BAR_WORDS 3456
#define XB_SPIN_CAP (1u << 18)

__device__ __forceinline__ unsigned xb_ld(unsigned* p)              { return __hip_atomic_load(p, __ATOMIC_RELAXED, __HIP_MEMORY_SCOPE_AGENT); }
__device__ __forceinline__ unsigned xb_add(unsigned* p, unsigned v) { return __hip_atomic_fetch_add(p, v, __ATOMIC_RELAXED, __HIP_MEMORY_SCOPE_AGENT); }
__device__ __forceinline__ unsigned xb_xcc_id() { return (unsigned)__builtin_amdgcn_s_getreg((3 << 11) | 20) & 0xFu; }
#define XB_SPIN(cond, bar) do { unsigned _sp = 0; while (cond) { __builtin_amdgcn_s_sleep(1); \
    if ((++_sp & 255u) == 0u) { if (xb_ld(&(bar)[XB_TMO])) break; if (_sp > XB_SPIN_CAP) { atomicAdd(&(bar)[XB_TMO], 1u); break; } } } } while (0)

struct XcdBarrier {
    unsigned* bar; unsigned x;
    volatile LAS unsigned* st;
};

__device__ __forceinline__ XcdBarrier xcd_barrier_post(unsigned* bar, volatile LAS unsigned* st) {
    XcdBarrier b; b.bar = bar; b.x = xb_xcc_id(); b.st = st;
    if (threadIdx.x == 0) (void)xb_add(&bar[XB_XCNT(b.x)], 1u);
    return b;
}
__device__ __forceinline__ void xcd_barrier_complete(unsigned* bar, unsigned x, unsigned& nloc, unsigned& nx) {
    const unsigned G = gridDim.x * gridDim.y * gridDim.z;
    unsigned sum, cnt, mine, sp = 0u;
    for (;;) {
        sum = 0u; cnt = 0u; mine = 0u;
#pragma unroll
        for (unsigned j = 0; j < 16; ++j) { const unsigned c = xb_ld(&bar[XB_XCNT(j)]); sum += c; cnt += (c > 0u) ? 1u : 0u; mine = (j == x) ? c : mine; }
        if (sum == G) break;
        __builtin_amdgcn_s_sleep(1);
        if ((++sp & 255u) == 0u) { if (xb_ld(&bar[XB_TMO])) break; if (sp > XB_SPIN_CAP) { atomicAdd(&bar[XB_TMO], 1u); break; } }
    }
    nloc = mine > 0u ? mine : 1u; nx = cnt > 0u ? cnt : 1u;
}

__device__ __forceinline__ void xcd_barrier(const XcdBarrier& b) {
    asm volatile("s_waitcnt vmcnt(0)" ::: "memory");
    __syncthreads();
    if (threadIdx.x == 0) {
        unsigned* bar = b.bar;
        __builtin_amdgcn_s_waitcnt(0);
        unsigned nloc = b.st[0], nx = b.st[1];
        if (nloc == 0u) { xcd_barrier_complete(bar, b.x, nloc, nx); b.st[0] = nloc; b.st[1] = nx; }
        const unsigned old = xb_add(&bar[XB_XSUB(b.x)], 1u);
        const unsigned gen = old / nloc;
        if (old + 1u == (gen + 1u) * nloc) {
            __builtin_amdgcn_fence(__ATOMIC_RELEASE, "agent");
            asm volatile("s_waitcnt vmcnt(0)" ::: "memory");
            const unsigned og = xb_add(&bar[XB_TOP], 1u);
            const unsigned tg = og / nx;
            if (og + 1u == (tg + 1u) * nx) xb_add(&bar[XB_TOPGEN], 1u);
            else XB_SPIN(xb_ld(&bar[XB_TOPGEN]) == tg, bar);
            __builtin_amdgcn_fence(__ATOMIC_ACQUIRE, "agent");
            xb_add(&bar[XB_XGEN(b.x)], 1u);
            asm volatile("s_waitcnt vmcnt(0)" ::: "memory");
        } else {
            XB_SPIN(xb_ld(&bar[XB_XGEN(b.x)]) == gen, bar);
            __builtin_amdgcn_fence(__ATOMIC_ACQUIRE, "agent");
            asm volatile("s_waitcnt vmcnt(0)" ::: "memory");
        }
    }
    __syncthreads();
}

constexpr int LDSCTL_OFF = 131072, MISC_OFF = LDSCTL_OFF + 320, CW_BAR = 4096;
struct Args { const float* in[24]; float* out; unsigned char* ws; int ph_lo, ph_hi; };
enum { I_XP = 0, I_XS, I_CK, I_CV, I_SD, I_C, I_CCTX, I_WMOD, I_BMOD, I_N1, I_N2, I_AWIN, I_AQG, I_AKG, I_AWOUT, I_DWIN, I_DCONV, I_DALOG, I_DDTB, I_DNORM, I_DWOUT, I_W1, I_W2, I_FN };

__global__ void __launch_bounds__(NWAVES * 64, 2) mk_fwd(Args args) {
    extern __shared__ __attribute__((aligned(16))) unsigned char lds_raw[];
    cg::grid_group grid = cg::this_grid();
    for (int u = threadIdx.x; u < (LDS_BYTES - LDSCTL_OFF) / 4; u += NWAVES * 64) ((LAS unsigned*)((LAS unsigned char*)lds_raw + LDSCTL_OFF))[u] = 0u;
    __syncthreads();
    const XcdBarrier bar = xcd_barrier_post((unsigned*)(args.ws + WS_CTL) + CW_BAR, (volatile LAS unsigned*)((LAS unsigned char*)lds_raw + MISC_OFF) + 8);

    const int lo = args.ph_lo, hi = args.ph_hi;
    int ph = 0;
#define PHASE_BEGIN() if (ph >= lo && ph < hi) { int z = 0; asm volatile("" : "+s"(z)); unsigned char* const ws = args.ws + z; (void)ws; \
    Ctx C; C.lds = (LAS unsigned char*)lds_raw + z; C.tid = threadIdx.x + z; C.lane = C.tid & 63; C.wid = __builtin_amdgcn_readfirstlane(C.tid >> 6); \
    C.nblk = gridDim.x + z; C.blk = blockIdx.x + z; C.gw = C.blk * NWAVES + C.wid; C.ngw = C.nblk * NWAVES;
#ifndef REP_KIND
#define REP_KIND -1
#endif
#define BARX() do { XcdBarrier b2_ = bar; asm volatile("" : "+s"(b2_.bar)); xcd_barrier(b2_); } while (0)
#define PHASE_END() if (ph + 1 < hi) { if (ph == 0) grid.sync(); else BARX(); } } ++ph;
#define INP(i) (args.in[(i) + z])
#define WSF(off) ((float*)(ws + (off)))
#define WSB(off) ((bf16raw*)(ws + (off)))

    PHASE_BEGIN() {
        ProPtrs P{INP(I_C), INP(I_CCTX), INP(I_WMOD), INP(I_BMOD), INP(I_AWIN), INP(I_AWOUT), INP(I_DWIN), INP(I_DWOUT), INP(I_W1), INP(I_W2), WSF(WS_MODS), WSF(WS_ROPE),
                  WSB(WS_WT_AIN), WSB(WS_WT_AOUT), WSB(WS_WT_DIN), WSB(WS_WT_DOUT), WSB(WS_WT_W1), WSB(WS_WT_W2)};
        phase_prologue(C, P); } PHASE_END()
    for (int l = 0; l < 4; ++l) {
        const int j = l >> 1;
        PHASE_BEGIN() { const float* mods_l = WSF(WS_MODS) + (size_t)l * 3 * 6144;
            const float* xs_ctx = l == 0 ? INP(I_XP) : WSF(WS_X); const float* xs_lat = l == 0 ? INP(I_XS) : WSF(WS_X) + (size_t)NCTX * D;
            phase_norm(C, xs_ctx, xs_lat, INP(I_N1) + l * D, mods_l, WSB(WS_H)); } PHASE_END()
        if ((l & 1) == 0) {
            PHASE_BEGIN() { pg8::Gemm g{WSB(WS_H), WSB(WS_WT_AIN) + (size_t)j * QKVW * D, MTOK, QKVW, D, z}; pg8::StaticOrder S; S.init(MTOK, QKVW, C.nblk, C.blk);
                pg8::EpiBf16<0> E{WSB(WS_PROJ), QKVW, nullptr, 0, 0, 1.f};
                pg8::gemm_phase<pg8::EpiBf16<0>, pg8::StaticOrder, true, true>(C.lds, g, S, E); } PHASE_END()
            PHASE_BEGIN() { QknPtrs P{WSB(WS_PROJ), WSB(WS_QB), WSB(WS_KB), WSB(WS_VB), INP(I_AQG) + j * 128, INP(I_AKG) + j * 128, WSF(WS_ROPE), INP(I_CK), INP(I_CV), args.out + z};
                phase_qkn(C, P, j); if (REP_KIND == 3) { BARX(); phase_qkn(C, P, j); } } PHASE_END()
            PHASE_BEGIN() { { AttnPtrs P{WSB(WS_QB), WSB(WS_KB), WSB(WS_VB), WSB(WS_Y)}; phase_attn(C, P); }
                { int z = 0; asm volatile("" : "+s"(z)); unsigned char* const ws = args.ws + z;
                  ProPtrs W{INP(I_C), INP(I_CCTX), INP(I_WMOD), INP(I_BMOD), INP(I_AWIN), INP(I_AWOUT), INP(I_DWIN), INP(I_DWOUT), INP(I_W1), INP(I_W2), WSF(WS_MODS), WSF(WS_ROPE),
                            WSB(WS_WT_AIN), WSB(WS_WT_AOUT), WSB(WS_WT_DIN), WSB(WS_WT_DOUT), WSB(WS_WT_W1), WSB(WS_WT_W2)};
                  phase_attn_tail(C, W, 1 + j); } } PHASE_END()
        } else {
            PHASE_BEGIN() { pg8::Gemm g{WSB(WS_H), WSB(WS_WT_DIN) + (size_t)j * DNINP * D, MTOK, DNINP, D, z}; pg8::StaticOrder S; S.init(MTOK, DNINP, C.nblk, C.blk);
                pg8::EpiDnIn E{WSB(WS_PROJ), WSF(WS_AB)};
                pg8::gemm_phase<pg8::EpiDnIn, pg8::StaticOrder, true, true>(C.lds, g, S, E); } PHASE_END()
            PHASE_BEGIN() { DnLocalPtrs P{WSB(WS_PROJ), WSF(WS_AB), INP(I_DCONV) + (size_t)j * 5 * 3072, INP(I_DALOG) + j * 16, INP(I_DDTB) + j * 16, ws + WS_SOP, WSF(WS_EGL)};
                phase_dn_local(C, P); if (REP_KIND == 6) { BARX(); phase_dn_local(C, P); } } PHASE_END()
            PHASE_BEGIN() { DnScanPtrs P{ws + WS_SOP, WSF(WS_EGL), INP(I_SD), WSB(WS_OF), WSB(WS_OB), args.out + z}; phase_dn_scan2(C, P, j); } PHASE_END()
            PHASE_BEGIN() { GatePtrs P{WSB(WS_OF), WSB(WS_OB), WSB(WS_PROJ), WSB(WS_Y), INP(I_DNORM) + j * 128}; phase_gate(C, P); if (REP_KIND == 8) { BARX(); phase_gate(C, P); } } PHASE_END()
        }
        PHASE_BEGIN() { const float* mods_l = WSF(WS_MODS) + (size_t)l * 3 * 6144;
            const float* xs_ctx = l == 0 ? INP(I_XP) : WSF(WS_X); const float* xs_lat = l == 0 ? INP(I_XS) : WSF(WS_X) + (size_t)NCTX * D;
            pg8::Gemm g{WSB(WS_Y), ((l & 1) ? WSB(WS_WT_DOUT) : WSB(WS_WT_AOUT)) + (size_t)j * D * D, MTOK, D, D, z}; pg8::StaticOrder S; S.init(64 * 256, D, C.nblk, C.blk);
            pg8::EpiRes160 E{xs_ctx, xs_lat, WSF(WS_X), mods_l + 2048};
            pg8::gemm_phase<pg8::EpiRes160, pg8::StaticOrder, true, true, true>(C.lds, g, S, E, NCTX); } PHASE_END()
        PHASE_BEGIN() { const float* mods_l = WSF(WS_MODS) + (size_t)l * 3 * 6144;
            phase_norm(C, WSF(WS_X), WSF(WS_X) + (size_t)NCTX * D, INP(I_N2) + l * D, mods_l + 3072, WSB(WS_H)); } PHASE_END()
        PHASE_BEGIN() { pg8::Gemm g{WSB(WS_H), WSB(WS_WT_W1) + (size_t)l * FF * D, MTOK, FF, D, z}; pg8::StaticOrder S; S.init(MTOK, FF, C.nblk, C.blk);
            pg8::EpiBf16<2> E{WSB(WS_PROJ), FF, nullptr, 0, 0, 1.f};
            pg8::gemm_phase<pg8::EpiBf16<2>, pg8::StaticOrder, true, true>(C.lds, g, S, E); } PHASE_END()
        PHASE_BEGIN() { const float* mods_l = WSF(WS_MODS) + (size_t)l * 3 * 6144;
            pg8::Gemm g{WSB(WS_PROJ), WSB(WS_WT_W2) + (size_t)l * D * FF, MTOK, D, FF, z}; pg8::StaticOrder S; S.init(64 * 256, D, C.nblk, C.blk);
            pg8::EpiRes160 E{WSF(WS_X), WSF(WS_X) + (size_t)NCTX * D, WSF(WS_X), mods_l + 5120};
            pg8::gemm_phase<pg8::EpiRes160, pg8::StaticOrder, true, true, true>(C.lds, g, S, E, NCTX); } PHASE_END()
    }
    PHASE_BEGIN() { phase_final(C, WSF(WS_X), INP(I_FN), args.out + z); } PHASE_END()
#undef PHASE_BEGIN
#undef PHASE_END
}

extern "C" void kernel_launch(void* const* d_in, const int* in_sizes, int n_in, void* d_out, int out_size, void* d_ws, size_t ws_size, hipStream_t stream) {
    static int grid = 0;
    if (grid == 0) {
        if (n_in != 24 || ws_size < WS_END) { fprintf(stderr, "kernel_launch: unexpected n_in %d / ws %zu\n", n_in, ws_size); grid = -1; return; }
        int dev = 0, cus = 0, per_cu = 0;
        if (hipGetDevice(&dev) != hipSuccess || hipDeviceGetAttribute(&cus, hipDeviceAttributeMultiprocessorCount, dev) != hipSuccess) { grid = -1; return; }
        if (hipFuncSetAttribute((const void*)mk_fwd, hipFuncAttributeMaxDynamicSharedMemorySize, LDS_BYTES) != hipSuccess) { fprintf(stderr, "kernel_launch: hipFuncSetAttribute failed\n"); grid = -1; return; }
        if (hipOccupancyMaxActiveBlocksPerMultiprocessor(&per_cu, (const void*)mk_fwd, NWAVES * 64, LDS_BYTES) != hipSuccess || per_cu < 1) { fprintf(stderr, "kernel_launch: occupancy query failed (%d)\n", per_cu); (void)hipGetLastError(); grid = -1; return; }
        grid = cus * 1;
    }
    if (grid < 0) return;
    (void)hipMemsetAsync((char*)d_ws + WS_CTL, 0, CTL_ZERO_BYTES, stream);
    Args a; memset(&a, 0, sizeof(a));
    for (int i = 0; i < 24; ++i) a.in[i] = (const float*)d_in[i];
    a.out = (float*)d_out; a.ws = (unsigned char*)d_ws; a.ph_lo = 0; a.ph_hi = 1000;
    void* kargs[] = {&a};
    hipError_t e = hipLaunchCooperativeKernel((const void*)mk_fwd, dim3(grid), dim3(NWAVES * 64), kargs, LDS_BYTES, stream);
    if (e != hipSuccess) fprintf(stderr, "kernel_launch: cooperative launch failed: %s (grid %d)\n", hipGetErrorString(e), grid);
}
```

```cpp
#include <hip/hip_runtime.h>
#include <hip/hip_cooperative_groups.h>
#include <cstdio>
#include <cstdint>
#include <cstring>
namespace cg = cooperative_groups;

constexpr int D = 1024, NCTX = 8192, NLAT = 2048, MTOK = 10240, FF = 4096;
constexpr int QKVW = 1536, DNIN = 4128, DNINP = 4352, PROJW = 4096;
constexpr int KVROWS = 8192 + 2 * 1280;
constexpr float EPS = 1e-6f;
constexpr float ATT_SCALE = 0.08838834764831845f;
constexpr size_t O_Y = 0, O_CK = (size_t)MTOK * D, O_CV = O_CK + 4194304, O_ST = O_CV + 4194304;

typedef unsigned short bf16raw;
typedef float f32x4_t __attribute__((ext_vector_type(4)));
typedef float f32x2_t __attribute__((ext_vector_type(2)));
typedef unsigned u32x4_t __attribute__((ext_vector_type(4)));
typedef unsigned u32x2_t __attribute__((ext_vector_type(2)));

__device__ __forceinline__ unsigned f2bf(float f) { unsigned u = __builtin_bit_cast(unsigned, f); return (u + 0x7fffu + ((u >> 16) & 1u)) >> 16; }
__device__ __forceinline__ unsigned pk2(float lo, float hi) { return f2bf(lo) | (f2bf(hi) << 16); }
__device__ __forceinline__ float bf_lo(unsigned w) { return __builtin_bit_cast(float, w << 16); }
__device__ __forceinline__ float bf_hi(unsigned w) { return __builtin_bit_cast(float, w & 0xffff0000u); }
__device__ __forceinline__ float bf2f(bf16raw h) { return __builtin_bit_cast(float, (unsigned)h << 16); }
__device__ __forceinline__ float silu_f(float x) { return x / (1.f + __expf(-x)); }
__device__ __forceinline__ int cond_of(int row) { return row < NCTX ? 0 : 1 + ((row - NCTX) >> 10); }
__device__ __forceinline__ float lane_xor_f(float v, int lane, int k) { return __builtin_bit_cast(float, __builtin_amdgcn_ds_bpermute((lane ^ k) << 2, __builtin_bit_cast(int, v))); }
__device__ __forceinline__ float wave_sum(float v, int lane) {
#pragma unroll
    for (int o = 1; o < 64; o <<= 1) v += lane_xor_f(v, lane, o);
    return v;
}
__device__ __forceinline__ float wave_max(float v, int lane) {
#pragma unroll
    for (int o = 1; o < 64; o <<= 1) v = fmaxf(v, lane_xor_f(v, lane, o));
    return v;
}
__device__ __forceinline__ float dpp_xadd(float v, const int ctrl_tag) { return v; }
#define DPP_ADD(v, ctrl) ((v) + __builtin_bit_cast(float, __builtin_amdgcn_update_dpp(0, __builtin_bit_cast(int, (v)), (ctrl), 0xf, 0xf, true)))
__device__ __forceinline__ float wave_sum_dpp(float v) {
    v = DPP_ADD(v, 0xB1); v = DPP_ADD(v, 0x4E); v = DPP_ADD(v, 0x141); v = DPP_ADD(v, 0x140);
    const int iv = __builtin_bit_cast(int, v);
    return (__builtin_bit_cast(float, __builtin_amdgcn_readlane(iv, 0)) + __builtin_bit_cast(float, __builtin_amdgcn_readlane(iv, 16))) +
           (__builtin_bit_cast(float, __builtin_amdgcn_readlane(iv, 32)) + __builtin_bit_cast(float, __builtin_amdgcn_readlane(iv, 48)));
}
namespace pg8 {
#define PG8_LAS __attribute__((address_space(3)))
typedef unsigned short bf16_t;
typedef short bf16x8 __attribute__((ext_vector_type(8)));
typedef float f32x4 __attribute__((ext_vector_type(4)));
typedef unsigned u32x4 __attribute__((ext_vector_type(4)));
constexpr int BM = 256, BK = 64, HALF = 128, HTB = HALF * BK * 2  , STAGE_BYTES = 8 * HTB, NXCD = 8, WGM = 8;

__host__ __device__ __forceinline__ int lds_byte(int r, int c) { const int st = (r >> 4) * 2 + (c >> 5), rr = r & 15, cc = c & 31, ob = rr * 64 + cc * 2; return st * 1024 + (ob ^ (((ob >> 9) & 1) << 5)); }
__host__ __device__ __forceinline__ void stage_rc(int b, int& R, int& C) { const int st = b / 1024, sb = b % 1024, swz = sb ^ (((sb >> 9) & 1) << 5); R = (st >> 1) * 16 + swz / 64; C = (st & 1) * 32 + (swz % 64) / 2; }
__host__ __device__ __forceinline__ int perm32(int rho) { const int n = rho >> 4, i = rho & 15; return 8 * (i >> 2) + 4 * n + (i & 3); }

struct Unit { int pm, pn; };
struct Gemm { const bf16_t* A; const bf16_t* Bt; int M, N, K; int z; };

struct StaticOrder {
    int nM, nN, nwg, G, c;
    __host__ __device__ void init(int M, int N, int G_, int c_) { nM = M / BM; nN = N / BM; nwg = nM * nN; G = G_; c = c_; }
    __host__ __device__ bool next(int i, Unit& u) const {
        const long L = (long)i * G + c; if (L >= nwg) return false;
        int wgid = (int)L; { const int q = nwg / NXCD, r = nwg % NXCD, xcd = wgid % NXCD, off = wgid / NXCD; wgid = (xcd < r ? xcd * (q + 1) : r * (q + 1) + (xcd - r) * q) + off; }
        const int nig = WGM * nN, gid = wgid / nig, fm = gid * WGM, gsz = (nM - fm) < WGM ? (nM - fm) : WGM;
        u.pm = fm + ((wgid % nig) % gsz); u.pn = (wgid % nig) / gsz; return true;
    }
    __device__ __forceinline__ void a_ready(const Unit&) const {}
    __device__ __forceinline__ void done(const Unit&) const {}
};

__device__ __forceinline__ unsigned cvt_pk_bf16(float lo, float hi) { unsigned r; asm volatile("v_cvt_pk_bf16_f32 %0, %1, %2" : "=v"(r) : "v"(lo), "v"(hi)); return r; }
typedef float f32x2 __attribute__((ext_vector_type(2)));
__device__ __forceinline__ f32x2 gelu_pk(f32x2 v) {
    const f32x2 av = __builtin_elementwise_abs(v), d = av * 0.2316418882f + 1.0f;
    f32x2 t; t.x = __builtin_amdgcn_rcpf(d.x); t.y = __builtin_amdgcn_rcpf(d.y);
    f32x2 q = t * 0.5307027145f + (-0.7265760135f); q = q * t + 0.7107068705f; q = q * t + (-0.142248368f); q = q * t + 0.127414796f; q = q * t;
    const f32x2 s = (v * v) * (-0.72134752044f);
    f32x2 e; e.x = __builtin_amdgcn_exp2f(s.x); e.y = __builtin_amdgcn_exp2f(s.y);
    const f32x2 m = v * (q * e), r = v - m;
    f32x2 o; o.x = v.x < 0.f ? m.x : r.x; o.y = v.y < 0.f ? m.y : r.y; return o;
}

template <int ACT  > struct EpiBf16 {
    static constexpr bool PERM = true, AFTER_DRAIN = false; static_assert(ACT >= 0 && ACT <= 2, "EpiBf16: ACT is 0 (none), 1 (gelu_pk) or 2 (squared relu)");
    bf16_t* O; int ldc; const float* bias; int split_cols; size_t split_stride; float scale0;
    __device__ __forceinline__ void operator()(const f32x4 (&acc)[2][2][4][2], const Unit& u, int wr, int wc, int fr, int fq) const {
        const int row0 = u.pm * BM + wr * 64 + fr; int colt = u.pn * BM; bf16_t* base = O;
        float sc = 1.f; if (split_cols) { const int t = colt / split_cols; base += (size_t)t * split_stride; colt -= t * split_cols; if (t == 0) sc = scale0; }
        const int col0 = colt + wc * 32 + 8 * fq, bcol0 = u.pn * BM + wc * 32 + 8 * fq;
        f32x4 bv[2][2];
#pragma unroll
        for (int bj = 0; bj < 2; ++bj)
#pragma unroll
            for (int n = 0; n < 2; ++n) bv[bj][n] = bias ? *(const f32x4*)(bias + bcol0 + bj * HALF + 4 * n) : (f32x4){0.f, 0.f, 0.f, 0.f};
#pragma unroll
        for (int ai = 0; ai < 2; ++ai)
#pragma unroll
            for (int m = 0; m < 4; ++m) { bf16_t* rowp = base + (size_t)(row0 + ai * HALF + m * 16) * ldc + col0;
#pragma unroll
                for (int bj = 0; bj < 2; ++bj) { f32x4 v0 = acc[ai][bj][m][0] + bv[bj][0], v1 = acc[ai][bj][m][1] + bv[bj][1];
                    if (ACT == 1) { f32x2 a = gelu_pk((f32x2){v0[0], v0[1]}), b = gelu_pk((f32x2){v0[2], v0[3]}), c = gelu_pk((f32x2){v1[0], v1[1]}), d = gelu_pk((f32x2){v1[2], v1[3]});
                        v0 = (f32x4){a.x, a.y, b.x, b.y}; v1 = (f32x4){c.x, c.y, d.x, d.y}; }
                    if (ACT == 2) { v0 = __builtin_elementwise_max(v0, (f32x4){0.f, 0.f, 0.f, 0.f}); v1 = __builtin_elementwise_max(v1, (f32x4){0.f, 0.f, 0.f, 0.f}); v0 = v0 * v0; v1 = v1 * v1; }
                    v0 = v0 * sc; v1 = v1 * sc; u32x4 w; w.x = cvt_pk_bf16(v0[0], v0[1]); w.y = cvt_pk_bf16(v0[2], v0[3]); w.z = cvt_pk_bf16(v1[0], v1[1]); w.w = cvt_pk_bf16(v1[2], v1[3]);
                    *(u32x4*)(rowp + bj * HALF) = w; } }
    }
};

struct PanelStats {
    unsigned* xbuf;
    unsigned* cnt;
    unsigned* tmo;
    int ntn; float eps;
    unsigned code;
    __device__ __forceinline__ bool run(const f32x4 (&v)[2][2][4][2], const Unit& u, int wr, int wc, int fr, int fq, PG8_LAS unsigned char* lds, int wid, int lane) const {
        typedef float f32x2v __attribute__((ext_vector_type(2)));
        PG8_LAS f32x2v* P = (PG8_LAS f32x2v*)lds;
        PG8_LAS f32x2v* S = (PG8_LAS f32x2v*)(lds + 8192);
        PG8_LAS unsigned* flag = (PG8_LAS unsigned*)(lds + 8192 + 2048);
#pragma unroll
        for (int ai = 0; ai < 2; ++ai)
#pragma unroll
            for (int m = 0; m < 4; ++m) {
                float s = 0.f;
#pragma unroll
                for (int bj = 0; bj < 2; ++bj)
#pragma unroll
                    for (int n = 0; n < 2; ++n) { const f32x4 x = v[ai][bj][m][n]; s += (x[0] + x[1]) + (x[2] + x[3]); }
                s += __shfl_xor(s, 16); s += __shfl_xor(s, 32);
                const float mw = s * (1.0f / 64.0f); float q = 0.f;
#pragma unroll
                for (int bj = 0; bj < 2; ++bj)
#pragma unroll
                    for (int n = 0; n < 2; ++n) { const f32x4 d = v[ai][bj][m][n] - mw; q += (d[0] * d[0] + d[1] * d[1]) + (d[2] * d[2] + d[3] * d[3]); }
                q += __shfl_xor(q, 16); q += __shfl_xor(q, 32);
                if (fq == 0) P[(ai * HALF + wr * 64 + m * 16 + fr) * 4 + wc] = (f32x2v){mw, q};
            }
        asm volatile("s_waitcnt lgkmcnt(0)" ::: "memory"); __builtin_amdgcn_s_barrier(); asm volatile("" ::: "memory");
#if defined(BROKEN_EXCHANGE_NO_WAIT)
#warning BROKEN CONTROL BUILD: the row-statistics exchange does not wait; results are wrong by design
        if (blockIdx.x >= 64) { const long long t0_ = clock64(); while (clock64() - t0_ < 60000) __builtin_amdgcn_s_sleep(8); }
#endif
        const int row = wid * 32 + (lane & 31);
        if (lane < 32) {
            const f32x2v a = P[row * 4 + 0], b = P[row * 4 + 1], c = P[row * 4 + 2], d = P[row * 4 + 3];
            const float mt = (a.x + b.x + c.x + d.x) * 0.25f;
            const float da = a.x - mt, db = b.x - mt, dc = c.x - mt, dd = d.x - mt;
            const float m2 = (a.y + b.y) + (c.y + d.y) + 64.0f * ((da * da + db * db) + (dc * dc + dd * dd));
            unsigned long long* slot = (unsigned long long*)xbuf + ((size_t)(u.pm * BM + row) * 4 + u.pn);
            __hip_atomic_store(slot, ((unsigned long long)__float_as_uint(m2) << 32) | __float_as_uint(mt), __ATOMIC_RELAXED, __HIP_MEMORY_SCOPE_AGENT);
        }
        asm volatile("s_waitcnt vmcnt(0)" ::: "memory");
        if (lane == 0) __hip_atomic_fetch_add(cnt + 64 * u.pm, 1u, __ATOMIC_RELAXED, __HIP_MEMORY_SCOPE_AGENT);
        if (wid == 0) {
            bool dead = false; const unsigned long long t0 = __builtin_amdgcn_s_memrealtime(); const unsigned want = 8u * (unsigned)ntn;
            for (;;) {
#if defined(BROKEN_EXCHANGE_NO_WAIT)
                break;
#endif
                if ((unsigned)__builtin_amdgcn_readfirstlane(__hip_atomic_load(cnt + 64 * u.pm, __ATOMIC_RELAXED, __HIP_MEMORY_SCOPE_AGENT)) >= want) break;
                if (__builtin_amdgcn_s_memrealtime() - t0 > 2000000ull) {
                    if (lane == 0) { unsigned expect = 0u; __hip_atomic_compare_exchange_strong(tmo + 1, &expect, code | (unsigned)(u.pm & 0xff), __ATOMIC_RELAXED, __ATOMIC_RELAXED, __HIP_MEMORY_SCOPE_AGENT);
                                     __hip_atomic_store(tmo, 1u, __ATOMIC_RELAXED, __HIP_MEMORY_SCOPE_AGENT); }
                    dead = true; break; }
                __builtin_amdgcn_s_sleep(2);
            }
            __builtin_amdgcn_fence(__ATOMIC_ACQUIRE, "agent");
            if (lane == 0) flag[0] = dead ? 1u : 0u;
        }
        asm volatile("s_waitcnt vmcnt(0) lgkmcnt(0)" ::: "memory"); __builtin_amdgcn_s_barrier(); asm volatile("" ::: "memory");
        const bool bad = flag[0] != 0u;
        if (lane < 32) {
            const unsigned long long* slot = (const unsigned long long*)xbuf + (size_t)(u.pm * BM + row) * 4; float mt[4], m2[4]; float ms = 0.f;
#pragma unroll
            for (int t = 0; t < 4; ++t) { if (t < ntn) { const unsigned long long w = __hip_atomic_load(slot + t, __ATOMIC_RELAXED, __HIP_MEMORY_SCOPE_AGENT); mt[t] = __uint_as_float((unsigned)w); m2[t] = __uint_as_float((unsigned)(w >> 32)); } else { mt[t] = 0.f; m2[t] = 0.f; } ms += mt[t]; }
            const float mean = ms / (float)ntn; float q = 0.f;
#pragma unroll
            for (int t = 0; t < 4; ++t) if (t < ntn) { const float dm = mt[t] - mean; q += m2[t] + 256.0f * dm * dm; }
            S[row] = (f32x2v){mean, 1.0f / sqrtf(q / (256.0f * (float)ntn) + eps)};
        }
        asm volatile("s_waitcnt lgkmcnt(0)" ::: "memory"); __builtin_amdgcn_s_barrier(); asm volatile("" ::: "memory");
        return bad;
    }
};
struct EpiLnRes {
    static constexpr bool PERM = false, AFTER_DRAIN = true;
    const float* base; float* out; int ldc; const float* bias; PanelStats st; unsigned poison;
    __device__ __forceinline__ void fused(f32x4 (&acc)[2][2][4][2], const Unit& u, int wr, int wc, int fr, int fq, PG8_LAS unsigned char* lds, int wid, int lane) const {
        typedef float f32x2v __attribute__((ext_vector_type(2)));
        const PG8_LAS f32x2v* S = (const PG8_LAS f32x2v*)(lds + 8192);
        const int col0 = u.pn * BM + wc * 32 + 4 * fq;
#pragma unroll
        for (int bj = 0; bj < 2; ++bj)
#pragma unroll
            for (int n = 0; n < 2; ++n) { const f32x4 bv = bias ? *(const f32x4*)(bias + col0 + bj * HALF + n * 16) : (f32x4){0.f, 0.f, 0.f, 0.f};
#pragma unroll
                for (int ai = 0; ai < 2; ++ai)
#pragma unroll
                    for (int m = 0; m < 4; ++m) acc[ai][bj][m][n] += bv; }
        f32x4 pre[4][2][2];
#pragma unroll
        for (int m = 0; m < 4; ++m) { const size_t off = (size_t)(u.pm * BM + wr * 64 + m * 16 + fr) * ldc + col0;
#pragma unroll
            for (int bj = 0; bj < 2; ++bj)
#pragma unroll
                for (int n = 0; n < 2; ++n) pre[m][bj][n] = *(const f32x4*)(base + off + bj * HALF + n * 16); }
        const bool bad = st.run(acc, u, wr, wc, fr, fq, lds, wid, lane) || poison != 0u;
        const float qnan = __builtin_nanf("");
#pragma unroll
        for (int ai = 0; ai < 2; ++ai)
#pragma unroll
            for (int m = 0; m < 4; ++m) { const int r = ai * HALF + wr * 64 + m * 16 + fr; const f32x2v sr = S[r]; const size_t off = (size_t)(u.pm * BM + r) * ldc + col0;
#pragma unroll
                for (int bj = 0; bj < 2; ++bj)
#pragma unroll
                    for (int n = 0; n < 2; ++n) { const f32x4 bs = ai == 0 ? pre[m][bj][n] : *(const f32x4*)(base + off + bj * HALF + n * 16); f32x4 o = bs + (acc[ai][bj][m][n] - sr.x) * sr.y;
                        if (bad) o = (f32x4){qnan, qnan, qnan, qnan}; *(f32x4*)(out + off + bj * HALF + n * 16) = o; }
                if (m & 1) asm volatile("" ::: "memory"); }
    }
};
struct EpiLnResLn {
    static constexpr bool PERM = false, AFTER_DRAIN = true;
    const float* base; float* out; bf16_t* xn; int ldc; const float* bias; PanelStats st1, st2; unsigned poison;
    __device__ __forceinline__ void fused(f32x4 (&acc)[2][2][4][2], const Unit& u, int wr, int wc, int fr, int fq, PG8_LAS unsigned char* lds, int wid, int lane) const {
        typedef float f32x2v __attribute__((ext_vector_type(2))); typedef unsigned u32x2v __attribute__((ext_vector_type(2)));
        const PG8_LAS f32x2v* S = (const PG8_LAS f32x2v*)(lds + 8192);
        const int col0 = u.pn * BM + wc * 32 + 4 * fq;
#pragma unroll
        for (int bj = 0; bj < 2; ++bj)
#pragma unroll
            for (int n = 0; n < 2; ++n) { const f32x4 bv = bias ? *(const f32x4*)(bias + col0 + bj * HALF + n * 16) : (f32x4){0.f, 0.f, 0.f, 0.f};
#pragma unroll
                for (int ai = 0; ai < 2; ++ai)
#pragma unroll
                    for (int m = 0; m < 4; ++m) acc[ai][bj][m][n] += bv; }
        bool bad = st1.run(acc, u, wr, wc, fr, fq, lds, wid, lane) || poison != 0u;
        const float qnan = __builtin_nanf("");
#pragma unroll
        for (int ai = 0; ai < 2; ++ai)
#pragma unroll
            for (int m = 0; m < 4; ++m) { const int r = ai * HALF + wr * 64 + m * 16 + fr; const f32x2v sr = S[r]; const size_t off = (size_t)(u.pm * BM + r) * ldc + col0;
#pragma unroll
                for (int bj = 0; bj < 2; ++bj)
#pragma unroll
                    for (int n = 0; n < 2; ++n) { const f32x4 bs = *(const f32x4*)(base + off + bj * HALF + n * 16); acc[ai][bj][m][n] = bs + (acc[ai][bj][m][n] - sr.x) * sr.y; }
                asm volatile("" : "+v"(acc[ai][0][m][0]), "+v"(acc[ai][0][m][1]), "+v"(acc[ai][1][m][0]), "+v"(acc[ai][1][m][1]));
                if (m & 1) asm volatile("" ::: "memory"); }
        const bool bad1 = bad;
        bad = st2.run(acc, u, wr, wc, fr, fq, lds, wid, lane) || bad;
#pragma unroll
        for (int ai = 0; ai < 2; ++ai)
#pragma unroll
            for (int m = 0; m < 4; ++m) { const int r = ai * HALF + wr * 64 + m * 16 + fr; const f32x2v sr = S[r]; const size_t off = (size_t)(u.pm * BM + r) * ldc + col0;
#pragma unroll
                for (int bj = 0; bj < 2; ++bj)
#pragma unroll
                    for (int n = 0; n < 2; ++n) { const f32x4 x1 = acc[ai][bj][m][n]; *(f32x4*)(out + off + bj * HALF + n * 16) = bad1 ? (f32x4){qnan, qnan, qnan, qnan} : x1;
                        const f32x4 o = (x1 - sr.x) * sr.y; u32x2v w; w.x = cvt_pk_bf16(o[0], o[1]); w.y = cvt_pk_bf16(o[2], o[3]);
                        if (bad) { w.x = 0x7fc07fc0u; w.y = 0x7fc07fc0u; } *(u32x2v*)(xn + off + bj * HALF + n * 16) = w; }
                asm volatile("" ::: "memory"); }
    }
};

template <class Epi, class Sched, bool ALIGN_EPI = false, bool SP2 = false, bool T160 = false>
__device__ __forceinline__ void gemm_phase(PG8_LAS unsigned char* lds, const Gemm g, const Sched& S, const Epi& E, const int row1 = 0) {
    static_assert(!T160 || SP2, "T160 is implemented on the SP2 loop only");
    const int tid = threadIdx.x + g.z, wid = __builtin_amdgcn_readfirstlane(tid >> 6), lane = tid & 63, wr = wid >> 2, wc = wid & 3, fr = lane & 15, fq = lane >> 4;
    const int K = g.K, nt = K / BK;
    unsigned voffA[2], voffB[2], voffA1[2];
#pragma unroll
    for (int i = 0; i < 2; ++i) { int R, C; stage_rc(tid * 16 + i * 8192, R, C); const int Rb = Epi::PERM ? ((R & ~31) + perm32(R & 31)) : R;
        voffA[i] = (unsigned)(R * K + C) * 2u; voffB[i] = (unsigned)(Rb * K + C) * 2u; voffA1[i] = T160 ? (unsigned)((R & 31) * K + C) * 2u : voffA[i]; }
    const size_t kstep = (size_t)(BK * 2);
    const size_t hstep = (size_t)HALF * K * 2;
    const size_t tstep = 2 * hstep;
    const size_t tstepA = T160 ? hstep : tstep;
    const size_t t1step = (size_t)32 * K * 2;
    const unsigned ldsw = (unsigned)wid * 1024u;
    const int aoff = lds_byte(wr * 64 + fr, fq * 8), boff = lds_byte(wc * 32 + fr, fq * 8), aoff1 = lds_byte(wr * 16 + fr, fq * 8);
#define PG8_SA(b, h) (((b) * 2 + (h)) * HTB)
#define PG8_SB(b, h) ((4 + (b) * 2 + (h)) * HTB)
#define PG8_STAGE(bufoff, gbase, voff) do { _Pragma("unroll") for (int _i = 0; _i < 2; ++_i) \
        __builtin_amdgcn_global_load_lds((const unsigned*)((const char*)(gbase) + (voff)[_i]), (PG8_LAS unsigned*)(lds + (bufoff) + ldsw + _i * 8192), 16, 0, 0); } while (0)
#define PG8_LDA(dst, b, h) do { _Pragma("unroll") for (int m = 0; m < 4; ++m) _Pragma("unroll") for (int k = 0; k < 2; ++k) dst[m][k] = *(const PG8_LAS bf16x8*)(lds + PG8_SA(b, h) + aoff + m * 2048 + k * 1024); } while (0)
#define PG8_LDB(dst, b, h) do { _Pragma("unroll") for (int n = 0; n < 2; ++n) _Pragma("unroll") for (int k = 0; k < 2; ++k) dst[n][k] = *(const PG8_LAS bf16x8*)(lds + PG8_SB(b, h) + boff + n * 2048 + k * 1024); } while (0)
#define PG8_MMA(ai, bj, At, Bt) do { __builtin_amdgcn_s_setprio(1); _Pragma("unroll") for (int m = 0; m < 4; ++m) _Pragma("unroll") for (int n = 0; n < 2; ++n) _Pragma("unroll") for (int k = 0; k < 2; ++k) \
        acc[ai][bj][m][n] = __builtin_amdgcn_mfma_f32_16x16x32_bf16(Bt[n][k], At[m][k], acc[ai][bj][m][n], 0, 0, 0); __builtin_amdgcn_s_setprio(0); } while (0)
#define PG8_LDA1(dst, b) do { if constexpr (T160) { _Pragma("unroll") for (int k = 0; k < 2; ++k) dst[0][k] = *(const PG8_LAS bf16x8*)(lds + PG8_SA(b, 1) + aoff1 + k * 1024); } else { PG8_LDA(dst, b, 1); } } while (0)
#define PG8_MMA1(bj, At, Bt) do { if constexpr (T160) { __builtin_amdgcn_s_setprio(1); _Pragma("unroll") for (int n = 0; n < 2; ++n) _Pragma("unroll") for (int k = 0; k < 2; ++k) \
        acc[1][bj][0][n] = __builtin_amdgcn_mfma_f32_16x16x32_bf16(Bt[n][k], At[0][k], acc[1][bj][0][n], 0, 0, 0); __builtin_amdgcn_s_setprio(0); } else { PG8_MMA(1, bj, At, Bt); } } while (0)
#define PG8_WAIT_V(n) asm volatile("s_waitcnt vmcnt(" #n ")" ::: "memory")
#define PG8_WAIT_L(n) asm volatile("s_waitcnt lgkmcnt(" #n ")" ::: "memory")
#define PG8_BAR __builtin_amdgcn_s_barrier()
#define PG8_SCHED __builtin_amdgcn_sched_barrier(0)
    Unit cur, nxt; int ui = 0;
    if (!S.next(0, cur)) return;
    f32x4 acc[2][2][4][2];
#pragma unroll
    for (int a = 0; a < 2; ++a)
#pragma unroll
        for (int b = 0; b < 2; ++b)
#pragma unroll
            for (int m = 0; m < 4; ++m)
#pragma unroll
                for (int n = 0; n < 2; ++n) acc[a][b][m][n] = (f32x4){0.f, 0.f, 0.f, 0.f};
    bf16x8 At[4][2], B0[2][2], B1[2][2];
    const char* cA = (const char*)g.A + (size_t)cur.pm * tstepA; const char* cB = (const char*)g.Bt + (size_t)cur.pn * tstep;
#define PG8_DA(pm_) (T160 ? (ptrdiff_t)((size_t)row1 * K * 2 + (size_t)(pm_) * t1step) - (ptrdiff_t)((size_t)(pm_) * tstepA) : (ptrdiff_t)hstep)
    ptrdiff_t dA = PG8_DA(cur.pm), dAn = dA;
    S.a_ready(cur);
    if constexpr (SP2) {
        PG8_STAGE(PG8_SB(0, 0), cB, voffB); PG8_STAGE(PG8_SB(0, 1), cB + hstep, voffB); PG8_STAGE(PG8_SA(0, 0), cA, voffA); PG8_STAGE(PG8_SA(0, 1), cA + dA, voffA1);
        if (wr == 1) PG8_BAR;
        PG8_WAIT_V(2); PG8_BAR;
        PG8_STAGE(PG8_SB(1, 0), cB + kstep, voffB); PG8_STAGE(PG8_SA(1, 0), cA + kstep, voffA); PG8_STAGE(PG8_SB(1, 1), cB + hstep + kstep, voffB);
        PG8_WAIT_V(6); PG8_BAR;
    } else {
        PG8_STAGE(PG8_SB(0, 0), cB, voffB); PG8_STAGE(PG8_SA(0, 0), cA, voffA); PG8_STAGE(PG8_SB(0, 1), cB + hstep, voffB); PG8_STAGE(PG8_SA(0, 1), cA + hstep, voffA);
        if (wr == 1) PG8_BAR;
        PG8_WAIT_V(4); PG8_BAR;
        PG8_STAGE(PG8_SB(1, 0), cB + kstep, voffB); PG8_STAGE(PG8_SA(1, 0), cA + kstep, voffA); PG8_STAGE(PG8_SB(1, 1), cB + hstep + kstep, voffB);
        PG8_WAIT_V(6); PG8_BAR;
    }
    for (;;) {
        const bool has_next = S.next(ui + 1, nxt);
        const char* nA = has_next ? (const char*)g.A + (size_t)nxt.pm * tstepA : cA; const char* nB = has_next ? (const char*)g.Bt + (size_t)nxt.pn * tstep : cB;
        dAn = has_next ? PG8_DA(nxt.pm) : dA;
        for (int t = 0; t < nt; t += 2) {
            const bool last = (t == nt - 2);
            const char* a1 = cA + (size_t)(t + 1) * kstep;
            const char* a2 = last ? nA : cA + (size_t)(t + 2) * kstep; const char* b2 = last ? nB : cB + (size_t)(t + 2) * kstep;
            const char* a3 = a2 + kstep; const char* b3 = b2 + kstep;
            const ptrdiff_t d2 = last ? dAn : dA;
            if (last && has_next) S.a_ready(nxt);
            if constexpr (SP2) {
            PG8_LDB(B0, 0, 0); PG8_LDB(B1, 0, 1); PG8_SCHED; PG8_LDA(At, 0, 0); PG8_STAGE(PG8_SA(1, 1), a1 + dA, voffA1);
            PG8_WAIT_V(8); PG8_WAIT_L(0); PG8_BAR; PG8_MMA(0, 0, At, B0); PG8_MMA(0, 1, At, B1); PG8_BAR; PG8_SCHED;
            PG8_LDA1(At, 0); PG8_STAGE(PG8_SB(0, 0), b2, voffB); PG8_STAGE(PG8_SB(0, 1), b2 + hstep, voffB); PG8_STAGE(PG8_SA(0, 0), a2, voffA);
            PG8_WAIT_V(8); PG8_WAIT_L(0); PG8_BAR; PG8_MMA1(0, At, B0); PG8_MMA1(1, At, B1); PG8_BAR; PG8_SCHED;
            PG8_LDB(B0, 1, 0); PG8_LDB(B1, 1, 1); PG8_SCHED; PG8_LDA(At, 1, 0); PG8_STAGE(PG8_SA(0, 1), a2 + d2, voffA1);
            PG8_WAIT_V(8); PG8_WAIT_L(0); PG8_BAR; PG8_MMA(0, 0, At, B0); PG8_MMA(0, 1, At, B1); PG8_BAR; PG8_SCHED;
            PG8_LDA1(At, 1); PG8_STAGE(PG8_SB(1, 0), b3, voffB); PG8_STAGE(PG8_SB(1, 1), b3 + hstep, voffB); PG8_STAGE(PG8_SA(1, 0), a3, voffA);
            PG8_WAIT_V(8); PG8_WAIT_L(0); PG8_BAR; PG8_MMA1(0, At, B0); PG8_MMA1(1, At, B1); PG8_BAR; PG8_SCHED;
            } else {
            PG8_LDB(B0, 0, 0); PG8_SCHED; PG8_LDA(At, 0, 0); PG8_STAGE(PG8_SA(1, 1), a1 + hstep, voffA);
            PG8_WAIT_L(8); PG8_BAR; PG8_WAIT_L(0); PG8_MMA(0, 0, At, B0); PG8_BAR; PG8_SCHED;
            PG8_LDB(B1, 0, 1); PG8_STAGE(PG8_SB(0, 0), b2, voffB);
            PG8_BAR; PG8_WAIT_L(0); PG8_MMA(0, 1, At, B1); PG8_BAR;
            PG8_LDA(At, 0, 1); PG8_STAGE(PG8_SA(0, 0), a2, voffA);
            PG8_BAR; PG8_WAIT_L(0); PG8_MMA(1, 0, At, B0); PG8_BAR; PG8_SCHED;
            PG8_STAGE(PG8_SB(0, 1), b2 + hstep, voffB);
            PG8_WAIT_V(6); PG8_BAR; PG8_MMA(1, 1, At, B1); PG8_BAR;
            PG8_LDB(B0, 1, 0); PG8_SCHED; PG8_LDA(At, 1, 0); PG8_STAGE(PG8_SA(0, 1), a2 + hstep, voffA);
            PG8_WAIT_L(8); PG8_BAR; PG8_WAIT_L(0); PG8_MMA(0, 0, At, B0); PG8_BAR; PG8_SCHED;
            PG8_LDB(B1, 1, 1); PG8_STAGE(PG8_SB(1, 0), b3, voffB);
            PG8_BAR; PG8_WAIT_L(0); PG8_MMA(0, 1, At, B1); PG8_BAR;
            PG8_LDA(At, 1, 1); PG8_STAGE(PG8_SA(1, 0), a3, voffA);
            PG8_BAR; PG8_WAIT_L(0); PG8_MMA(1, 0, At, B0); PG8_BAR; PG8_SCHED;
            PG8_STAGE(PG8_SB(1, 1), b3 + hstep, voffB);
            PG8_WAIT_V(6); PG8_BAR; PG8_MMA(1, 1, At, B1); PG8_BAR;
            }
        }
        if constexpr (ALIGN_EPI) { if (wr == 0) PG8_BAR; }
        if constexpr (!Epi::AFTER_DRAIN) { E(acc, cur, wr, wc, fr, fq); S.done(cur); }
        if (!has_next) break;
#pragma unroll
        for (int a = 0; a < 2; ++a)
#pragma unroll
            for (int b = 0; b < 2; ++b)
#pragma unroll
                for (int m = 0; m < 4; ++m)
#pragma unroll
                    for (int n = 0; n < 2; ++n) acc[a][b][m][n] = (f32x4){0.f, 0.f, 0.f, 0.f};
        cur = nxt; cA = nA; cB = nB; dA = dAn; ++ui;
        if constexpr (ALIGN_EPI) { if (wr == 1) PG8_BAR; }
    }
    PG8_WAIT_V(0);
    if constexpr (!ALIGN_EPI) { if (wr == 0) PG8_BAR; }
    PG8_BAR;
    if constexpr (Epi::AFTER_DRAIN) { E.fused(acc, cur, wr, wc, fr, fq, lds, wid, lane); S.done(cur); }
#undef PG8_SA
#undef PG8_SB
#undef PG8_STAGE
#undef PG8_LDA
#undef PG8_LDB
#undef PG8_MMA
#undef PG8_WAIT_V
#undef PG8_LDA1
#undef PG8_MMA1
#undef PG8_DA
#undef PG8_WAIT_L
#undef PG8_BAR
#undef PG8_SCHED
}
}

#ifndef PG8_SP2
#define PG8_SP2 true
#endif
#ifndef PG8_ALIGN
#define PG8_ALIGN true
#endif
namespace pg8 {
typedef __bf16 bf16x2v __attribute__((ext_vector_type(2))); typedef float f32x2v_ __attribute__((ext_vector_type(2)));
__device__ __forceinline__ unsigned cvt_pk_vis(float lo, float hi) { const f32x2v_ v = {lo, hi}; return __builtin_bit_cast(unsigned, __builtin_convertvector(v, bf16x2v)); }
struct EpiRes {
    static constexpr bool PERM = false, AFTER_DRAIN = false;
    const float* src_ctx; const float* src_lat; float* X; const float* gate;
    __device__ __forceinline__ void operator()(const f32x4 (&acc)[2][2][4][2], const Unit& u, int wr, int wc, int fr, int fq) const {
        const int cond = u.pm < 32 ? 0 : 1 + ((u.pm - 32) >> 2);
        const float* g = gate + cond * 6144;
        const float* sb = u.pm < 32 ? src_ctx + (size_t)u.pm * BM * 1024 : src_lat + (size_t)(u.pm - 32) * BM * 1024;
        float* xb = X + (size_t)u.pm * BM * 1024;
        const int col0 = u.pn * BM + wc * 32 + 4 * fq;
        f32x4 gv[2][2];
#pragma unroll
        for (int bj = 0; bj < 2; ++bj)
#pragma unroll
            for (int n = 0; n < 2; ++n) gv[bj][n] = *(const f32x4*)(g + col0 + bj * HALF + n * 16);
#pragma unroll
        for (int ai = 0; ai < 2; ++ai)
#pragma unroll
            for (int m = 0; m < 4; ++m) { const size_t off = (size_t)(ai * HALF + wr * 64 + m * 16 + fr) * 1024 + col0;
#pragma unroll
                for (int bj = 0; bj < 2; ++bj)
#pragma unroll
                    for (int n = 0; n < 2; ++n) { const f32x4 xv = *(const f32x4*)(sb + off + bj * HALF + n * 16);
                        *(f32x4*)(xb + off + bj * HALF + n * 16) = xv + gv[bj][n] * acc[ai][bj][m][n]; } }
    }
};
struct EpiRes160 {
    static constexpr bool PERM = true, AFTER_DRAIN = false;
    bf16_t* X; const float* gate;
    __device__ __forceinline__ void operator()(const f32x4 (&acc)[2][2][4][2], const Unit& u, int wr, int wc, int fr, int fq) const {
        const int col0 = u.pn * BM + wc * 32 + 8 * fq;
        const int cond1 = 1 + (u.pm >> 5);
        bf16_t* xb0 = X + (size_t)u.pm * 128 * 1024 + col0; bf16_t* xb1 = X + ((size_t)NCTX + 32 * u.pm) * 1024 + col0;
        u32x4 xv[5][2]; f32x4 gv[2][2][2];
#pragma unroll
        for (int bj = 0; bj < 2; ++bj) {
#pragma unroll
            for (int n = 0; n < 2; ++n) { gv[0][bj][n] = *(const f32x4*)(gate + col0 + bj * HALF + 4 * n); gv[1][bj][n] = *(const f32x4*)(gate + cond1 * 6144 + col0 + bj * HALF + 4 * n); }
#pragma unroll
            for (int m = 0; m < 4; ++m) xv[m][bj] = *(const u32x4*)(xb0 + (size_t)(wr * 64 + m * 16 + fr) * 1024 + bj * HALF);
            xv[4][bj] = *(const u32x4*)(xb1 + (size_t)(wr * 16 + fr) * 1024 + bj * HALF); }
#pragma unroll
        for (int m = 0; m < 5; ++m) {
            const int hs = m < 4 ? 0 : 1;
            bf16_t* rowp = m < 4 ? xb0 + (size_t)(wr * 64 + m * 16 + fr) * 1024 : xb1 + (size_t)(wr * 16 + fr) * 1024;
#pragma unroll
            for (int bj = 0; bj < 2; ++bj) {
                const f32x4 a0 = m < 4 ? acc[0][bj][m < 4 ? m : 0][0] : acc[1][bj][0][0], a1 = m < 4 ? acc[0][bj][m < 4 ? m : 0][1] : acc[1][bj][0][1];
                const u32x4 x = xv[m][bj];
                const f32x4 x0 = {__builtin_bit_cast(float, x.x << 16), __builtin_bit_cast(float, x.x & 0xffff0000u), __builtin_bit_cast(float, x.y << 16), __builtin_bit_cast(float, x.y & 0xffff0000u)};
                const f32x4 x1 = {__builtin_bit_cast(float, x.z << 16), __builtin_bit_cast(float, x.z & 0xffff0000u), __builtin_bit_cast(float, x.w << 16), __builtin_bit_cast(float, x.w & 0xffff0000u)};
                const f32x4 y0 = x0 + gv[hs][bj][0] * a0, y1 = x1 + gv[hs][bj][1] * a1;
                u32x4 w; w.x = cvt_pk_vis(y0[0], y0[1]); w.y = cvt_pk_vis(y0[2], y0[3]); w.z = cvt_pk_vis(y1[0], y1[1]); w.w = cvt_pk_vis(y1[2], y1[3]);
                *(u32x4*)(rowp + bj * HALF) = w; }
        }
    }
};
struct EpiDnIn {
    static constexpr bool PERM = true, AFTER_DRAIN = false;
    bf16_t* O; float* AB;
    __device__ __forceinline__ void operator()(const f32x4 (&acc)[2][2][4][2], const Unit& u, int wr, int wc, int fr, int fq) const {
        const int row0 = u.pm * BM + wr * 64 + fr;
        if (u.pn < 16) {
            const int col0 = u.pn * BM + wc * 32 + 8 * fq;
#pragma unroll
            for (int ai = 0; ai < 2; ++ai)
#pragma unroll
                for (int m = 0; m < 4; ++m) { bf16_t* rowp = O + (size_t)(row0 + ai * HALF + m * 16) * 4096 + col0;
#pragma unroll
                    for (int bj = 0; bj < 2; ++bj) { const f32x4 v0 = acc[ai][bj][m][0], v1 = acc[ai][bj][m][1];
                        u32x4 w; w.x = cvt_pk_vis(v0[0], v0[1]); w.y = cvt_pk_vis(v0[2], v0[3]); w.z = cvt_pk_vis(v1[0], v1[1]); w.w = cvt_pk_vis(v1[2], v1[3]);
                        *(u32x4*)(rowp + bj * HALF) = w; } }
        } else if (wc == 0) {
#pragma unroll
            for (int ai = 0; ai < 2; ++ai)
#pragma unroll
                for (int m = 0; m < 4; ++m) { float* rp = AB + (size_t)(row0 + ai * HALF + m * 16) * 32 + 8 * fq;
                    *(f32x4*)rp = acc[ai][0][m][0]; *(f32x4*)(rp + 4) = acc[ai][0][m][1]; }
        }
    }
};
}
#include <hip/hip_bf16.h>
namespace attn {
using bf16 = __hip_bfloat16;
constexpr int D = 128, NW = 8, QBLK = 32, KVBLK = 64;
constexpr float SCALE = 0.088388347648318440f;
constexpr float THR = 8.f;
constexpr int SDEPTH = 2;
constexpr int LDQ = 1024, LDK = 256, LDO = 1024;
constexpr size_t SHM_V = KVBLK * D * 2, SHM_K = KVBLK * D * 2, SHM_ATTN = 2 * SHM_V + 2 * SHM_K + NW * 64 * 4;
using bf16x8 = __attribute__((ext_vector_type(8))) short;
using s16x4  = __attribute__((ext_vector_type(4))) short;
using f32x16 = __attribute__((ext_vector_type(16))) float;
using f32x8  = __attribute__((ext_vector_type(8))) float;
using u32x4  = __attribute__((ext_vector_type(4))) unsigned;
#define KSWZ(row, colB) ((row) * 256 + ((colB) ^ (((row) & 7) << 4)))
#define SBAR() __builtin_amdgcn_sched_barrier(0)
__device__ __forceinline__ int crow(int r, int hi) { return (r & 3) + 8 * (r >> 2) + 4 * hi; }
__device__ __forceinline__ unsigned cvtpk(float lo, float hi) {
  unsigned r; asm volatile("v_cvt_pk_bf16_f32 %0, %1, %2" : "=v"(r) : "v"(lo), "v"(hi)); return r;
}
template <typename TIn> struct Stage;
template <> struct Stage<bf16>  { using T = bf16x8;
  __device__ static __forceinline__ T ld8(const bf16* p) { return *reinterpret_cast<const bf16x8*>(p); }
  __device__ static __forceinline__ bf16x8 tobf(T x) { return x; } };
template <> struct Stage<float> { using T = f32x8;
  __device__ static __forceinline__ T ld8(const float* p) { return *reinterpret_cast<const f32x8*>(p); }
  __device__ static __forceinline__ bf16x8 tobf(T x) {
    u32x4 w = {cvtpk(x[0], x[1]), cvtpk(x[2], x[3]), cvtpk(x[4], x[5]), cvtpk(x[6], x[7])}; return *reinterpret_cast<bf16x8*>(&w); } };

__device__ __forceinline__ void partialSM(f32x16& p0, f32x16& p1, float& m_reg, float& mn, float& alpha) {
  constexpr float C = SCALE * 1.4426950408889634f;
  float pmax = p0[0]; for (int r = 1; r < 16; ++r) pmax = fmaxf(pmax, p0[r]); for (int r = 0; r < 16; ++r) pmax = fmaxf(pmax, p1[r]);
  { auto rr = __builtin_amdgcn_permlane32_swap(__float_as_uint(pmax), __float_as_uint(pmax), false, false);
    pmax = fmaxf(__uint_as_float(rr[0]), __uint_as_float(rr[1])); }
  if (__builtin_expect(__all(pmax - m_reg <= THR / SCALE), 1)) { mn = m_reg; alpha = 1.f; }
  else { mn = fmaxf(m_reg, pmax); alpha = __builtin_amdgcn_exp2f((m_reg - mn) * C); m_reg = mn; }
  float mnC = -mn * C;
  for (int r = 0; r < 16; ++r) p0[r] = fmaf(p0[r], C, mnC); for (int r = 0; r < 16; ++r) p1[r] = fmaf(p1[r], C, mnC);
  for (int r = 0; r < 16; ++r) p0[r] = __builtin_amdgcn_exp2f(p0[r]);
}
__device__ __forceinline__ void finishSM(f32x16& p0, f32x16& p1, float alpha, float& l_reg, bf16x8& pa0, bf16x8& pa1, bf16x8& pa2, bf16x8& pa3) {
  for (int r = 0; r < 16; ++r) p1[r] = __builtin_amdgcn_exp2f(p1[r]);
  float ps = 0; for (int r = 0; r < 16; ++r) ps += p0[r]; for (int r = 0; r < 16; ++r) ps += p1[r];
  { auto rr = __builtin_amdgcn_permlane32_swap(__float_as_uint(ps), __float_as_uint(ps), false, false);
    ps = __uint_as_float(rr[0]) + __uint_as_float(rr[1]); }
  l_reg = l_reg * alpha + ps;
#define PK4(P, BASE, OUT) do { unsigned a0 = cvtpk(P[BASE + 0], P[BASE + 1]), a1 = cvtpk(P[BASE + 2], P[BASE + 3]);   \
    unsigned b0 = cvtpk(P[BASE + 4], P[BASE + 5]), b1 = cvtpk(P[BASE + 6], P[BASE + 7]);                              \
    auto r0 = __builtin_amdgcn_permlane32_swap(a0, b0, false, false); auto r1 = __builtin_amdgcn_permlane32_swap(a1, b1, false, false); \
    u32x4 w = {r0[0], r1[0], r0[1], r1[1]}; OUT = *reinterpret_cast<bf16x8*>(&w); } while (0)
  PK4(p0, 0, pa0); PK4(p0, 8, pa1); PK4(p1, 0, pa2); PK4(p1, 8, pa3);
#undef PK4
}
__device__ __forceinline__ void qkt(f32x16& p0, f32x16& p1, const bf16* Ks, const bf16x8* qr, int r32, int hi) {
  p0 = f32x16{}; p1 = f32x16{};
  for (int d0 = 0; d0 < 8; ++d0) { int cb = (d0 * 16 + hi * 8) * 2;
    bf16x8 b0 = *reinterpret_cast<const bf16x8*>((const char*)Ks + KSWZ(r32, cb));
    bf16x8 b1 = *reinterpret_cast<const bf16x8*>((const char*)Ks + KSWZ(32 + r32, cb));
    p0 = __builtin_amdgcn_mfma_f32_32x32x16_bf16(b0, qr[d0], p0, 0, 0, 0);
    p1 = __builtin_amdgcn_mfma_f32_32x32x16_bf16(b1, qr[d0], p1, 0, 0, 0); }
}
__device__ __forceinline__ int v_st(int k, int c) { const int kk = (k & ~0xC) | ((k & 4) << 1) | ((k & 8) >> 1); return ((kk >> 3) * 4 + (c >> 5)) * 512 + ((kk & 7) * 32 + (c & 31)) * 2; }
__device__ __forceinline__ int v_rd_base(int lane) { return ((lane & 3) << 3) | (((lane >> 2) & 3) << 6) | (((lane >> 4) & 1) << 5) | (((lane >> 5) & 1) << 8); }
constexpr int v_rd_off(int d0, int ks, int half) { return d0 * 512 + ks * 4096 + half * 2048; }
template <int OFF> __device__ __forceinline__ s16x4 tr_read(int vb) {
  s16x4 r; asm volatile("ds_read_b64_tr_b16 %0, %1 offset:%2" : "=&v"(r) : "v"(vb), "i"(OFF) : "memory"); return r;
}
template <int D0> __device__ __forceinline__ void pv_one(f32x16& od, int vb, bf16x8 pa0, bf16x8 pa1, bf16x8 pa2, bf16x8 pa3) {
  const s16x4 l0 = tr_read<v_rd_off(D0, 0, 0)>(vb), h0 = tr_read<v_rd_off(D0, 0, 1)>(vb), l1 = tr_read<v_rd_off(D0, 1, 0)>(vb), h1 = tr_read<v_rd_off(D0, 1, 1)>(vb);
  const s16x4 l2 = tr_read<v_rd_off(D0, 2, 0)>(vb), h2 = tr_read<v_rd_off(D0, 2, 1)>(vb), l3 = tr_read<v_rd_off(D0, 3, 0)>(vb), h3 = tr_read<v_rd_off(D0, 3, 1)>(vb);
  asm volatile("s_waitcnt lgkmcnt(0)" ::: "memory"); SBAR();
#define PK(L, H) (bf16x8){L[0], L[1], L[2], L[3], H[0], H[1], H[2], H[3]}
  od = __builtin_amdgcn_mfma_f32_32x32x16_bf16(pa0, PK(l0, h0), od, 0, 0, 0);
  od = __builtin_amdgcn_mfma_f32_32x32x16_bf16(pa1, PK(l1, h1), od, 0, 0, 0);
  od = __builtin_amdgcn_mfma_f32_32x32x16_bf16(pa2, PK(l2, h2), od, 0, 0, 0);
  od = __builtin_amdgcn_mfma_f32_32x32x16_bf16(pa3, PK(l3, h3), od, 0, 0, 0);
#undef PK
}
__device__ __forceinline__ void pv_d0(f32x16* o, int vb, bf16x8 pa0, bf16x8 pa1, bf16x8 pa2, bf16x8 pa3) {
  pv_one<0>(o[0], vb, pa0, pa1, pa2, pa3); pv_one<1>(o[1], vb, pa0, pa1, pa2, pa3); pv_one<2>(o[2], vb, pa0, pa1, pa2, pa3); pv_one<3>(o[3], vb, pa0, pa1, pa2, pa3);
}

template <typename TQ>
__device__ __forceinline__ void attn_dense_body(const TQ* __restrict__ Qb, const bf16* __restrict__ Kh, const bf16* __restrict__ Vh,
                                                unsigned short* __restrict__ Ob, int seq, char* lds, const int tid) {
  using St = Stage<bf16>; using SQ = Stage<TQ>;
  const int wid = tid >> 6, lane = tid & 63, r32 = lane & 31, hi = lane >> 5;
  bf16* V_lds = (bf16*)lds; bf16* K_lds = (bf16*)(lds + 2 * SHM_V);
  float* ws = (float*)(lds + 2 * SHM_V + 2 * SHM_K) + wid * 64; float* li_l = ws; float* al_l = ws + 32;
  float m_reg = -1e30f, l_reg = 0; f32x16 o[4] = {}; bf16x8 qr[8];
  const TQ* Qw = Qb + (int)(wid * QBLK + r32) * LDQ + hi * 8;
#pragma unroll
  for (int d0 = 0; d0 < 8; ++d0) qr[d0] = SQ::tobf(SQ::ld8(Qw + d0 * 16));
  const int sr = tid >> 4, sc = (tid & 15) * 8, vst0 = v_st(sr, sc), vst1 = v_st(32 + sr, sc);
  const int vb0 = (int)(uintptr_t)V_lds + v_rd_base(lane);
  struct { typename St::T vs0, vs1, ks0, ks1; } sr_[SDEPTH];
#define SLOAD(i, k0) do { sr_[i].vs0 = St::ld8(&Vh[(int)((k0) + sr) * LDK + sc]); sr_[i].vs1 = St::ld8(&Vh[(int)((k0) + 32 + sr) * LDK + sc]); \
    sr_[i].ks0 = St::ld8(&Kh[(int)((k0) + sr) * LDK + sc]); sr_[i].ks1 = St::ld8(&Kh[(int)((k0) + 32 + sr) * LDK + sc]); } while (0)
#define SWRITE(b, i) do { *(bf16x8*)((char*)V_lds + (b) * SHM_V + vst0) = St::tobf(sr_[i].vs0);          \
    *(bf16x8*)((char*)V_lds + (b) * SHM_V + vst1) = St::tobf(sr_[i].vs1); int kc = sc * 2;               \
    *(bf16x8*)((char*)K_lds + (b) * SHM_K + KSWZ(sr, kc)) = St::tobf(sr_[i].ks0);                       \
    *(bf16x8*)((char*)K_lds + (b) * SHM_K + KSWZ(32 + sr, kc)) = St::tobf(sr_[i].ks1); } while (0)
#define SWAIT() do { if constexpr (SDEPTH == 2) asm volatile("s_waitcnt vmcnt(4)" ::: "memory"); else asm volatile("s_waitcnt vmcnt(0)" ::: "memory"); } while (0)
#define RESC(a) do { if (__any((a) < 1.f)) { if (hi == 0) al_l[r32] = (a); asm volatile("s_waitcnt lgkmcnt(0)" ::: "memory"); \
    for (int d = 0; d < 4; ++d) for (int r = 0; r < 16; ++r) o[d][r] *= al_l[crow(r, hi)]; } } while (0)
  f32x16 pA0, pA1, pB0, pB1; float mnA, mnB, alA, alB; bf16x8 pa0, pa1, pa2, pa3; const int NT = seq / KVBLK;
  constexpr int SE = 0, SO = SDEPTH - 1;
  SLOAD(SE, 0); asm volatile("s_waitcnt vmcnt(0)" ::: "memory"); SWRITE(0, SE); __syncthreads();
  qkt(pA0, pA1, K_lds, qr, r32, hi); partialSM(pA0, pA1, m_reg, mnA, alA);
  SLOAD(SO, KVBLK); if constexpr (SDEPTH == 2) { if (2 < NT) SLOAD(SE, 2 * KVBLK); }
  SWAIT(); SWRITE(1, SO); __syncthreads();
  for (int j = 1; j + 1 < NT; j += 2) {
    SBAR(); qkt(pB0, pB1, (bf16*)((char*)K_lds + SHM_K), qr, r32, hi);
    finishSM(pA0, pA1, alA, l_reg, pa0, pa1, pa2, pa3); SBAR();
    SLOAD(SO, (j + SDEPTH) * KVBLK); SBAR();
    pv_d0(o, vb0, pa0, pa1, pa2, pa3); partialSM(pB0, pB1, m_reg, mnB, alB);
    __syncthreads(); SWAIT(); SWRITE(0, SE);
    RESC(alB); __syncthreads();
    SBAR(); qkt(pA0, pA1, K_lds, qr, r32, hi);
    finishSM(pB0, pB1, alB, l_reg, pa0, pa1, pa2, pa3); SBAR();
    if (SDEPTH == 1 || j + 3 < NT) SLOAD(SE, (j + 1 + SDEPTH) * KVBLK); SBAR();
    pv_d0(o, vb0 + (int)SHM_V, pa0, pa1, pa2, pa3); partialSM(pA0, pA1, m_reg, mnA, alA);
    __syncthreads(); SWAIT(); SWRITE(1, SO);
    RESC(alA); __syncthreads();
  }
  SBAR(); qkt(pB0, pB1, (bf16*)((char*)K_lds + SHM_K), qr, r32, hi);
  finishSM(pA0, pA1, alA, l_reg, pa0, pa1, pa2, pa3); SBAR();
  pv_d0(o, vb0, pa0, pa1, pa2, pa3); partialSM(pB0, pB1, m_reg, mnB, alB);
  __syncthreads(); RESC(alB);
  finishSM(pB0, pB1, alB, l_reg, pa0, pa1, pa2, pa3); SBAR();
  pv_d0(o, vb0 + (int)SHM_V, pa0, pa1, pa2, pa3);
  if (hi == 0) li_l[r32] = l_reg; asm volatile("s_waitcnt lgkmcnt(0)" ::: "memory");
  float rli[16];
#pragma unroll
  for (int r = 0; r < 16; ++r) rli[r] = __builtin_amdgcn_rcpf(li_l[crow(r, hi)]);
  unsigned short* Ow = Ob + (int)(wid * QBLK) * LDO;
#pragma unroll
  for (int r = 0; r < 16; ++r) { int orow = crow(r, hi);
    for (int d0 = 0; d0 < 4; ++d0) Ow[(int)orow * LDO + d0 * 32 + r32] = (unsigned short)f2bf(o[d0][r] * rli[r]); }
#undef SLOAD
#undef SWRITE
#undef SWAIT
#undef RESC
}

#undef KSWZ
#undef SBAR
}
#define LAS __attribute__((address_space(3)))
constexpr int NWAVES = 8;
constexpr int LDS_BYTES = 147456;
constexpr size_t MiB = (size_t)1 << 20;
constexpr size_t WS_CTL = 0, CTL_ZERO_BYTES = 1 * MiB;
constexpr size_t WS_MODS = 1 * MiB, WS_ROPE = WS_MODS + MiB / 2;
constexpr size_t WS_WT_AIN = 2 * MiB, WS_WT_AOUT = 8 * MiB, WS_WT_DIN = 12 * MiB, WS_WT_DOUT = 29 * MiB, WS_WT_W1 = 33 * MiB, WS_WT_W2 = 65 * MiB;
constexpr size_t WS_X = 97 * MiB, WS_H = 137 * MiB, WS_Y = 157 * MiB, WS_PROJ = 177 * MiB, WS_AB = 257 * MiB;
constexpr size_t WS_SOP = 291 * MiB, WS_QB = 291 * MiB, WS_KB = 311 * MiB, WS_VB = 317 * MiB;
constexpr size_t WS_EGL = 471 * MiB, WS_OF = 472 * MiB, WS_OB = 492 * MiB, WS_END = 512 * MiB;
static_assert(WS_SOP + (size_t)2560 * 73728 <= WS_EGL, "operand records");

struct Ctx {
    LAS unsigned char* lds;
    int tid, lane, wid, gw, ngw, nblk, blk;
};
struct ProPtrs { const float *c, *c_ctx, *w_mod, *b_mod, *attn_w_in, *attn_w_out, *dn_w_in, *dn_w_out, *mlp_w1, *mlp_w2; float *mods, *rope; bf16raw *wt_ain, *wt_aout, *wt_din, *wt_dout, *wt_w1, *wt_w2; const float *x_prompt, *x_sample; bf16raw* X; };

#define LDS_WAIT() asm volatile("s_waitcnt lgkmcnt(0)" ::: "memory")

__device__ __forceinline__ void p0_transpose_item(const float* W, int K, int N, bf16raw* WT, LAS float* scr, int item, int lane) {
    const int nblk = N / 32, kb = item / nblk, nb = item % nblk, k0 = 64 * kb, n0 = 32 * nb;
#pragma unroll 8
    for (int i = 0; i < 32; ++i) { const int kk = 2 * i + (lane >> 5); scr[kk * 33 + (lane & 31)] = W[(size_t)(k0 + kk) * N + n0 + (lane & 31)]; }
    LDS_WAIT(); asm volatile("" ::: "memory");
    const int c = lane & 7;
#pragma unroll
    for (int j = 0; j < 4; ++j) { const int n = (lane >> 3) + 8 * j; const LAS float* s = scr + (8 * c) * 33 + n;
        u32x4_t o; o.x = pk2(s[0 * 33], s[1 * 33]); o.y = pk2(s[2 * 33], s[3 * 33]); o.z = pk2(s[4 * 33], s[5 * 33]); o.w = pk2(s[6 * 33], s[7 * 33]);
        *(u32x4_t*)(WT + (size_t)(n0 + n) * K + k0 + 8 * c) = o; }
    LDS_WAIT(); asm volatile("" ::: "memory");
}

__device__ __forceinline__ void phase_prologue(Ctx& C, const ProPtrs& P) {
    LAS float* sc = (LAS float*)C.lds;
    LAS float* red = (LAS float*)(C.lds + 12288);
    for (int k = C.tid; k < 1024; k += 512) { sc[k] = silu_f(P.c_ctx[k]); sc[1024 + k] = silu_f(P.c[k]); sc[2048 + k] = silu_f(P.c[1024 + k]); }
    __syncthreads();
    for (int u = C.blk; u < 4 * 96; u += C.nblk) {
        const int l = u / 96, n0 = (u % 96) * 64;
        const float* w = P.w_mod + ((size_t)l * 1024 + C.wid * 128) * 6144 + n0 + C.lane;
        float a0 = 0.f, a1 = 0.f, a2 = 0.f;
#pragma unroll 8
        for (int k = 0; k < 128; ++k) { const float wv = w[(size_t)k * 6144]; const int kk = C.wid * 128 + k; a0 += sc[kk] * wv; a1 += sc[1024 + kk] * wv; a2 += sc[2048 + kk] * wv; }
        red[(C.wid * 3 + 0) * 64 + C.lane] = a0; red[(C.wid * 3 + 1) * 64 + C.lane] = a1; red[(C.wid * 3 + 2) * 64 + C.lane] = a2;
        __syncthreads();
        if (C.tid < 192) { const int s = C.tid >> 6, ln = C.tid & 63; float t = 0.f;
#pragma unroll
            for (int w8 = 0; w8 < 8; ++w8) t += red[(w8 * 3 + s) * 64 + ln];
            P.mods[(size_t)(l * 3 + s) * 6144 + n0 + ln] = t + P.b_mod[l * 6144 + n0 + ln]; }
        __syncthreads();
    }
    __syncthreads();
    LAS float* scr = (LAS float*)(C.lds + C.wid * 16384);
    constexpr int I0 = 2 * 768, I1 = 2 * 512, I2 = 2 * 2064, I3 = 2 * 512, I4 = 4 * 2048, I5 = 4 * 2048;
    for (int it = C.gw; it < I0 + I1 + I2 + I3 + I4 + I5; it += C.ngw) {
        int r = it;
        if (r < I0) { const int j = r / 768; p0_transpose_item(P.attn_w_in + (size_t)j * 1024 * 1536, 1024, 1536, P.wt_ain + (size_t)j * 1536 * 1024, scr, r % 768, C.lane); continue; } r -= I0;
        if (r < I1) { const int j = r / 512; p0_transpose_item(P.attn_w_out + (size_t)j * 1024 * 1024, 1024, 1024, P.wt_aout + (size_t)j * 1024 * 1024, scr, r % 512, C.lane); continue; } r -= I1;
        if (r < I2) { const int j = r / 2064; p0_transpose_item(P.dn_w_in + (size_t)j * 1024 * DNIN, 1024, DNIN, P.wt_din + (size_t)j * DNINP * 1024, scr, r % 2064, C.lane); continue; } r -= I2;
        if (r < I3) { const int j = r / 512; p0_transpose_item(P.dn_w_out + (size_t)j * 1024 * 1024, 1024, 1024, P.wt_dout + (size_t)j * 1024 * 1024, scr, r % 512, C.lane); continue; } r -= I3;
        if (r < I4) { const int l = r / 2048; p0_transpose_item(P.mlp_w1 + (size_t)l * 1024 * 4096, 1024, 4096, P.wt_w1 + (size_t)l * 4096 * 1024, scr, r % 2048, C.lane); continue; } r -= I4;
        { const int l = r / 2048; p0_transpose_item(P.mlp_w2 + (size_t)l * 4096 * 1024, 4096, 1024, P.wt_w2 + (size_t)l * 1024 * 4096, scr, r % 2048, C.lane); }
    }
    for (int i = C.blk * 512 + C.tid; i < MTOK * D / 8; i += C.nblk * 512) { const size_t e = (size_t)i * 8;
        const float* src = e < (size_t)NCTX * D ? P.x_prompt + e : P.x_sample + (e - (size_t)NCTX * D);
        const f32x4_t a = *(const f32x4_t*)src, b = *(const f32x4_t*)(src + 4);
        *(u32x4_t*)(P.X + e) = (u32x4_t){pk2(a.x, a.y), pk2(a.z, a.w), pk2(b.x, b.y), pk2(b.z, b.w)}; }
    const int gt = C.blk * 512 + C.tid, ngt = C.nblk * 512;
    for (int i = gt; i < 2 * 28672; i += ngt) { const int j = i / 28672, o = i % 28672;
        *(u32x4_t*)(P.wt_din + ((size_t)j * DNINP + DNIN) * 1024 + (size_t)o * 8) = (u32x4_t){0u, 0u, 0u, 0u}; }
    for (int i = gt; i < 1024 * 64; i += ngt) { const int t = i >> 6, a = (i >> 5) & 1, f = i & 31;
        const float inv = exp2f(-(float)f * (13.287712379549449f / 32.f)); const float ang = (float)(a ? (t & 63) : (t >> 6)) * inv;
        P.rope[2 * i] = __cosf(ang); P.rope[2 * i + 1] = __sinf(ang); }
}

__device__ __forceinline__ void phase_norm(Ctx& C, const bf16raw* X, const float* gain, const float* md0, bf16raw* H) {
    for (int row = C.gw; row < MTOK; row += C.ngw) {
        const float* md = md0 + cond_of(row) * 6144;
        float v[2][8]; float ss = 0.f;
#pragma unroll
        for (int j = 0; j < 2; ++j) { const u32x4_t w = *(const u32x4_t*)(X + (size_t)row * D + 8 * C.lane + 512 * j);
            v[j][0] = bf_lo(w.x); v[j][1] = bf_hi(w.x); v[j][2] = bf_lo(w.y); v[j][3] = bf_hi(w.y); v[j][4] = bf_lo(w.z); v[j][5] = bf_hi(w.z); v[j][6] = bf_lo(w.w); v[j][7] = bf_hi(w.w);
#pragma unroll
            for (int q = 0; q < 8; ++q) ss += v[j][q] * v[j][q]; }
        const float rinv = rsqrtf(wave_sum_dpp(ss) * (1.f / D) + EPS);
#pragma unroll
        for (int j = 0; j < 2; ++j) { const int c = 8 * C.lane + 512 * j; float y[8];
#pragma unroll
            for (int q = 0; q < 2; ++q) { const f32x4_t g = *(const f32x4_t*)(gain + c + 4 * q), sh = *(const f32x4_t*)(md + c + 4 * q), sc = *(const f32x4_t*)(md + 1024 + c + 4 * q);
                y[4 * q + 0] = v[j][4 * q + 0] * rinv * g.x * (sc.x + 1.f) + sh.x; y[4 * q + 1] = v[j][4 * q + 1] * rinv * g.y * (sc.y + 1.f) + sh.y;
                y[4 * q + 2] = v[j][4 * q + 2] * rinv * g.z * (sc.z + 1.f) + sh.z; y[4 * q + 3] = v[j][4 * q + 3] * rinv * g.w * (sc.w + 1.f) + sh.w; }
            *(u32x4_t*)(H + (size_t)row * D + c) = (u32x4_t){pk2(y[0], y[1]), pk2(y[2], y[3]), pk2(y[4], y[5]), pk2(y[6], y[7])}; }
    }
}
__device__ __forceinline__ void phase_final(Ctx& C, const bf16raw* X, const float* final_norm, float* out) {
    for (int row = C.gw; row < MTOK; row += C.ngw) {
        float v[2][8]; float ss = 0.f;
#pragma unroll
        for (int j = 0; j < 2; ++j) { const u32x4_t w = *(const u32x4_t*)(X + (size_t)row * D + 8 * C.lane + 512 * j);
            v[j][0] = bf_lo(w.x); v[j][1] = bf_hi(w.x); v[j][2] = bf_lo(w.y); v[j][3] = bf_hi(w.y); v[j][4] = bf_lo(w.z); v[j][5] = bf_hi(w.z); v[j][6] = bf_lo(w.w); v[j][7] = bf_hi(w.w);
#pragma unroll
            for (int q = 0; q < 8; ++q) ss += v[j][q] * v[j][q]; }
        const float rinv = rsqrtf(wave_sum_dpp(ss) * (1.f / D) + EPS);
#pragma unroll
        for (int j = 0; j < 2; ++j) { const int c = 8 * C.lane + 512 * j;
#pragma unroll
            for (int q = 0; q < 2; ++q) { const f32x4_t g = *(const f32x4_t*)(final_norm + c + 4 * q);
                *(f32x4_t*)(out + O_Y + (size_t)row * D + c + 4 * q) = (f32x4_t){v[j][4 * q] * rinv * g.x, v[j][4 * q + 1] * rinv * g.y, v[j][4 * q + 2] * rinv * g.z, v[j][4 * q + 3] * rinv * g.w}; } }
    }
}

struct QknPtrs { const bf16raw* PROJ; bf16raw *QB, *KB, *VB; const float *qg, *kg, *rope, *cache_k, *cache_v; float* out; };
__device__ __forceinline__ void phase_qkn(Ctx& C, const QknPtrs& P, int j) {
    const unsigned* P32 = (const unsigned*)P.PROJ; unsigned* Q32 = (unsigned*)P.QB; unsigned* K32 = (unsigned*)P.KB; unsigned* V32 = (unsigned*)P.VB;
    const float* qg = P.qg; const float* kg = P.kg;
    const int lane = C.lane;
    const f32x2_t gq = *(const f32x2_t*)(qg + 2 * lane), gk = *(const f32x2_t*)(kg + 2 * lane);
    for (int row = C.gw; row < MTOK; row += C.ngw) {
        const bool lat = row >= NCTX;
        const int b = lat ? (row - NCTX) >> 10 : row >> 8, t = lat ? (row - NCTX) & 1023 : row & 255;
        const int krow = lat ? 8192 + b * 1280 + 256 + t : row;
        f32x4_t rp = (f32x4_t){1.f, 0.f, 1.f, 0.f};
        if (lat) rp = *(const f32x4_t*)(P.rope + ((size_t)t * 64 + (lane >> 5) * 32 + 2 * (lane & 15)) * 2);
        const bool ph = (lane >> 4) & 1;
#pragma unroll
        for (int slot = 0; slot < 12; ++slot) {
            const unsigned w = P32[(size_t)row * 768 + slot * 64 + lane];
            float v0 = bf_lo(w), v1 = bf_hi(w);
            if (slot < 10) {
                const float rinv = rsqrtf(wave_sum(v0 * v0 + v1 * v1, lane) * (1.f / 128.f) + EPS);
                const f32x2_t g = slot < 8 ? gq : gk;
                v0 = v0 * rinv * g.x; v1 = v1 * rinv * g.y;
                if (lat) { const float y0 = lane_xor_f(v0, lane, 16), y1 = lane_xor_f(v1, lane, 16);
                    v0 = v0 * rp.x + (ph ? y0 : -y0) * rp.y; v1 = v1 * rp.z + (ph ? y1 : -y1) * rp.w; }
            }
            const unsigned o = pk2(v0, v1);
            if (slot < 8) Q32[(size_t)row * 512 + slot * 64 + lane] = o;
            else if (slot < 10) K32[(size_t)krow * 128 + (slot - 8) * 64 + lane] = o;
            else V32[(size_t)krow * 128 + (slot - 10) * 64 + lane] = o;
            if (!lat && slot >= 8) { float* op = P.out + (slot < 10 ? O_CK : O_CV) + ((size_t)(b * 2 + j) * 256 + t) * 256 + (slot & 1) * 128 + 2 * lane;
                *(f32x2_t*)op = (f32x2_t){v0, v1}; }
        }
    }
    for (int it = C.gw; it < 2 * 256 * 2; it += C.ngw) {
        const int kv = it & 1, key = (it >> 1) & 255, b = it >> 9;
        const float* src = (kv ? P.cache_v : P.cache_k) + ((size_t)(b * 2 + j) * 256 + key) * 256 + 4 * lane;
        const f32x4_t v = *(const f32x4_t*)src;
        u32x2_t o; o.x = pk2(v.x, v.y); o.y = pk2(v.z, v.w);
        *(u32x2_t*)((kv ? P.VB : P.KB) + (size_t)(8192 + b * 1280 + key) * 256 + 4 * lane) = o;
    }
}

struct AttnPtrs { const bf16raw *QB, *KB, *VB; bf16raw* Y; };
__device__ __forceinline__ void phase_attn(Ctx& C, const AttnPtrs& P) {
    char* lds = (char*)C.lds;
    for (int r = 0; r * C.nblk < 320; ++r) {
        const int u = r * C.nblk + (C.blk + r * (C.nblk - 64)) % C.nblk;
        if (u >= 320) continue;
        int row0, krow0, hq, seq;
        if (u < 64) { const int b = u >> 5, qb = u & 3; hq = (u >> 2) & 7; row0 = NCTX + b * 1024 + qb * 256; krow0 = 8192 + b * 1280; seq = 1280; }
        else { const int c = u - 64, b = c >> 3; hq = c & 7; row0 = b * 256; krow0 = b * 256; seq = 256; }
        const int kvh = hq >> 2;
        if (r > 0) __syncthreads();
        attn::attn_dense_body<attn::bf16>((const attn::bf16*)(P.QB + (size_t)row0 * 1024 + hq * 128), (const attn::bf16*)(P.KB + (size_t)krow0 * 256 + kvh * 128),
                                          (const attn::bf16*)(P.VB + (size_t)krow0 * 256 + kvh * 128), P.Y + (size_t)row0 * 1024 + hq * 128, seq, lds, C.tid);
    }
}
struct GatePtrs { const bf16raw *OF, *OB, *PROJ; bf16raw* Y; const float* gain; };
__device__ __forceinline__ void phase_gate(Ctx& C, const GatePtrs& P) {
    const unsigned* F32 = (const unsigned*)P.OF; const unsigned* B32 = (const unsigned*)P.OB; const unsigned* P32 = (const unsigned*)P.PROJ; unsigned* Y32 = (unsigned*)P.Y;
    const int lane = C.lane;
    const f32x2_t g = *(const f32x2_t*)(P.gain + 2 * lane);
    for (int it = C.gw; it < MTOK * 8; it += C.ngw) {
        const int row = it >> 3, h = it & 7;
        const unsigned wf = F32[(size_t)row * 512 + h * 64 + lane], wb = B32[(size_t)row * 512 + h * 64 + lane], wz = P32[(size_t)row * 2048 + 1536 + h * 64 + lane];
        const float v0 = bf_lo(wf) + bf_lo(wb), v1 = bf_hi(wf) + bf_hi(wb);
        const float rinv = rsqrtf(wave_sum(v0 * v0 + v1 * v1, lane) * (1.f / 128.f) + EPS);
        Y32[(size_t)row * 512 + h * 64 + lane] = pk2(v0 * rinv * g.x * silu_f(bf_lo(wz)), v1 * rinv * g.y * silu_f(bf_hi(wz)));
    }
}
constexpr int REC_U = 0, REC_WN = 16384, REC_QT = 32768, REC_QK = 49152, REC_KT = 57344, REC_BYTES = 73728;
typedef short dn_bf16x8 __attribute__((ext_vector_type(8)));
typedef float dn_f32x16 __attribute__((ext_vector_type(16)));
__device__ __forceinline__ int dn_crow(int r, int hi) { return (r & 3) + 8 * (r >> 2) + 4 * hi; }
typedef __bf16 dn_bf16x2 __attribute__((ext_vector_type(2)));
__device__ __forceinline__ unsigned dn_cvt_pk(float lo, float hi) { const f32x2_t v = {lo, hi}; return __builtin_bit_cast(unsigned, __builtin_convertvector(v, dn_bf16x2)); }

struct DnLocalPtrs { const bf16raw* PROJ; const float *AB, *cw, *alog, *dtb; unsigned char* SOP; float* EGL; };

__device__ __forceinline__ void phase_dn_local(Ctx& C, const DnLocalPtrs& P) {
    constexpr int L_Q = 0, L_K = 17408, L_V = 34816, L_GC = 52224, L_BT = 52736, L_AM = 53248, L_QK = L_AM + 2 * 17408, L_TB = L_QK + 2 * 9216;
    LAS unsigned char* L = C.lds;
    const unsigned* P32 = (const unsigned*)P.PROJ;
    LAS float* gcs = (LAS float*)(L + L_GC); LAS float* bts = (LAS float*)(L + L_BT);
    for (int u = C.blk; u < 1280; u += C.nblk) {
        int tid = C.tid; asm volatile("" : "+v"(tid));
        const int lane = tid & 63, wid = __builtin_amdgcn_readfirstlane(tid >> 6), dir = wid >> 2, w4 = wid & 3, t256 = tid & 255, r32 = lane & 31, hi = lane >> 5;
        const int h = u & 7, cidx = u >> 3;
        int npr, N, T, base, cbase;
        if (cidx < 128) { const int seq = cidx >> 2; npr = cidx & 3; N = 4; T = 256; base = seq * 256; cbase = cidx - npr; }
        else { const int c2 = cidx - 128, sq = c2 >> 4; npr = c2 & 15; N = 16; T = 1024; base = NCTX + sq * 1024; cbase = cidx - npr; }
        if (wid < 2) {
            const int tau = wid ? 63 - lane : lane; const size_t row = (size_t)(base + 64 * npr + tau);
            const float a = P.AB[row * 32 + wid * 8 + h], b = P.AB[row * 32 + 16 + wid * 8 + h];
            const float x = a + P.dtb[wid * 8 + h]; const float sp = fmaxf(x, 0.f) + __logf(1.f + __expf(-fabsf(x)));
            float g = -__expf(P.alog[wid * 8 + h]) * sp;
#pragma unroll
            for (int o = 1; o < 64; o <<= 1) { const float t = __builtin_bit_cast(float, __builtin_amdgcn_ds_bpermute((lane - o) << 2, __builtin_bit_cast(int, g))); if (lane >= o) g += t; }
            gcs[wid * 64 + lane] = g; bts[wid * 64 + lane] = 1.f / (1.f + __expf(-b));
        }
        {
            const int tau0 = 8 * wid;
#pragma unroll
            for (int X = 0; X < 3; ++X) {
                const int cb = X * 1024 + h * 128;
                float w0[12], w1[12];
#pragma unroll
                for (int i = 0; i < 12; ++i) { const int tt = 64 * npr + tau0 - 2 + i; unsigned w = 0u;
                    if (tt >= 0 && tt < T) w = P32[(size_t)(base + tt) * 2048 + (cb >> 1) + lane];
                    w0[i] = bf_lo(w); w1[i] = bf_hi(w); }
                f32x2_t cwv[5];
#pragma unroll
                for (int i = 0; i < 5; ++i) cwv[i] = *(const f32x2_t*)(P.cw + i * 3072 + cb + 2 * lane);
#pragma unroll
                for (int r = 0; r < 8; ++r) {
                    float a0 = 0.f, a1 = 0.f;
#pragma unroll
                    for (int i = 0; i < 5; ++i) { a0 += w0[r + i] * cwv[i].x; a1 += w1[r + i] * cwv[i].y; }
                    a0 = silu_f(a0); a1 = silu_f(a1);
                    if (X < 2) { const float rinv = rsqrtf(wave_sum_dpp(a0 * a0 + a1 * a1) + EPS); a0 *= rinv; a1 *= rinv; }
                    *(LAS unsigned*)(L + (X == 0 ? L_Q : X == 1 ? L_K : L_V) + (tau0 + r) * 272 + lane * 4) = pk2(a0, a1);
                }
            }
        }
        __syncthreads();
        {
            const int ti = w4 >> 1, tj = w4 & 1;
            dn_f32x16 accK = {}, accQ = {};
            if (ti >= tj) {
                const int pa = 32 * ti + r32, pb = 32 * tj + r32;
                const int rowA = dir ? 63 - pa : pa, rowB = dir ? 63 - pb : pb;
#pragma unroll
                for (int s = 0; s < 8; ++s) {
                    const int co = (16 * s + 8 * hi) * 2;
                    const dn_bf16x8 Ak = *(const LAS dn_bf16x8*)(L + L_K + rowA * 272 + co), Aq = *(const LAS dn_bf16x8*)(L + L_Q + rowA * 272 + co), Bk = *(const LAS dn_bf16x8*)(L + L_K + rowB * 272 + co);
                    accK = __builtin_amdgcn_mfma_f32_32x32x16_bf16(Ak, Bk, accK, 0, 0, 0);
                    accQ = __builtin_amdgcn_mfma_f32_32x32x16_bf16(Aq, Bk, accQ, 0, 0, 0);
                }
            }
            const int pj = 32 * tj + r32; const float gcj = gcs[dir * 64 + pj];
#pragma unroll
            for (int reg = 0; reg < 16; ++reg) {
                const int pi = 32 * ti + dn_crow(reg, hi);
                const float dec = pi >= pj ? __expf(gcs[dir * 64 + pi] - gcj) : 0.f;
                const float am = pi > pj ? bts[dir * 64 + pi] * accK[reg] * dec : 0.f;
                const float qk = ATT_SCALE * accQ[reg] * dec;
                *(LAS float*)(L + L_AM + dir * 17408 + pi * 272 + pj * 4) = am;
                *(LAS bf16raw*)(L + L_QK + dir * 9216 + pi * 144 + pj * 2) = (bf16raw)f2bf(qk);
            }
        }
        __syncthreads();
        const int rec_n = dir ? N - 1 - npr : npr;
        const int recid = ((cbase + rec_n) * 8 + h) * 2 + dir;
        unsigned char* rec = P.SOP + (size_t)recid * REC_BYTES;
        if (w4 == 0) {
            const LAS unsigned char* am = L + L_AM + dir * 17408;
            float x[64];
            f32x4_t nx[16];
            nx[0] = (f32x4_t){0.f, 0.f, 0.f, 0.f};
#pragma unroll
            for (int i = 0; i < 64; ++i) {
                f32x4_t cu[16];
#pragma unroll
                for (int j4 = 0; j4 < (i + 3) / 4; ++j4) cu[j4] = nx[j4];
                if (i + 1 < 64) {
#pragma unroll
                    for (int j4 = 0; j4 < (i + 4) / 4; ++j4) nx[j4] = *(const LAS f32x4_t*)(am + (i + 1) * 272 + j4 * 16);
                }
                asm volatile("" ::: "memory");
                float acc0 = (i == lane) ? 1.f : 0.f, acc1 = 0.f;
#pragma unroll
                for (int j4 = 0; j4 < (i + 3) / 4; ++j4) {
                    if (4 * j4 + 0 < i) acc0 -= cu[j4].x * x[4 * j4 + 0];
                    if (4 * j4 + 1 < i) acc1 -= cu[j4].y * x[4 * j4 + 1];
                    if (4 * j4 + 2 < i) acc0 -= cu[j4].z * x[4 * j4 + 2];
                    if (4 * j4 + 3 < i) acc1 -= cu[j4].w * x[4 * j4 + 3];
                }
                x[i] = acc0 + acc1;
            }
            LAS unsigned char* tb = L + L_TB + dir * 9216 + lane * 2;
#pragma unroll
            for (int i = 0; i < 64; ++i) *(LAS bf16raw*)(tb + i * 144) = (bf16raw)f2bf(x[i]);
        } else {
            const int t192 = (w4 - 1) * 64 + lane;
            const float glast = gcs[dir * 64 + 63];
            for (int id = t192; id < 1024; id += 192) {
                const int mt = id >> 9, kt = (id >> 6) & 7, r = id & 31, hh = (id >> 5) & 1;
                const int p = 32 * mt + r, dk0 = 32 * (kt >> 1) + 16 * (kt & 1) + 4 * hh;
                const int tau = dir ? 63 - p : p; const float sc = ATT_SCALE * __expf(gcs[dir * 64 + p]);
                const u32x2_t ql = *(const LAS u32x2_t*)(L + L_Q + tau * 272 + dk0 * 2), qh = *(const LAS u32x2_t*)(L + L_Q + tau * 272 + (dk0 + 8) * 2);
                u32x4_t qo; qo.x = dn_cvt_pk(bf_lo(ql.x) * sc, bf_hi(ql.x) * sc); qo.y = dn_cvt_pk(bf_lo(ql.y) * sc, bf_hi(ql.y) * sc);
                qo.z = dn_cvt_pk(bf_lo(qh.x) * sc, bf_hi(qh.x) * sc); qo.w = dn_cvt_pk(bf_lo(qh.y) * sc, bf_hi(qh.y) * sc);
                *(u32x4_t*)(rec + REC_QT + (size_t)id * 16) = qo;
            }
            for (int id = t192; id < 1024; id += 192) {
                const int mt = id >> 8, kt = (id >> 6) & 3, r = id & 31, hh = (id >> 5) & 1;
                const int c0 = 32 * (kt >> 1) + 16 * (kt & 1) + 4 * hh;
                float kv[8];
#pragma unroll
                for (int jj = 0; jj < 8; ++jj) { const int c = c0 + 8 * (jj >> 2) + (jj & 3); const int tau = dir ? 63 - c : c;
                    kv[jj] = bf2f(*(const LAS bf16raw*)(L + L_K + tau * 272 + (32 * mt + r) * 2)) * __expf(glast - gcs[dir * 64 + c]); }
                u32x4_t ko; ko.x = dn_cvt_pk(kv[0], kv[1]); ko.y = dn_cvt_pk(kv[2], kv[3]); ko.z = dn_cvt_pk(kv[4], kv[5]); ko.w = dn_cvt_pk(kv[6], kv[7]);
                *(u32x4_t*)(rec + REC_KT + (size_t)id * 16) = ko;
            }
            for (int id = t192; id < 512; id += 192) {
                const int mt = id >> 8, kt = (id >> 6) & 3, r = id & 31, hh = (id >> 5) & 1;
                const int c0 = 32 * (kt >> 1) + 16 * (kt & 1) + 4 * hh;
                const LAS unsigned char* qp = L + L_QK + dir * 9216 + (32 * mt + r) * 144;
                const u32x2_t qa = *(const LAS u32x2_t*)(qp + c0 * 2), qb = *(const LAS u32x2_t*)(qp + (c0 + 8) * 2);
                *(u32x4_t*)(rec + REC_QK + (size_t)id * 16) = (u32x4_t){qa.x, qa.y, qb.x, qb.y};
            }
            if (t192 == 0) P.EGL[recid] = __expf(glast);
        }
        __syncthreads();
        {
            const bool isK = w4 >= 2;
            const LAS unsigned char* srcb = L + (isK ? L_K : L_V);
            dn_f32x16 acc[2][2] = {};
#pragma unroll
            for (int ks = 0; ks < 4; ++ks) {
                dn_bf16x8 At[2];
#pragma unroll
                for (int mt = 0; mt < 2; ++mt) At[mt] = *(const LAS dn_bf16x8*)(L + L_TB + dir * 9216 + (32 * mt + r32) * 144 + (16 * ks + 8 * hi) * 2);
                float bt[8], eg8[8];
#pragma unroll
                for (int jj = 0; jj < 8; ++jj) { const int jrow = 16 * ks + 8 * hi + jj; bt[jj] = bts[dir * 64 + jrow]; eg8[jj] = isK ? __expf(gcs[dir * 64 + jrow]) : 1.f; }
#pragma unroll
                for (int nl = 0; nl < 2; ++nl) {
                    const int col = (32 * (2 * w4 + nl) + r32) & 127;
                    float rv[8];
#pragma unroll
                    for (int jj = 0; jj < 8; ++jj) { const int jrow = 16 * ks + 8 * hi + jj; const int tau = dir ? 63 - jrow : jrow;
                        rv[jj] = bf2f(*(const LAS bf16raw*)(srcb + tau * 272 + col * 2)) * bt[jj] * eg8[jj]; }
                    u32x4_t bw; bw.x = dn_cvt_pk(rv[0], rv[1]); bw.y = dn_cvt_pk(rv[2], rv[3]); bw.z = dn_cvt_pk(rv[4], rv[5]); bw.w = dn_cvt_pk(rv[6], rv[7]);
                    const dn_bf16x8 Bf = __builtin_bit_cast(dn_bf16x8, bw);
#pragma unroll
                    for (int mt = 0; mt < 2; ++mt) acc[mt][nl] = __builtin_amdgcn_mfma_f32_32x32x16_bf16(At[mt], Bf, acc[mt][nl], 0, 0, 0);
                }
            }
            if (!isK) {
#pragma unroll
                for (int mt = 0; mt < 2; ++mt)
#pragma unroll
                    for (int nl = 0; nl < 2; ++nl) { const dn_f32x16 a = acc[mt][nl];
                        u32x4_t o0, o1; o0.x = dn_cvt_pk(a[0], a[1]); o0.y = dn_cvt_pk(a[2], a[3]); o0.z = dn_cvt_pk(a[4], a[5]); o0.w = dn_cvt_pk(a[6], a[7]);
                        o1.x = dn_cvt_pk(a[8], a[9]); o1.y = dn_cvt_pk(a[10], a[11]); o1.z = dn_cvt_pk(a[12], a[13]); o1.w = dn_cvt_pk(a[14], a[15]);
                        unsigned char* up = rec + REC_U + (size_t)(((mt * 4 + 2 * w4 + nl) * 64 + lane) * 32);
                        *(u32x4_t*)up = o0; *(u32x4_t*)(up + 16) = o1; }
            } else {
#pragma unroll
                for (int mt = 0; mt < 2; ++mt)
#pragma unroll
                    for (int nl = 0; nl < 2; ++nl) { const int dk = 32 * (2 * (w4 - 2) + nl) + r32;
#pragma unroll
                        for (int reg = 0; reg < 16; ++reg) *(LAS bf16raw*)(L + L_AM + dir * 17408 + (32 * mt + dn_crow(reg, hi)) * 264 + dk * 2) = (bf16raw)f2bf(-acc[mt][nl][reg]); }
            }
        }
        __syncthreads();
        {
            const LAS unsigned char* wt = L + L_AM + dir * 17408;
#pragma unroll
            for (int i = 0; i < 4; ++i) {
                const int id = t256 + 256 * i, mt = id >> 9, kt = (id >> 6) & 7, r = id & 31, hh = (id >> 5) & 1;
                const int p = 32 * mt + r, dk0 = 32 * (kt >> 1) + 16 * (kt & 1) + 4 * hh;
                const u32x2_t wl = *(const LAS u32x2_t*)(wt + p * 264 + dk0 * 2), wh = *(const LAS u32x2_t*)(wt + p * 264 + (dk0 + 8) * 2);
                *(u32x4_t*)(rec + REC_WN + (size_t)id * 16) = (u32x4_t){wl.x, wl.y, wh.x, wh.y};
            }
        }
        __syncthreads();
    }
}

struct DnScanPtrs { const unsigned char* SOP; const float *EGL, *state_delta; bf16raw *OF, *OB; float* out; };

__device__ __forceinline__ dn_bf16x8 dn_acc_frag(const dn_f32x16& a, int s) {
    u32x4_t w;
    if (s == 0) { w.x = dn_cvt_pk(a[0], a[1]); w.y = dn_cvt_pk(a[2], a[3]); w.z = dn_cvt_pk(a[4], a[5]); w.w = dn_cvt_pk(a[6], a[7]); }
    else { w.x = dn_cvt_pk(a[8], a[9]); w.y = dn_cvt_pk(a[10], a[11]); w.z = dn_cvt_pk(a[12], a[13]); w.w = dn_cvt_pk(a[14], a[15]); }
    return __builtin_bit_cast(dn_bf16x8, w);
}

__device__ __forceinline__ void phase_dn_scan(Ctx& C, const DnScanPtrs& P, int j) {
    const int slot = C.wid * C.nblk + C.blk, nslot = C.ngw;
    for (int r = 0; r * nslot < 2176; ++r) {
        const int u = r * nslot + (slot + r * (nslot - 128)) % nslot;
        if (u >= 2176) continue;
        int lane = C.lane; asm volatile("" : "+v"(lane));
        const int r32 = lane & 31, hi = lane >> 5;
        int seq, h, dir, sl, N, T, base, cbase; bool lat = u < 128;
        if (lat) { seq = 32 + (u >> 6); h = (u >> 3) & 7; dir = (u >> 2) & 1; sl = u & 3; N = 16; T = 1024; base = NCTX + (seq - 32) * 1024; cbase = 128 + 16 * (seq - 32); }
        else { const int c = u - 128; seq = c >> 6; h = (c >> 3) & 7; dir = (c >> 2) & 1; sl = c & 3; N = 4; T = 256; base = seq * 256; cbase = 4 * seq; }
        dn_f32x16 S[4];
        if (lat) { const float* sp = P.state_delta + ((((size_t)(seq - 32) * 2 + j) * 2 + dir) * 8 + h) * 16384 + 32 * sl + r32;
#pragma unroll
            for (int t4 = 0; t4 < 4; ++t4)
#pragma unroll
                for (int reg = 0; reg < 16; ++reg) S[t4][reg] = sp[(size_t)(32 * t4 + dn_crow(reg, hi)) * 128]; }
        else {
#pragma unroll
            for (int t4 = 0; t4 < 4; ++t4) S[t4] = (dn_f32x16){}; }
        bf16raw* Od = (dir ? P.OB : P.OF) + (size_t)base * 1024 + h * 128 + 32 * sl + r32;
        for (int n = 0; n < N; ++n) {
            const int recid = ((cbase + n) * 8 + h) * 2 + dir;
            const unsigned char* rec = P.SOP + (size_t)recid * REC_BYTES + lane * 16;
            const float eg = P.EGL[recid];
            dn_bf16x8 Sb[8];
#pragma unroll
            for (int kt = 0; kt < 8; ++kt) Sb[kt] = dn_acc_frag(S[kt >> 1], kt & 1);
#define DN_FENCE() asm volatile("" ::: "memory")
#define DN_LD8(F, off) do { _Pragma("unroll") for (int q_ = 0; q_ < 8; ++q_) F[q_] = *(const dn_bf16x8*)(rec + (off) + q_ * 1024); } while (0)
            dn_bf16x8 F[8];
            dn_f32x16 av[2];
#pragma unroll
            for (int mt = 0; mt < 2; ++mt) {
                const unsigned char* up = P.SOP + (size_t)recid * REC_BYTES + REC_U + (size_t)(((mt * 4 + sl) * 64 + lane) * 32);
                const u32x4_t u0 = *(const u32x4_t*)up, u1 = *(const u32x4_t*)(up + 16);
                DN_LD8(F, REC_WN + mt * 8192);
                DN_FENCE();
                dn_f32x16 a;
                a[0] = bf_lo(u0.x); a[1] = bf_hi(u0.x); a[2] = bf_lo(u0.y); a[3] = bf_hi(u0.y); a[4] = bf_lo(u0.z); a[5] = bf_hi(u0.z); a[6] = bf_lo(u0.w); a[7] = bf_hi(u0.w);
                a[8] = bf_lo(u1.x); a[9] = bf_hi(u1.x); a[10] = bf_lo(u1.y); a[11] = bf_hi(u1.y); a[12] = bf_lo(u1.z); a[13] = bf_hi(u1.z); a[14] = bf_lo(u1.w); a[15] = bf_hi(u1.w);
#pragma unroll
                for (int kt = 0; kt < 8; ++kt) a = __builtin_amdgcn_mfma_f32_32x32x16_bf16(F[kt], Sb[kt], a, 0, 0, 0);
                av[mt] = a;
                DN_FENCE();
            }
            dn_bf16x8 vb[4];
#pragma unroll
            for (int kt = 0; kt < 4; ++kt) vb[kt] = dn_acc_frag(av[kt >> 1], kt & 1);
            dn_f32x16 ao[2];
#pragma unroll
            for (int mt = 0; mt < 2; ++mt) {
                DN_LD8(F, REC_QT + mt * 8192);
                DN_FENCE();
                dn_f32x16 a = {};
#pragma unroll
                for (int kt = 0; kt < 8; ++kt) a = __builtin_amdgcn_mfma_f32_32x32x16_bf16(F[kt], Sb[kt], a, 0, 0, 0);
                ao[mt] = a;
                DN_FENCE();
            }
            DN_LD8(F, REC_QK);
            DN_FENCE();
#pragma unroll
            for (int mt = 0; mt < 2; ++mt) {
                dn_f32x16 a = ao[mt];
#pragma unroll
                for (int kt = 0; kt < 4; ++kt) a = __builtin_amdgcn_mfma_f32_32x32x16_bf16(F[mt * 4 + kt], vb[kt], a, 0, 0, 0);
#pragma unroll
                for (int reg = 0; reg < 16; ++reg) { const int p = 64 * n + 32 * mt + dn_crow(reg, hi); const int t = dir ? T - 1 - p : p;
                    Od[(size_t)t * 1024] = (bf16raw)f2bf(a[reg]); }
            }
            DN_FENCE();
#pragma unroll
            for (int t2 = 0; t2 < 2; ++t2) {
                DN_LD8(F, REC_KT + t2 * 8192);
                DN_FENCE();
#pragma unroll
                for (int tt = 0; tt < 2; ++tt) {
                    dn_f32x16 a = S[2 * t2 + tt] * eg;
#pragma unroll
                    for (int kt = 0; kt < 4; ++kt) a = __builtin_amdgcn_mfma_f32_32x32x16_bf16(F[tt * 4 + kt], vb[kt], a, 0, 0, 0);
                    S[2 * t2 + tt] = a;
                }
                DN_FENCE();
            }
#undef DN_FENCE
#undef DN_LD8
        }
        if (!lat) { float* sp = P.out + O_ST + ((((size_t)seq * 2 + j) * 2 + dir) * 8 + h) * 16384 + 32 * sl + r32;
#pragma unroll
            for (int t4 = 0; t4 < 4; ++t4)
#pragma unroll
                for (int reg = 0; reg < 16; ++reg) sp[(size_t)(32 * t4 + dn_crow(reg, hi)) * 128] = S[t4][reg]; }
    }
}

__device__ __forceinline__ void phase_dn_scan2(Ctx& C, const DnScanPtrs& P, int j) {
    LAS unsigned char* L = C.lds;
    const int wid = C.wid; const bool consumer = wid < 4; const int sl = wid & 3;
    const int nun = C.nblk == 256 ? (C.blk < 32 ? 1 : 3) : (544 + C.nblk - 1) / C.nblk;
    for (int ui = 0; ui < nun; ++ui) {
        int sid;
        if (C.nblk == 256) { if (C.blk < 32) sid = C.blk; else { const int c = (C.blk - 32) + 224 * ui; if (c >= 512) break; sid = 32 + c; } }
        else { sid = C.blk + ui * C.nblk; if (sid >= 544) break; }
        int lane = C.lane; asm volatile("" : "+v"(lane));
        const int r32 = lane & 31, hi = lane >> 5;
        int seq, h, dir, N, T, base, cbase; const bool lat = sid < 32;
        if (lat) { seq = 32 + (sid >> 4); h = (sid >> 1) & 7; dir = sid & 1; N = 16; T = 1024; base = NCTX + (seq - 32) * 1024; cbase = 128 + 16 * (seq - 32); }
        else { const int c = sid - 32; seq = c >> 4; h = (c >> 1) & 7; dir = c & 1; N = 4; T = 256; base = seq * 256; cbase = 4 * seq; }
        const int rec0 = (cbase * 8 + h) * 2 + dir;
        const unsigned char* rbase = P.SOP + (size_t)rec0 * REC_BYTES;
        constexpr size_t RSTRIDE = (size_t)16 * REC_BYTES;
#define DN2_BAR() __builtin_amdgcn_s_barrier()
        if (consumer) {
            dn_f32x16 S[4];
            if (lat) { const float* sp = P.state_delta + ((((size_t)(seq - 32) * 2 + j) * 2 + dir) * 8 + h) * 16384 + 32 * sl + r32;
#pragma unroll
                for (int t4 = 0; t4 < 4; ++t4)
#pragma unroll
                    for (int reg = 0; reg < 16; ++reg) S[t4][reg] = sp[(size_t)(32 * t4 + dn_crow(reg, hi)) * 128]; }
            else {
#pragma unroll
                for (int t4 = 0; t4 < 4; ++t4) S[t4] = (dn_f32x16){}; }
            bf16raw* Od = (dir ? P.OB : P.OF) + (size_t)base * 1024 + h * 128 + 32 * sl + r32;
            u32x4_t ua[2][2];
#pragma unroll
            for (int mt = 0; mt < 2; ++mt) { const unsigned char* up = rbase + REC_U + (size_t)(((mt * 4 + sl) * 64 + lane) * 32); ua[mt][0] = *(const u32x4_t*)up; ua[mt][1] = *(const u32x4_t*)(up + 16); }
            int g = 0;
#define DN2_CSYNC() do { asm volatile("s_waitcnt lgkmcnt(0)" ::: "memory"); DN2_BAR(); asm volatile("" ::: "memory"); } while (0)
#define DN2_RD8(F) do { const LAS unsigned char* sp_ = L + (g & 15) * 8192 + lane * 16; _Pragma("unroll") for (int q_ = 0; q_ < 8; ++q_) F[q_] = *(const LAS dn_bf16x8*)(sp_ + q_ * 1024); ++g; } while (0)
            for (int n = 0; n < N; ++n) {
                const float eg = P.EGL[rec0 + 16 * n];
                dn_bf16x8 Sb[8];
#pragma unroll
                for (int kt = 0; kt < 8; ++kt) Sb[kt] = dn_acc_frag(S[kt >> 1], kt & 1);
                dn_bf16x8 F[8];
                dn_f32x16 av[2];
#pragma unroll
                for (int mt = 0; mt < 2; ++mt) {
                    DN2_CSYNC(); DN2_RD8(F);
                    const u32x4_t u0 = ua[mt][0], u1 = ua[mt][1];
                    dn_f32x16 a;
                    a[0] = bf_lo(u0.x); a[1] = bf_hi(u0.x); a[2] = bf_lo(u0.y); a[3] = bf_hi(u0.y); a[4] = bf_lo(u0.z); a[5] = bf_hi(u0.z); a[6] = bf_lo(u0.w); a[7] = bf_hi(u0.w);
                    a[8] = bf_lo(u1.x); a[9] = bf_hi(u1.x); a[10] = bf_lo(u1.y); a[11] = bf_hi(u1.y); a[12] = bf_lo(u1.z); a[13] = bf_hi(u1.z); a[14] = bf_lo(u1.w); a[15] = bf_hi(u1.w);
#pragma unroll
                    for (int kt = 0; kt < 8; ++kt) a = __builtin_amdgcn_mfma_f32_32x32x16_bf16(F[kt], Sb[kt], a, 0, 0, 0);
                    av[mt] = a;
                }
                if (n + 1 < N) {
#pragma unroll
                    for (int mt = 0; mt < 2; ++mt) { const unsigned char* up = rbase + (size_t)(n + 1) * RSTRIDE + REC_U + (size_t)(((mt * 4 + sl) * 64 + lane) * 32); ua[mt][0] = *(const u32x4_t*)up; ua[mt][1] = *(const u32x4_t*)(up + 16); }
                }
                dn_bf16x8 vb[4];
#pragma unroll
                for (int kt = 0; kt < 4; ++kt) vb[kt] = dn_acc_frag(av[kt >> 1], kt & 1);
                dn_f32x16 ao[2];
#pragma unroll
                for (int mt = 0; mt < 2; ++mt) {
                    DN2_CSYNC(); DN2_RD8(F);
                    dn_f32x16 a = {};
#pragma unroll
                    for (int kt = 0; kt < 8; ++kt) a = __builtin_amdgcn_mfma_f32_32x32x16_bf16(F[kt], Sb[kt], a, 0, 0, 0);
                    ao[mt] = a;
                }
                DN2_CSYNC(); DN2_RD8(F);
#pragma unroll
                for (int mt = 0; mt < 2; ++mt) {
                    dn_f32x16 a = ao[mt];
#pragma unroll
                    for (int kt = 0; kt < 4; ++kt) a = __builtin_amdgcn_mfma_f32_32x32x16_bf16(F[mt * 4 + kt], vb[kt], a, 0, 0, 0);
#pragma unroll
                    for (int reg = 0; reg < 16; ++reg) { const int p = 64 * n + 32 * mt + dn_crow(reg, hi); const int t = dir ? T - 1 - p : p;
                        Od[(size_t)t * 1024] = (bf16raw)f2bf(a[reg]); }
                }
#pragma unroll
                for (int t2 = 0; t2 < 2; ++t2) {
                    DN2_CSYNC(); DN2_RD8(F);
#pragma unroll
                    for (int tt = 0; tt < 2; ++tt) {
                        dn_f32x16 a = S[2 * t2 + tt] * eg;
#pragma unroll
                        for (int kt = 0; kt < 4; ++kt) a = __builtin_amdgcn_mfma_f32_32x32x16_bf16(F[tt * 4 + kt], vb[kt], a, 0, 0, 0);
                        S[2 * t2 + tt] = a;
                    }
                }
            }
            DN2_CSYNC();
            if (!lat) { float* sp = P.out + O_ST + ((((size_t)seq * 2 + j) * 2 + dir) * 8 + h) * 16384 + 32 * sl + r32;
#pragma unroll
                for (int t4 = 0; t4 < 4; ++t4)
#pragma unroll
                    for (int reg = 0; reg < 16; ++reg) sp[(size_t)(32 * t4 + dn_crow(reg, hi)) * 128] = S[t4][reg]; }
#undef DN2_CSYNC
#undef DN2_RD8
        } else {
            const int ld = wid - 4;
            int ln = 0, ls = 0;
            const unsigned char* gsrc = rbase + REC_WN + (size_t)(2 * ld) * 1024 + lane * 16;
#define DN2_ISSUE(slot) do { const unsigned char* s_ = gsrc + (size_t)ln * RSTRIDE + ls * 8192; LAS unsigned char* d_ = L + (slot) * 8192 + (2 * ld) * 1024; \
        __builtin_amdgcn_global_load_lds((const unsigned*)s_, (LAS unsigned*)d_, 16, 0, 0); __builtin_amdgcn_global_load_lds((const unsigned*)(s_ + 1024), (LAS unsigned*)(d_ + 1024), 16, 0, 0); \
        if (++ls == 7) { ls = 0; if (ln < N - 1) ++ln; } } while (0)
            for (int q = 0; q < 15; ++q) DN2_ISSUE(q);
            const int G = 7 * N;
            for (int g = 0; g < G; ++g) {
                asm volatile("s_waitcnt vmcnt(28)" ::: "memory");
                DN2_BAR();
                DN2_ISSUE((g + 15) & 15);
            }
            asm volatile("s_waitcnt vmcnt(0)" ::: "memory");
            DN2_BAR();
#undef DN2_ISSUE
        }
#undef DN2_BAR
    }
}
#define XB_TMO      128
#define XB_XCNT(j)  (256  + 64 * (j))
#define XB_XSUB(j)  (1280 + 64 * (j))
#define XB_XGEN(j)  (2304 + 64 * (j))
#define XB_TOP      3328
#define XB_TOPGEN   3392
#define XCD_BAR_WORDS 3456
#define XB_SPIN_CAP (1u << 18)

__device__ __forceinline__ unsigned xb_ld(unsigned* p)              { return __hip_atomic_load(p, __ATOMIC_RELAXED, __HIP_MEMORY_SCOPE_AGENT); }
__device__ __forceinline__ unsigned xb_add(unsigned* p, unsigned v) { return __hip_atomic_fetch_add(p, v, __ATOMIC_RELAXED, __HIP_MEMORY_SCOPE_AGENT); }
__device__ __forceinline__ unsigned xb_xcc_id() { return (unsigned)__builtin_amdgcn_s_getreg((3 << 11) | 20) & 0xFu; }
#define XB_SPIN(cond, bar) do { unsigned _sp = 0; while (cond) { __builtin_amdgcn_s_sleep(1); \
    if ((++_sp & 255u) == 0u) { if (xb_ld(&(bar)[XB_TMO])) break; if (_sp > XB_SPIN_CAP) { atomicAdd(&(bar)[XB_TMO], 1u); break; } } } } while (0)

struct XcdBarrier {
    unsigned* bar; unsigned x;
    volatile LAS unsigned* st;
};

__device__ __forceinline__ XcdBarrier xcd_barrier_post(unsigned* bar, volatile LAS unsigned* st) {
    XcdBarrier b; b.bar = bar; b.x = xb_xcc_id(); b.st = st;
    if (threadIdx.x == 0) (void)xb_add(&bar[XB_XCNT(b.x)], 1u);
    return b;
}
__device__ __forceinline__ void xcd_barrier_complete(unsigned* bar, unsigned x, unsigned& nloc, unsigned& nx) {
    const unsigned G = gridDim.x * gridDim.y * gridDim.z;
    unsigned sum, cnt, mine, sp = 0u;
    for (;;) {
        sum = 0u; cnt = 0u; mine = 0u;
#pragma unroll
        for (unsigned j = 0; j < 16; ++j) { const unsigned c = xb_ld(&bar[XB_XCNT(j)]); sum += c; cnt += (c > 0u) ? 1u : 0u; mine = (j == x) ? c : mine; }
        if (sum == G) break;
        __builtin_amdgcn_s_sleep(1);
        if ((++sp & 255u) == 0u) { if (xb_ld(&bar[XB_TMO])) break; if (sp > XB_SPIN_CAP) { atomicAdd(&bar[XB_TMO], 1u); break; } }
    }
    nloc = mine > 0u ? mine : 1u; nx = cnt > 0u ? cnt : 1u;
}

__device__ __forceinline__ void xcd_barrier(const XcdBarrier& b) {
    asm volatile("s_waitcnt vmcnt(0)" ::: "memory");
    __syncthreads();
    if (threadIdx.x == 0) {
        unsigned* bar = b.bar;
        __builtin_amdgcn_s_waitcnt(0);
        unsigned nloc = b.st[0], nx = b.st[1];
        const unsigned old = xb_add(&bar[XB_XSUB(b.x)], 1u);
        const unsigned gen = old / nloc;
        if (old + 1u == (gen + 1u) * nloc) {
            __builtin_amdgcn_fence(__ATOMIC_RELEASE, "agent");
            asm volatile("s_waitcnt vmcnt(0)" ::: "memory");
            const unsigned og = xb_add(&bar[XB_TOP], 1u);
            const unsigned tg = og / nx;
            if (og + 1u == (tg + 1u) * nx) xb_add(&bar[XB_TOPGEN], 1u);
            else XB_SPIN(xb_ld(&bar[XB_TOPGEN]) == tg, bar);
            __builtin_amdgcn_fence(__ATOMIC_ACQUIRE, "agent");
            xb_add(&bar[XB_XGEN(b.x)], 1u);
            asm volatile("s_waitcnt vmcnt(0)" ::: "memory");
        } else {
            XB_SPIN(xb_ld(&bar[XB_XGEN(b.x)]) == gen, bar);
            __builtin_amdgcn_fence(__ATOMIC_ACQUIRE, "agent");
            asm volatile("s_waitcnt vmcnt(0)" ::: "memory");
        }
    }
    __syncthreads();
}

constexpr int LDSCTL_OFF = 131072, MISC_OFF = LDSCTL_OFF + 320, CW_BAR = 4096;
struct Args { const float* in[24]; float* out; unsigned char* ws; int ph_lo, ph_hi; };
enum { I_XP = 0, I_XS, I_CK, I_CV, I_SD, I_C, I_CCTX, I_WMOD, I_BMOD, I_N1, I_N2, I_AWIN, I_AQG, I_AKG, I_AWOUT, I_DWIN, I_DCONV, I_DALOG, I_DDTB, I_DNORM, I_DWOUT, I_W1, I_W2, I_FN };

__global__ void __launch_bounds__(NWAVES * 64, 2) mk_fwd(Args args) {
    extern __shared__ __attribute__((aligned(16))) unsigned char lds_raw[];
    cg::grid_group grid = cg::this_grid();
    for (int u = threadIdx.x; u < (LDS_BYTES - LDSCTL_OFF) / 4; u += NWAVES * 64) ((LAS unsigned*)((LAS unsigned char*)lds_raw + LDSCTL_OFF))[u] = 0u;
    __syncthreads();
    const XcdBarrier bar = xcd_barrier_post((unsigned*)(args.ws + WS_CTL) + CW_BAR, (volatile LAS unsigned*)((LAS unsigned char*)lds_raw + MISC_OFF) + 8);

    const int lo = args.ph_lo, hi = args.ph_hi;
    int ph = 0;
#define PHASE_BEGIN() if (ph >= lo && ph < hi) { int z = 0; asm volatile("" : "+s"(z)); unsigned char* const ws = args.ws + z; (void)ws; \
    Ctx C; C.lds = (LAS unsigned char*)lds_raw + z; C.tid = threadIdx.x + z; C.lane = C.tid & 63; C.wid = __builtin_amdgcn_readfirstlane(C.tid >> 6); \
    C.nblk = gridDim.x + z; C.blk = blockIdx.x + z; C.gw = C.blk * NWAVES + C.wid; C.ngw = C.nblk * NWAVES;
#ifndef REP_KIND
#define REP_KIND -1
#endif
#define BARX() do { XcdBarrier b2_ = bar; asm volatile("" : "+s"(b2_.bar)); xcd_barrier(b2_); } while (0)
#define PHASE_END() if (ph + 1 < hi) { if (ph == 0) { grid.sync(); if (threadIdx.x == 0) { unsigned nloc_, nx_; xcd_barrier_complete(bar.bar, bar.x, nloc_, nx_); bar.st[0] = nloc_; bar.st[1] = nx_; } __syncthreads(); } else BARX(); } } ++ph;
#define INP(i) (args.in[(i) + z])
#define WSF(off) ((float*)(ws + (off)))
#define WSB(off) ((bf16raw*)(ws + (off)))

    PHASE_BEGIN() {
        ProPtrs P{INP(I_C), INP(I_CCTX), INP(I_WMOD), INP(I_BMOD), INP(I_AWIN), INP(I_AWOUT), INP(I_DWIN), INP(I_DWOUT), INP(I_W1), INP(I_W2), WSF(WS_MODS), WSF(WS_ROPE),
                  WSB(WS_WT_AIN), WSB(WS_WT_AOUT), WSB(WS_WT_DIN), WSB(WS_WT_DOUT), WSB(WS_WT_W1), WSB(WS_WT_W2), INP(I_XP), INP(I_XS), WSB(WS_X)};
        phase_prologue(C, P); } PHASE_END()
    for (int l = 0; l < 4; ++l) {
        const int j = l >> 1;
        PHASE_BEGIN() { const float* mods_l = WSF(WS_MODS) + (size_t)l * 3 * 6144;
            phase_norm(C, WSB(WS_X), INP(I_N1) + l * D, mods_l, WSB(WS_H)); } PHASE_END()
        if ((l & 1) == 0) {
            PHASE_BEGIN() { pg8::Gemm g{WSB(WS_H), WSB(WS_WT_AIN) + (size_t)j * QKVW * D, MTOK, QKVW, D, z}; pg8::StaticOrder S; S.init(MTOK, QKVW, C.nblk, C.blk);
                pg8::EpiBf16<0> E{WSB(WS_PROJ), QKVW, nullptr, 0, 0, 1.f};
                pg8::gemm_phase<pg8::EpiBf16<0>, pg8::StaticOrder, true, true>(C.lds, g, S, E); } PHASE_END()
            PHASE_BEGIN() { QknPtrs P{WSB(WS_PROJ), WSB(WS_QB), WSB(WS_KB), WSB(WS_VB), INP(I_AQG) + j * 128, INP(I_AKG) + j * 128, WSF(WS_ROPE), INP(I_CK), INP(I_CV), args.out + z};
                phase_qkn(C, P, j); if (REP_KIND == 3) { BARX(); phase_qkn(C, P, j); } } PHASE_END()
            PHASE_BEGIN() { AttnPtrs P{WSB(WS_QB), WSB(WS_KB), WSB(WS_VB), WSB(WS_Y)}; phase_attn(C, P); if (REP_KIND == 4) { BARX(); phase_attn(C, P); } } PHASE_END()
        } else {
            PHASE_BEGIN() { pg8::Gemm g{WSB(WS_H), WSB(WS_WT_DIN) + (size_t)j * DNINP * D, MTOK, DNINP, D, z}; pg8::StaticOrder S; S.init(MTOK, DNINP, C.nblk, C.blk);
                pg8::EpiDnIn E{WSB(WS_PROJ), WSF(WS_AB)};
                pg8::gemm_phase<pg8::EpiDnIn, pg8::StaticOrder, true, true>(C.lds, g, S, E); } PHASE_END()
            PHASE_BEGIN() { DnLocalPtrs P{WSB(WS_PROJ), WSF(WS_AB), INP(I_DCONV) + (size_t)j * 5 * 3072, INP(I_DALOG) + j * 16, INP(I_DDTB) + j * 16, ws + WS_SOP, WSF(WS_EGL)};
                phase_dn_local(C, P); if (REP_KIND == 6) { BARX(); phase_dn_local(C, P); } } PHASE_END()
            PHASE_BEGIN() { DnScanPtrs P{ws + WS_SOP, WSF(WS_EGL), INP(I_SD), WSB(WS_OF), WSB(WS_OB), args.out + z}; phase_dn_scan2(C, P, j); } PHASE_END()
            PHASE_BEGIN() { GatePtrs P{WSB(WS_OF), WSB(WS_OB), WSB(WS_PROJ), WSB(WS_Y), INP(I_DNORM) + j * 128}; phase_gate(C, P); if (REP_KIND == 8) { BARX(); phase_gate(C, P); } } PHASE_END()
        }
        PHASE_BEGIN() { const float* mods_l = WSF(WS_MODS) + (size_t)l * 3 * 6144;
            pg8::Gemm g{WSB(WS_Y), ((l & 1) ? WSB(WS_WT_DOUT) : WSB(WS_WT_AOUT)) + (size_t)j * D * D, MTOK, D, D, z}; pg8::StaticOrder S; S.init(64 * 256, D, C.nblk, C.blk);
            pg8::EpiRes160 E{WSB(WS_X), mods_l + 2048};
            pg8::gemm_phase<pg8::EpiRes160, pg8::StaticOrder, true, true, true>(C.lds, g, S, E, NCTX); } PHASE_END()
        PHASE_BEGIN() { const float* mods_l = WSF(WS_MODS) + (size_t)l * 3 * 6144;
            phase_norm(C, WSB(WS_X), INP(I_N2) + l * D, mods_l + 3072, WSB(WS_H)); } PHASE_END()
        PHASE_BEGIN() { pg8::Gemm g{WSB(WS_H), WSB(WS_WT_W1) + (size_t)l * FF * D, MTOK, FF, D, z}; pg8::StaticOrder S; S.init(MTOK, FF, C.nblk, C.blk);
            pg8::EpiBf16<2> E{WSB(WS_PROJ), FF, nullptr, 0, 0, 1.f};
            for (int rep = 0; rep < (REP_KIND == 10 ? 2 : 1); ++rep) { if (rep) BARX(); pg8::gemm_phase<pg8::EpiBf16<2>, pg8::StaticOrder, true, true>(C.lds, g, S, E); } } PHASE_END()
        PHASE_BEGIN() { const float* mods_l = WSF(WS_MODS) + (size_t)l * 3 * 6144;
            pg8::Gemm g{WSB(WS_PROJ), WSB(WS_WT_W2) + (size_t)l * D * FF, MTOK, D, FF, z}; pg8::StaticOrder S; S.init(64 * 256, D, C.nblk, C.blk);
            pg8::EpiRes160 E{WSB(WS_X), mods_l + 5120};
            pg8::gemm_phase<pg8::EpiRes160, pg8::StaticOrder, true, true, true>(C.lds, g, S, E, NCTX); } PHASE_END()
    }
    PHASE_BEGIN() { phase_final(C, WSB(WS_X), INP(I_FN), args.out + z); } PHASE_END()
#undef PHASE_BEGIN
#undef PHASE_END
}

extern "C" void kernel_launch(void* const* d_in, const int* in_sizes, int n_in, void* d_out, int out_size, void* d_ws, size_t ws_size, hipStream_t stream) {
    static int grid = 0;
    if (grid == 0) {
        if (n_in != 24 || ws_size < WS_END) { fprintf(stderr, "kernel_launch: unexpected n_in %d / ws %zu\n", n_in, ws_size); grid = -1; return; }
        int dev = 0, cus = 0, per_cu = 0;
        if (hipGetDevice(&dev) != hipSuccess || hipDeviceGetAttribute(&cus, hipDeviceAttributeMultiprocessorCount, dev) != hipSuccess) { grid = -1; return; }
        if (hipFuncSetAttribute((const void*)mk_fwd, hipFuncAttributeMaxDynamicSharedMemorySize, LDS_BYTES) != hipSuccess) { fprintf(stderr, "kernel_launch: hipFuncSetAttribute failed\n"); grid = -1; return; }
        if (hipOccupancyMaxActiveBlocksPerMultiprocessor(&per_cu, (const void*)mk_fwd, NWAVES * 64, LDS_BYTES) != hipSuccess || per_cu < 1) { fprintf(stderr, "kernel_launch: occupancy query failed (%d)\n", per_cu); (void)hipGetLastError(); grid = -1; return; }
        grid = cus * 1;
    }
    if (grid < 0) return;
    (void)hipMemsetAsync((char*)d_ws + WS_CTL, 0, CTL_ZERO_BYTES, stream);
    Args a; memset(&a, 0, sizeof(a));
    for (int i = 0; i < 24; ++i) a.in[i] = (const float*)d_in[i];
    a.out = (float*)d_out; a.ws = (unsigned char*)d_ws; a.ph_lo = 0; a.ph_hi = 1000;
    void* kargs[] = {&a};
    hipError_t e = hipLaunchCooperativeKernel((const void*)mk_fwd, dim3(grid), dim3(NWAVES * 64), kargs, LDS_BYTES, stream);
    if (e != hipSuccess) fprintf(stderr, "kernel_launch: cooperative launch failed: %s (grid %d)\n", hipGetErrorString(e), grid);
}
```

```cpp
#include <hip/hip_runtime.h>
#include <hip/hip_cooperative_groups.h>
#include <cstdio>
#include <cstdint>
#include <cstring>
namespace cg = cooperative_groups;

constexpr int D = 1024, NCTX = 8192, NLAT = 2048, MTOK = 10240, FF = 4096;
constexpr int QKVW = 1536, DNIN = 4128, DNINP = 4352, PROJW = 4096;
constexpr int KVROWS = 8192 + 2 * 1280;
constexpr float EPS = 1e-6f;
constexpr float ATT_SCALE = 0.08838834764831845f;
constexpr size_t O_Y = 0, O_CK = (size_t)MTOK * D, O_CV = O_CK + 4194304, O_ST = O_CV + 4194304;

typedef unsigned short bf16raw;
typedef float f32x4_t __attribute__((ext_vector_type(4)));
typedef float f32x2_t __attribute__((ext_vector_type(2)));
typedef unsigned u32x4_t __attribute__((ext_vector_type(4)));
typedef unsigned u32x2_t __attribute__((ext_vector_type(2)));

__device__ __forceinline__ unsigned f2bf(float f) { unsigned u = __builtin_bit_cast(unsigned, f); return (u + 0x7fffu + ((u >> 16) & 1u)) >> 16; }
__device__ __forceinline__ unsigned pk2(float lo, float hi) { return f2bf(lo) | (f2bf(hi) << 16); }
__device__ __forceinline__ float bf_lo(unsigned w) { return __builtin_bit_cast(float, w << 16); }
__device__ __forceinline__ float bf_hi(unsigned w) { return __builtin_bit_cast(float, w & 0xffff0000u); }
__device__ __forceinline__ float bf2f(bf16raw h) { return __builtin_bit_cast(float, (unsigned)h << 16); }
__device__ __forceinline__ float silu_f(float x) { return x / (1.f + __expf(-x)); }
__device__ __forceinline__ int cond_of(int row) { return row < NCTX ? 0 : 1 + ((row - NCTX) >> 10); }
__device__ __forceinline__ float lane_xor_f(float v, int lane, int k) { return __builtin_bit_cast(float, __builtin_amdgcn_ds_bpermute((lane ^ k) << 2, __builtin_bit_cast(int, v))); }
__device__ __forceinline__ float wave_sum(float v, int lane) {
#pragma unroll
    for (int o = 1; o < 64; o <<= 1) v += lane_xor_f(v, lane, o);
    return v;
}
__device__ __forceinline__ float wave_max(float v, int lane) {
#pragma unroll
    for (int o = 1; o < 64; o <<= 1) v = fmaxf(v, lane_xor_f(v, lane, o));
    return v;
}
__device__ __forceinline__ float dpp_xadd(float v, const int ctrl_tag) { return v; }
#define DPP_ADD(v, ctrl) ((v) + __builtin_bit_cast(float, __builtin_amdgcn_update_dpp(0, __builtin_bit_cast(int, (v)), (ctrl), 0xf, 0xf, true)))
__device__ __forceinline__ float wave_sum_dpp(float v) {
    v = DPP_ADD(v, 0xB1); v = DPP_ADD(v, 0x4E); v = DPP_ADD(v, 0x141); v = DPP_ADD(v, 0x140);
    const int iv = __builtin_bit_cast(int, v);
    return (__builtin_bit_cast(float, __builtin_amdgcn_readlane(iv, 0)) + __builtin_bit_cast(float, __builtin_amdgcn_readlane(iv, 16))) +
           (__builtin_bit_cast(float, __builtin_amdgcn_readlane(iv, 32)) + __builtin_bit_cast(float, __builtin_amdgcn_readlane(iv, 48)));
}
namespace pg8 {
#define PG8_LAS __attribute__((address_space(3)))
typedef unsigned short bf16_t;
typedef short bf16x8 __attribute__((ext_vector_type(8)));
typedef float f32x4 __attribute__((ext_vector_type(4)));
typedef unsigned u32x4 __attribute__((ext_vector_type(4)));
constexpr int BM = 256, BK = 64, HALF = 128, HTB = HALF * BK * 2  , STAGE_BYTES = 8 * HTB, NXCD = 8, WGM = 8;

__host__ __device__ __forceinline__ int lds_byte(int r, int c) { const int st = (r >> 4) * 2 + (c >> 5), rr = r & 15, cc = c & 31, ob = rr * 64 + cc * 2; return st * 1024 + (ob ^ (((ob >> 9) & 1) << 5)); }
__host__ __device__ __forceinline__ void stage_rc(int b, int& R, int& C) { const int st = b / 1024, sb = b % 1024, swz = sb ^ (((sb >> 9) & 1) << 5); R = (st >> 1) * 16 + swz / 64; C = (st & 1) * 32 + (swz % 64) / 2; }
__host__ __device__ __forceinline__ int perm32(int rho) { const int n = rho >> 4, i = rho & 15; return 8 * (i >> 2) + 4 * n + (i & 3); }

struct Unit { int pm, pn; };
struct Gemm { const bf16_t* A; const bf16_t* Bt; int M, N, K; int z; };

struct StaticOrder {
    int nM, nN, nwg, G, c;
    __host__ __device__ void init(int M, int N, int G_, int c_) { nM = M / BM; nN = N / BM; nwg = nM * nN; G = G_; c = c_; }
    __host__ __device__ bool next(int i, Unit& u) const {
        const long L = (long)i * G + c; if (L >= nwg) return false;
        int wgid = (int)L; { const int q = nwg / NXCD, r = nwg % NXCD, xcd = wgid % NXCD, off = wgid / NXCD; wgid = (xcd < r ? xcd * (q + 1) : r * (q + 1) + (xcd - r) * q) + off; }
        const int nig = WGM * nN, gid = wgid / nig, fm = gid * WGM, gsz = (nM - fm) < WGM ? (nM - fm) : WGM;
        u.pm = fm + ((wgid % nig) % gsz); u.pn = (wgid % nig) / gsz; return true;
    }
    __device__ __forceinline__ void a_ready(const Unit&) const {}
    __device__ __forceinline__ void done(const Unit&) const {}
};

__device__ __forceinline__ unsigned cvt_pk_bf16(float lo, float hi) { unsigned r; asm volatile("v_cvt_pk_bf16_f32 %0, %1, %2" : "=v"(r) : "v"(lo), "v"(hi)); return r; }
typedef float f32x2 __attribute__((ext_vector_type(2)));
__device__ __forceinline__ f32x2 gelu_pk(f32x2 v) {
    const f32x2 av = __builtin_elementwise_abs(v), d = av * 0.2316418882f + 1.0f;
    f32x2 t; t.x = __builtin_amdgcn_rcpf(d.x); t.y = __builtin_amdgcn_rcpf(d.y);
    f32x2 q = t * 0.5307027145f + (-0.7265760135f); q = q * t + 0.7107068705f; q = q * t + (-0.142248368f); q = q * t + 0.127414796f; q = q * t;
    const f32x2 s = (v * v) * (-0.72134752044f);
    f32x2 e; e.x = __builtin_amdgcn_exp2f(s.x); e.y = __builtin_amdgcn_exp2f(s.y);
    const f32x2 m = v * (q * e), r = v - m;
    f32x2 o; o.x = v.x < 0.f ? m.x : r.x; o.y = v.y < 0.f ? m.y : r.y; return o;
}

template <int ACT  > struct EpiBf16 {
    static constexpr bool PERM = true, AFTER_DRAIN = false; static_assert(ACT >= 0 && ACT <= 2, "EpiBf16: ACT is 0 (none), 1 (gelu_pk) or 2 (squared relu)");
    bf16_t* O; int ldc; const float* bias; int split_cols; size_t split_stride; float scale0;
    __device__ __forceinline__ void operator()(const f32x4 (&acc)[2][2][4][2], const Unit& u, int wr, int wc, int fr, int fq) const {
        const int row0 = u.pm * BM + wr * 64 + fr; int colt = u.pn * BM; bf16_t* base = O;
        float sc = 1.f; if (split_cols) { const int t = colt / split_cols; base += (size_t)t * split_stride; colt -= t * split_cols; if (t == 0) sc = scale0; }
        const int col0 = colt + wc * 32 + 8 * fq, bcol0 = u.pn * BM + wc * 32 + 8 * fq;
        f32x4 bv[2][2];
#pragma unroll
        for (int bj = 0; bj < 2; ++bj)
#pragma unroll
            for (int n = 0; n < 2; ++n) bv[bj][n] = bias ? *(const f32x4*)(bias + bcol0 + bj * HALF + 4 * n) : (f32x4){0.f, 0.f, 0.f, 0.f};
#pragma unroll
        for (int ai = 0; ai < 2; ++ai)
#pragma unroll
            for (int m = 0; m < 4; ++m) { bf16_t* rowp = base + (size_t)(row0 + ai * HALF + m * 16) * ldc + col0;
#pragma unroll
                for (int bj = 0; bj < 2; ++bj) { f32x4 v0 = acc[ai][bj][m][0] + bv[bj][0], v1 = acc[ai][bj][m][1] + bv[bj][1];
                    if (ACT == 1) { f32x2 a = gelu_pk((f32x2){v0[0], v0[1]}), b = gelu_pk((f32x2){v0[2], v0[3]}), c = gelu_pk((f32x2){v1[0], v1[1]}), d = gelu_pk((f32x2){v1[2], v1[3]});
                        v0 = (f32x4){a.x, a.y, b.x, b.y}; v1 = (f32x4){c.x, c.y, d.x, d.y}; }
                    if (ACT == 2) { v0 = __builtin_elementwise_max(v0, (f32x4){0.f, 0.f, 0.f, 0.f}); v1 = __builtin_elementwise_max(v1, (f32x4){0.f, 0.f, 0.f, 0.f}); v0 = v0 * v0; v1 = v1 * v1; }
                    v0 = v0 * sc; v1 = v1 * sc; u32x4 w; w.x = cvt_pk_bf16(v0[0], v0[1]); w.y = cvt_pk_bf16(v0[2], v0[3]); w.z = cvt_pk_bf16(v1[0], v1[1]); w.w = cvt_pk_bf16(v1[2], v1[3]);
                    *(u32x4*)(rowp + bj * HALF) = w; } }
    }
};

struct PanelStats {
    unsigned* xbuf;
    unsigned* cnt;
    unsigned* tmo;
    int ntn; float eps;
    unsigned code;
    __device__ __forceinline__ bool run(const f32x4 (&v)[2][2][4][2], const Unit& u, int wr, int wc, int fr, int fq, PG8_LAS unsigned char* lds, int wid, int lane) const {
        typedef float f32x2v __attribute__((ext_vector_type(2)));
        PG8_LAS f32x2v* P = (PG8_LAS f32x2v*)lds;
        PG8_LAS f32x2v* S = (PG8_LAS f32x2v*)(lds + 8192);
        PG8_LAS unsigned* flag = (PG8_LAS unsigned*)(lds + 8192 + 2048);
#pragma unroll
        for (int ai = 0; ai < 2; ++ai)
#pragma unroll
            for (int m = 0; m < 4; ++m) {
                float s = 0.f;
#pragma unroll
                for (int bj = 0; bj < 2; ++bj)
#pragma unroll
                    for (int n = 0; n < 2; ++n) { const f32x4 x = v[ai][bj][m][n]; s += (x[0] + x[1]) + (x[2] + x[3]); }
                s += __shfl_xor(s, 16); s += __shfl_xor(s, 32);
                const float mw = s * (1.0f / 64.0f); float q = 0.f;
#pragma unroll
                for (int bj = 0; bj < 2; ++bj)
#pragma unroll
                    for (int n = 0; n < 2; ++n) { const f32x4 d = v[ai][bj][m][n] - mw; q += (d[0] * d[0] + d[1] * d[1]) + (d[2] * d[2] + d[3] * d[3]); }
                q += __shfl_xor(q, 16); q += __shfl_xor(q, 32);
                if (fq == 0) P[(ai * HALF + wr * 64 + m * 16 + fr) * 4 + wc] = (f32x2v){mw, q};
            }
        asm volatile("s_waitcnt lgkmcnt(0)" ::: "memory"); __builtin_amdgcn_s_barrier(); asm volatile("" ::: "memory");
#if defined(BROKEN_EXCHANGE_NO_WAIT)
#warning BROKEN CONTROL BUILD: the row-statistics exchange does not wait; results are wrong by design
        if (blockIdx.x >= 64) { const long long t0_ = clock64(); while (clock64() - t0_ < 60000) __builtin_amdgcn_s_sleep(8); }
#endif
        const int row = wid * 32 + (lane & 31);
        if (lane < 32) {
            const f32x2v a = P[row * 4 + 0], b = P[row * 4 + 1], c = P[row * 4 + 2], d = P[row * 4 + 3];
            const float mt = (a.x + b.x + c.x + d.x) * 0.25f;
            const float da = a.x - mt, db = b.x - mt, dc = c.x - mt, dd = d.x - mt;
            const float m2 = (a.y + b.y) + (c.y + d.y) + 64.0f * ((da * da + db * db) + (dc * dc + dd * dd));
            unsigned long long* slot = (unsigned long long*)xbuf + ((size_t)(u.pm * BM + row) * 4 + u.pn);
            __hip_atomic_store(slot, ((unsigned long long)__float_as_uint(m2) << 32) | __float_as_uint(mt), __ATOMIC_RELAXED, __HIP_MEMORY_SCOPE_AGENT);
        }
        asm volatile("s_waitcnt vmcnt(0)" ::: "memory");
        if (lane == 0) __hip_atomic_fetch_add(cnt + 64 * u.pm, 1u, __ATOMIC_RELAXED, __HIP_MEMORY_SCOPE_AGENT);
        if (wid == 0) {
            bool dead = false; const unsigned long long t0 = __builtin_amdgcn_s_memrealtime(); const unsigned want = 8u * (unsigned)ntn;
            for (;;) {
#if defined(BROKEN_EXCHANGE_NO_WAIT)
                break;
#endif
                if ((unsigned)__builtin_amdgcn_readfirstlane(__hip_atomic_load(cnt + 64 * u.pm, __ATOMIC_RELAXED, __HIP_MEMORY_SCOPE_AGENT)) >= want) break;
                if (__builtin_amdgcn_s_memrealtime() - t0 > 2000000ull) {
                    if (lane == 0) { unsigned expect = 0u; __hip_atomic_compare_exchange_strong(tmo + 1, &expect, code | (unsigned)(u.pm & 0xff), __ATOMIC_RELAXED, __ATOMIC_RELAXED, __HIP_MEMORY_SCOPE_AGENT);
                                     __hip_atomic_store(tmo, 1u, __ATOMIC_RELAXED, __HIP_MEMORY_SCOPE_AGENT); }
                    dead = true; break; }
                __builtin_amdgcn_s_sleep(2);
            }
            __builtin_amdgcn_fence(__ATOMIC_ACQUIRE, "agent");
            if (lane == 0) flag[0] = dead ? 1u : 0u;
        }
        asm volatile("s_waitcnt vmcnt(0) lgkmcnt(0)" ::: "memory"); __builtin_amdgcn_s_barrier(); asm volatile("" ::: "memory");
        const bool bad = flag[0] != 0u;
        if (lane < 32) {
            const unsigned long long* slot = (const unsigned long long*)xbuf + (size_t)(u.pm * BM + row) * 4; float mt[4], m2[4]; float ms = 0.f;
#pragma unroll
            for (int t = 0; t < 4; ++t) { if (t < ntn) { const unsigned long long w = __hip_atomic_load(slot + t, __ATOMIC_RELAXED, __HIP_MEMORY_SCOPE_AGENT); mt[t] = __uint_as_float((unsigned)w); m2[t] = __uint_as_float((unsigned)(w >> 32)); } else { mt[t] = 0.f; m2[t] = 0.f; } ms += mt[t]; }
            const float mean = ms / (float)ntn; float q = 0.f;
#pragma unroll
            for (int t = 0; t < 4; ++t) if (t < ntn) { const float dm = mt[t] - mean; q += m2[t] + 256.0f * dm * dm; }
            S[row] = (f32x2v){mean, 1.0f / sqrtf(q / (256.0f * (float)ntn) + eps)};
        }
        asm volatile("s_waitcnt lgkmcnt(0)" ::: "memory"); __builtin_amdgcn_s_barrier(); asm volatile("" ::: "memory");
        return bad;
    }
};
struct EpiLnRes {
    static constexpr bool PERM = false, AFTER_DRAIN = true;
    const float* base; float* out; int ldc; const float* bias; PanelStats st; unsigned poison;
    __device__ __forceinline__ void fused(f32x4 (&acc)[2][2][4][2], const Unit& u, int wr, int wc, int fr, int fq, PG8_LAS unsigned char* lds, int wid, int lane) const {
        typedef float f32x2v __attribute__((ext_vector_type(2)));
        const PG8_LAS f32x2v* S = (const PG8_LAS f32x2v*)(lds + 8192);
        const int col0 = u.pn * BM + wc * 32 + 4 * fq;
#pragma unroll
        for (int bj = 0; bj < 2; ++bj)
#pragma unroll
            for (int n = 0; n < 2; ++n) { const f32x4 bv = bias ? *(const f32x4*)(bias + col0 + bj * HALF + n * 16) : (f32x4){0.f, 0.f, 0.f, 0.f};
#pragma unroll
                for (int ai = 0; ai < 2; ++ai)
#pragma unroll
                    for (int m = 0; m < 4; ++m) acc[ai][bj][m][n] += bv; }
        f32x4 pre[4][2][2];
#pragma unroll
        for (int m = 0; m < 4; ++m) { const size_t off = (size_t)(u.pm * BM + wr * 64 + m * 16 + fr) * ldc + col0;
#pragma unroll
            for (int bj = 0; bj < 2; ++bj)
#pragma unroll
                for (int n = 0; n < 2; ++n) pre[m][bj][n] = *(const f32x4*)(base + off + bj * HALF + n * 16); }
        const bool bad = st.run(acc, u, wr, wc, fr, fq, lds, wid, lane) || poison != 0u;
        const float qnan = __builtin_nanf("");
#pragma unroll
        for (int ai = 0; ai < 2; ++ai)
#pragma unroll
            for (int m = 0; m < 4; ++m) { const int r = ai * HALF + wr * 64 + m * 16 + fr; const f32x2v sr = S[r]; const size_t off = (size_t)(u.pm * BM + r) * ldc + col0;
#pragma unroll
                for (int bj = 0; bj < 2; ++bj)
#pragma unroll
                    for (int n = 0; n < 2; ++n) { const f32x4 bs = ai == 0 ? pre[m][bj][n] : *(const f32x4*)(base + off + bj * HALF + n * 16); f32x4 o = bs + (acc[ai][bj][m][n] - sr.x) * sr.y;
                        if (bad) o = (f32x4){qnan, qnan, qnan, qnan}; *(f32x4*)(out + off + bj * HALF + n * 16) = o; }
                if (m & 1) asm volatile("" ::: "memory"); }
    }
};
struct EpiLnResLn {
    static constexpr bool PERM = false, AFTER_DRAIN = true;
    const float* base; float* out; bf16_t* xn; int ldc; const float* bias; PanelStats st1, st2; unsigned poison;
    __device__ __forceinline__ void fused(f32x4 (&acc)[2][2][4][2], const Unit& u, int wr, int wc, int fr, int fq, PG8_LAS unsigned char* lds, int wid, int lane) const {
        typedef float f32x2v __attribute__((ext_vector_type(2))); typedef unsigned u32x2v __attribute__((ext_vector_type(2)));
        const PG8_LAS f32x2v* S = (const PG8_LAS f32x2v*)(lds + 8192);
        const int col0 = u.pn * BM + wc * 32 + 4 * fq;
#pragma unroll
        for (int bj = 0; bj < 2; ++bj)
#pragma unroll
            for (int n = 0; n < 2; ++n) { const f32x4 bv = bias ? *(const f32x4*)(bias + col0 + bj * HALF + n * 16) : (f32x4){0.f, 0.f, 0.f, 0.f};
#pragma unroll
                for (int ai = 0; ai < 2; ++ai)
#pragma unroll
                    for (int m = 0; m < 4; ++m) acc[ai][bj][m][n] += bv; }
        bool bad = st1.run(acc, u, wr, wc, fr, fq, lds, wid, lane) || poison != 0u;
        const float qnan = __builtin_nanf("");
#pragma unroll
        for (int ai = 0; ai < 2; ++ai)
#pragma unroll
            for (int m = 0; m < 4; ++m) { const int r = ai * HALF + wr * 64 + m * 16 + fr; const f32x2v sr = S[r]; const size_t off = (size_t)(u.pm * BM + r) * ldc + col0;
#pragma unroll
                for (int bj = 0; bj < 2; ++bj)
#pragma unroll
                    for (int n = 0; n < 2; ++n) { const f32x4 bs = *(const f32x4*)(base + off + bj * HALF + n * 16); acc[ai][bj][m][n] = bs + (acc[ai][bj][m][n] - sr.x) * sr.y; }
                asm volatile("" : "+v"(acc[ai][0][m][0]), "+v"(acc[ai][0][m][1]), "+v"(acc[ai][1][m][0]), "+v"(acc[ai][1][m][1]));
                if (m & 1) asm volatile("" ::: "memory"); }
        const bool bad1 = bad;
        bad = st2.run(acc, u, wr, wc, fr, fq, lds, wid, lane) || bad;
#pragma unroll
        for (int ai = 0; ai < 2; ++ai)
#pragma unroll
            for (int m = 0; m < 4; ++m) { const int r = ai * HALF + wr * 64 + m * 16 + fr; const f32x2v sr = S[r]; const size_t off = (size_t)(u.pm * BM + r) * ldc + col0;
#pragma unroll
                for (int bj = 0; bj < 2; ++bj)
#pragma unroll
                    for (int n = 0; n < 2; ++n) { const f32x4 x1 = acc[ai][bj][m][n]; *(f32x4*)(out + off + bj * HALF + n * 16) = bad1 ? (f32x4){qnan, qnan, qnan, qnan} : x1;
                        const f32x4 o = (x1 - sr.x) * sr.y; u32x2v w; w.x = cvt_pk_bf16(o[0], o[1]); w.y = cvt_pk_bf16(o[2], o[3]);
                        if (bad) { w.x = 0x7fc07fc0u; w.y = 0x7fc07fc0u; } *(u32x2v*)(xn + off + bj * HALF + n * 16) = w; }
                asm volatile("" ::: "memory"); }
    }
};

template <class Epi, class Sched, bool ALIGN_EPI = false, bool SP2 = false, bool T160 = false>
__device__ __forceinline__ void gemm_phase(PG8_LAS unsigned char* lds, const Gemm g, const Sched& S, const Epi& E, const int row1 = 0) {
    static_assert(!T160 || SP2, "T160 is implemented on the SP2 loop only");
    const int tid = threadIdx.x + g.z, wid = __builtin_amdgcn_readfirstlane(tid >> 6), lane = tid & 63, wr = wid >> 2, wc = wid & 3, fr = lane & 15, fq = lane >> 4;
    const int K = g.K, nt = K / BK;
    unsigned voffA[2], voffB[2], voffA1[2];
#pragma unroll
    for (int i = 0; i < 2; ++i) { int R, C; stage_rc(tid * 16 + i * 8192, R, C); const int Rb = Epi::PERM ? ((R & ~31) + perm32(R & 31)) : R;
        voffA[i] = (unsigned)(R * K + C) * 2u; voffB[i] = (unsigned)(Rb * K + C) * 2u; voffA1[i] = T160 ? (unsigned)((R & 31) * K + C) * 2u : voffA[i]; }
    const size_t kstep = (size_t)(BK * 2);
    const size_t hstep = (size_t)HALF * K * 2;
    const size_t tstep = 2 * hstep;
    const size_t tstepA = T160 ? hstep : tstep;
    const size_t t1step = (size_t)32 * K * 2;
    const unsigned ldsw = (unsigned)wid * 1024u;
    const int aoff = lds_byte(wr * 64 + fr, fq * 8), boff = lds_byte(wc * 32 + fr, fq * 8), aoff1 = lds_byte(wr * 16 + fr, fq * 8);
#define PG8_SA(b, h) (((b) * 2 + (h)) * HTB)
#define PG8_SB(b, h) ((4 + (b) * 2 + (h)) * HTB)
#define PG8_STAGE(bufoff, gbase, voff) do { _Pragma("unroll") for (int _i = 0; _i < 2; ++_i) \
        __builtin_amdgcn_global_load_lds((const unsigned*)((const char*)(gbase) + (voff)[_i]), (PG8_LAS unsigned*)(lds + (bufoff) + ldsw + _i * 8192), 16, 0, 0); } while (0)
#define PG8_LDA(dst, b, h) do { _Pragma("unroll") for (int m = 0; m < 4; ++m) _Pragma("unroll") for (int k = 0; k < 2; ++k) dst[m][k] = *(const PG8_LAS bf16x8*)(lds + PG8_SA(b, h) + aoff + m * 2048 + k * 1024); } while (0)
#define PG8_LDB(dst, b, h) do { _Pragma("unroll") for (int n = 0; n < 2; ++n) _Pragma("unroll") for (int k = 0; k < 2; ++k) dst[n][k] = *(const PG8_LAS bf16x8*)(lds + PG8_SB(b, h) + boff + n * 2048 + k * 1024); } while (0)
#define PG8_MMA(ai, bj, At, Bt) do { __builtin_amdgcn_s_setprio(1); _Pragma("unroll") for (int m = 0; m < 4; ++m) _Pragma("unroll") for (int n = 0; n < 2; ++n) _Pragma("unroll") for (int k = 0; k < 2; ++k) \
        acc[ai][bj][m][n] = __builtin_amdgcn_mfma_f32_16x16x32_bf16(Bt[n][k], At[m][k], acc[ai][bj][m][n], 0, 0, 0); __builtin_amdgcn_s_setprio(0); } while (0)
#define PG8_LDA1(dst, b) do { if constexpr (T160) { _Pragma("unroll") for (int k = 0; k < 2; ++k) At1[0][k] = *(const PG8_LAS bf16x8*)(lds + PG8_SA(b, 1) + aoff1 + k * 1024); } else { PG8_LDA(dst, b, 1); } } while (0)
#define PG8_MMA1(bj, At, Bt) do { if constexpr (T160) { __builtin_amdgcn_s_setprio(1); _Pragma("unroll") for (int n = 0; n < 2; ++n) _Pragma("unroll") for (int k = 0; k < 2; ++k) \
        acc[1][bj][0][n] = __builtin_amdgcn_mfma_f32_16x16x32_bf16(Bt[n][k], At1[0][k], acc[1][bj][0][n], 0, 0, 0); __builtin_amdgcn_s_setprio(0); } else { PG8_MMA(1, bj, At, Bt); } } while (0)
#define PG8_WAIT_V(n) asm volatile("s_waitcnt vmcnt(" #n ")" ::: "memory")
#define PG8_WAIT_L(n) asm volatile("s_waitcnt lgkmcnt(" #n ")" ::: "memory")
#define PG8_BAR __builtin_amdgcn_s_barrier()
#define PG8_SCHED __builtin_amdgcn_sched_barrier(0)
    Unit cur, nxt; int ui = 0;
    if (!S.next(0, cur)) return;
    f32x4 acc[2][2][4][2];
#pragma unroll
    for (int a = 0; a < 2; ++a)
#pragma unroll
        for (int b = 0; b < 2; ++b)
#pragma unroll
            for (int m = 0; m < 4; ++m)
#pragma unroll
                for (int n = 0; n < 2; ++n) acc[a][b][m][n] = (f32x4){0.f, 0.f, 0.f, 0.f};
    bf16x8 At[4][2], B0[2][2], B1[2][2], At1[1][2];
    const char* cA = (const char*)g.A + (size_t)cur.pm * tstepA; const char* cB = (const char*)g.Bt + (size_t)cur.pn * tstep;
#define PG8_DA(pm_) (T160 ? (ptrdiff_t)((size_t)row1 * K * 2 + (size_t)(pm_) * t1step) - (ptrdiff_t)((size_t)(pm_) * tstepA) : (ptrdiff_t)hstep)
    ptrdiff_t dA = PG8_DA(cur.pm), dAn = dA;
    S.a_ready(cur);
    if constexpr (SP2) {
        PG8_STAGE(PG8_SB(0, 0), cB, voffB); PG8_STAGE(PG8_SB(0, 1), cB + hstep, voffB); PG8_STAGE(PG8_SA(0, 0), cA, voffA); PG8_STAGE(PG8_SA(0, 1), cA + dA, voffA1);
        if (wr == 1) PG8_BAR;
        PG8_WAIT_V(2); PG8_BAR;
        PG8_STAGE(PG8_SB(1, 0), cB + kstep, voffB); PG8_STAGE(PG8_SA(1, 0), cA + kstep, voffA); PG8_STAGE(PG8_SB(1, 1), cB + hstep + kstep, voffB);
        PG8_WAIT_V(6); PG8_BAR;
    } else {
        PG8_STAGE(PG8_SB(0, 0), cB, voffB); PG8_STAGE(PG8_SA(0, 0), cA, voffA); PG8_STAGE(PG8_SB(0, 1), cB + hstep, voffB); PG8_STAGE(PG8_SA(0, 1), cA + hstep, voffA);
        if (wr == 1) PG8_BAR;
        PG8_WAIT_V(4); PG8_BAR;
        PG8_STAGE(PG8_SB(1, 0), cB + kstep, voffB); PG8_STAGE(PG8_SA(1, 0), cA + kstep, voffA); PG8_STAGE(PG8_SB(1, 1), cB + hstep + kstep, voffB);
        PG8_WAIT_V(6); PG8_BAR;
    }
    for (;;) {
        const bool has_next = S.next(ui + 1, nxt);
        const char* nA = has_next ? (const char*)g.A + (size_t)nxt.pm * tstepA : cA; const char* nB = has_next ? (const char*)g.Bt + (size_t)nxt.pn * tstep : cB;
        dAn = has_next ? PG8_DA(nxt.pm) : dA;
        for (int t = 0; t < nt; t += 2) {
            const bool last = (t == nt - 2);
            const char* a1 = cA + (size_t)(t + 1) * kstep;
            const char* a2 = last ? nA : cA + (size_t)(t + 2) * kstep; const char* b2 = last ? nB : cB + (size_t)(t + 2) * kstep;
            const char* a3 = a2 + kstep; const char* b3 = b2 + kstep;
            const ptrdiff_t d2 = last ? dAn : dA;
            if (last && has_next) S.a_ready(nxt);
            if constexpr (SP2) {
            PG8_LDB(B0, 0, 0); PG8_LDB(B1, 0, 1); PG8_SCHED; PG8_LDA(At, 0, 0); PG8_STAGE(PG8_SA(1, 1), a1 + dA, voffA1);
            PG8_WAIT_V(8); PG8_WAIT_L(0); PG8_BAR; PG8_MMA(0, 0, At, B0); if constexpr (!T160) { PG8_MMA(0, 1, At, B1); } PG8_BAR; PG8_SCHED;
            PG8_LDA1(At, 0); PG8_STAGE(PG8_SB(0, 0), b2, voffB); PG8_STAGE(PG8_SB(0, 1), b2 + hstep, voffB); PG8_STAGE(PG8_SA(0, 0), a2, voffA);
            PG8_WAIT_V(8); PG8_WAIT_L(0); PG8_BAR; if constexpr (T160) { PG8_MMA(0, 1, At, B1); } PG8_MMA1(0, At, B0); PG8_MMA1(1, At, B1); PG8_BAR; PG8_SCHED;
            PG8_LDB(B0, 1, 0); PG8_LDB(B1, 1, 1); PG8_SCHED; PG8_LDA(At, 1, 0); PG8_STAGE(PG8_SA(0, 1), a2 + d2, voffA1);
            PG8_WAIT_V(8); PG8_WAIT_L(0); PG8_BAR; PG8_MMA(0, 0, At, B0); if constexpr (!T160) { PG8_MMA(0, 1, At, B1); } PG8_BAR; PG8_SCHED;
            PG8_LDA1(At, 1); PG8_STAGE(PG8_SB(1, 0), b3, voffB); PG8_STAGE(PG8_SB(1, 1), b3 + hstep, voffB); PG8_STAGE(PG8_SA(1, 0), a3, voffA);
            PG8_WAIT_V(8); PG8_WAIT_L(0); PG8_BAR; if constexpr (T160) { PG8_MMA(0, 1, At, B1); } PG8_MMA1(0, At, B0); PG8_MMA1(1, At, B1); PG8_BAR; PG8_SCHED;
            } else {
            PG8_LDB(B0, 0, 0); PG8_SCHED; PG8_LDA(At, 0, 0); PG8_STAGE(PG8_SA(1, 1), a1 + hstep, voffA);
            PG8_WAIT_L(8); PG8_BAR; PG8_WAIT_L(0); PG8_MMA(0, 0, At, B0); PG8_BAR; PG8_SCHED;
            PG8_LDB(B1, 0, 1); PG8_STAGE(PG8_SB(0, 0), b2, voffB);
            PG8_BAR; PG8_WAIT_L(0); PG8_MMA(0, 1, At, B1); PG8_BAR;
            PG8_LDA(At, 0, 1); PG8_STAGE(PG8_SA(0, 0), a2, voffA);
            PG8_BAR; PG8_WAIT_L(0); PG8_MMA(1, 0, At, B0); PG8_BAR; PG8_SCHED;
            PG8_STAGE(PG8_SB(0, 1), b2 + hstep, voffB);
            PG8_WAIT_V(6); PG8_BAR; PG8_MMA(1, 1, At, B1); PG8_BAR;
            PG8_LDB(B0, 1, 0); PG8_SCHED; PG8_LDA(At, 1, 0); PG8_STAGE(PG8_SA(0, 1), a2 + hstep, voffA);
            PG8_WAIT_L(8); PG8_BAR; PG8_WAIT_L(0); PG8_MMA(0, 0, At, B0); PG8_BAR; PG8_SCHED;
            PG8_LDB(B1, 1, 1); PG8_STAGE(PG8_SB(1, 0), b3, voffB);
            PG8_BAR; PG8_WAIT_L(0); PG8_MMA(0, 1, At, B1); PG8_BAR;
            PG8_LDA(At, 1, 1); PG8_STAGE(PG8_SA(1, 0), a3, voffA);
            PG8_BAR; PG8_WAIT_L(0); PG8_MMA(1, 0, At, B0); PG8_BAR; PG8_SCHED;
            PG8_STAGE(PG8_SB(1, 1), b3 + hstep, voffB);
            PG8_WAIT_V(6); PG8_BAR; PG8_MMA(1, 1, At, B1); PG8_BAR;
            }
        }
        if constexpr (ALIGN_EPI) { if (wr == 0) PG8_BAR; }
        if constexpr (!Epi::AFTER_DRAIN) { E(acc, cur, wr, wc, fr, fq); S.done(cur); }
        if (!has_next) break;
#pragma unroll
        for (int a = 0; a < 2; ++a)
#pragma unroll
            for (int b = 0; b < 2; ++b)
#pragma unroll
                for (int m = 0; m < 4; ++m)
#pragma unroll
                    for (int n = 0; n < 2; ++n) acc[a][b][m][n] = (f32x4){0.f, 0.f, 0.f, 0.f};
        cur = nxt; cA = nA; cB = nB; dA = dAn; ++ui;
        if constexpr (ALIGN_EPI) { if (wr == 1) PG8_BAR; }
    }
    PG8_WAIT_V(0);
    if constexpr (!ALIGN_EPI) { if (wr == 0) PG8_BAR; }
    PG8_BAR;
    if constexpr (Epi::AFTER_DRAIN) { E.fused(acc, cur, wr, wc, fr, fq, lds, wid, lane); S.done(cur); }
#undef PG8_SA
#undef PG8_SB
#undef PG8_STAGE
#undef PG8_LDA
#undef PG8_LDB
#undef PG8_MMA
#undef PG8_WAIT_V
#undef PG8_LDA1
#undef PG8_MMA1
#undef PG8_DA
#undef PG8_WAIT_L
#undef PG8_BAR
#undef PG8_SCHED
}
}

#ifndef PG8_SP2
#define PG8_SP2 true
#endif
#ifndef PG8_ALIGN
#define PG8_ALIGN true
#endif
namespace pg8 {
typedef __bf16 bf16x2v __attribute__((ext_vector_type(2))); typedef float f32x2v_ __attribute__((ext_vector_type(2)));
__device__ __forceinline__ unsigned cvt_pk_vis(float lo, float hi) { const f32x2v_ v = {lo, hi}; return __builtin_bit_cast(unsigned, __builtin_convertvector(v, bf16x2v)); }
struct EpiRes {
    static constexpr bool PERM = false, AFTER_DRAIN = false;
    const float* src_ctx; const float* src_lat; float* X; const float* gate;
    __device__ __forceinline__ void operator()(const f32x4 (&acc)[2][2][4][2], const Unit& u, int wr, int wc, int fr, int fq) const {
        const int cond = u.pm < 32 ? 0 : 1 + ((u.pm - 32) >> 2);
        const float* g = gate + cond * 6144;
        const float* sb = u.pm < 32 ? src_ctx + (size_t)u.pm * BM * 1024 : src_lat + (size_t)(u.pm - 32) * BM * 1024;
        float* xb = X + (size_t)u.pm * BM * 1024;
        const int col0 = u.pn * BM + wc * 32 + 4 * fq;
        f32x4 gv[2][2];
#pragma unroll
        for (int bj = 0; bj < 2; ++bj)
#pragma unroll
            for (int n = 0; n < 2; ++n) gv[bj][n] = *(const f32x4*)(g + col0 + bj * HALF + n * 16);
#pragma unroll
        for (int ai = 0; ai < 2; ++ai)
#pragma unroll
            for (int m = 0; m < 4; ++m) { const size_t off = (size_t)(ai * HALF + wr * 64 + m * 16 + fr) * 1024 + col0;
#pragma unroll
                for (int bj = 0; bj < 2; ++bj)
#pragma unroll
                    for (int n = 0; n < 2; ++n) { const f32x4 xv = *(const f32x4*)(sb + off + bj * HALF + n * 16);
                        *(f32x4*)(xb + off + bj * HALF + n * 16) = xv + gv[bj][n] * acc[ai][bj][m][n]; } }
    }
};
struct EpiRes160 {
    static constexpr bool PERM = true, AFTER_DRAIN = false;
    bf16_t* X; const float* gate;
    __device__ __forceinline__ void operator()(const f32x4 (&acc)[2][2][4][2], const Unit& u, int wr, int wc, int fr, int fq) const {
        const int col0 = u.pn * BM + wc * 32 + 8 * fq;
        const int cond1 = 1 + (u.pm >> 5);
        bf16_t* xb0 = X + (size_t)u.pm * 128 * 1024 + col0; bf16_t* xb1 = X + ((size_t)NCTX + 32 * u.pm) * 1024 + col0;
        u32x4 xv[5][2]; f32x4 gv[2][2][2];
#pragma unroll
        for (int bj = 0; bj < 2; ++bj) {
#pragma unroll
            for (int n = 0; n < 2; ++n) { gv[0][bj][n] = *(const f32x4*)(gate + col0 + bj * HALF + 4 * n); gv[1][bj][n] = *(const f32x4*)(gate + cond1 * 6144 + col0 + bj * HALF + 4 * n); }
#pragma unroll
            for (int m = 0; m < 4; ++m) xv[m][bj] = *(const u32x4*)(xb0 + (size_t)(wr * 64 + m * 16 + fr) * 1024 + bj * HALF);
            xv[4][bj] = *(const u32x4*)(xb1 + (size_t)(wr * 16 + fr) * 1024 + bj * HALF); }
#pragma unroll
        for (int m = 0; m < 5; ++m) {
            const int hs = m < 4 ? 0 : 1;
            bf16_t* rowp = m < 4 ? xb0 + (size_t)(wr * 64 + m * 16 + fr) * 1024 : xb1 + (size_t)(wr * 16 + fr) * 1024;
#pragma unroll
            for (int bj = 0; bj < 2; ++bj) {
                const f32x4 a0 = m < 4 ? acc[0][bj][m < 4 ? m : 0][0] : acc[1][bj][0][0], a1 = m < 4 ? acc[0][bj][m < 4 ? m : 0][1] : acc[1][bj][0][1];
                const u32x4 x = xv[m][bj];
                const f32x4 x0 = {__builtin_bit_cast(float, x.x << 16), __builtin_bit_cast(float, x.x & 0xffff0000u), __builtin_bit_cast(float, x.y << 16), __builtin_bit_cast(float, x.y & 0xffff0000u)};
                const f32x4 x1 = {__builtin_bit_cast(float, x.z << 16), __builtin_bit_cast(float, x.z & 0xffff0000u), __builtin_bit_cast(float, x.w << 16), __builtin_bit_cast(float, x.w & 0xffff0000u)};
                const f32x4 y0 = x0 + gv[hs][bj][0] * a0, y1 = x1 + gv[hs][bj][1] * a1;
                u32x4 w; w.x = cvt_pk_vis(y0[0], y0[1]); w.y = cvt_pk_vis(y0[2], y0[3]); w.z = cvt_pk_vis(y1[0], y1[1]); w.w = cvt_pk_vis(y1[2], y1[3]);
                *(u32x4*)(rowp + bj * HALF) = w; }
        }
    }
};
struct EpiDnIn {
    static constexpr bool PERM = true, AFTER_DRAIN = false;
    bf16_t* O; float* AB;
    __device__ __forceinline__ void operator()(const f32x4 (&acc)[2][2][4][2], const Unit& u, int wr, int wc, int fr, int fq) const {
        const int row0 = u.pm * BM + wr * 64 + fr;
        if (u.pn < 16) {
            const int col0 = u.pn * BM + wc * 32 + 8 * fq;
#pragma unroll
            for (int ai = 0; ai < 2; ++ai)
#pragma unroll
                for (int m = 0; m < 4; ++m) { bf16_t* rowp = O + (size_t)(row0 + ai * HALF + m * 16) * 4096 + col0;
#pragma unroll
                    for (int bj = 0; bj < 2; ++bj) { const f32x4 v0 = acc[ai][bj][m][0], v1 = acc[ai][bj][m][1];
                        u32x4 w; w.x = cvt_pk_vis(v0[0], v0[1]); w.y = cvt_pk_vis(v0[2], v0[3]); w.z = cvt_pk_vis(v1[0], v1[1]); w.w = cvt_pk_vis(v1[2], v1[3]);
                        *(u32x4*)(rowp + bj * HALF) = w; } }
        } else if (wc == 0) {
#pragma unroll
            for (int ai = 0; ai < 2; ++ai)
#pragma unroll
                for (int m = 0; m < 4; ++m) { float* rp = AB + (size_t)(row0 + ai * HALF + m * 16) * 32 + 8 * fq;
                    *(f32x4*)rp = acc[ai][0][m][0]; *(f32x4*)(rp + 4) = acc[ai][0][m][1]; }
        }
    }
};
}
#include <hip/hip_bf16.h>
namespace attn {
using bf16 = __hip_bfloat16;
constexpr int D = 128, NW = 8, QBLK = 32, KVBLK = 64;
constexpr float SCALE = 0.088388347648318440f;
constexpr float THR = 8.f;
constexpr int SDEPTH = 2;
constexpr int LDQ = 1024, LDK = 256, LDO = 1024;
constexpr size_t SHM_V = KVBLK * D * 2, SHM_K = KVBLK * D * 2, SHM_ATTN = 2 * SHM_V + 2 * SHM_K + NW * 64 * 4;
using bf16x8 = __attribute__((ext_vector_type(8))) short;
using s16x4  = __attribute__((ext_vector_type(4))) short;
using f32x16 = __attribute__((ext_vector_type(16))) float;
using f32x8  = __attribute__((ext_vector_type(8))) float;
using u32x4  = __attribute__((ext_vector_type(4))) unsigned;
#define KSWZ(row, colB) ((row) * 256 + ((colB) ^ (((row) & 7) << 4)))
#define SBAR() __builtin_amdgcn_sched_barrier(0)
__device__ __forceinline__ int crow(int r, int hi) { return (r & 3) + 8 * (r >> 2) + 4 * hi; }
__device__ __forceinline__ unsigned cvtpk(float lo, float hi) {
  unsigned r; asm volatile("v_cvt_pk_bf16_f32 %0, %1, %2" : "=v"(r) : "v"(lo), "v"(hi)); return r;
}
template <typename TIn> struct Stage;
template <> struct Stage<bf16>  { using T = bf16x8;
  __device__ static __forceinline__ T ld8(const bf16* p) { return *reinterpret_cast<const bf16x8*>(p); }
  __device__ static __forceinline__ bf16x8 tobf(T x) { return x; } };
template <> struct Stage<float> { using T = f32x8;
  __device__ static __forceinline__ T ld8(const float* p) { return *reinterpret_cast<const f32x8*>(p); }
  __device__ static __forceinline__ bf16x8 tobf(T x) {
    u32x4 w = {cvtpk(x[0], x[1]), cvtpk(x[2], x[3]), cvtpk(x[4], x[5]), cvtpk(x[6], x[7])}; return *reinterpret_cast<bf16x8*>(&w); } };

__device__ __forceinline__ void partialSM(f32x16& p0, f32x16& p1, float& m_reg, float& mn, float& alpha) {
  constexpr float C = SCALE * 1.4426950408889634f;
  float pmax = p0[0]; for (int r = 1; r < 16; ++r) pmax = fmaxf(pmax, p0[r]); for (int r = 0; r < 16; ++r) pmax = fmaxf(pmax, p1[r]);
  { auto rr = __builtin_amdgcn_permlane32_swap(__float_as_uint(pmax), __float_as_uint(pmax), false, false);
    pmax = fmaxf(__uint_as_float(rr[0]), __uint_as_float(rr[1])); }
  if (__builtin_expect(__all(pmax - m_reg <= THR / SCALE), 1)) { mn = m_reg; alpha = 1.f; }
  else { mn = fmaxf(m_reg, pmax); alpha = __builtin_amdgcn_exp2f((m_reg - mn) * C); m_reg = mn; }
  float mnC = -mn * C;
  for (int r = 0; r < 16; ++r) p0[r] = fmaf(p0[r], C, mnC); for (int r = 0; r < 16; ++r) p1[r] = fmaf(p1[r], C, mnC);
  for (int r = 0; r < 16; ++r) p0[r] = __builtin_amdgcn_exp2f(p0[r]);
}
__device__ __forceinline__ void finishSM(f32x16& p0, f32x16& p1, float alpha, float& l_reg, bf16x8& pa0, bf16x8& pa1, bf16x8& pa2, bf16x8& pa3) {
  for (int r = 0; r < 16; ++r) p1[r] = __builtin_amdgcn_exp2f(p1[r]);
  float ps = 0; for (int r = 0; r < 16; ++r) ps += p0[r]; for (int r = 0; r < 16; ++r) ps += p1[r];
  { auto rr = __builtin_amdgcn_permlane32_swap(__float_as_uint(ps), __float_as_uint(ps), false, false);
    ps = __uint_as_float(rr[0]) + __uint_as_float(rr[1]); }
  l_reg = l_reg * alpha + ps;
#define PK4(P, BASE, OUT) do { unsigned a0 = cvtpk(P[BASE + 0], P[BASE + 1]), a1 = cvtpk(P[BASE + 2], P[BASE + 3]);   \
    unsigned b0 = cvtpk(P[BASE + 4], P[BASE + 5]), b1 = cvtpk(P[BASE + 6], P[BASE + 7]);                              \
    auto r0 = __builtin_amdgcn_permlane32_swap(a0, b0, false, false); auto r1 = __builtin_amdgcn_permlane32_swap(a1, b1, false, false); \
    u32x4 w = {r0[0], r1[0], r0[1], r1[1]}; OUT = *reinterpret_cast<bf16x8*>(&w); } while (0)
  PK4(p0, 0, pa0); PK4(p0, 8, pa1); PK4(p1, 0, pa2); PK4(p1, 8, pa3);
#undef PK4
}
__device__ __forceinline__ void qkt(f32x16& p0, f32x16& p1, const bf16* Ks, const bf16x8* qr, int r32, int hi) {
  p0 = f32x16{}; p1 = f32x16{};
  for (int d0 = 0; d0 < 8; ++d0) { int cb = (d0 * 16 + hi * 8) * 2;
    bf16x8 b0 = *reinterpret_cast<const bf16x8*>((const char*)Ks + KSWZ(r32, cb));
    bf16x8 b1 = *reinterpret_cast<const bf16x8*>((const char*)Ks + KSWZ(32 + r32, cb));
    p0 = __builtin_amdgcn_mfma_f32_32x32x16_bf16(b0, qr[d0], p0, 0, 0, 0);
    p1 = __builtin_amdgcn_mfma_f32_32x32x16_bf16(b1, qr[d0], p1, 0, 0, 0); }
}
__device__ __forceinline__ int v_st(int k, int c) { const int kk = (k & ~0xC) | ((k & 4) << 1) | ((k & 8) >> 1); return ((kk >> 3) * 4 + (c >> 5)) * 512 + ((kk & 7) * 32 + (c & 31)) * 2; }
__device__ __forceinline__ int v_rd_base(int lane) { return ((lane & 3) << 3) | (((lane >> 2) & 3) << 6) | (((lane >> 4) & 1) << 5) | (((lane >> 5) & 1) << 8); }
constexpr int v_rd_off(int d0, int ks, int half) { return d0 * 512 + ks * 4096 + half * 2048; }
template <int OFF> __device__ __forceinline__ s16x4 tr_read(int vb) {
  s16x4 r; asm volatile("ds_read_b64_tr_b16 %0, %1 offset:%2" : "=&v"(r) : "v"(vb), "i"(OFF) : "memory"); return r;
}
template <int D0> __device__ __forceinline__ void pv_one(f32x16& od, int vb, bf16x8 pa0, bf16x8 pa1, bf16x8 pa2, bf16x8 pa3) {
  const s16x4 l0 = tr_read<v_rd_off(D0, 0, 0)>(vb), h0 = tr_read<v_rd_off(D0, 0, 1)>(vb), l1 = tr_read<v_rd_off(D0, 1, 0)>(vb), h1 = tr_read<v_rd_off(D0, 1, 1)>(vb);
  const s16x4 l2 = tr_read<v_rd_off(D0, 2, 0)>(vb), h2 = tr_read<v_rd_off(D0, 2, 1)>(vb), l3 = tr_read<v_rd_off(D0, 3, 0)>(vb), h3 = tr_read<v_rd_off(D0, 3, 1)>(vb);
  asm volatile("s_waitcnt lgkmcnt(0)" ::: "memory"); SBAR();
#define PK(L, H) (bf16x8){L[0], L[1], L[2], L[3], H[0], H[1], H[2], H[3]}
  od = __builtin_amdgcn_mfma_f32_32x32x16_bf16(pa0, PK(l0, h0), od, 0, 0, 0);
  od = __builtin_amdgcn_mfma_f32_32x32x16_bf16(pa1, PK(l1, h1), od, 0, 0, 0);
  od = __builtin_amdgcn_mfma_f32_32x32x16_bf16(pa2, PK(l2, h2), od, 0, 0, 0);
  od = __builtin_amdgcn_mfma_f32_32x32x16_bf16(pa3, PK(l3, h3), od, 0, 0, 0);
#undef PK
}
__device__ __forceinline__ void pv_d0(f32x16* o, int vb, bf16x8 pa0, bf16x8 pa1, bf16x8 pa2, bf16x8 pa3) {
  pv_one<0>(o[0], vb, pa0, pa1, pa2, pa3); pv_one<1>(o[1], vb, pa0, pa1, pa2, pa3); pv_one<2>(o[2], vb, pa0, pa1, pa2, pa3); pv_one<3>(o[3], vb, pa0, pa1, pa2, pa3);
}

template <typename TQ>
__device__ __forceinline__ void attn_dense_body(const TQ* __restrict__ Qb, const bf16* __restrict__ Kh, const bf16* __restrict__ Vh,
                                                unsigned short* __restrict__ Ob, int seq, char* lds, const int tid) {
  using St = Stage<bf16>; using SQ = Stage<TQ>;
  const int wid = tid >> 6, lane = tid & 63, r32 = lane & 31, hi = lane >> 5;
  bf16* V_lds = (bf16*)lds; bf16* K_lds = (bf16*)(lds + 2 * SHM_V);
  float* ws = (float*)(lds + 2 * SHM_V + 2 * SHM_K) + wid * 64; float* li_l = ws; float* al_l = ws + 32;
  float m_reg = -1e30f, l_reg = 0; f32x16 o[4] = {}; bf16x8 qr[8];
  const TQ* Qw = Qb + (int)(wid * QBLK + r32) * LDQ + hi * 8;
#pragma unroll
  for (int d0 = 0; d0 < 8; ++d0) qr[d0] = SQ::tobf(SQ::ld8(Qw + d0 * 16));
  const int sr = tid >> 4, sc = (tid & 15) * 8, vst0 = v_st(sr, sc), vst1 = v_st(32 + sr, sc);
  const int vb0 = (int)(uintptr_t)V_lds + v_rd_base(lane);
  struct { typename St::T vs0, vs1, ks0, ks1; } sr_[SDEPTH];
#define SLOAD(i, k0) do { sr_[i].vs0 = St::ld8(&Vh[(int)((k0) + sr) * LDK + sc]); sr_[i].vs1 = St::ld8(&Vh[(int)((k0) + 32 + sr) * LDK + sc]); \
    sr_[i].ks0 = St::ld8(&Kh[(int)((k0) + sr) * LDK + sc]); sr_[i].ks1 = St::ld8(&Kh[(int)((k0) + 32 + sr) * LDK + sc]); } while (0)
#define SWRITE(b, i) do { *(bf16x8*)((char*)V_lds + (b) * SHM_V + vst0) = St::tobf(sr_[i].vs0);          \
    *(bf16x8*)((char*)V_lds + (b) * SHM_V + vst1) = St::tobf(sr_[i].vs1); int kc = sc * 2;               \
    *(bf16x8*)((char*)K_lds + (b) * SHM_K + KSWZ(sr, kc)) = St::tobf(sr_[i].ks0);                       \
    *(bf16x8*)((char*)K_lds + (b) * SHM_K + KSWZ(32 + sr, kc)) = St::tobf(sr_[i].ks1); } while (0)
#define SWAIT() do { if constexpr (SDEPTH == 2) asm volatile("s_waitcnt vmcnt(4)" ::: "memory"); else asm volatile("s_waitcnt vmcnt(0)" ::: "memory"); } while (0)
#define RESC(a) do { if (__any((a) < 1.f)) { if (hi == 0) al_l[r32] = (a); asm volatile("s_waitcnt lgkmcnt(0)" ::: "memory"); \
    for (int d = 0; d < 4; ++d) for (int r = 0; r < 16; ++r) o[d][r] *= al_l[crow(r, hi)]; } } while (0)
  f32x16 pA0, pA1, pB0, pB1; float mnA, mnB, alA, alB; bf16x8 pa0, pa1, pa2, pa3; const int NT = seq / KVBLK;
  constexpr int SE = 0, SO = SDEPTH - 1;
  SLOAD(SE, 0); asm volatile("s_waitcnt vmcnt(0)" ::: "memory"); SWRITE(0, SE); __syncthreads();
  qkt(pA0, pA1, K_lds, qr, r32, hi); partialSM(pA0, pA1, m_reg, mnA, alA);
  SLOAD(SO, KVBLK); if constexpr (SDEPTH == 2) { if (2 < NT) SLOAD(SE, 2 * KVBLK); }
  SWAIT(); SWRITE(1, SO); __syncthreads();
  for (int j = 1; j + 1 < NT; j += 2) {
    SBAR(); qkt(pB0, pB1, (bf16*)((char*)K_lds + SHM_K), qr, r32, hi);
    finishSM(pA0, pA1, alA, l_reg, pa0, pa1, pa2, pa3); SBAR();
    SLOAD(SO, (j + SDEPTH) * KVBLK); SBAR();
    pv_d0(o, vb0, pa0, pa1, pa2, pa3); partialSM(pB0, pB1, m_reg, mnB, alB);
    __syncthreads(); SWAIT(); SWRITE(0, SE);
    RESC(alB); __syncthreads();
    SBAR(); qkt(pA0, pA1, K_lds, qr, r32, hi);
    finishSM(pB0, pB1, alB, l_reg, pa0, pa1, pa2, pa3); SBAR();
    if (SDEPTH == 1 || j + 3 < NT) SLOAD(SE, (j + 1 + SDEPTH) * KVBLK); SBAR();
    pv_d0(o, vb0 + (int)SHM_V, pa0, pa1, pa2, pa3); partialSM(pA0, pA1, m_reg, mnA, alA);
    __syncthreads(); SWAIT(); SWRITE(1, SO);
    RESC(alA); __syncthreads();
  }
  SBAR(); qkt(pB0, pB1, (bf16*)((char*)K_lds + SHM_K), qr, r32, hi);
  finishSM(pA0, pA1, alA, l_reg, pa0, pa1, pa2, pa3); SBAR();
  pv_d0(o, vb0, pa0, pa1, pa2, pa3); partialSM(pB0, pB1, m_reg, mnB, alB);
  __syncthreads(); RESC(alB);
  finishSM(pB0, pB1, alB, l_reg, pa0, pa1, pa2, pa3); SBAR();
  pv_d0(o, vb0 + (int)SHM_V, pa0, pa1, pa2, pa3);
  if (hi == 0) li_l[r32] = l_reg; asm volatile("s_waitcnt lgkmcnt(0)" ::: "memory");
  float rli[16];
#pragma unroll
  for (int r = 0; r < 16; ++r) rli[r] = __builtin_amdgcn_rcpf(li_l[crow(r, hi)]);
  unsigned short* Ow = Ob + (int)(wid * QBLK) * LDO;
#pragma unroll
  for (int r = 0; r < 16; ++r) { int orow = crow(r, hi);
    for (int d0 = 0; d0 < 4; ++d0) Ow[(int)orow * LDO + d0 * 32 + r32] = (unsigned short)f2bf(o[d0][r] * rli[r]); }
#undef SLOAD
#undef SWRITE
#undef SWAIT
#undef RESC
}

#undef KSWZ
#undef SBAR
}
#define LAS __attribute__((address_space(3)))
constexpr int NWAVES = 8;
constexpr int LDS_BYTES = 147456;
constexpr size_t MiB = (size_t)1 << 20;
constexpr size_t WS_CTL = 0, CTL_ZERO_BYTES = 1 * MiB;
constexpr size_t WS_MODS = 1 * MiB, WS_ROPE = WS_MODS + MiB / 2;
constexpr size_t WS_WT_AIN = 2 * MiB, WS_WT_AOUT = 8 * MiB, WS_WT_DIN = 12 * MiB, WS_WT_DOUT = 29 * MiB, WS_WT_W1 = 33 * MiB, WS_WT_W2 = 65 * MiB;
constexpr size_t WS_X = 97 * MiB, WS_H = 137 * MiB, WS_Y = 157 * MiB, WS_PROJ = 177 * MiB, WS_AB = 257 * MiB;
constexpr size_t WS_SOP = 291 * MiB, WS_QB = 291 * MiB, WS_KB = 311 * MiB, WS_VB = 317 * MiB;
constexpr size_t WS_EGL = 471 * MiB, WS_OF = 472 * MiB, WS_OB = 492 * MiB, WS_END = 512 * MiB;
static_assert(WS_SOP + (size_t)2560 * 73728 <= WS_EGL, "operand records");

struct Ctx {
    LAS unsigned char* lds;
    int tid, lane, wid, gw, ngw, nblk, blk;
};
struct ProPtrs { const float *c, *c_ctx, *w_mod, *b_mod, *attn_w_in, *attn_w_out, *dn_w_in, *dn_w_out, *mlp_w1, *mlp_w2; float *mods, *rope; bf16raw *wt_ain, *wt_aout, *wt_din, *wt_dout, *wt_w1, *wt_w2; const float *x_prompt, *x_sample; bf16raw* X; };

#define LDS_WAIT() asm volatile("s_waitcnt lgkmcnt(0)" ::: "memory")

__device__ __forceinline__ void p0_transpose_item(const float* W, int K, int N, bf16raw* WT, LAS float* scr, int item, int lane) {
    const int nblk = N / 32, kb = item / nblk, nb = item % nblk, k0 = 64 * kb, n0 = 32 * nb;
#pragma unroll 8
    for (int i = 0; i < 32; ++i) { const int kk = 2 * i + (lane >> 5); scr[kk * 33 + (lane & 31)] = W[(size_t)(k0 + kk) * N + n0 + (lane & 31)]; }
    LDS_WAIT(); asm volatile("" ::: "memory");
    const int c = lane & 7;
#pragma unroll
    for (int j = 0; j < 4; ++j) { const int n = (lane >> 3) + 8 * j; const LAS float* s = scr + (8 * c) * 33 + n;
        u32x4_t o; o.x = pk2(s[0 * 33], s[1 * 33]); o.y = pk2(s[2 * 33], s[3 * 33]); o.z = pk2(s[4 * 33], s[5 * 33]); o.w = pk2(s[6 * 33], s[7 * 33]);
        *(u32x4_t*)(WT + (size_t)(n0 + n) * K + k0 + 8 * c) = o; }
    LDS_WAIT(); asm volatile("" ::: "memory");
}

__device__ __forceinline__ void phase_prologue(Ctx& C, const ProPtrs& P) {
    LAS float* sc = (LAS float*)C.lds;
    LAS float* red = (LAS float*)(C.lds + 12288);
    for (int k = C.tid; k < 1024; k += 512) { sc[k] = silu_f(P.c_ctx[k]); sc[1024 + k] = silu_f(P.c[k]); sc[2048 + k] = silu_f(P.c[1024 + k]); }
    __syncthreads();
    for (int u = C.blk; u < 4 * 96; u += C.nblk) {
        const int l = u / 96, n0 = (u % 96) * 64;
        const float* w = P.w_mod + ((size_t)l * 1024 + C.wid * 128) * 6144 + n0 + C.lane;
        float a0 = 0.f, a1 = 0.f, a2 = 0.f;
#pragma unroll 8
        for (int k = 0; k < 128; ++k) { const float wv = w[(size_t)k * 6144]; const int kk = C.wid * 128 + k; a0 += sc[kk] * wv; a1 += sc[1024 + kk] * wv; a2 += sc[2048 + kk] * wv; }
        red[(C.wid * 3 + 0) * 64 + C.lane] = a0; red[(C.wid * 3 + 1) * 64 + C.lane] = a1; red[(C.wid * 3 + 2) * 64 + C.lane] = a2;
        __syncthreads();
        if (C.tid < 192) { const int s = C.tid >> 6, ln = C.tid & 63; float t = 0.f;
#pragma unroll
            for (int w8 = 0; w8 < 8; ++w8) t += red[(w8 * 3 + s) * 64 + ln];
            P.mods[(size_t)(l * 3 + s) * 6144 + n0 + ln] = t + P.b_mod[l * 6144 + n0 + ln]; }
        __syncthreads();
    }
    __syncthreads();
    LAS float* scr = (LAS float*)(C.lds + C.wid * 16384);
    constexpr int I0 = 2 * 768, I1 = 2 * 512, I2 = 2 * 2064, I3 = 2 * 512, I4 = 4 * 2048, I5 = 4 * 2048;
    for (int it = C.gw; it < I0 + I1 + I2 + I3 + I4 + I5; it += C.ngw) {
        int r = it;
        if (r < I0) { const int j = r / 768; p0_transpose_item(P.attn_w_in + (size_t)j * 1024 * 1536, 1024, 1536, P.wt_ain + (size_t)j * 1536 * 1024, scr, r % 768, C.lane); continue; } r -= I0;
        if (r < I1) { const int j = r / 512; p0_transpose_item(P.attn_w_out + (size_t)j * 1024 * 1024, 1024, 1024, P.wt_aout + (size_t)j * 1024 * 1024, scr, r % 512, C.lane); continue; } r -= I1;
        if (r < I2) { const int j = r / 2064; p0_transpose_item(P.dn_w_in + (size_t)j * 1024 * DNIN, 1024, DNIN, P.wt_din + (size_t)j * DNINP * 1024, scr, r % 2064, C.lane); continue; } r -= I2;
        if (r < I3) { const int j = r / 512; p0_transpose_item(P.dn_w_out + (size_t)j * 1024 * 1024, 1024, 1024, P.wt_dout + (size_t)j * 1024 * 1024, scr, r % 512, C.lane); continue; } r -= I3;
        if (r < I4) { const int l = r / 2048; p0_transpose_item(P.mlp_w1 + (size_t)l * 1024 * 4096, 1024, 4096, P.wt_w1 + (size_t)l * 4096 * 1024, scr, r % 2048, C.lane); continue; } r -= I4;
        { const int l = r / 2048; p0_transpose_item(P.mlp_w2 + (size_t)l * 4096 * 1024, 4096, 1024, P.wt_w2 + (size_t)l * 1024 * 4096, scr, r % 2048, C.lane); }
    }
    for (int i = C.blk * 512 + C.tid; i < MTOK * D / 8; i += C.nblk * 512) { const size_t e = (size_t)i * 8;
        const float* src = e < (size_t)NCTX * D ? P.x_prompt + e : P.x_sample + (e - (size_t)NCTX * D);
        const f32x4_t a = *(const f32x4_t*)src, b = *(const f32x4_t*)(src + 4);
        *(u32x4_t*)(P.X + e) = (u32x4_t){pk2(a.x, a.y), pk2(a.z, a.w), pk2(b.x, b.y), pk2(b.z, b.w)}; }
    const int gt = C.blk * 512 + C.tid, ngt = C.nblk * 512;
    for (int i = gt; i < 2 * 28672; i += ngt) { const int j = i / 28672, o = i % 28672;
        *(u32x4_t*)(P.wt_din + ((size_t)j * DNINP + DNIN) * 1024 + (size_t)o * 8) = (u32x4_t){0u, 0u, 0u, 0u}; }
    for (int i = gt; i < 1024 * 64; i += ngt) { const int t = i >> 6, a = (i >> 5) & 1, f = i & 31;
        const float inv = exp2f(-(float)f * (13.287712379549449f / 32.f)); const float ang = (float)(a ? (t & 63) : (t >> 6)) * inv;
        P.rope[2 * i] = __cosf(ang); P.rope[2 * i + 1] = __sinf(ang); }
}

__device__ __forceinline__ void phase_norm(Ctx& C, const bf16raw* X, const float* gain, const float* md0, bf16raw* H) {
    for (int row = C.gw; row < MTOK; row += C.ngw) {
        const float* md = md0 + cond_of(row) * 6144;
        float v[2][8]; float ss = 0.f;
#pragma unroll
        for (int j = 0; j < 2; ++j) { const u32x4_t w = *(const u32x4_t*)(X + (size_t)row * D + 8 * C.lane + 512 * j);
            v[j][0] = bf_lo(w.x); v[j][1] = bf_hi(w.x); v[j][2] = bf_lo(w.y); v[j][3] = bf_hi(w.y); v[j][4] = bf_lo(w.z); v[j][5] = bf_hi(w.z); v[j][6] = bf_lo(w.w); v[j][7] = bf_hi(w.w);
#pragma unroll
            for (int q = 0; q < 8; ++q) ss += v[j][q] * v[j][q]; }
        const float rinv = rsqrtf(wave_sum_dpp(ss) * (1.f / D) + EPS);
#pragma unroll
        for (int j = 0; j < 2; ++j) { const int c = 8 * C.lane + 512 * j; float y[8];
#pragma unroll
            for (int q = 0; q < 2; ++q) { const f32x4_t g = *(const f32x4_t*)(gain + c + 4 * q), sh = *(const f32x4_t*)(md + c + 4 * q), sc = *(const f32x4_t*)(md + 1024 + c + 4 * q);
                y[4 * q + 0] = v[j][4 * q + 0] * rinv * g.x * (sc.x + 1.f) + sh.x; y[4 * q + 1] = v[j][4 * q + 1] * rinv * g.y * (sc.y + 1.f) + sh.y;
                y[4 * q + 2] = v[j][4 * q + 2] * rinv * g.z * (sc.z + 1.f) + sh.z; y[4 * q + 3] = v[j][4 * q + 3] * rinv * g.w * (sc.w + 1.f) + sh.w; }
            *(u32x4_t*)(H + (size_t)row * D + c) = (u32x4_t){pk2(y[0], y[1]), pk2(y[2], y[3]), pk2(y[4], y[5]), pk2(y[6], y[7])}; }
    }
}
__device__ __forceinline__ void phase_final(Ctx& C, const bf16raw* X, const float* final_norm, float* out) {
    for (int row = C.gw; row < MTOK; row += C.ngw) {
        float v[2][8]; float ss = 0.f;
#pragma unroll
        for (int j = 0; j < 2; ++j) { const u32x4_t w = *(const u32x4_t*)(X + (size_t)row * D + 8 * C.lane + 512 * j);
            v[j][0] = bf_lo(w.x); v[j][1] = bf_hi(w.x); v[j][2] = bf_lo(w.y); v[j][3] = bf_hi(w.y); v[j][4] = bf_lo(w.z); v[j][5] = bf_hi(w.z); v[j][6] = bf_lo(w.w); v[j][7] = bf_hi(w.w);
#pragma unroll
            for (int q = 0; q < 8; ++q) ss += v[j][q] * v[j][q]; }
        const float rinv = rsqrtf(wave_sum_dpp(ss) * (1.f / D) + EPS);
#pragma unroll
        for (int j = 0; j < 2; ++j) { const int c = 8 * C.lane + 512 * j;
#pragma unroll
            for (int q = 0; q < 2; ++q) { const f32x4_t g = *(const f32x4_t*)(final_norm + c + 4 * q);
                *(f32x4_t*)(out + O_Y + (size_t)row * D + c + 4 * q) = (f32x4_t){v[j][4 * q] * rinv * g.x, v[j][4 * q + 1] * rinv * g.y, v[j][4 * q + 2] * rinv * g.z, v[j][4 * q + 3] * rinv * g.w}; } }
    }
}

struct QknPtrs { const bf16raw* PROJ; bf16raw *QB, *KB, *VB; const float *qg, *kg, *rope, *cache_k, *cache_v; float* out; };
__device__ __forceinline__ void phase_qkn(Ctx& C, const QknPtrs& P, int j) {
    const unsigned* P32 = (const unsigned*)P.PROJ; unsigned* Q32 = (unsigned*)P.QB; unsigned* K32 = (unsigned*)P.KB; unsigned* V32 = (unsigned*)P.VB;
    const float* qg = P.qg; const float* kg = P.kg;
    const int lane = C.lane;
    const f32x2_t gq = *(const f32x2_t*)(qg + 2 * lane), gk = *(const f32x2_t*)(kg + 2 * lane);
    for (int row = C.gw; row < MTOK; row += C.ngw) {
        const bool lat = row >= NCTX;
        const int b = lat ? (row - NCTX) >> 10 : row >> 8, t = lat ? (row - NCTX) & 1023 : row & 255;
        const int krow = lat ? 8192 + b * 1280 + 256 + t : row;
        f32x4_t rp = (f32x4_t){1.f, 0.f, 1.f, 0.f};
        if (lat) rp = *(const f32x4_t*)(P.rope + ((size_t)t * 64 + (lane >> 5) * 32 + 2 * (lane & 15)) * 2);
        const bool ph = (lane >> 4) & 1;
#pragma unroll
        for (int slot = 0; slot < 12; ++slot) {
            const unsigned w = P32[(size_t)row * 768 + slot * 64 + lane];
            float v0 = bf_lo(w), v1 = bf_hi(w);
            if (slot < 10) {
                const float rinv = rsqrtf(wave_sum(v0 * v0 + v1 * v1, lane) * (1.f / 128.f) + EPS);
                const f32x2_t g = slot < 8 ? gq : gk;
                v0 = v0 * rinv * g.x; v1 = v1 * rinv * g.y;
                if (lat) { const float y0 = lane_xor_f(v0, lane, 16), y1 = lane_xor_f(v1, lane, 16);
                    v0 = v0 * rp.x + (ph ? y0 : -y0) * rp.y; v1 = v1 * rp.z + (ph ? y1 : -y1) * rp.w; }
            }
            const unsigned o = pk2(v0, v1);
            if (slot < 8) Q32[(size_t)row * 512 + slot * 64 + lane] = o;
            else if (slot < 10) K32[(size_t)krow * 128 + (slot - 8) * 64 + lane] = o;
            else V32[(size_t)krow * 128 + (slot - 10) * 64 + lane] = o;
            if (!lat && slot >= 8) { float* op = P.out + (slot < 10 ? O_CK : O_CV) + ((size_t)(b * 2 + j) * 256 + t) * 256 + (slot & 1) * 128 + 2 * lane;
                *(f32x2_t*)op = (f32x2_t){v0, v1}; }
        }
    }
    for (int it = C.gw; it < 2 * 256 * 2; it += C.ngw) {
        const int kv = it & 1, key = (it >> 1) & 255, b = it >> 9;
        const float* src = (kv ? P.cache_v : P.cache_k) + ((size_t)(b * 2 + j) * 256 + key) * 256 + 4 * lane;
        const f32x4_t v = *(const f32x4_t*)src;
        u32x2_t o; o.x = pk2(v.x, v.y); o.y = pk2(v.z, v.w);
        *(u32x2_t*)((kv ? P.VB : P.KB) + (size_t)(8192 + b * 1280 + key) * 256 + 4 * lane) = o;
    }
}

struct AttnPtrs { const bf16raw *QB, *KB, *VB; bf16raw* Y; };
__device__ __forceinline__ void phase_attn(Ctx& C, const AttnPtrs& P) {
    char* lds = (char*)C.lds;
    for (int r = 0; r * C.nblk < 320; ++r) {
        const int u = r * C.nblk + (C.blk + r * (C.nblk - 64)) % C.nblk;
        if (u >= 320) continue;
        int row0, krow0, hq, seq;
        if (u < 64) { const int b = u >> 5, qb = u & 3; hq = (u >> 2) & 7; row0 = NCTX + b * 1024 + qb * 256; krow0 = 8192 + b * 1280; seq = 1280; }
        else { const int c = u - 64, b = c >> 3; hq = c & 7; row0 = b * 256; krow0 = b * 256; seq = 256; }
        const int kvh = hq >> 2;
        if (r > 0) __syncthreads();
        attn::attn_dense_body<attn::bf16>((const attn::bf16*)(P.QB + (size_t)row0 * 1024 + hq * 128), (const attn::bf16*)(P.KB + (size_t)krow0 * 256 + kvh * 128),
                                          (const attn::bf16*)(P.VB + (size_t)krow0 * 256 + kvh * 128), P.Y + (size_t)row0 * 1024 + hq * 128, seq, lds, C.tid);
    }
}
struct GatePtrs { const bf16raw *OF, *OB, *PROJ; bf16raw* Y; const float* gain; };
__device__ __forceinline__ void phase_gate(Ctx& C, const GatePtrs& P) {
    const unsigned* F32 = (const unsigned*)P.OF; const unsigned* B32 = (const unsigned*)P.OB; const unsigned* P32 = (const unsigned*)P.PROJ; unsigned* Y32 = (unsigned*)P.Y;
    const int lane = C.lane;
    const f32x2_t g = *(const f32x2_t*)(P.gain + 2 * lane);
    for (int it = C.gw; it < MTOK * 8; it += C.ngw) {
        const int row = it >> 3, h = it & 7;
        const unsigned wf = F32[(size_t)row * 512 + h * 64 + lane], wb = B32[(size_t)row * 512 + h * 64 + lane], wz = P32[(size_t)row * 2048 + 1536 + h * 64 + lane];
        const float v0 = bf_lo(wf) + bf_lo(wb), v1 = bf_hi(wf) + bf_hi(wb);
        const float rinv = rsqrtf(wave_sum(v0 * v0 + v1 * v1, lane) * (1.f / 128.f) + EPS);
        Y32[(size_t)row * 512 + h * 64 + lane] = pk2(v0 * rinv * g.x * silu_f(bf_lo(wz)), v1 * rinv * g.y * silu_f(bf_hi(wz)));
    }
}
constexpr int REC_U = 0, REC_WN = 16384, REC_QT = 32768, REC_QK = 49152, REC_KT = 57344, REC_BYTES = 73728;
typedef short dn_bf16x8 __attribute__((ext_vector_type(8)));
typedef float dn_f32x16 __attribute__((ext_vector_type(16)));
__device__ __forceinline__ int dn_crow(int r, int hi) { return (r & 3) + 8 * (r >> 2) + 4 * hi; }
typedef __bf16 dn_bf16x2 __attribute__((ext_vector_type(2)));
__device__ __forceinline__ unsigned dn_cvt_pk(float lo, float hi) { const f32x2_t v = {lo, hi}; return __builtin_bit_cast(unsigned, __builtin_convertvector(v, dn_bf16x2)); }

__device__ __forceinline__ dn_bf16x8 dn_acc_frag(const dn_f32x16& a, int s) {
    u32x4_t w;
    if (s == 0) { w.x = dn_cvt_pk(a[0], a[1]); w.y = dn_cvt_pk(a[2], a[3]); w.z = dn_cvt_pk(a[4], a[5]); w.w = dn_cvt_pk(a[6], a[7]); }
    else { w.x = dn_cvt_pk(a[8], a[9]); w.y = dn_cvt_pk(a[10], a[11]); w.z = dn_cvt_pk(a[12], a[13]); w.w = dn_cvt_pk(a[14], a[15]); }
    return __builtin_bit_cast(dn_bf16x8, w);
}

struct DnLocalPtrs { const bf16raw* PROJ; const float *AB, *cw, *alog, *dtb; unsigned char* SOP; float* EGL; };

__device__ __forceinline__ void phase_dn_local(Ctx& C, const DnLocalPtrs& P) {
    constexpr int L_Q = 0, L_K = 17408, L_V = 34816, L_GC = 52224, L_BT = 52736, L_AM = 53248, L_QK = L_AM + 2 * 17408, L_TB = L_QK + 2 * 9216;
    LAS unsigned char* L = C.lds;
    const unsigned* P32 = (const unsigned*)P.PROJ;
    LAS float* gcs = (LAS float*)(L + L_GC); LAS float* bts = (LAS float*)(L + L_BT);
    for (int u = C.blk; u < 1280; u += C.nblk) {
        int tid = C.tid; asm volatile("" : "+v"(tid));
        const int lane = tid & 63, wid = __builtin_amdgcn_readfirstlane(tid >> 6), dir = wid >> 2, w4 = wid & 3, t256 = tid & 255, r32 = lane & 31, hi = lane >> 5;
        const int h = u & 7, cidx = u >> 3;
        int npr, N, T, base, cbase;
        if (cidx < 128) { const int seq = cidx >> 2; npr = cidx & 3; N = 4; T = 256; base = seq * 256; cbase = cidx - npr; }
        else { const int c2 = cidx - 128, sq = c2 >> 4; npr = c2 & 15; N = 16; T = 1024; base = NCTX + sq * 1024; cbase = cidx - npr; }
        if (wid < 2) {
            const int tau = wid ? 63 - lane : lane; const size_t row = (size_t)(base + 64 * npr + tau);
            const float a = P.AB[row * 32 + wid * 8 + h], b = P.AB[row * 32 + 16 + wid * 8 + h];
            const float x = a + P.dtb[wid * 8 + h]; const float sp = fmaxf(x, 0.f) + __logf(1.f + __expf(-fabsf(x)));
            float g = -__expf(P.alog[wid * 8 + h]) * sp;
#pragma unroll
            for (int o = 1; o < 64; o <<= 1) { const float t = __builtin_bit_cast(float, __builtin_amdgcn_ds_bpermute((lane - o) << 2, __builtin_bit_cast(int, g))); if (lane >= o) g += t; }
            gcs[wid * 64 + lane] = g; bts[wid * 64 + lane] = 1.f / (1.f + __expf(-b));
        }
        {
            const int tau0 = 8 * wid;
#pragma unroll
            for (int X = 0; X < 3; ++X) {
                const int cb = X * 1024 + h * 128;
                float w0[12], w1[12];
#pragma unroll
                for (int i = 0; i < 12; ++i) { const int tt = 64 * npr + tau0 - 2 + i; unsigned w = 0u;
                    if (tt >= 0 && tt < T) w = P32[(size_t)(base + tt) * 2048 + (cb >> 1) + lane];
                    w0[i] = bf_lo(w); w1[i] = bf_hi(w); }
                f32x2_t cwv[5];
#pragma unroll
                for (int i = 0; i < 5; ++i) cwv[i] = *(const f32x2_t*)(P.cw + i * 3072 + cb + 2 * lane);
#pragma unroll
                for (int r = 0; r < 8; ++r) {
                    float a0 = 0.f, a1 = 0.f;
#pragma unroll
                    for (int i = 0; i < 5; ++i) { a0 += w0[r + i] * cwv[i].x; a1 += w1[r + i] * cwv[i].y; }
                    a0 = silu_f(a0); a1 = silu_f(a1);
                    if (X < 2) { const float rinv = rsqrtf(wave_sum_dpp(a0 * a0 + a1 * a1) + EPS); a0 *= rinv; a1 *= rinv; }
                    *(LAS unsigned*)(L + (X == 0 ? L_Q : X == 1 ? L_K : L_V) + (tau0 + r) * 272 + lane * 4) = pk2(a0, a1);
                }
            }
        }
        __syncthreads();
        {
            const int ti = w4 >> 1, tj = w4 & 1;
            dn_f32x16 accK = {}, accQ = {};
            if (ti >= tj) {
                const int pa = 32 * ti + r32, pb = 32 * tj + r32;
                const int rowA = dir ? 63 - pa : pa, rowB = dir ? 63 - pb : pb;
#pragma unroll
                for (int s = 0; s < 8; ++s) {
                    const int co = (16 * s + 8 * hi) * 2;
                    const dn_bf16x8 Ak = *(const LAS dn_bf16x8*)(L + L_K + rowA * 272 + co), Aq = *(const LAS dn_bf16x8*)(L + L_Q + rowA * 272 + co), Bk = *(const LAS dn_bf16x8*)(L + L_K + rowB * 272 + co);
                    accK = __builtin_amdgcn_mfma_f32_32x32x16_bf16(Ak, Bk, accK, 0, 0, 0);
                    accQ = __builtin_amdgcn_mfma_f32_32x32x16_bf16(Aq, Bk, accQ, 0, 0, 0);
                }
            }
            const int pj = 32 * tj + r32; const float gcj = gcs[dir * 64 + pj];
#pragma unroll
            for (int reg = 0; reg < 16; ++reg) {
                const int pi = 32 * ti + dn_crow(reg, hi);
                const float dec = pi >= pj ? __expf(gcs[dir * 64 + pi] - gcj) : 0.f;
                const float am = pi > pj ? bts[dir * 64 + pi] * accK[reg] * dec : 0.f;
                const float qk = ATT_SCALE * accQ[reg] * dec;
                *(LAS float*)(L + L_AM + dir * 17408 + pi * 272 + pj * 4) = am;
                *(LAS bf16raw*)(L + L_QK + dir * 9216 + pi * 144 + pj * 2) = (bf16raw)f2bf(qk);
            }
        }
        __syncthreads();
        const int rec_n = dir ? N - 1 - npr : npr;
        const int recid = ((cbase + rec_n) * 8 + h) * 2 + dir;
        unsigned char* rec = P.SOP + (size_t)recid * REC_BYTES;
        if (w4 == 0) {
            const int hf = lane >> 5, c32 = lane & 31, off = 32 * hf;
            const LAS unsigned char* am = L + L_AM + dir * 17408 + off * 272 + off * 4;
            float x[32];
            f32x4_t nx[8];
            nx[0] = (f32x4_t){0.f, 0.f, 0.f, 0.f};
#pragma unroll
            for (int i = 0; i < 32; ++i) {
                f32x4_t cu[8];
#pragma unroll
                for (int j4 = 0; j4 < (i + 3) / 4; ++j4) cu[j4] = nx[j4];
                if (i + 1 < 32) {
#pragma unroll
                    for (int j4 = 0; j4 < (i + 4) / 4; ++j4) nx[j4] = *(const LAS f32x4_t*)(am + (i + 1) * 272 + j4 * 16);
                }
                asm volatile("" ::: "memory");
                float acc0 = (i == c32) ? 1.f : 0.f, acc1 = 0.f;
#pragma unroll
                for (int j4 = 0; j4 < (i + 3) / 4; ++j4) {
                    if (4 * j4 + 0 < i) acc0 -= cu[j4].x * x[4 * j4 + 0];
                    if (4 * j4 + 1 < i) acc1 -= cu[j4].y * x[4 * j4 + 1];
                    if (4 * j4 + 2 < i) acc0 -= cu[j4].z * x[4 * j4 + 2];
                    if (4 * j4 + 3 < i) acc1 -= cu[j4].w * x[4 * j4 + 3];
                }
                x[i] = acc0 + acc1;
            }
            LAS unsigned char* tbd = L + L_TB + dir * 9216;
#pragma unroll
            for (int i = 0; i < 32; ++i) *(LAS bf16raw*)(tbd + (off + i) * 144 + (off + c32) * 2) = (bf16raw)f2bf(x[i]);
            if (hf) {
#pragma unroll
                for (int i = 0; i < 32; ++i) *(LAS bf16raw*)(tbd + i * 144 + (32 + c32) * 2) = (bf16raw)0;
            }
            const LAS unsigned char* amf = L + L_AM + dir * 17408;
            dn_f32x16 Pm = {};
#pragma unroll
            for (int ks = 0; ks < 2; ++ks) {
                const f32x4_t a0 = *(const LAS f32x4_t*)(amf + (32 + r32) * 272 + (16 * ks + 8 * hi) * 4), a1 = *(const LAS f32x4_t*)(amf + (32 + r32) * 272 + (16 * ks + 8 * hi + 4) * 4);
                u32x4_t aw; aw.x = dn_cvt_pk(a0.x, a0.y); aw.y = dn_cvt_pk(a0.z, a0.w); aw.z = dn_cvt_pk(a1.x, a1.y); aw.w = dn_cvt_pk(a1.z, a1.w);
                unsigned short tv[8];
#pragma unroll
                for (int jj = 0; jj < 8; ++jj) tv[jj] = *(const LAS bf16raw*)(tbd + (16 * ks + 8 * hi + jj) * 144 + r32 * 2);
                u32x4_t bw; bw.x = tv[0] | ((unsigned)tv[1] << 16); bw.y = tv[2] | ((unsigned)tv[3] << 16); bw.z = tv[4] | ((unsigned)tv[5] << 16); bw.w = tv[6] | ((unsigned)tv[7] << 16);
                Pm = __builtin_amdgcn_mfma_f32_32x32x16_bf16(__builtin_bit_cast(dn_bf16x8, aw), __builtin_bit_cast(dn_bf16x8, bw), Pm, 0, 0, 0);
            }
            dn_f32x16 Tm = {};
#pragma unroll
            for (int ss = 0; ss < 2; ++ss) {
                const LAS unsigned char* tp = tbd + (32 + r32) * 144 + (32 + 16 * ss + 4 * hi) * 2;
                const u32x2_t tl = *(const LAS u32x2_t*)tp, th = *(const LAS u32x2_t*)(tp + 16);
                const u32x4_t aw = {tl.x, tl.y, th.x, th.y};
                Tm = __builtin_amdgcn_mfma_f32_32x32x16_bf16(__builtin_bit_cast(dn_bf16x8, aw), dn_acc_frag(Pm, ss), Tm, 0, 0, 0);
            }
#pragma unroll
            for (int reg = 0; reg < 16; ++reg) *(LAS bf16raw*)(tbd + (32 + dn_crow(reg, hi)) * 144 + r32 * 2) = (bf16raw)f2bf(-Tm[reg]);
        } else {
            const int t192 = (w4 - 1) * 64 + lane;
            const float glast = gcs[dir * 64 + 63];
            for (int id = t192; id < 1024; id += 192) {
                const int mt = id >> 9, kt = (id >> 6) & 7, r = id & 31, hh = (id >> 5) & 1;
                const int p = 32 * mt + r, dk0 = 32 * (kt >> 1) + 16 * (kt & 1) + 4 * hh;
                const int tau = dir ? 63 - p : p; const float sc = ATT_SCALE * __expf(gcs[dir * 64 + p]);
                const u32x2_t ql = *(const LAS u32x2_t*)(L + L_Q + tau * 272 + dk0 * 2), qh = *(const LAS u32x2_t*)(L + L_Q + tau * 272 + (dk0 + 8) * 2);
                u32x4_t qo; qo.x = dn_cvt_pk(bf_lo(ql.x) * sc, bf_hi(ql.x) * sc); qo.y = dn_cvt_pk(bf_lo(ql.y) * sc, bf_hi(ql.y) * sc);
                qo.z = dn_cvt_pk(bf_lo(qh.x) * sc, bf_hi(qh.x) * sc); qo.w = dn_cvt_pk(bf_lo(qh.y) * sc, bf_hi(qh.y) * sc);
                *(u32x4_t*)(rec + REC_QT + (size_t)id * 16) = qo;
            }
            for (int id = t192; id < 1024; id += 192) {
                const int mt = id >> 8, kt = (id >> 6) & 3, r = id & 31, hh = (id >> 5) & 1;
                const int c0 = 32 * (kt >> 1) + 16 * (kt & 1) + 4 * hh;
                float kv[8];
#pragma unroll
                for (int jj = 0; jj < 8; ++jj) { const int c = c0 + 8 * (jj >> 2) + (jj & 3); const int tau = dir ? 63 - c : c;
                    kv[jj] = bf2f(*(const LAS bf16raw*)(L + L_K + tau * 272 + (32 * mt + r) * 2)) * __expf(glast - gcs[dir * 64 + c]); }
                u32x4_t ko; ko.x = dn_cvt_pk(kv[0], kv[1]); ko.y = dn_cvt_pk(kv[2], kv[3]); ko.z = dn_cvt_pk(kv[4], kv[5]); ko.w = dn_cvt_pk(kv[6], kv[7]);
                *(u32x4_t*)(rec + REC_KT + (size_t)id * 16) = ko;
            }
            for (int id = t192; id < 512; id += 192) {
                const int mt = id >> 8, kt = (id >> 6) & 3, r = id & 31, hh = (id >> 5) & 1;
                const int c0 = 32 * (kt >> 1) + 16 * (kt & 1) + 4 * hh;
                const LAS unsigned char* qp = L + L_QK + dir * 9216 + (32 * mt + r) * 144;
                const u32x2_t qa = *(const LAS u32x2_t*)(qp + c0 * 2), qb = *(const LAS u32x2_t*)(qp + (c0 + 8) * 2);
                *(u32x4_t*)(rec + REC_QK + (size_t)id * 16) = (u32x4_t){qa.x, qa.y, qb.x, qb.y};
            }
            if (t192 == 0) P.EGL[recid] = __expf(glast);
        }
        __syncthreads();
        {
            const bool isK = w4 >= 2;
            const LAS unsigned char* srcb = L + (isK ? L_K : L_V);
            dn_f32x16 acc[2][2] = {};
#pragma unroll
            for (int ks = 0; ks < 4; ++ks) {
                dn_bf16x8 At[2];
#pragma unroll
                for (int mt = 0; mt < 2; ++mt) At[mt] = *(const LAS dn_bf16x8*)(L + L_TB + dir * 9216 + (32 * mt + r32) * 144 + (16 * ks + 8 * hi) * 2);
                float bt[8], eg8[8];
#pragma unroll
                for (int jj = 0; jj < 8; ++jj) { const int jrow = 16 * ks + 8 * hi + jj; bt[jj] = bts[dir * 64 + jrow]; eg8[jj] = isK ? __expf(gcs[dir * 64 + jrow]) : 1.f; }
#pragma unroll
                for (int nl = 0; nl < 2; ++nl) {
                    const int col = (32 * (2 * w4 + nl) + r32) & 127;
                    float rv[8];
#pragma unroll
                    for (int jj = 0; jj < 8; ++jj) { const int jrow = 16 * ks + 8 * hi + jj; const int tau = dir ? 63 - jrow : jrow;
                        rv[jj] = bf2f(*(const LAS bf16raw*)(srcb + tau * 272 + col * 2)) * bt[jj] * eg8[jj]; }
                    u32x4_t bw; bw.x = dn_cvt_pk(rv[0], rv[1]); bw.y = dn_cvt_pk(rv[2], rv[3]); bw.z = dn_cvt_pk(rv[4], rv[5]); bw.w = dn_cvt_pk(rv[6], rv[7]);
                    const dn_bf16x8 Bf = __builtin_bit_cast(dn_bf16x8, bw);
#pragma unroll
                    for (int mt = 0; mt < 2; ++mt) acc[mt][nl] = __builtin_amdgcn_mfma_f32_32x32x16_bf16(At[mt], Bf, acc[mt][nl], 0, 0, 0);
                }
            }
            if (!isK) {
#pragma unroll
                for (int mt = 0; mt < 2; ++mt)
#pragma unroll
                    for (int nl = 0; nl < 2; ++nl) { const dn_f32x16 a = acc[mt][nl];
                        u32x4_t o0, o1; o0.x = dn_cvt_pk(a[0], a[1]); o0.y = dn_cvt_pk(a[2], a[3]); o0.z = dn_cvt_pk(a[4], a[5]); o0.w = dn_cvt_pk(a[6], a[7]);
                        o1.x = dn_cvt_pk(a[8], a[9]); o1.y = dn_cvt_pk(a[10], a[11]); o1.z = dn_cvt_pk(a[12], a[13]); o1.w = dn_cvt_pk(a[14], a[15]);
                        unsigned char* up = rec + REC_U + (size_t)(((mt * 4 + 2 * w4 + nl) * 64 + lane) * 32);
                        *(u32x4_t*)up = o0; *(u32x4_t*)(up + 16) = o1; }
            } else {
#pragma unroll
                for (int mt = 0; mt < 2; ++mt)
#pragma unroll
                    for (int nl = 0; nl < 2; ++nl) { const int dk = 32 * (2 * (w4 - 2) + nl) + r32;
#pragma unroll
                        for (int reg = 0; reg < 16; ++reg) *(LAS bf16raw*)(L + L_AM + dir * 17408 + (32 * mt + dn_crow(reg, hi)) * 264 + dk * 2) = (bf16raw)f2bf(-acc[mt][nl][reg]); }
            }
        }
        __syncthreads();
        {
            const LAS unsigned char* wt = L + L_AM + dir * 17408;
#pragma unroll
            for (int i = 0; i < 4; ++i) {
                const int id = t256 + 256 * i, mt = id >> 9, kt = (id >> 6) & 7, r = id & 31, hh = (id >> 5) & 1;
                const int p = 32 * mt + r, dk0 = 32 * (kt >> 1) + 16 * (kt & 1) + 4 * hh;
                const u32x2_t wl = *(const LAS u32x2_t*)(wt + p * 264 + dk0 * 2), wh = *(const LAS u32x2_t*)(wt + p * 264 + (dk0 + 8) * 2);
                *(u32x4_t*)(rec + REC_WN + (size_t)id * 16) = (u32x4_t){wl.x, wl.y, wh.x, wh.y};
            }
        }
        __syncthreads();
    }
}

struct DnScanPtrs { const unsigned char* SOP; const float *EGL, *state_delta; bf16raw *OF, *OB; float* out; };


__device__ __forceinline__ void phase_dn_scan(Ctx& C, const DnScanPtrs& P, int j) {
    const int slot = C.wid * C.nblk + C.blk, nslot = C.ngw;
    for (int r = 0; r * nslot < 2176; ++r) {
        const int u = r * nslot + (slot + r * (nslot - 128)) % nslot;
        if (u >= 2176) continue;
        int lane = C.lane; asm volatile("" : "+v"(lane));
        const int r32 = lane & 31, hi = lane >> 5;
        int seq, h, dir, sl, N, T, base, cbase; bool lat = u < 128;
        if (lat) { seq = 32 + (u >> 6); h = (u >> 3) & 7; dir = (u >> 2) & 1; sl = u & 3; N = 16; T = 1024; base = NCTX + (seq - 32) * 1024; cbase = 128 + 16 * (seq - 32); }
        else { const int c = u - 128; seq = c >> 6; h = (c >> 3) & 7; dir = (c >> 2) & 1; sl = c & 3; N = 4; T = 256; base = seq * 256; cbase = 4 * seq; }
        dn_f32x16 S[4];
        if (lat) { const float* sp = P.state_delta + ((((size_t)(seq - 32) * 2 + j) * 2 + dir) * 8 + h) * 16384 + 32 * sl + r32;
#pragma unroll
            for (int t4 = 0; t4 < 4; ++t4)
#pragma unroll
                for (int reg = 0; reg < 16; ++reg) S[t4][reg] = sp[(size_t)(32 * t4 + dn_crow(reg, hi)) * 128]; }
        else {
#pragma unroll
            for (int t4 = 0; t4 < 4; ++t4) S[t4] = (dn_f32x16){}; }
        bf16raw* Od = (dir ? P.OB : P.OF) + (size_t)base * 1024 + h * 128 + 32 * sl + r32;
        for (int n = 0; n < N; ++n) {
            const int recid = ((cbase + n) * 8 + h) * 2 + dir;
            const unsigned char* rec = P.SOP + (size_t)recid * REC_BYTES + lane * 16;
            const float eg = P.EGL[recid];
            dn_bf16x8 Sb[8];
#pragma unroll
            for (int kt = 0; kt < 8; ++kt) Sb[kt] = dn_acc_frag(S[kt >> 1], kt & 1);
#define DN_FENCE() asm volatile("" ::: "memory")
#define DN_LD8(F, off) do { _Pragma("unroll") for (int q_ = 0; q_ < 8; ++q_) F[q_] = *(const dn_bf16x8*)(rec + (off) + q_ * 1024); } while (0)
            dn_bf16x8 F[8];
            dn_f32x16 av[2];
#pragma unroll
            for (int mt = 0; mt < 2; ++mt) {
                const unsigned char* up = P.SOP + (size_t)recid * REC_BYTES + REC_U + (size_t)(((mt * 4 + sl) * 64 + lane) * 32);
                const u32x4_t u0 = *(const u32x4_t*)up, u1 = *(const u32x4_t*)(up + 16);
                DN_LD8(F, REC_WN + mt * 8192);
                DN_FENCE();
                dn_f32x16 a;
                a[0] = bf_lo(u0.x); a[1] = bf_hi(u0.x); a[2] = bf_lo(u0.y); a[3] = bf_hi(u0.y); a[4] = bf_lo(u0.z); a[5] = bf_hi(u0.z); a[6] = bf_lo(u0.w); a[7] = bf_hi(u0.w);
                a[8] = bf_lo(u1.x); a[9] = bf_hi(u1.x); a[10] = bf_lo(u1.y); a[11] = bf_hi(u1.y); a[12] = bf_lo(u1.z); a[13] = bf_hi(u1.z); a[14] = bf_lo(u1.w); a[15] = bf_hi(u1.w);
#pragma unroll
                for (int kt = 0; kt < 8; ++kt) a = __builtin_amdgcn_mfma_f32_32x32x16_bf16(F[kt], Sb[kt], a, 0, 0, 0);
                av[mt] = a;
                DN_FENCE();
            }
            dn_bf16x8 vb[4];
#pragma unroll
            for (int kt = 0; kt < 4; ++kt) vb[kt] = dn_acc_frag(av[kt >> 1], kt & 1);
            dn_f32x16 ao[2];
#pragma unroll
            for (int mt = 0; mt < 2; ++mt) {
                DN_LD8(F, REC_QT + mt * 8192);
                DN_FENCE();
                dn_f32x16 a = {};
#pragma unroll
                for (int kt = 0; kt < 8; ++kt) a = __builtin_amdgcn_mfma_f32_32x32x16_bf16(F[kt], Sb[kt], a, 0, 0, 0);
                ao[mt] = a;
                DN_FENCE();
            }
            DN_LD8(F, REC_QK);
            DN_FENCE();
#pragma unroll
            for (int mt = 0; mt < 2; ++mt) {
                dn_f32x16 a = ao[mt];
#pragma unroll
                for (int kt = 0; kt < 4; ++kt) a = __builtin_amdgcn_mfma_f32_32x32x16_bf16(F[mt * 4 + kt], vb[kt], a, 0, 0, 0);
#pragma unroll
                for (int reg = 0; reg < 16; ++reg) { const int p = 64 * n + 32 * mt + dn_crow(reg, hi); const int t = dir ? T - 1 - p : p;
                    Od[(size_t)t * 1024] = (bf16raw)f2bf(a[reg]); }
            }
            DN_FENCE();
#pragma unroll
            for (int t2 = 0; t2 < 2; ++t2) {
                DN_LD8(F, REC_KT + t2 * 8192);
                DN_FENCE();
#pragma unroll
                for (int tt = 0; tt < 2; ++tt) {
                    dn_f32x16 a = S[2 * t2 + tt] * eg;
#pragma unroll
                    for (int kt = 0; kt < 4; ++kt) a = __builtin_amdgcn_mfma_f32_32x32x16_bf16(F[tt * 4 + kt], vb[kt], a, 0, 0, 0);
                    S[2 * t2 + tt] = a;
                }
                DN_FENCE();
            }
#undef DN_FENCE
#undef DN_LD8
        }
        if (!lat) { float* sp = P.out + O_ST + ((((size_t)seq * 2 + j) * 2 + dir) * 8 + h) * 16384 + 32 * sl + r32;
#pragma unroll
            for (int t4 = 0; t4 < 4; ++t4)
#pragma unroll
                for (int reg = 0; reg < 16; ++reg) sp[(size_t)(32 * t4 + dn_crow(reg, hi)) * 128] = S[t4][reg]; }
    }
}

__device__ __forceinline__ void phase_dn_scan2(Ctx& C, const DnScanPtrs& P, int j) {
    LAS unsigned char* L = C.lds;
    const int wid = C.wid; const bool consumer = wid < 4; const int sl = wid & 3;
    const int nun = C.nblk == 256 ? (C.blk < 32 ? 1 : 3) : (544 + C.nblk - 1) / C.nblk;
    for (int ui = 0; ui < nun; ++ui) {
        int sid;
        if (C.nblk == 256) { if (C.blk < 32) sid = C.blk; else { const int c = (C.blk - 32) + 224 * ui; if (c >= 512) break; sid = 32 + c; } }
        else { sid = C.blk + ui * C.nblk; if (sid >= 544) break; }
        int lane = C.lane; asm volatile("" : "+v"(lane));
        const int r32 = lane & 31, hi = lane >> 5;
        int seq, h, dir, N, T, base, cbase; const bool lat = sid < 32;
        if (lat) { seq = 32 + (sid >> 4); h = (sid >> 1) & 7; dir = sid & 1; N = 16; T = 1024; base = NCTX + (seq - 32) * 1024; cbase = 128 + 16 * (seq - 32); }
        else { const int c = sid - 32; seq = c >> 4; h = (c >> 1) & 7; dir = c & 1; N = 4; T = 256; base = seq * 256; cbase = 4 * seq; }
        const int rec0 = (cbase * 8 + h) * 2 + dir;
        const unsigned char* rbase = P.SOP + (size_t)rec0 * REC_BYTES;
        constexpr size_t RSTRIDE = (size_t)16 * REC_BYTES;
#define DN2_BAR() __builtin_amdgcn_s_barrier()
        if (consumer) {
            dn_f32x16 S[4];
            if (lat) { const float* sp = P.state_delta + ((((size_t)(seq - 32) * 2 + j) * 2 + dir) * 8 + h) * 16384 + 32 * sl + r32;
#pragma unroll
                for (int t4 = 0; t4 < 4; ++t4)
#pragma unroll
                    for (int reg = 0; reg < 16; ++reg) S[t4][reg] = sp[(size_t)(32 * t4 + dn_crow(reg, hi)) * 128]; }
            else {
#pragma unroll
                for (int t4 = 0; t4 < 4; ++t4) S[t4] = (dn_f32x16){}; }
            bf16raw* Od = (dir ? P.OB : P.OF) + (size_t)base * 1024 + h * 128 + 32 * sl + r32;
            u32x4_t ua[2][2];
#pragma unroll
            for (int mt = 0; mt < 2; ++mt) { const unsigned char* up = rbase + REC_U + (size_t)(((mt * 4 + sl) * 64 + lane) * 32); ua[mt][0] = *(const u32x4_t*)up; ua[mt][1] = *(const u32x4_t*)(up + 16); }
            int g = 0;
#define DN2_CSYNC() do { asm volatile("s_waitcnt lgkmcnt(0)" ::: "memory"); DN2_BAR(); asm volatile("" ::: "memory"); } while (0)
#define DN2_RD8(F) do { const LAS unsigned char* sp_ = L + (g & 15) * 8192 + lane * 16; _Pragma("unroll") for (int q_ = 0; q_ < 8; ++q_) F[q_] = *(const LAS dn_bf16x8*)(sp_ + q_ * 1024); ++g; } while (0)
            for (int n = 0; n < N; ++n) {
                const float eg = P.EGL[rec0 + 16 * n];
                dn_bf16x8 Sb[8];
#pragma unroll
                for (int kt = 0; kt < 8; ++kt) Sb[kt] = dn_acc_frag(S[kt >> 1], kt & 1);
                dn_bf16x8 F[8];
                dn_f32x16 av[2];
#pragma unroll
                for (int mt = 0; mt < 2; ++mt) {
                    DN2_CSYNC(); DN2_RD8(F);
                    const u32x4_t u0 = ua[mt][0], u1 = ua[mt][1];
                    dn_f32x16 a;
                    a[0] = bf_lo(u0.x); a[1] = bf_hi(u0.x); a[2] = bf_lo(u0.y); a[3] = bf_hi(u0.y); a[4] = bf_lo(u0.z); a[5] = bf_hi(u0.z); a[6] = bf_lo(u0.w); a[7] = bf_hi(u0.w);
                    a[8] = bf_lo(u1.x); a[9] = bf_hi(u1.x); a[10] = bf_lo(u1.y); a[11] = bf_hi(u1.y); a[12] = bf_lo(u1.z); a[13] = bf_hi(u1.z); a[14] = bf_lo(u1.w); a[15] = bf_hi(u1.w);
#pragma unroll
                    for (int kt = 0; kt < 8; ++kt) a = __builtin_amdgcn_mfma_f32_32x32x16_bf16(F[kt], Sb[kt], a, 0, 0, 0);
                    av[mt] = a;
                }
                if (n + 1 < N) {
#pragma unroll
                    for (int mt = 0; mt < 2; ++mt) { const unsigned char* up = rbase + (size_t)(n + 1) * RSTRIDE + REC_U + (size_t)(((mt * 4 + sl) * 64 + lane) * 32); ua[mt][0] = *(const u32x4_t*)up; ua[mt][1] = *(const u32x4_t*)(up + 16); }
                }
                dn_bf16x8 vb[4];
#pragma unroll
                for (int kt = 0; kt < 4; ++kt) vb[kt] = dn_acc_frag(av[kt >> 1], kt & 1);
                dn_f32x16 ao[2];
#pragma unroll
                for (int mt = 0; mt < 2; ++mt) {
                    DN2_CSYNC(); DN2_RD8(F);
                    dn_f32x16 a = {};
#pragma unroll
                    for (int kt = 0; kt < 8; ++kt) a = __builtin_amdgcn_mfma_f32_32x32x16_bf16(F[kt], Sb[kt], a, 0, 0, 0);
                    ao[mt] = a;
                }
                DN2_CSYNC(); DN2_RD8(F);
#pragma unroll
                for (int mt = 0; mt < 2; ++mt) {
                    dn_f32x16 a = ao[mt];
#pragma unroll
                    for (int kt = 0; kt < 4; ++kt) a = __builtin_amdgcn_mfma_f32_32x32x16_bf16(F[mt * 4 + kt], vb[kt], a, 0, 0, 0);
#pragma unroll
                    for (int reg = 0; reg < 16; ++reg) { const int p = 64 * n + 32 * mt + dn_crow(reg, hi); const int t = dir ? T - 1 - p : p;
                        Od[(size_t)t * 1024] = (bf16raw)f2bf(a[reg]); }
                }
#pragma unroll
                for (int t2 = 0; t2 < 2; ++t2) {
                    DN2_CSYNC(); DN2_RD8(F);
#pragma unroll
                    for (int tt = 0; tt < 2; ++tt) {
                        dn_f32x16 a = S[2 * t2 + tt] * eg;
#pragma unroll
                        for (int kt = 0; kt < 4; ++kt) a = __builtin_amdgcn_mfma_f32_32x32x16_bf16(F[tt * 4 + kt], vb[kt], a, 0, 0, 0);
                        S[2 * t2 + tt] = a;
                    }
                }
            }
            DN2_CSYNC();
            if (!lat) { float* sp = P.out + O_ST + ((((size_t)seq * 2 + j) * 2 + dir) * 8 + h) * 16384 + 32 * sl + r32;
#pragma unroll
                for (int t4 = 0; t4 < 4; ++t4)
#pragma unroll
                    for (int reg = 0; reg < 16; ++reg) sp[(size_t)(32 * t4 + dn_crow(reg, hi)) * 128] = S[t4][reg]; }
#undef DN2_CSYNC
#undef DN2_RD8
        } else {
            const int ld = wid - 4;
            int ln = 0, ls = 0;
            const unsigned char* gsrc = rbase + REC_WN + (size_t)(2 * ld) * 1024 + lane * 16;
#define DN2_ISSUE(slot) do { const unsigned char* s_ = gsrc + (size_t)ln * RSTRIDE + ls * 8192; LAS unsigned char* d_ = L + (slot) * 8192 + (2 * ld) * 1024; \
        __builtin_amdgcn_global_load_lds((const unsigned*)s_, (LAS unsigned*)d_, 16, 0, 0); __builtin_amdgcn_global_load_lds((const unsigned*)(s_ + 1024), (LAS unsigned*)(d_ + 1024), 16, 0, 0); \
        if (++ls == 7) { ls = 0; if (ln < N - 1) ++ln; } } while (0)
            for (int q = 0; q < 15; ++q) DN2_ISSUE(q);
            const int G = 7 * N;
            for (int g = 0; g < G; ++g) {
                asm volatile("s_waitcnt vmcnt(28)" ::: "memory");
                DN2_BAR();
                DN2_ISSUE((g + 15) & 15);
            }
            asm volatile("s_waitcnt vmcnt(0)" ::: "memory");
            DN2_BAR();
#undef DN2_ISSUE
        }
#undef DN2_BAR
    }
}
#define XB_TMO      128
#define XB_XCNT(j)  (256  + 64 * (j))
#define XB_XSUB(j)  (1280 + 64 * (j))
#define XB_XGEN(j)  (2304 + 64 * (j))
#define XB_TOP      3328
#define XB_TOPGEN   3392
#define XCD_BAR_WORDS 3456
#define XB_SPIN_CAP (1u << 18)

__device__ __forceinline__ unsigned xb_ld(unsigned* p)              { return __hip_atomic_load(p, __ATOMIC_RELAXED, __HIP_MEMORY_SCOPE_AGENT); }
__device__ __forceinline__ unsigned xb_add(unsigned* p, unsigned v) { return __hip_atomic_fetch_add(p, v, __ATOMIC_RELAXED, __HIP_MEMORY_SCOPE_AGENT); }
__device__ __forceinline__ unsigned xb_xcc_id() { return (unsigned)__builtin_amdgcn_s_getreg((3 << 11) | 20) & 0xFu; }
#define XB_SPIN(cond, bar) do { unsigned _sp = 0; while (cond) { __builtin_amdgcn_s_sleep(1); \
    if ((++_sp & 255u) == 0u) { if (xb_ld(&(bar)[XB_TMO])) break; if (_sp > XB_SPIN_CAP) { atomicAdd(&(bar)[XB_TMO], 1u); break; } } } } while (0)

struct XcdBarrier {
    unsigned* bar; unsigned x;
    volatile LAS unsigned* st;
};

__device__ __forceinline__ XcdBarrier xcd_barrier_post(unsigned* bar, volatile LAS unsigned* st) {
    XcdBarrier b; b.bar = bar; b.x = xb_xcc_id(); b.st = st;
    if (threadIdx.x == 0) (void)xb_add(&bar[XB_XCNT(b.x)], 1u);
    return b;
}
__device__ __forceinline__ void xcd_barrier_complete(unsigned* bar, unsigned x, unsigned& nloc, unsigned& nx) {
    const unsigned G = gridDim.x * gridDim.y * gridDim.z;
    unsigned sum, cnt, mine, sp = 0u;
    for (;;) {
        sum = 0u; cnt = 0u; mine = 0u;
#pragma unroll
        for (unsigned j = 0; j < 16; ++j) { const unsigned c = xb_ld(&bar[XB_XCNT(j)]); sum += c; cnt += (c > 0u) ? 1u : 0u; mine = (j == x) ? c : mine; }
        if (sum == G) break;
        __builtin_amdgcn_s_sleep(1);
        if ((++sp & 255u) == 0u) { if (xb_ld(&bar[XB_TMO])) break; if (sp > XB_SPIN_CAP) { atomicAdd(&bar[XB_TMO], 1u); break; } }
    }
    nloc = mine > 0u ? mine : 1u; nx = cnt > 0u ? cnt : 1u;
}

__device__ __forceinline__ void xcd_barrier(const XcdBarrier& b) {
    asm volatile("s_waitcnt vmcnt(0)" ::: "memory");
    __syncthreads();
    if (threadIdx.x == 0) {
        unsigned* bar = b.bar;
        __builtin_amdgcn_s_waitcnt(0);
        unsigned nloc = b.st[0], nx = b.st[1];
        const unsigned old = xb_add(&bar[XB_XSUB(b.x)], 1u);
        const unsigned gen = old / nloc;
        if (old + 1u == (gen + 1u) * nloc) {
            __builtin_amdgcn_fence(__ATOMIC_RELEASE, "agent");
            asm volatile("s_waitcnt vmcnt(0)" ::: "memory");
            const unsigned og = xb_add(&bar[XB_TOP], 1u);
            const unsigned tg = og / nx;
            if (og + 1u == (tg + 1u) * nx) xb_add(&bar[XB_TOPGEN], 1u);
            else XB_SPIN(xb_ld(&bar[XB_TOPGEN]) == tg, bar);
            __builtin_amdgcn_fence(__ATOMIC_ACQUIRE, "agent");
            xb_add(&bar[XB_XGEN(b.x)], 1u);
            asm volatile("s_waitcnt vmcnt(0)" ::: "memory");
        } else {
            XB_SPIN(xb_ld(&bar[XB_XGEN(b.x)]) == gen, bar);
            __builtin_amdgcn_fence(__ATOMIC_ACQUIRE, "agent");
            asm volatile("s_waitcnt vmcnt(0)" ::: "memory");
        }
    }
    __syncthreads();
}

constexpr int LDSCTL_OFF = 131072, MISC_OFF = LDSCTL_OFF + 320, CW_BAR = 4096;
struct Args { const float* in[24]; float* out; unsigned char* ws; int ph_lo, ph_hi; };
enum { I_XP = 0, I_XS, I_CK, I_CV, I_SD, I_C, I_CCTX, I_WMOD, I_BMOD, I_N1, I_N2, I_AWIN, I_AQG, I_AKG, I_AWOUT, I_DWIN, I_DCONV, I_DALOG, I_DDTB, I_DNORM, I_DWOUT, I_W1, I_W2, I_FN };

__global__ void __launch_bounds__(NWAVES * 64, 2) mk_fwd(Args args) {
    extern __shared__ __attribute__((aligned(16))) unsigned char lds_raw[];
    cg::grid_group grid = cg::this_grid();
    for (int u = threadIdx.x; u < (LDS_BYTES - LDSCTL_OFF) / 4; u += NWAVES * 64) ((LAS unsigned*)((LAS unsigned char*)lds_raw + LDSCTL_OFF))[u] = 0u;
    __syncthreads();
    const XcdBarrier bar = xcd_barrier_post((unsigned*)(args.ws + WS_CTL) + CW_BAR, (volatile LAS unsigned*)((LAS unsigned char*)lds_raw + MISC_OFF) + 8);

    const int lo = args.ph_lo, hi = args.ph_hi;
    int ph = 0;
#define PHASE_BEGIN() if (ph >= lo && ph < hi) { int z = 0; asm volatile("" : "+s"(z)); unsigned char* const ws = args.ws + z; (void)ws; \
    Ctx C; C.lds = (LAS unsigned char*)lds_raw + z; C.tid = threadIdx.x + z; C.lane = C.tid & 63; C.wid = __builtin_amdgcn_readfirstlane(C.tid >> 6); \
    C.nblk = gridDim.x + z; C.blk = blockIdx.x + z; C.gw = C.blk * NWAVES + C.wid; C.ngw = C.nblk * NWAVES;
#ifndef REP_KIND
#define REP_KIND -1
#endif
#define BARX() do { XcdBarrier b2_ = bar; asm volatile("" : "+s"(b2_.bar)); xcd_barrier(b2_); } while (0)
#define PHASE_END() if (ph + 1 < hi) { if (ph == 0) { grid.sync(); if (threadIdx.x == 0) { unsigned nloc_, nx_; xcd_barrier_complete(bar.bar, bar.x, nloc_, nx_); bar.st[0] = nloc_; bar.st[1] = nx_; } __syncthreads(); } else BARX(); } } ++ph;
#define INP(i) (args.in[(i) + z])
#define WSF(off) ((float*)(ws + (off)))
#define WSB(off) ((bf16raw*)(ws + (off)))

    PHASE_BEGIN() {
        ProPtrs P{INP(I_C), INP(I_CCTX), INP(I_WMOD), INP(I_BMOD), INP(I_AWIN), INP(I_AWOUT), INP(I_DWIN), INP(I_DWOUT), INP(I_W1), INP(I_W2), WSF(WS_MODS), WSF(WS_ROPE),
                  WSB(WS_WT_AIN), WSB(WS_WT_AOUT), WSB(WS_WT_DIN), WSB(WS_WT_DOUT), WSB(WS_WT_W1), WSB(WS_WT_W2), INP(I_XP), INP(I_XS), WSB(WS_X)};
        phase_prologue(C, P); } PHASE_END()
    for (int l = 0; l < 4; ++l) {
        const int j = l >> 1;
        PHASE_BEGIN() { const float* mods_l = WSF(WS_MODS) + (size_t)l * 3 * 6144;
            phase_norm(C, WSB(WS_X), INP(I_N1) + l * D, mods_l, WSB(WS_H)); } PHASE_END()
        if ((l & 1) == 0) {
            PHASE_BEGIN() { pg8::Gemm g{WSB(WS_H), WSB(WS_WT_AIN) + (size_t)j * QKVW * D, MTOK, QKVW, D, z}; pg8::StaticOrder S; S.init(MTOK, QKVW, C.nblk, C.blk);
                pg8::EpiBf16<0> E{WSB(WS_PROJ), QKVW, nullptr, 0, 0, 1.f};
                pg8::gemm_phase<pg8::EpiBf16<0>, pg8::StaticOrder, true, true>(C.lds, g, S, E); } PHASE_END()
            PHASE_BEGIN() { QknPtrs P{WSB(WS_PROJ), WSB(WS_QB), WSB(WS_KB), WSB(WS_VB), INP(I_AQG) + j * 128, INP(I_AKG) + j * 128, WSF(WS_ROPE), INP(I_CK), INP(I_CV), args.out + z};
                phase_qkn(C, P, j); if (REP_KIND == 3) { BARX(); phase_qkn(C, P, j); } } PHASE_END()
            PHASE_BEGIN() { AttnPtrs P{WSB(WS_QB), WSB(WS_KB), WSB(WS_VB), WSB(WS_Y)}; phase_attn(C, P); if (REP_KIND == 4) { BARX(); phase_attn(C, P); } } PHASE_END()
        } else {
            PHASE_BEGIN() { pg8::Gemm g{WSB(WS_H), WSB(WS_WT_DIN) + (size_t)j * DNINP * D, MTOK, DNINP, D, z}; pg8::StaticOrder S; S.init(MTOK, DNINP, C.nblk, C.blk);
                pg8::EpiDnIn E{WSB(WS_PROJ), WSF(WS_AB)};
                pg8::gemm_phase<pg8::EpiDnIn, pg8::StaticOrder, true, true>(C.lds, g, S, E); } PHASE_END()
            PHASE_BEGIN() { DnLocalPtrs P{WSB(WS_PROJ), WSF(WS_AB), INP(I_DCONV) + (size_t)j * 5 * 3072, INP(I_DALOG) + j * 16, INP(I_DDTB) + j * 16, ws + WS_SOP, WSF(WS_EGL)};
                phase_dn_local(C, P); if (REP_KIND == 6) { BARX(); phase_dn_local(C, P); } } PHASE_END()
            PHASE_BEGIN() { DnScanPtrs P{ws + WS_SOP, WSF(WS_EGL), INP(I_SD), WSB(WS_OF), WSB(WS_OB), args.out + z}; phase_dn_scan2(C, P, j); } PHASE_END()
            PHASE_BEGIN() { GatePtrs P{WSB(WS_OF), WSB(WS_OB), WSB(WS_PROJ), WSB(WS_Y), INP(I_DNORM) + j * 128}; phase_gate(C, P); if (REP_KIND == 8) { BARX(); phase_gate(C, P); } } PHASE_END()
        }
        PHASE_BEGIN() { const float* mods_l = WSF(WS_MODS) + (size_t)l * 3 * 6144;
            pg8::Gemm g{WSB(WS_Y), ((l & 1) ? WSB(WS_WT_DOUT) : WSB(WS_WT_AOUT)) + (size_t)j * D * D, MTOK, D, D, z}; pg8::StaticOrder S; S.init(64 * 256, D, C.nblk, C.blk);
            pg8::EpiRes160 E{WSB(WS_X), mods_l + 2048};
            pg8::gemm_phase<pg8::EpiRes160, pg8::StaticOrder, true, true, true>(C.lds, g, S, E, NCTX); } PHASE_END()
        PHASE_BEGIN() { const float* mods_l = WSF(WS_MODS) + (size_t)l * 3 * 6144;
            phase_norm(C, WSB(WS_X), INP(I_N2) + l * D, mods_l + 3072, WSB(WS_H)); } PHASE_END()
        PHASE_BEGIN() { pg8::Gemm g{WSB(WS_H), WSB(WS_WT_W1) + (size_t)l * FF * D, MTOK, FF, D, z}; pg8::StaticOrder S; S.init(MTOK, FF, C.nblk, C.blk);
            pg8::EpiBf16<2> E{WSB(WS_PROJ), FF, nullptr, 0, 0, 1.f};
            for (int rep = 0; rep < (REP_KIND == 10 ? 2 : 1); ++rep) { if (rep) BARX(); pg8::gemm_phase<pg8::EpiBf16<2>, pg8::StaticOrder, true, true>(C.lds, g, S, E); } } PHASE_END()
        PHASE_BEGIN() { const float* mods_l = WSF(WS_MODS) + (size_t)l * 3 * 6144;
            pg8::Gemm g{WSB(WS_PROJ), WSB(WS_WT_W2) + (size_t)l * D * FF, MTOK, D, FF, z}; pg8::StaticOrder S; S.init(64 * 256, D, C.nblk, C.blk);
            pg8::EpiRes160 E{WSB(WS_X), mods_l + 5120};
            pg8::gemm_phase<pg8::EpiRes160, pg8::StaticOrder, true, true, true>(C.lds, g, S, E, NCTX); } PHASE_END()
    }
    PHASE_BEGIN() { phase_final(C, WSB(WS_X), INP(I_FN), args.out + z); } PHASE_END()
#undef PHASE_BEGIN
#undef PHASE_END
}

extern "C" void kernel_launch(void* const* d_in, const int* in_sizes, int n_in, void* d_out, int out_size, void* d_ws, size_t ws_size, hipStream_t stream) {
    static int grid = 0;
    if (grid == 0) {
        if (n_in != 24 || ws_size < WS_END) { fprintf(stderr, "kernel_launch: unexpected n_in %d / ws %zu\n", n_in, ws_size); grid = -1; return; }
        int dev = 0, cus = 0, per_cu = 0;
        if (hipGetDevice(&dev) != hipSuccess || hipDeviceGetAttribute(&cus, hipDeviceAttributeMultiprocessorCount, dev) != hipSuccess) { grid = -1; return; }
        if (hipFuncSetAttribute((const void*)mk_fwd, hipFuncAttributeMaxDynamicSharedMemorySize, LDS_BYTES) != hipSuccess) { fprintf(stderr, "kernel_launch: hipFuncSetAttribute failed\n"); grid = -1; return; }
        if (hipOccupancyMaxActiveBlocksPerMultiprocessor(&per_cu, (const void*)mk_fwd, NWAVES * 64, LDS_BYTES) != hipSuccess || per_cu < 1) { fprintf(stderr, "kernel_launch: occupancy query failed (%d)\n", per_cu); (void)hipGetLastError(); grid = -1; return; }
        grid = cus * 1;
    }
    if (grid < 0) return;
    (void)hipMemsetAsync((char*)d_ws + WS_CTL, 0, CTL_ZERO_BYTES, stream);
    Args a; memset(&a, 0, sizeof(a));
    for (int i = 0; i < 24; ++i) a.in[i] = (const float*)d_in[i];
    a.out = (float*)d_out; a.ws = (unsigned char*)d_ws; a.ph_lo = 0; a.ph_hi = 1000;
    void* kargs[] = {&a};
    hipError_t e = hipLaunchCooperativeKernel((const void*)mk_fwd, dim3(grid), dim3(NWAVES * 64), kargs, LDS_BYTES, stream);
    if (e != hipSuccess) fprintf(stderr, "kernel_launch: cooperative launch failed: %s (grid %d)\n", hipGetErrorString(e), grid);
}
```

```cpp
#include <hip/hip_runtime.h>
#include <hip/hip_cooperative_groups.h>
#include <cstdio>
#include <cstdint>
#include <cstring>
namespace cg = cooperative_groups;

constexpr int D = 1024, NCTX = 8192, NLAT = 2048, MTOK = 10240, FF = 4096;
constexpr int QKVW = 1536, DNIN = 4128, DNINP = 4352, PROJW = 4096;
constexpr int KVROWS = 8192 + 2 * 1280;
constexpr float EPS = 1e-6f;
constexpr float ATT_SCALE = 0.08838834764831845f;
constexpr size_t O_Y = 0, O_CK = (size_t)MTOK * D, O_CV = O_CK + 4194304, O_ST = O_CV + 4194304;

typedef unsigned short bf16raw;
typedef float f32x4_t __attribute__((ext_vector_type(4)));
typedef float f32x2_t __attribute__((ext_vector_type(2)));
typedef unsigned u32x4_t __attribute__((ext_vector_type(4)));
typedef unsigned u32x2_t __attribute__((ext_vector_type(2)));

__device__ __forceinline__ unsigned f2bf(float f) { unsigned u = __builtin_bit_cast(unsigned, f); return (u + 0x7fffu + ((u >> 16) & 1u)) >> 16; }
__device__ __forceinline__ unsigned pk2(float lo, float hi) { return f2bf(lo) | (f2bf(hi) << 16); }
__device__ __forceinline__ float bf_lo(unsigned w) { return __builtin_bit_cast(float, w << 16); }
__device__ __forceinline__ float bf_hi(unsigned w) { return __builtin_bit_cast(float, w & 0xffff0000u); }
__device__ __forceinline__ float bf2f(bf16raw h) { return __builtin_bit_cast(float, (unsigned)h << 16); }
__device__ __forceinline__ float silu_f(float x) { return x / (1.f + __expf(-x)); }
__device__ __forceinline__ int cond_of(int row) { return row < NCTX ? 0 : 1 + ((row - NCTX) >> 10); }
__device__ __forceinline__ float lane_xor_f(float v, int lane, int k) { return __builtin_bit_cast(float, __builtin_amdgcn_ds_bpermute((lane ^ k) << 2, __builtin_bit_cast(int, v))); }
__device__ __forceinline__ float wave_sum(float v, int lane) {
#pragma unroll
    for (int o = 1; o < 64; o <<= 1) v += lane_xor_f(v, lane, o);
    return v;
}
__device__ __forceinline__ float wave_max(float v, int lane) {
#pragma unroll
    for (int o = 1; o < 64; o <<= 1) v = fmaxf(v, lane_xor_f(v, lane, o));
    return v;
}
__device__ __forceinline__ float dpp_xadd(float v, const int ctrl_tag) { return v; }
#define DPP_ADD(v, ctrl) ((v) + __builtin_bit_cast(float, __builtin_amdgcn_update_dpp(0, __builtin_bit_cast(int, (v)), (ctrl), 0xf, 0xf, true)))
__device__ __forceinline__ float wave_sum_dpp(float v) {
    v = DPP_ADD(v, 0xB1); v = DPP_ADD(v, 0x4E); v = DPP_ADD(v, 0x141); v = DPP_ADD(v, 0x140);
    const int iv = __builtin_bit_cast(int, v);
    return (__builtin_bit_cast(float, __builtin_amdgcn_readlane(iv, 0)) + __builtin_bit_cast(float, __builtin_amdgcn_readlane(iv, 16))) +
           (__builtin_bit_cast(float, __builtin_amdgcn_readlane(iv, 32)) + __builtin_bit_cast(float, __builtin_amdgcn_readlane(iv, 48)));
}
namespace pg8 {
#define PG8_LAS __attribute__((address_space(3)))
typedef unsigned short bf16_t;
typedef short bf16x8 __attribute__((ext_vector_type(8)));
typedef float f32x4 __attribute__((ext_vector_type(4)));
typedef unsigned u32x4 __attribute__((ext_vector_type(4)));
constexpr int BM = 256, BK = 64, HALF = 128, HTB = HALF * BK * 2  , STAGE_BYTES = 8 * HTB, NXCD = 8, WGM = 8;

__host__ __device__ __forceinline__ int lds_byte(int r, int c) { const int st = (r >> 4) * 2 + (c >> 5), rr = r & 15, cc = c & 31, ob = rr * 64 + cc * 2; return st * 1024 + (ob ^ (((ob >> 9) & 1) << 5)); }
__host__ __device__ __forceinline__ void stage_rc(int b, int& R, int& C) { const int st = b / 1024, sb = b % 1024, swz = sb ^ (((sb >> 9) & 1) << 5); R = (st >> 1) * 16 + swz / 64; C = (st & 1) * 32 + (swz % 64) / 2; }
__host__ __device__ __forceinline__ int perm32(int rho) { const int n = rho >> 4, i = rho & 15; return 8 * (i >> 2) + 4 * n + (i & 3); }

struct Unit { int pm, pn; };
struct Gemm { const bf16_t* A; const bf16_t* Bt; int M, N, K; int z; };

struct StaticOrder {
    int nM, nN, nwg, G, c;
    __host__ __device__ void init(int M, int N, int G_, int c_) { nM = M / BM; nN = N / BM; nwg = nM * nN; G = G_; c = c_; }
    __host__ __device__ bool next(int i, Unit& u) const {
        const long L = (long)i * G + c; if (L >= nwg) return false;
        int wgid = (int)L; { const int q = nwg / NXCD, r = nwg % NXCD, xcd = wgid % NXCD, off = wgid / NXCD; wgid = (xcd < r ? xcd * (q + 1) : r * (q + 1) + (xcd - r) * q) + off; }
        const int nig = WGM * nN, gid = wgid / nig, fm = gid * WGM, gsz = (nM - fm) < WGM ? (nM - fm) : WGM;
        u.pm = fm + ((wgid % nig) % gsz); u.pn = (wgid % nig) / gsz; return true;
    }
    __device__ __forceinline__ void a_ready(const Unit&) const {}
    __device__ __forceinline__ void done(const Unit&) const {}
};

__device__ __forceinline__ unsigned cvt_pk_bf16(float lo, float hi) { unsigned r; asm volatile("v_cvt_pk_bf16_f32 %0, %1, %2" : "=v"(r) : "v"(lo), "v"(hi)); return r; }
typedef float f32x2 __attribute__((ext_vector_type(2)));
__device__ __forceinline__ f32x2 gelu_pk(f32x2 v) {
    const f32x2 av = __builtin_elementwise_abs(v), d = av * 0.2316418882f + 1.0f;
    f32x2 t; t.x = __builtin_amdgcn_rcpf(d.x); t.y = __builtin_amdgcn_rcpf(d.y);
    f32x2 q = t * 0.5307027145f + (-0.7265760135f); q = q * t + 0.7107068705f; q = q * t + (-0.142248368f); q = q * t + 0.127414796f; q = q * t;
    const f32x2 s = (v * v) * (-0.72134752044f);
    f32x2 e; e.x = __builtin_amdgcn_exp2f(s.x); e.y = __builtin_amdgcn_exp2f(s.y);
    const f32x2 m = v * (q * e), r = v - m;
    f32x2 o; o.x = v.x < 0.f ? m.x : r.x; o.y = v.y < 0.f ? m.y : r.y; return o;
}

template <int ACT  > struct EpiBf16 {
    static constexpr bool PERM = true, AFTER_DRAIN = false; static_assert(ACT >= 0 && ACT <= 2, "EpiBf16: ACT is 0 (none), 1 (gelu_pk) or 2 (squared relu)");
    bf16_t* O; int ldc; const float* bias; int split_cols; size_t split_stride; float scale0;
    __device__ __forceinline__ void operator()(const f32x4 (&acc)[2][2][4][2], const Unit& u, int wr, int wc, int fr, int fq) const {
        const int row0 = u.pm * BM + wr * 64 + fr; int colt = u.pn * BM; bf16_t* base = O;
        float sc = 1.f; if (split_cols) { const int t = colt / split_cols; base += (size_t)t * split_stride; colt -= t * split_cols; if (t == 0) sc = scale0; }
        const int col0 = colt + wc * 32 + 8 * fq, bcol0 = u.pn * BM + wc * 32 + 8 * fq;
        f32x4 bv[2][2];
#pragma unroll
        for (int bj = 0; bj < 2; ++bj)
#pragma unroll
            for (int n = 0; n < 2; ++n) bv[bj][n] = bias ? *(const f32x4*)(bias + bcol0 + bj * HALF + 4 * n) : (f32x4){0.f, 0.f, 0.f, 0.f};
#pragma unroll
        for (int ai = 0; ai < 2; ++ai)
#pragma unroll
            for (int m = 0; m < 4; ++m) { bf16_t* rowp = base + (size_t)(row0 + ai * HALF + m * 16) * ldc + col0;
#pragma unroll
                for (int bj = 0; bj < 2; ++bj) { f32x4 v0 = acc[ai][bj][m][0] + bv[bj][0], v1 = acc[ai][bj][m][1] + bv[bj][1];
                    if (ACT == 1) { f32x2 a = gelu_pk((f32x2){v0[0], v0[1]}), b = gelu_pk((f32x2){v0[2], v0[3]}), c = gelu_pk((f32x2){v1[0], v1[1]}), d = gelu_pk((f32x2){v1[2], v1[3]});
                        v0 = (f32x4){a.x, a.y, b.x, b.y}; v1 = (f32x4){c.x, c.y, d.x, d.y}; }
                    if (ACT == 2) { v0 = __builtin_elementwise_max(v0, (f32x4){0.f, 0.f, 0.f, 0.f}); v1 = __builtin_elementwise_max(v1, (f32x4){0.f, 0.f, 0.f, 0.f}); v0 = v0 * v0; v1 = v1 * v1; }
                    v0 = v0 * sc; v1 = v1 * sc; u32x4 w; w.x = cvt_pk_bf16(v0[0], v0[1]); w.y = cvt_pk_bf16(v0[2], v0[3]); w.z = cvt_pk_bf16(v1[0], v1[1]); w.w = cvt_pk_bf16(v1[2], v1[3]);
                    *(u32x4*)(rowp + bj * HALF) = w; } }
    }
};

struct PanelStats {
    unsigned* xbuf;
    unsigned* cnt;
    unsigned* tmo;
    int ntn; float eps;
    unsigned code;
    __device__ __forceinline__ bool run(const f32x4 (&v)[2][2][4][2], const Unit& u, int wr, int wc, int fr, int fq, PG8_LAS unsigned char* lds, int wid, int lane) const {
        typedef float f32x2v __attribute__((ext_vector_type(2)));
        PG8_LAS f32x2v* P = (PG8_LAS f32x2v*)lds;
        PG8_LAS f32x2v* S = (PG8_LAS f32x2v*)(lds + 8192);
        PG8_LAS unsigned* flag = (PG8_LAS unsigned*)(lds + 8192 + 2048);
#pragma unroll
        for (int ai = 0; ai < 2; ++ai)
#pragma unroll
            for (int m = 0; m < 4; ++m) {
                float s = 0.f;
#pragma unroll
                for (int bj = 0; bj < 2; ++bj)
#pragma unroll
                    for (int n = 0; n < 2; ++n) { const f32x4 x = v[ai][bj][m][n]; s += (x[0] + x[1]) + (x[2] + x[3]); }
                s += __shfl_xor(s, 16); s += __shfl_xor(s, 32);
                const float mw = s * (1.0f / 64.0f); float q = 0.f;
#pragma unroll
                for (int bj = 0; bj < 2; ++bj)
#pragma unroll
                    for (int n = 0; n < 2; ++n) { const f32x4 d = v[ai][bj][m][n] - mw; q += (d[0] * d[0] + d[1] * d[1]) + (d[2] * d[2] + d[3] * d[3]); }
                q += __shfl_xor(q, 16); q += __shfl_xor(q, 32);
                if (fq == 0) P[(ai * HALF + wr * 64 + m * 16 + fr) * 4 + wc] = (f32x2v){mw, q};
            }
        asm volatile("s_waitcnt lgkmcnt(0)" ::: "memory"); __builtin_amdgcn_s_barrier(); asm volatile("" ::: "memory");
#if defined(BROKEN_EXCHANGE_NO_WAIT)
#warning BROKEN CONTROL BUILD: the row-statistics exchange does not wait; results are wrong by design
        if (blockIdx.x >= 64) { const long long t0_ = clock64(); while (clock64() - t0_ < 60000) __builtin_amdgcn_s_sleep(8); }
#endif
        const int row = wid * 32 + (lane & 31);
        if (lane < 32) {
            const f32x2v a = P[row * 4 + 0], b = P[row * 4 + 1], c = P[row * 4 + 2], d = P[row * 4 + 3];
            const float mt = (a.x + b.x + c.x + d.x) * 0.25f;
            const float da = a.x - mt, db = b.x - mt, dc = c.x - mt, dd = d.x - mt;
            const float m2 = (a.y + b.y) + (c.y + d.y) + 64.0f * ((da * da + db * db) + (dc * dc + dd * dd));
            unsigned long long* slot = (unsigned long long*)xbuf + ((size_t)(u.pm * BM + row) * 4 + u.pn);
            __hip_atomic_store(slot, ((unsigned long long)__float_as_uint(m2) << 32) | __float_as_uint(mt), __ATOMIC_RELAXED, __HIP_MEMORY_SCOPE_AGENT);
        }
        asm volatile("s_waitcnt vmcnt(0)" ::: "memory");
        if (lane == 0) __hip_atomic_fetch_add(cnt + 64 * u.pm, 1u, __ATOMIC_RELAXED, __HIP_MEMORY_SCOPE_AGENT);
        if (wid == 0) {
            bool dead = false; const unsigned long long t0 = __builtin_amdgcn_s_memrealtime(); const unsigned want = 8u * (unsigned)ntn;
            for (;;) {
#if defined(BROKEN_EXCHANGE_NO_WAIT)
                break;
#endif
                if ((unsigned)__builtin_amdgcn_readfirstlane(__hip_atomic_load(cnt + 64 * u.pm, __ATOMIC_RELAXED, __HIP_MEMORY_SCOPE_AGENT)) >= want) break;
                if (__builtin_amdgcn_s_memrealtime() - t0 > 2000000ull) {
                    if (lane == 0) { unsigned expect = 0u; __hip_atomic_compare_exchange_strong(tmo + 1, &expect, code | (unsigned)(u.pm & 0xff), __ATOMIC_RELAXED, __ATOMIC_RELAXED, __HIP_MEMORY_SCOPE_AGENT);
                                     __hip_atomic_store(tmo, 1u, __ATOMIC_RELAXED, __HIP_MEMORY_SCOPE_AGENT); }
                    dead = true; break; }
                __builtin_amdgcn_s_sleep(2);
            }
            __builtin_amdgcn_fence(__ATOMIC_ACQUIRE, "agent");
            if (lane == 0) flag[0] = dead ? 1u : 0u;
        }
        asm volatile("s_waitcnt vmcnt(0) lgkmcnt(0)" ::: "memory"); __builtin_amdgcn_s_barrier(); asm volatile("" ::: "memory");
        const bool bad = flag[0] != 0u;
        if (lane < 32) {
            const unsigned long long* slot = (const unsigned long long*)xbuf + (size_t)(u.pm * BM + row) * 4; float mt[4], m2[4]; float ms = 0.f;
#pragma unroll
            for (int t = 0; t < 4; ++t) { if (t < ntn) { const unsigned long long w = __hip_atomic_load(slot + t, __ATOMIC_RELAXED, __HIP_MEMORY_SCOPE_AGENT); mt[t] = __uint_as_float((unsigned)w); m2[t] = __uint_as_float((unsigned)(w >> 32)); } else { mt[t] = 0.f; m2[t] = 0.f; } ms += mt[t]; }
            const float mean = ms / (float)ntn; float q = 0.f;
#pragma unroll
            for (int t = 0; t < 4; ++t) if (t < ntn) { const float dm = mt[t] - mean; q += m2[t] + 256.0f * dm * dm; }
            S[row] = (f32x2v){mean, 1.0f / sqrtf(q / (256.0f * (float)ntn) + eps)};
        }
        asm volatile("s_waitcnt lgkmcnt(0)" ::: "memory"); __builtin_amdgcn_s_barrier(); asm volatile("" ::: "memory");
        return bad;
    }
};
struct EpiLnRes {
    static constexpr bool PERM = false, AFTER_DRAIN = true;
    const float* base; float* out; int ldc; const float* bias; PanelStats st; unsigned poison;
    __device__ __forceinline__ void fused(f32x4 (&acc)[2][2][4][2], const Unit& u, int wr, int wc, int fr, int fq, PG8_LAS unsigned char* lds, int wid, int lane) const {
        typedef float f32x2v __attribute__((ext_vector_type(2)));
        const PG8_LAS f32x2v* S = (const PG8_LAS f32x2v*)(lds + 8192);
        const int col0 = u.pn * BM + wc * 32 + 4 * fq;
#pragma unroll
        for (int bj = 0; bj < 2; ++bj)
#pragma unroll
            for (int n = 0; n < 2; ++n) { const f32x4 bv = bias ? *(const f32x4*)(bias + col0 + bj * HALF + n * 16) : (f32x4){0.f, 0.f, 0.f, 0.f};
#pragma unroll
                for (int ai = 0; ai < 2; ++ai)
#pragma unroll
                    for (int m = 0; m < 4; ++m) acc[ai][bj][m][n] += bv; }
        f32x4 pre[4][2][2];
#pragma unroll
        for (int m = 0; m < 4; ++m) { const size_t off = (size_t)(u.pm * BM + wr * 64 + m * 16 + fr) * ldc + col0;
#pragma unroll
            for (int bj = 0; bj < 2; ++bj)
#pragma unroll
                for (int n = 0; n < 2; ++n) pre[m][bj][n] = *(const f32x4*)(base + off + bj * HALF + n * 16); }
        const bool bad = st.run(acc, u, wr, wc, fr, fq, lds, wid, lane) || poison != 0u;
        const float qnan = __builtin_nanf("");
#pragma unroll
        for (int ai = 0; ai < 2; ++ai)
#pragma unroll
            for (int m = 0; m < 4; ++m) { const int r = ai * HALF + wr * 64 + m * 16 + fr; const f32x2v sr = S[r]; const size_t off = (size_t)(u.pm * BM + r) * ldc + col0;
#pragma unroll
                for (int bj = 0; bj < 2; ++bj)
#pragma unroll
                    for (int n = 0; n < 2; ++n) { const f32x4 bs = ai == 0 ? pre[m][bj][n] : *(const f32x4*)(base + off + bj * HALF + n * 16); f32x4 o = bs + (acc[ai][bj][m][n] - sr.x) * sr.y;
                        if (bad) o = (f32x4){qnan, qnan, qnan, qnan}; *(f32x4*)(out + off + bj * HALF + n * 16) = o; }
                if (m & 1) asm volatile("" ::: "memory"); }
    }
};
struct EpiLnResLn {
    static constexpr bool PERM = false, AFTER_DRAIN = true;
    const float* base; float* out; bf16_t* xn; int ldc; const float* bias; PanelStats st1, st2; unsigned poison;
    __device__ __forceinline__ void fused(f32x4 (&acc)[2][2][4][2], const Unit& u, int wr, int wc, int fr, int fq, PG8_LAS unsigned char* lds, int wid, int lane) const {
        typedef float f32x2v __attribute__((ext_vector_type(2))); typedef unsigned u32x2v __attribute__((ext_vector_type(2)));
        const PG8_LAS f32x2v* S = (const PG8_LAS f32x2v*)(lds + 8192);
        const int col0 = u.pn * BM + wc * 32 + 4 * fq;
#pragma unroll
        for (int bj = 0; bj < 2; ++bj)
#pragma unroll
            for (int n = 0; n < 2; ++n) { const f32x4 bv = bias ? *(const f32x4*)(bias + col0 + bj * HALF + n * 16) : (f32x4){0.f, 0.f, 0.f, 0.f};
#pragma unroll
                for (int ai = 0; ai < 2; ++ai)
#pragma unroll
                    for (int m = 0; m < 4; ++m) acc[ai][bj][m][n] += bv; }
        bool bad = st1.run(acc, u, wr, wc, fr, fq, lds, wid, lane) || poison != 0u;
        const float qnan = __builtin_nanf("");
#pragma unroll
        for (int ai = 0; ai < 2; ++ai)
#pragma unroll
            for (int m = 0; m < 4; ++m) { const int r = ai * HALF + wr * 64 + m * 16 + fr; const f32x2v sr = S[r]; const size_t off = (size_t)(u.pm * BM + r) * ldc + col0;
#pragma unroll
                for (int bj = 0; bj < 2; ++bj)
#pragma unroll
                    for (int n = 0; n < 2; ++n) { const f32x4 bs = *(const f32x4*)(base + off + bj * HALF + n * 16); acc[ai][bj][m][n] = bs + (acc[ai][bj][m][n] - sr.x) * sr.y; }
                asm volatile("" : "+v"(acc[ai][0][m][0]), "+v"(acc[ai][0][m][1]), "+v"(acc[ai][1][m][0]), "+v"(acc[ai][1][m][1]));
                if (m & 1) asm volatile("" ::: "memory"); }
        const bool bad1 = bad;
        bad = st2.run(acc, u, wr, wc, fr, fq, lds, wid, lane) || bad;
#pragma unroll
        for (int ai = 0; ai < 2; ++ai)
#pragma unroll
            for (int m = 0; m < 4; ++m) { const int r = ai * HALF + wr * 64 + m * 16 + fr; const f32x2v sr = S[r]; const size_t off = (size_t)(u.pm * BM + r) * ldc + col0;
#pragma unroll
                for (int bj = 0; bj < 2; ++bj)
#pragma unroll
                    for (int n = 0; n < 2; ++n) { const f32x4 x1 = acc[ai][bj][m][n]; *(f32x4*)(out + off + bj * HALF + n * 16) = bad1 ? (f32x4){qnan, qnan, qnan, qnan} : x1;
                        const f32x4 o = (x1 - sr.x) * sr.y; u32x2v w; w.x = cvt_pk_bf16(o[0], o[1]); w.y = cvt_pk_bf16(o[2], o[3]);
                        if (bad) { w.x = 0x7fc07fc0u; w.y = 0x7fc07fc0u; } *(u32x2v*)(xn + off + bj * HALF + n * 16) = w; }
                asm volatile("" ::: "memory"); }
    }
};

template <class Epi, class Sched, bool ALIGN_EPI = false, bool SP2 = false, bool T160 = false>
__device__ __forceinline__ void gemm_phase(PG8_LAS unsigned char* lds, const Gemm g, const Sched& S, const Epi& E, const int row1 = 0) {
    static_assert(!T160 || SP2, "T160 is implemented on the SP2 loop only");
    const int tid = threadIdx.x + g.z, wid = __builtin_amdgcn_readfirstlane(tid >> 6), lane = tid & 63, wr = wid >> 2, wc = wid & 3, fr = lane & 15, fq = lane >> 4;
    const int K = g.K, nt = K / BK;
    unsigned voffA[2], voffB[2], voffA1[2];
#pragma unroll
    for (int i = 0; i < 2; ++i) { int R, C; stage_rc(tid * 16 + i * 8192, R, C); const int Rb = Epi::PERM ? ((R & ~31) + perm32(R & 31)) : R;
        voffA[i] = (unsigned)(R * K + C) * 2u; voffB[i] = (unsigned)(Rb * K + C) * 2u; voffA1[i] = T160 ? (unsigned)((R & 31) * K + C) * 2u : voffA[i]; }
    const size_t kstep = (size_t)(BK * 2);
    const size_t hstep = (size_t)HALF * K * 2;
    const size_t tstep = 2 * hstep;
    const size_t tstepA = T160 ? hstep : tstep;
    const size_t t1step = (size_t)32 * K * 2;
    const unsigned ldsw = (unsigned)wid * 1024u;
    const int aoff = lds_byte(wr * 64 + fr, fq * 8), boff = lds_byte(wc * 32 + fr, fq * 8), aoff1 = lds_byte(wr * 16 + fr, fq * 8);
#define PG8_SA(b, h) (((b) * 2 + (h)) * HTB)
#define PG8_SB(b, h) ((4 + (b) * 2 + (h)) * HTB)
#define PG8_STAGE(bufoff, gbase, voff) do { _Pragma("unroll") for (int _i = 0; _i < 2; ++_i) \
        __builtin_amdgcn_global_load_lds((const unsigned*)((const char*)(gbase) + (voff)[_i]), (PG8_LAS unsigned*)(lds + (bufoff) + ldsw + _i * 8192), 16, 0, 0); } while (0)
#define PG8_LDA(dst, b, h) do { _Pragma("unroll") for (int m = 0; m < 4; ++m) _Pragma("unroll") for (int k = 0; k < 2; ++k) dst[m][k] = *(const PG8_LAS bf16x8*)(lds + PG8_SA(b, h) + aoff + m * 2048 + k * 1024); } while (0)
#define PG8_LDB(dst, b, h) do { _Pragma("unroll") for (int n = 0; n < 2; ++n) _Pragma("unroll") for (int k = 0; k < 2; ++k) dst[n][k] = *(const PG8_LAS bf16x8*)(lds + PG8_SB(b, h) + boff + n * 2048 + k * 1024); } while (0)
#define PG8_MMA(ai, bj, At, Bt) do { __builtin_amdgcn_s_setprio(1); _Pragma("unroll") for (int m = 0; m < 4; ++m) _Pragma("unroll") for (int n = 0; n < 2; ++n) _Pragma("unroll") for (int k = 0; k < 2; ++k) \
        acc[ai][bj][m][n] = __builtin_amdgcn_mfma_f32_16x16x32_bf16(Bt[n][k], At[m][k], acc[ai][bj][m][n], 0, 0, 0); __builtin_amdgcn_s_setprio(0); } while (0)
#define PG8_LDA1(dst, b) do { if constexpr (T160) { _Pragma("unroll") for (int k = 0; k < 2; ++k) At1[0][k] = *(const PG8_LAS bf16x8*)(lds + PG8_SA(b, 1) + aoff1 + k * 1024); } else { PG8_LDA(dst, b, 1); } } while (0)
#define PG8_MMA1(bj, At, Bt) do { if constexpr (T160) { __builtin_amdgcn_s_setprio(1); _Pragma("unroll") for (int n = 0; n < 2; ++n) _Pragma("unroll") for (int k = 0; k < 2; ++k) \
        acc[1][bj][0][n] = __builtin_amdgcn_mfma_f32_16x16x32_bf16(Bt[n][k], At1[0][k], acc[1][bj][0][n], 0, 0, 0); __builtin_amdgcn_s_setprio(0); } else { PG8_MMA(1, bj, At, Bt); } } while (0)
#define PG8_WAIT_V(n) asm volatile("s_waitcnt vmcnt(" #n ")" ::: "memory")
#define PG8_WAIT_L(n) asm volatile("s_waitcnt lgkmcnt(" #n ")" ::: "memory")
#define PG8_BAR __builtin_amdgcn_s_barrier()
#define PG8_SCHED __builtin_amdgcn_sched_barrier(0)
    Unit cur, nxt; int ui = 0;
    if (!S.next(0, cur)) return;
    f32x4 acc[2][2][4][2];
#pragma unroll
    for (int a = 0; a < 2; ++a)
#pragma unroll
        for (int b = 0; b < 2; ++b)
#pragma unroll
            for (int m = 0; m < 4; ++m)
#pragma unroll
                for (int n = 0; n < 2; ++n) acc[a][b][m][n] = (f32x4){0.f, 0.f, 0.f, 0.f};
    bf16x8 At[4][2], B0[2][2], B1[2][2], At1[1][2];
    const char* cA = (const char*)g.A + (size_t)cur.pm * tstepA; const char* cB = (const char*)g.Bt + (size_t)cur.pn * tstep;
#define PG8_DA(pm_) (T160 ? (ptrdiff_t)((size_t)row1 * K * 2 + (size_t)(pm_) * t1step) - (ptrdiff_t)((size_t)(pm_) * tstepA) : (ptrdiff_t)hstep)
    ptrdiff_t dA = PG8_DA(cur.pm), dAn = dA;
    S.a_ready(cur);
    if constexpr (SP2) {
        PG8_STAGE(PG8_SB(0, 0), cB, voffB); PG8_STAGE(PG8_SB(0, 1), cB + hstep, voffB); PG8_STAGE(PG8_SA(0, 0), cA, voffA); PG8_STAGE(PG8_SA(0, 1), cA + dA, voffA1);
        if (wr == 1) PG8_BAR;
        PG8_WAIT_V(2); PG8_BAR;
        PG8_STAGE(PG8_SB(1, 0), cB + kstep, voffB); PG8_STAGE(PG8_SA(1, 0), cA + kstep, voffA); PG8_STAGE(PG8_SB(1, 1), cB + hstep + kstep, voffB);
        PG8_WAIT_V(6); PG8_BAR;
    } else {
        PG8_STAGE(PG8_SB(0, 0), cB, voffB); PG8_STAGE(PG8_SA(0, 0), cA, voffA); PG8_STAGE(PG8_SB(0, 1), cB + hstep, voffB); PG8_STAGE(PG8_SA(0, 1), cA + hstep, voffA);
        if (wr == 1) PG8_BAR;
        PG8_WAIT_V(4); PG8_BAR;
        PG8_STAGE(PG8_SB(1, 0), cB + kstep, voffB); PG8_STAGE(PG8_SA(1, 0), cA + kstep, voffA); PG8_STAGE(PG8_SB(1, 1), cB + hstep + kstep, voffB);
        PG8_WAIT_V(6); PG8_BAR;
    }
    for (;;) {
        const bool has_next = S.next(ui + 1, nxt);
        const char* nA = has_next ? (const char*)g.A + (size_t)nxt.pm * tstepA : cA; const char* nB = has_next ? (const char*)g.Bt + (size_t)nxt.pn * tstep : cB;
        dAn = has_next ? PG8_DA(nxt.pm) : dA;
        for (int t = 0; t < nt; t += 2) {
            const bool last = (t == nt - 2);
            const char* a1 = cA + (size_t)(t + 1) * kstep;
            const char* a2 = last ? nA : cA + (size_t)(t + 2) * kstep; const char* b2 = last ? nB : cB + (size_t)(t + 2) * kstep;
            const char* a3 = a2 + kstep; const char* b3 = b2 + kstep;
            const ptrdiff_t d2 = last ? dAn : dA;
            if (last && has_next) S.a_ready(nxt);
            if constexpr (SP2) {
            PG8_LDB(B0, 0, 0); PG8_LDB(B1, 0, 1); PG8_SCHED; PG8_LDA(At, 0, 0); PG8_STAGE(PG8_SA(1, 1), a1 + dA, voffA1);
            PG8_WAIT_V(8); PG8_WAIT_L(0); PG8_BAR; PG8_MMA(0, 0, At, B0); if constexpr (!T160) { PG8_MMA(0, 1, At, B1); } PG8_BAR; PG8_SCHED;
            PG8_LDA1(At, 0); PG8_STAGE(PG8_SB(0, 0), b2, voffB); PG8_STAGE(PG8_SB(0, 1), b2 + hstep, voffB); PG8_STAGE(PG8_SA(0, 0), a2, voffA);
            PG8_WAIT_V(8); PG8_WAIT_L(0); PG8_BAR; if constexpr (T160) { PG8_MMA(0, 1, At, B1); } PG8_MMA1(0, At, B0); PG8_MMA1(1, At, B1); PG8_BAR; PG8_SCHED;
            PG8_LDB(B0, 1, 0); PG8_LDB(B1, 1, 1); PG8_SCHED; PG8_LDA(At, 1, 0); PG8_STAGE(PG8_SA(0, 1), a2 + d2, voffA1);
            PG8_WAIT_V(8); PG8_WAIT_L(0); PG8_BAR; PG8_MMA(0, 0, At, B0); if constexpr (!T160) { PG8_MMA(0, 1, At, B1); } PG8_BAR; PG8_SCHED;
            PG8_LDA1(At, 1); PG8_STAGE(PG8_SB(1, 0), b3, voffB); PG8_STAGE(PG8_SB(1, 1), b3 + hstep, voffB); PG8_STAGE(PG8_SA(1, 0), a3, voffA);
            PG8_WAIT_V(8); PG8_WAIT_L(0); PG8_BAR; if constexpr (T160) { PG8_MMA(0, 1, At, B1); } PG8_MMA1(0, At, B0); PG8_MMA1(1, At, B1); PG8_BAR; PG8_SCHED;
            } else {
            PG8_LDB(B0, 0, 0); PG8_SCHED; PG8_LDA(At, 0, 0); PG8_STAGE(PG8_SA(1, 1), a1 + hstep, voffA);
            PG8_WAIT_L(8); PG8_BAR; PG8_WAIT_L(0); PG8_MMA(0, 0, At, B0); PG8_BAR; PG8_SCHED;
            PG8_LDB(B1, 0, 1); PG8_STAGE(PG8_SB(0, 0), b2, voffB);
            PG8_BAR; PG8_WAIT_L(0); PG8_MMA(0, 1, At, B1); PG8_BAR;
            PG8_LDA(At, 0, 1); PG8_STAGE(PG8_SA(0, 0), a2, voffA);
            PG8_BAR; PG8_WAIT_L(0); PG8_MMA(1, 0, At, B0); PG8_BAR; PG8_SCHED;
            PG8_STAGE(PG8_SB(0, 1), b2 + hstep, voffB);
            PG8_WAIT_V(6); PG8_BAR; PG8_MMA(1, 1, At, B1); PG8_BAR;
            PG8_LDB(B0, 1, 0); PG8_SCHED; PG8_LDA(At, 1, 0); PG8_STAGE(PG8_SA(0, 1), a2 + hstep, voffA);
            PG8_WAIT_L(8); PG8_BAR; PG8_WAIT_L(0); PG8_MMA(0, 0, At, B0); PG8_BAR; PG8_SCHED;
            PG8_LDB(B1, 1, 1); PG8_STAGE(PG8_SB(1, 0), b3, voffB);
            PG8_BAR; PG8_WAIT_L(0); PG8_MMA(0, 1, At, B1); PG8_BAR;
            PG8_LDA(At, 1, 1); PG8_STAGE(PG8_SA(1, 0), a3, voffA);
            PG8_BAR; PG8_WAIT_L(0); PG8_MMA(1, 0, At, B0); PG8_BAR; PG8_SCHED;
            PG8_STAGE(PG8_SB(1, 1), b3 + hstep, voffB);
            PG8_WAIT_V(6); PG8_BAR; PG8_MMA(1, 1, At, B1); PG8_BAR;
            }
        }
        if constexpr (ALIGN_EPI) { if (wr == 0) PG8_BAR; }
        if constexpr (!Epi::AFTER_DRAIN) { E(acc, cur, wr, wc, fr, fq); S.done(cur); }
        if (!has_next) break;
#pragma unroll
        for (int a = 0; a < 2; ++a)
#pragma unroll
            for (int b = 0; b < 2; ++b)
#pragma unroll
                for (int m = 0; m < 4; ++m)
#pragma unroll
                    for (int n = 0; n < 2; ++n) acc[a][b][m][n] = (f32x4){0.f, 0.f, 0.f, 0.f};
        cur = nxt; cA = nA; cB = nB; dA = dAn; ++ui;
        if constexpr (ALIGN_EPI) { if (wr == 1) PG8_BAR; }
    }
    PG8_WAIT_V(0);
    if constexpr (!ALIGN_EPI) { if (wr == 0) PG8_BAR; }
    PG8_BAR;
    if constexpr (Epi::AFTER_DRAIN) { E.fused(acc, cur, wr, wc, fr, fq, lds, wid, lane); S.done(cur); }
#undef PG8_SA
#undef PG8_SB
#undef PG8_STAGE
#undef PG8_LDA
#undef PG8_LDB
#undef PG8_MMA
#undef PG8_WAIT_V
#undef PG8_LDA1
#undef PG8_MMA1
#undef PG8_DA
#undef PG8_WAIT_L
#undef PG8_BAR
#undef PG8_SCHED
}
}

#ifndef PG8_SP2
#define PG8_SP2 true
#endif
#ifndef PG8_ALIGN
#define PG8_ALIGN true
#endif
namespace pg8 {
typedef __bf16 bf16x2v __attribute__((ext_vector_type(2))); typedef float f32x2v_ __attribute__((ext_vector_type(2)));
__device__ __forceinline__ unsigned cvt_pk_vis(float lo, float hi) { const f32x2v_ v = {lo, hi}; return __builtin_bit_cast(unsigned, __builtin_convertvector(v, bf16x2v)); }
struct EpiRes {
    static constexpr bool PERM = false, AFTER_DRAIN = false;
    const float* src_ctx; const float* src_lat; float* X; const float* gate;
    __device__ __forceinline__ void operator()(const f32x4 (&acc)[2][2][4][2], const Unit& u, int wr, int wc, int fr, int fq) const {
        const int cond = u.pm < 32 ? 0 : 1 + ((u.pm - 32) >> 2);
        const float* g = gate + cond * 6144;
        const float* sb = u.pm < 32 ? src_ctx + (size_t)u.pm * BM * 1024 : src_lat + (size_t)(u.pm - 32) * BM * 1024;
        float* xb = X + (size_t)u.pm * BM * 1024;
        const int col0 = u.pn * BM + wc * 32 + 4 * fq;
        f32x4 gv[2][2];
#pragma unroll
        for (int bj = 0; bj < 2; ++bj)
#pragma unroll
            for (int n = 0; n < 2; ++n) gv[bj][n] = *(const f32x4*)(g + col0 + bj * HALF + n * 16);
#pragma unroll
        for (int ai = 0; ai < 2; ++ai)
#pragma unroll
            for (int m = 0; m < 4; ++m) { const size_t off = (size_t)(ai * HALF + wr * 64 + m * 16 + fr) * 1024 + col0;
#pragma unroll
                for (int bj = 0; bj < 2; ++bj)
#pragma unroll
                    for (int n = 0; n < 2; ++n) { const f32x4 xv = *(const f32x4*)(sb + off + bj * HALF + n * 16);
                        *(f32x4*)(xb + off + bj * HALF + n * 16) = xv + gv[bj][n] * acc[ai][bj][m][n]; } }
    }
};
struct EpiRes160 {
    static constexpr bool PERM = true, AFTER_DRAIN = false;
    bf16_t* X; const float* gate;
    __device__ __forceinline__ void operator()(const f32x4 (&acc)[2][2][4][2], const Unit& u, int wr, int wc, int fr, int fq) const {
        const int col0 = u.pn * BM + wc * 32 + 8 * fq;
        const int cond1 = 1 + (u.pm >> 5);
        bf16_t* xb0 = X + (size_t)u.pm * 128 * 1024 + col0; bf16_t* xb1 = X + ((size_t)NCTX + 32 * u.pm) * 1024 + col0;
        u32x4 xv[5][2]; f32x4 gv[2][2][2];
#pragma unroll
        for (int bj = 0; bj < 2; ++bj) {
#pragma unroll
            for (int n = 0; n < 2; ++n) { gv[0][bj][n] = *(const f32x4*)(gate + col0 + bj * HALF + 4 * n); gv[1][bj][n] = *(const f32x4*)(gate + cond1 * 6144 + col0 + bj * HALF + 4 * n); }
#pragma unroll
            for (int m = 0; m < 4; ++m) xv[m][bj] = *(const u32x4*)(xb0 + (size_t)(wr * 64 + m * 16 + fr) * 1024 + bj * HALF);
            xv[4][bj] = *(const u32x4*)(xb1 + (size_t)(wr * 16 + fr) * 1024 + bj * HALF); }
#pragma unroll
        for (int m = 0; m < 5; ++m) {
            const int hs = m < 4 ? 0 : 1;
            bf16_t* rowp = m < 4 ? xb0 + (size_t)(wr * 64 + m * 16 + fr) * 1024 : xb1 + (size_t)(wr * 16 + fr) * 1024;
#pragma unroll
            for (int bj = 0; bj < 2; ++bj) {
                const f32x4 a0 = m < 4 ? acc[0][bj][m < 4 ? m : 0][0] : acc[1][bj][0][0], a1 = m < 4 ? acc[0][bj][m < 4 ? m : 0][1] : acc[1][bj][0][1];
                const u32x4 x = xv[m][bj];
                const f32x4 x0 = {__builtin_bit_cast(float, x.x << 16), __builtin_bit_cast(float, x.x & 0xffff0000u), __builtin_bit_cast(float, x.y << 16), __builtin_bit_cast(float, x.y & 0xffff0000u)};
                const f32x4 x1 = {__builtin_bit_cast(float, x.z << 16), __builtin_bit_cast(float, x.z & 0xffff0000u), __builtin_bit_cast(float, x.w << 16), __builtin_bit_cast(float, x.w & 0xffff0000u)};
                const f32x4 y0 = x0 + gv[hs][bj][0] * a0, y1 = x1 + gv[hs][bj][1] * a1;
                u32x4 w; w.x = cvt_pk_vis(y0[0], y0[1]); w.y = cvt_pk_vis(y0[2], y0[3]); w.z = cvt_pk_vis(y1[0], y1[1]); w.w = cvt_pk_vis(y1[2], y1[3]);
                *(u32x4*)(rowp + bj * HALF) = w; }
        }
    }
};
struct EpiDnIn {
    static constexpr bool PERM = true, AFTER_DRAIN = false;
    bf16_t* O; float* AB;
    __device__ __forceinline__ void operator()(const f32x4 (&acc)[2][2][4][2], const Unit& u, int wr, int wc, int fr, int fq) const {
        const int row0 = u.pm * BM + wr * 64 + fr;
        if (u.pn < 16) {
            const int col0 = u.pn * BM + wc * 32 + 8 * fq;
#pragma unroll
            for (int ai = 0; ai < 2; ++ai)
#pragma unroll
                for (int m = 0; m < 4; ++m) { bf16_t* rowp = O + (size_t)(row0 + ai * HALF + m * 16) * 4096 + col0;
#pragma unroll
                    for (int bj = 0; bj < 2; ++bj) { const f32x4 v0 = acc[ai][bj][m][0], v1 = acc[ai][bj][m][1];
                        u32x4 w; w.x = cvt_pk_vis(v0[0], v0[1]); w.y = cvt_pk_vis(v0[2], v0[3]); w.z = cvt_pk_vis(v1[0], v1[1]); w.w = cvt_pk_vis(v1[2], v1[3]);
                        *(u32x4*)(rowp + bj * HALF) = w; } }
        } else if (wc == 0) {
#pragma unroll
            for (int ai = 0; ai < 2; ++ai)
#pragma unroll
                for (int m = 0; m < 4; ++m) { float* rp = AB + (size_t)(row0 + ai * HALF + m * 16) * 32 + 8 * fq;
                    *(f32x4*)rp = acc[ai][0][m][0]; *(f32x4*)(rp + 4) = acc[ai][0][m][1]; }
        }
    }
};
}
#include <hip/hip_bf16.h>
namespace attn {
using bf16 = __hip_bfloat16;
constexpr int D = 128, NW = 8, QBLK = 32, KVBLK = 64;
constexpr float SCALE = 0.088388347648318440f;
constexpr float THR = 8.f;
constexpr int SDEPTH = 2;
constexpr int LDQ = 1024, LDK = 256, LDO = 1024;
constexpr size_t SHM_V = KVBLK * D * 2, SHM_K = KVBLK * D * 2, SHM_ATTN = 2 * SHM_V + 2 * SHM_K + NW * 64 * 4;
using bf16x8 = __attribute__((ext_vector_type(8))) short;
using s16x4  = __attribute__((ext_vector_type(4))) short;
using f32x16 = __attribute__((ext_vector_type(16))) float;
using f32x8  = __attribute__((ext_vector_type(8))) float;
using u32x4  = __attribute__((ext_vector_type(4))) unsigned;
#define KSWZ(row, colB) ((row) * 256 + ((colB) ^ (((row) & 7) << 4)))
#define SBAR() __builtin_amdgcn_sched_barrier(0)
__device__ __forceinline__ int crow(int r, int hi) { return (r & 3) + 8 * (r >> 2) + 4 * hi; }
__device__ __forceinline__ unsigned cvtpk(float lo, float hi) {
  unsigned r; asm volatile("v_cvt_pk_bf16_f32 %0, %1, %2" : "=v"(r) : "v"(lo), "v"(hi)); return r;
}
template <typename TIn> struct Stage;
template <> struct Stage<bf16>  { using T = bf16x8;
  __device__ static __forceinline__ T ld8(const bf16* p) { return *reinterpret_cast<const bf16x8*>(p); }
  __device__ static __forceinline__ bf16x8 tobf(T x) { return x; } };
template <> struct Stage<float> { using T = f32x8;
  __device__ static __forceinline__ T ld8(const float* p) { return *reinterpret_cast<const f32x8*>(p); }
  __device__ static __forceinline__ bf16x8 tobf(T x) {
    u32x4 w = {cvtpk(x[0], x[1]), cvtpk(x[2], x[3]), cvtpk(x[4], x[5]), cvtpk(x[6], x[7])}; return *reinterpret_cast<bf16x8*>(&w); } };

__device__ __forceinline__ void partialSM(f32x16& p0, f32x16& p1, float& m_reg, float& mn, float& alpha) {
  constexpr float C = SCALE * 1.4426950408889634f;
  float pmax = p0[0]; for (int r = 1; r < 16; ++r) pmax = fmaxf(pmax, p0[r]); for (int r = 0; r < 16; ++r) pmax = fmaxf(pmax, p1[r]);
  { auto rr = __builtin_amdgcn_permlane32_swap(__float_as_uint(pmax), __float_as_uint(pmax), false, false);
    pmax = fmaxf(__uint_as_float(rr[0]), __uint_as_float(rr[1])); }
  if (__builtin_expect(__all(pmax - m_reg <= THR / SCALE), 1)) { mn = m_reg; alpha = 1.f; }
  else { mn = fmaxf(m_reg, pmax); alpha = __builtin_amdgcn_exp2f((m_reg - mn) * C); m_reg = mn; }
  float mnC = -mn * C;
  for (int r = 0; r < 16; ++r) p0[r] = fmaf(p0[r], C, mnC); for (int r = 0; r < 16; ++r) p1[r] = fmaf(p1[r], C, mnC);
  for (int r = 0; r < 16; ++r) p0[r] = __builtin_amdgcn_exp2f(p0[r]);
}
__device__ __forceinline__ void finishSM(f32x16& p0, f32x16& p1, float alpha, float& l_reg, bf16x8& pa0, bf16x8& pa1, bf16x8& pa2, bf16x8& pa3) {
  for (int r = 0; r < 16; ++r) p1[r] = __builtin_amdgcn_exp2f(p1[r]);
  float ps = 0; for (int r = 0; r < 16; ++r) ps += p0[r]; for (int r = 0; r < 16; ++r) ps += p1[r];
  { auto rr = __builtin_amdgcn_permlane32_swap(__float_as_uint(ps), __float_as_uint(ps), false, false);
    ps = __uint_as_float(rr[0]) + __uint_as_float(rr[1]); }
  l_reg = l_reg * alpha + ps;
#define PK4(P, BASE, OUT) do { unsigned a0 = cvtpk(P[BASE + 0], P[BASE + 1]), a1 = cvtpk(P[BASE + 2], P[BASE + 3]);   \
    unsigned b0 = cvtpk(P[BASE + 4], P[BASE + 5]), b1 = cvtpk(P[BASE + 6], P[BASE + 7]);                              \
    auto r0 = __builtin_amdgcn_permlane32_swap(a0, b0, false, false); auto r1 = __builtin_amdgcn_permlane32_swap(a1, b1, false, false); \
    u32x4 w = {r0[0], r1[0], r0[1], r1[1]}; OUT = *reinterpret_cast<bf16x8*>(&w); } while (0)
  PK4(p0, 0, pa0); PK4(p0, 8, pa1); PK4(p1, 0, pa2); PK4(p1, 8, pa3);
#undef PK4
}
__device__ __forceinline__ void qkt(f32x16& p0, f32x16& p1, const bf16* Ks, const bf16x8* qr, int r32, int hi) {
  p0 = f32x16{}; p1 = f32x16{};
  for (int d0 = 0; d0 < 8; ++d0) { int cb = (d0 * 16 + hi * 8) * 2;
    bf16x8 b0 = *reinterpret_cast<const bf16x8*>((const char*)Ks + KSWZ(r32, cb));
    bf16x8 b1 = *reinterpret_cast<const bf16x8*>((const char*)Ks + KSWZ(32 + r32, cb));
    p0 = __builtin_amdgcn_mfma_f32_32x32x16_bf16(b0, qr[d0], p0, 0, 0, 0);
    p1 = __builtin_amdgcn_mfma_f32_32x32x16_bf16(b1, qr[d0], p1, 0, 0, 0); }
}
__device__ __forceinline__ int v_st(int k, int c) { const int kk = (k & ~0xC) | ((k & 4) << 1) | ((k & 8) >> 1); return ((kk >> 3) * 4 + (c >> 5)) * 512 + ((kk & 7) * 32 + (c & 31)) * 2; }
__device__ __forceinline__ int v_rd_base(int lane) { return ((lane & 3) << 3) | (((lane >> 2) & 3) << 6) | (((lane >> 4) & 1) << 5) | (((lane >> 5) & 1) << 8); }
constexpr int v_rd_off(int d0, int ks, int half) { return d0 * 512 + ks * 4096 + half * 2048; }
template <int OFF> __device__ __forceinline__ s16x4 tr_read(int vb) {
  s16x4 r; asm volatile("ds_read_b64_tr_b16 %0, %1 offset:%2" : "=&v"(r) : "v"(vb), "i"(OFF) : "memory"); return r;
}
template <int D0> __device__ __forceinline__ void pv_one(f32x16& od, int vb, bf16x8 pa0, bf16x8 pa1, bf16x8 pa2, bf16x8 pa3) {
  const s16x4 l0 = tr_read<v_rd_off(D0, 0, 0)>(vb), h0 = tr_read<v_rd_off(D0, 0, 1)>(vb), l1 = tr_read<v_rd_off(D0, 1, 0)>(vb), h1 = tr_read<v_rd_off(D0, 1, 1)>(vb);
  const s16x4 l2 = tr_read<v_rd_off(D0, 2, 0)>(vb), h2 = tr_read<v_rd_off(D0, 2, 1)>(vb), l3 = tr_read<v_rd_off(D0, 3, 0)>(vb), h3 = tr_read<v_rd_off(D0, 3, 1)>(vb);
  asm volatile("s_waitcnt lgkmcnt(0)" ::: "memory"); SBAR();
#define PK(L, H) (bf16x8){L[0], L[1], L[2], L[3], H[0], H[1], H[2], H[3]}
  od = __builtin_amdgcn_mfma_f32_32x32x16_bf16(pa0, PK(l0, h0), od, 0, 0, 0);
  od = __builtin_amdgcn_mfma_f32_32x32x16_bf16(pa1, PK(l1, h1), od, 0, 0, 0);
  od = __builtin_amdgcn_mfma_f32_32x32x16_bf16(pa2, PK(l2, h2), od, 0, 0, 0);
  od = __builtin_amdgcn_mfma_f32_32x32x16_bf16(pa3, PK(l3, h3), od, 0, 0, 0);
#undef PK
}
__device__ __forceinline__ void pv_d0(f32x16* o, int vb, bf16x8 pa0, bf16x8 pa1, bf16x8 pa2, bf16x8 pa3) {
  pv_one<0>(o[0], vb, pa0, pa1, pa2, pa3); pv_one<1>(o[1], vb, pa0, pa1, pa2, pa3); pv_one<2>(o[2], vb, pa0, pa1, pa2, pa3); pv_one<3>(o[3], vb, pa0, pa1, pa2, pa3);
}

template <typename TQ>
__device__ __forceinline__ void attn_dense_body(const TQ* __restrict__ Qb, const bf16* __restrict__ Kh, const bf16* __restrict__ Vh,
                                                unsigned short* __restrict__ Ob, int seq, char* lds, const int tid,
                                                float* part_o, float* part_ml, const float* oth_o, const float* oth_ml, unsigned* cnt_word) {
  using St = Stage<bf16>; using SQ = Stage<TQ>;
  const int wid = tid >> 6, lane = tid & 63, r32 = lane & 31, hi = lane >> 5;
  bf16* V_lds = (bf16*)lds; bf16* K_lds = (bf16*)(lds + 2 * SHM_V);
  float* ws = (float*)(lds + 2 * SHM_V + 2 * SHM_K) + wid * 64; float* li_l = ws; float* al_l = ws + 32;
  float m_reg = -1e30f, l_reg = 0; f32x16 o[4] = {}; bf16x8 qr[8];
  const TQ* Qw = Qb + (unsigned)(wid * QBLK + r32) * LDQ + hi * 8;
#pragma unroll
  for (int d0 = 0; d0 < 8; ++d0) qr[d0] = SQ::tobf(SQ::ld8(Qw + d0 * 16));
#pragma unroll
  for (int d0 = 0; d0 < 8; ++d0) asm volatile("" : "+v"(qr[d0]));
  const int sr = tid >> 4, sc = (tid & 15) * 8, vst0 = v_st(sr, sc), vst1 = v_st(32 + sr, sc);
  const int vb0 = (int)(uintptr_t)V_lds + v_rd_base(lane);
  struct { typename St::T vs0, vs1, ks0, ks1; } sr_[SDEPTH];
#define SLOAD(i, k0) do { sr_[i].vs0 = St::ld8(&Vh[(unsigned)((k0) + sr) * LDK + sc]); sr_[i].vs1 = St::ld8(&Vh[(unsigned)((k0) + 32 + sr) * LDK + sc]); \
    sr_[i].ks0 = St::ld8(&Kh[(unsigned)((k0) + sr) * LDK + sc]); sr_[i].ks1 = St::ld8(&Kh[(unsigned)((k0) + 32 + sr) * LDK + sc]); } while (0)
#define SWRITE(b, i) do { *(bf16x8*)((char*)V_lds + (b) * SHM_V + vst0) = St::tobf(sr_[i].vs0);          \
    *(bf16x8*)((char*)V_lds + (b) * SHM_V + vst1) = St::tobf(sr_[i].vs1); int kc = sc * 2;               \
    *(bf16x8*)((char*)K_lds + (b) * SHM_K + KSWZ(sr, kc)) = St::tobf(sr_[i].ks0);                       \
    *(bf16x8*)((char*)K_lds + (b) * SHM_K + KSWZ(32 + sr, kc)) = St::tobf(sr_[i].ks1); } while (0)
#define SWAIT() do { if constexpr (SDEPTH == 2) asm volatile("s_waitcnt vmcnt(4)" ::: "memory"); else asm volatile("s_waitcnt vmcnt(0)" ::: "memory"); } while (0)
#define RESC(a) do { if (__any((a) < 1.f)) { if (hi == 0) al_l[r32] = (a); asm volatile("s_waitcnt lgkmcnt(0)" ::: "memory"); \
    for (int d = 0; d < 4; ++d) for (int r = 0; r < 16; ++r) o[d][r] *= al_l[crow(r, hi)]; } } while (0)
  f32x16 pA0, pA1, pB0, pB1; float mnA, mnB, alA, alB; bf16x8 pa0, pa1, pa2, pa3; const int NT = seq / KVBLK;
  constexpr int SE = 0, SO = SDEPTH - 1;
  SLOAD(SE, 0); asm volatile("s_waitcnt vmcnt(0)" ::: "memory"); SWRITE(0, SE); __syncthreads();
  qkt(pA0, pA1, K_lds, qr, r32, hi); partialSM(pA0, pA1, m_reg, mnA, alA);
  SLOAD(SO, KVBLK); if constexpr (SDEPTH == 2) { if (2 < NT) SLOAD(SE, 2 * KVBLK); }
  SWAIT(); SWRITE(1, SO); __syncthreads();
  for (int j = 1; j + 1 < NT; j += 2) {
    SBAR(); qkt(pB0, pB1, (bf16*)((char*)K_lds + SHM_K), qr, r32, hi);
    finishSM(pA0, pA1, alA, l_reg, pa0, pa1, pa2, pa3); SBAR();
    SLOAD(SO, (j + SDEPTH) * KVBLK); SBAR();
    pv_d0(o, vb0, pa0, pa1, pa2, pa3); partialSM(pB0, pB1, m_reg, mnB, alB);
    __syncthreads(); SWAIT(); SWRITE(0, SE);
    RESC(alB); __syncthreads();
    SBAR(); qkt(pA0, pA1, K_lds, qr, r32, hi);
    finishSM(pB0, pB1, alB, l_reg, pa0, pa1, pa2, pa3); SBAR();
    if (SDEPTH == 1 || j + 3 < NT) SLOAD(SE, (j + 1 + SDEPTH) * KVBLK); SBAR();
    pv_d0(o, vb0 + (int)SHM_V, pa0, pa1, pa2, pa3); partialSM(pA0, pA1, m_reg, mnA, alA);
    __syncthreads(); SWAIT(); SWRITE(1, SO);
    RESC(alA); __syncthreads();
  }
  SBAR(); qkt(pB0, pB1, (bf16*)((char*)K_lds + SHM_K), qr, r32, hi);
  finishSM(pA0, pA1, alA, l_reg, pa0, pa1, pa2, pa3); SBAR();
  pv_d0(o, vb0, pa0, pa1, pa2, pa3); partialSM(pB0, pB1, m_reg, mnB, alB);
  __syncthreads(); RESC(alB);
  finishSM(pB0, pB1, alB, l_reg, pa0, pa1, pa2, pa3); SBAR();
  pv_d0(o, vb0 + (int)SHM_V, pa0, pa1, pa2, pa3);
  int t2_ = tid; asm volatile("" : "+v"(t2_));
  const int ewid = t2_ >> 6, er32 = t2_ & 31, ehi = (t2_ >> 5) & 1;
  unsigned short* Ow = Ob + (int)(ewid * QBLK) * LDO;
  if (part_o == nullptr) {
    if (ehi == 0) li_l[er32] = l_reg; asm volatile("s_waitcnt lgkmcnt(0)" ::: "memory");
    float rli[16];
#pragma unroll
    for (int r = 0; r < 16; ++r) rli[r] = __builtin_amdgcn_rcpf(li_l[crow(r, ehi)]);
#pragma unroll
    for (int r = 0; r < 16; ++r) { int orow = crow(r, ehi);
      for (int d0 = 0; d0 < 4; ++d0) Ow[(int)orow * LDO + d0 * 32 + er32] = (unsigned short)f2bf(o[d0][r] * rli[r]); }
  } else {
    float* Po = part_o + (int)(ewid * QBLK) * 128;
#pragma unroll
    for (int r = 0; r < 16; ++r) { int orow = crow(r, ehi);
      for (int d0 = 0; d0 < 4; ++d0) Po[orow * 128 + d0 * 32 + er32] = o[d0][r]; }
    if (ehi == 0) { part_ml[(ewid * QBLK + er32) * 2] = m_reg; part_ml[(ewid * QBLK + er32) * 2 + 1] = l_reg; li_l[er32] = l_reg; al_l[er32] = m_reg; }
    volatile unsigned* flag = (volatile unsigned*)(lds + SHM_ATTN);
    asm volatile("s_waitcnt vmcnt(0) lgkmcnt(0)" ::: "memory"); __syncthreads();
    if (tid == 0) {
      __builtin_amdgcn_fence(__ATOMIC_RELEASE, "agent"); asm volatile("s_waitcnt vmcnt(0)" ::: "memory");
      const unsigned old = __hip_atomic_fetch_add(cnt_word, 1u, __ATOMIC_RELAXED, __HIP_MEMORY_SCOPE_AGENT);
      if (old == 1u) { __builtin_amdgcn_fence(__ATOMIC_ACQUIRE, "agent"); asm volatile("s_waitcnt vmcnt(0)" ::: "memory"); }
      flag[0] = old;
    }
    __syncthreads();
    if (flag[0] == 1u) {
      constexpr float C = SCALE * 1.4426950408889634f;
      const float* Qo = oth_o + (int)(ewid * QBLK) * 128;
#pragma unroll
      for (int rb = 0; rb < 16; rb += 8) {
        float qv[8][4], mo[8], lo[8];
#pragma unroll
        for (int r8 = 0; r8 < 8; ++r8) { const int orow = crow(rb + r8, ehi);
          mo[r8] = oth_ml[(ewid * QBLK + orow) * 2]; lo[r8] = oth_ml[(ewid * QBLK + orow) * 2 + 1];
#pragma unroll
          for (int d0 = 0; d0 < 4; ++d0) qv[r8][d0] = Qo[orow * 128 + d0 * 32 + er32]; }
#pragma unroll
        for (int r8 = 0; r8 < 8; ++r8) { const int r = rb + r8, orow = crow(r, ehi);
          const float ms = al_l[orow], ls = li_l[orow];
          const float M = fmaxf(ms, mo[r8]), wsf = __builtin_amdgcn_exp2f((ms - M) * C), wof = __builtin_amdgcn_exp2f((mo[r8] - M) * C);
          const float inv = __builtin_amdgcn_rcpf(ls * wsf + lo[r8] * wof);
#pragma unroll
          for (int d0 = 0; d0 < 4; ++d0) Ow[(int)orow * LDO + d0 * 32 + er32] = (unsigned short)f2bf((o[d0][r] * wsf + qv[r8][d0] * wof) * inv); }
        asm volatile("" ::: "memory");
      }
    }
  }
#undef SLOAD
#undef SWRITE
#undef SWAIT
#undef RESC
}

#undef KSWZ
#undef SBAR
}
#define LAS __attribute__((address_space(3)))
constexpr int NWAVES = 8;
constexpr int LDS_BYTES = 147456;
constexpr size_t MiB = (size_t)1 << 20;
constexpr size_t WS_CTL = 0, CTL_ZERO_BYTES = 1 * MiB;
constexpr size_t WS_MODS = 1 * MiB, WS_ROPE = WS_MODS + MiB / 2;
constexpr size_t WS_WT_AIN = 2 * MiB, WS_WT_AOUT = 8 * MiB, WS_WT_DIN = 12 * MiB, WS_WT_DOUT = 29 * MiB, WS_WT_W1 = 33 * MiB, WS_WT_W2 = 65 * MiB;
constexpr size_t WS_X = 97 * MiB, WS_H = 137 * MiB, WS_Y = 157 * MiB, WS_PROJ = 177 * MiB, WS_AB = 257 * MiB;
constexpr size_t WS_SOP = 291 * MiB, WS_QB = 291 * MiB, WS_KB = 311 * MiB, WS_VB = 317 * MiB;
constexpr size_t WS_PART_O = 330 * MiB, WS_PART_ML = 347 * MiB;
constexpr int CW_ATT = 8192;
constexpr size_t WS_EGL = 471 * MiB, WS_OF = 472 * MiB, WS_OB = 492 * MiB, WS_END = 512 * MiB;
static_assert(WS_SOP + (size_t)2560 * 73728 <= WS_EGL, "operand records");

struct Ctx {
    LAS unsigned char* lds;
    int tid, lane, wid, gw, ngw, nblk, blk;
};
struct ProPtrs { const float *c, *c_ctx, *w_mod, *b_mod, *attn_w_in, *attn_w_out, *dn_w_in, *dn_w_out, *mlp_w1, *mlp_w2; float *mods, *rope; bf16raw *wt_ain, *wt_aout, *wt_din, *wt_dout, *wt_w1, *wt_w2; const float *x_prompt, *x_sample; bf16raw* X; };

#define LDS_WAIT() asm volatile("s_waitcnt lgkmcnt(0)" ::: "memory")

__device__ __forceinline__ void p0_transpose_item(const float* W, int K, int N, bf16raw* WT, LAS float* scr, int item, int lane) {
    const int nblk = N / 32, kb = item / nblk, nb = item % nblk, k0 = 64 * kb, n0 = 32 * nb;
#pragma unroll 8
    for (int i = 0; i < 32; ++i) { const int kk = 2 * i + (lane >> 5); scr[kk * 33 + (lane & 31)] = W[(size_t)(k0 + kk) * N + n0 + (lane & 31)]; }
    LDS_WAIT(); asm volatile("" ::: "memory");
    const int c = lane & 7;
#pragma unroll
    for (int j = 0; j < 4; ++j) { const int n = (lane >> 3) + 8 * j; const LAS float* s = scr + (8 * c) * 33 + n;
        u32x4_t o; o.x = pk2(s[0 * 33], s[1 * 33]); o.y = pk2(s[2 * 33], s[3 * 33]); o.z = pk2(s[4 * 33], s[5 * 33]); o.w = pk2(s[6 * 33], s[7 * 33]);
        *(u32x4_t*)(WT + (size_t)(n0 + n) * K + k0 + 8 * c) = o; }
    LDS_WAIT(); asm volatile("" ::: "memory");
}

__device__ __forceinline__ void phase_prologue(Ctx& C, const ProPtrs& P) {
    LAS float* sc = (LAS float*)C.lds;
    LAS float* red = (LAS float*)(C.lds + 12288);
    for (int k = C.tid; k < 1024; k += 512) { sc[k] = silu_f(P.c_ctx[k]); sc[1024 + k] = silu_f(P.c[k]); sc[2048 + k] = silu_f(P.c[1024 + k]); }
    __syncthreads();
    for (int u = C.blk; u < 4 * 96; u += C.nblk) {
        const int l = u / 96, n0 = (u % 96) * 64;
        const float* w = P.w_mod + ((size_t)l * 1024 + C.wid * 128) * 6144 + n0 + C.lane;
        float a0 = 0.f, a1 = 0.f, a2 = 0.f;
#pragma unroll 8
        for (int k = 0; k < 128; ++k) { const float wv = w[(size_t)k * 6144]; const int kk = C.wid * 128 + k; a0 += sc[kk] * wv; a1 += sc[1024 + kk] * wv; a2 += sc[2048 + kk] * wv; }
        red[(C.wid * 3 + 0) * 64 + C.lane] = a0; red[(C.wid * 3 + 1) * 64 + C.lane] = a1; red[(C.wid * 3 + 2) * 64 + C.lane] = a2;
        __syncthreads();
        if (C.tid < 192) { const int s = C.tid >> 6, ln = C.tid & 63; float t = 0.f;
#pragma unroll
            for (int w8 = 0; w8 < 8; ++w8) t += red[(w8 * 3 + s) * 64 + ln];
            P.mods[(size_t)(l * 3 + s) * 6144 + n0 + ln] = t + P.b_mod[l * 6144 + n0 + ln]; }
        __syncthreads();
    }
    __syncthreads();
    LAS float* scr = (LAS float*)(C.lds + C.wid * 16384);
    constexpr int I0 = 2 * 768, I1 = 2 * 512, I2 = 2 * 2064, I3 = 2 * 512, I4 = 4 * 2048, I5 = 4 * 2048;
    for (int it = C.gw; it < I0 + I1 + I2 + I3 + I4 + I5; it += C.ngw) {
        int r = it;
        if (r < I0) { const int j = r / 768; p0_transpose_item(P.attn_w_in + (size_t)j * 1024 * 1536, 1024, 1536, P.wt_ain + (size_t)j * 1536 * 1024, scr, r % 768, C.lane); continue; } r -= I0;
        if (r < I1) { const int j = r / 512; p0_transpose_item(P.attn_w_out + (size_t)j * 1024 * 1024, 1024, 1024, P.wt_aout + (size_t)j * 1024 * 1024, scr, r % 512, C.lane); continue; } r -= I1;
        if (r < I2) { const int j = r / 2064; p0_transpose_item(P.dn_w_in + (size_t)j * 1024 * DNIN, 1024, DNIN, P.wt_din + (size_t)j * DNINP * 1024, scr, r % 2064, C.lane); continue; } r -= I2;
        if (r < I3) { const int j = r / 512; p0_transpose_item(P.dn_w_out + (size_t)j * 1024 * 1024, 1024, 1024, P.wt_dout + (size_t)j * 1024 * 1024, scr, r % 512, C.lane); continue; } r -= I3;
        if (r < I4) { const int l = r / 2048; p0_transpose_item(P.mlp_w1 + (size_t)l * 1024 * 4096, 1024, 4096, P.wt_w1 + (size_t)l * 4096 * 1024, scr, r % 2048, C.lane); continue; } r -= I4;
        { const int l = r / 2048; p0_transpose_item(P.mlp_w2 + (size_t)l * 4096 * 1024, 4096, 1024, P.wt_w2 + (size_t)l * 1024 * 4096, scr, r % 2048, C.lane); }
    }
    for (int i = C.blk * 512 + C.tid; i < MTOK * D / 8; i += C.nblk * 512) { const size_t e = (size_t)i * 8;
        const float* src = e < (size_t)NCTX * D ? P.x_prompt + e : P.x_sample + (e - (size_t)NCTX * D);
        const f32x4_t a = *(const f32x4_t*)src, b = *(const f32x4_t*)(src + 4);
        *(u32x4_t*)(P.X + e) = (u32x4_t){pk2(a.x, a.y), pk2(a.z, a.w), pk2(b.x, b.y), pk2(b.z, b.w)}; }
    const int gt = C.blk * 512 + C.tid, ngt = C.nblk * 512;
    for (int i = gt; i < 2 * 28672; i += ngt) { const int j = i / 28672, o = i % 28672;
        *(u32x4_t*)(P.wt_din + ((size_t)j * DNINP + DNIN) * 1024 + (size_t)o * 8) = (u32x4_t){0u, 0u, 0u, 0u}; }
    for (int i = gt; i < 1024 * 64; i += ngt) { const int t = i >> 6, a = (i >> 5) & 1, f = i & 31;
        const float inv = exp2f(-(float)f * (13.287712379549449f / 32.f)); const float ang = (float)(a ? (t & 63) : (t >> 6)) * inv;
        P.rope[2 * i] = __cosf(ang); P.rope[2 * i + 1] = __sinf(ang); }
}

__device__ __forceinline__ void phase_norm(Ctx& C, const bf16raw* X, const float* gain, const float* md0, bf16raw* H) {
    for (int row = C.gw; row < MTOK; row += C.ngw) {
        const float* md = md0 + cond_of(row) * 6144;
        float v[2][8]; float ss = 0.f;
#pragma unroll
        for (int j = 0; j < 2; ++j) { const u32x4_t w = *(const u32x4_t*)(X + (size_t)row * D + 8 * C.lane + 512 * j);
            v[j][0] = bf_lo(w.x); v[j][1] = bf_hi(w.x); v[j][2] = bf_lo(w.y); v[j][3] = bf_hi(w.y); v[j][4] = bf_lo(w.z); v[j][5] = bf_hi(w.z); v[j][6] = bf_lo(w.w); v[j][7] = bf_hi(w.w);
#pragma unroll
            for (int q = 0; q < 8; ++q) ss += v[j][q] * v[j][q]; }
        const float rinv = rsqrtf(wave_sum_dpp(ss) * (1.f / D) + EPS);
#pragma unroll
        for (int j = 0; j < 2; ++j) { const int c = 8 * C.lane + 512 * j; float y[8];
#pragma unroll
            for (int q = 0; q < 2; ++q) { const f32x4_t g = *(const f32x4_t*)(gain + c + 4 * q), sh = *(const f32x4_t*)(md + c + 4 * q), sc = *(const f32x4_t*)(md + 1024 + c + 4 * q);
                y[4 * q + 0] = v[j][4 * q + 0] * rinv * g.x * (sc.x + 1.f) + sh.x; y[4 * q + 1] = v[j][4 * q + 1] * rinv * g.y * (sc.y + 1.f) + sh.y;
                y[4 * q + 2] = v[j][4 * q + 2] * rinv * g.z * (sc.z + 1.f) + sh.z; y[4 * q + 3] = v[j][4 * q + 3] * rinv * g.w * (sc.w + 1.f) + sh.w; }
            *(u32x4_t*)(H + (size_t)row * D + c) = (u32x4_t){pk2(y[0], y[1]), pk2(y[2], y[3]), pk2(y[4], y[5]), pk2(y[6], y[7])}; }
    }
}
__device__ __forceinline__ void phase_final(Ctx& C, const bf16raw* X, const float* final_norm, float* out) {
    for (int row = C.gw; row < MTOK; row += C.ngw) {
        float v[2][8]; float ss = 0.f;
#pragma unroll
        for (int j = 0; j < 2; ++j) { const u32x4_t w = *(const u32x4_t*)(X + (size_t)row * D + 8 * C.lane + 512 * j);
            v[j][0] = bf_lo(w.x); v[j][1] = bf_hi(w.x); v[j][2] = bf_lo(w.y); v[j][3] = bf_hi(w.y); v[j][4] = bf_lo(w.z); v[j][5] = bf_hi(w.z); v[j][6] = bf_lo(w.w); v[j][7] = bf_hi(w.w);
#pragma unroll
            for (int q = 0; q < 8; ++q) ss += v[j][q] * v[j][q]; }
        const float rinv = rsqrtf(wave_sum_dpp(ss) * (1.f / D) + EPS);
#pragma unroll
        for (int j = 0; j < 2; ++j) { const int c = 8 * C.lane + 512 * j;
#pragma unroll
            for (int q = 0; q < 2; ++q) { const f32x4_t g = *(const f32x4_t*)(final_norm + c + 4 * q);
                *(f32x4_t*)(out + O_Y + (size_t)row * D + c + 4 * q) = (f32x4_t){v[j][4 * q] * rinv * g.x, v[j][4 * q + 1] * rinv * g.y, v[j][4 * q + 2] * rinv * g.z, v[j][4 * q + 3] * rinv * g.w}; } }
    }
}

struct QknPtrs { const bf16raw* PROJ; bf16raw *QB, *KB, *VB; const float *qg, *kg, *rope, *cache_k, *cache_v; float* out; };
__device__ __forceinline__ void phase_qkn(Ctx& C, const QknPtrs& P, int j) {
    const unsigned* P32 = (const unsigned*)P.PROJ; unsigned* Q32 = (unsigned*)P.QB; unsigned* K32 = (unsigned*)P.KB; unsigned* V32 = (unsigned*)P.VB;
    const float* qg = P.qg; const float* kg = P.kg;
    const int lane = C.lane;
    const f32x2_t gq = *(const f32x2_t*)(qg + 2 * lane), gk = *(const f32x2_t*)(kg + 2 * lane);
    for (int row = C.gw; row < MTOK; row += C.ngw) {
        const bool lat = row >= NCTX;
        const int b = lat ? (row - NCTX) >> 10 : row >> 8, t = lat ? (row - NCTX) & 1023 : row & 255;
        const int krow = lat ? 8192 + b * 1280 + 256 + t : row;
        f32x4_t rp = (f32x4_t){1.f, 0.f, 1.f, 0.f};
        if (lat) rp = *(const f32x4_t*)(P.rope + ((size_t)t * 64 + (lane >> 5) * 32 + 2 * (lane & 15)) * 2);
        const bool ph = (lane >> 4) & 1;
#pragma unroll
        for (int slot = 0; slot < 12; ++slot) {
            const unsigned w = P32[(size_t)row * 768 + slot * 64 + lane];
            float v0 = bf_lo(w), v1 = bf_hi(w);
            if (slot < 10) {
                const float rinv = rsqrtf(wave_sum(v0 * v0 + v1 * v1, lane) * (1.f / 128.f) + EPS);
                const f32x2_t g = slot < 8 ? gq : gk;
                v0 = v0 * rinv * g.x; v1 = v1 * rinv * g.y;
                if (lat) { const float y0 = lane_xor_f(v0, lane, 16), y1 = lane_xor_f(v1, lane, 16);
                    v0 = v0 * rp.x + (ph ? y0 : -y0) * rp.y; v1 = v1 * rp.z + (ph ? y1 : -y1) * rp.w; }
            }
            const unsigned o = pk2(v0, v1);
            if (slot < 8) Q32[(size_t)row * 512 + slot * 64 + lane] = o;
            else if (slot < 10) K32[(size_t)krow * 128 + (slot - 8) * 64 + lane] = o;
            else V32[(size_t)krow * 128 + (slot - 10) * 64 + lane] = o;
            if (!lat && slot >= 8) { float* op = P.out + (slot < 10 ? O_CK : O_CV) + ((size_t)(b * 2 + j) * 256 + t) * 256 + (slot & 1) * 128 + 2 * lane;
                *(f32x2_t*)op = (f32x2_t){v0, v1}; }
        }
    }
    for (int it = C.gw; it < 2 * 256 * 2; it += C.ngw) {
        const int kv = it & 1, key = (it >> 1) & 255, b = it >> 9;
        const float* src = (kv ? P.cache_v : P.cache_k) + ((size_t)(b * 2 + j) * 256 + key) * 256 + 4 * lane;
        const f32x4_t v = *(const f32x4_t*)src;
        u32x2_t o; o.x = pk2(v.x, v.y); o.y = pk2(v.z, v.w);
        *(u32x2_t*)((kv ? P.VB : P.KB) + (size_t)(8192 + b * 1280 + key) * 256 + 4 * lane) = o;
    }
}

struct AttnPtrs { const bf16raw *QB, *KB, *VB; bf16raw* Y; float *part_o, *part_ml; unsigned* cnt; };
__device__ __forceinline__ void phase_attn(Ctx& C, const AttnPtrs& P) {
    char* lds = (char*)C.lds;
    const bool split = C.nblk == 256;
    const int nit = split ? (C.blk < 128 ? 1 : 2) : (320 + C.nblk - 1) / C.nblk;
    for (int r = 0; r < nit; ++r) {
        int row0, krow0, hq, seq; float *po = nullptr, *pml = nullptr; const float *oo = nullptr, *oml = nullptr; unsigned* cw = nullptr;
        if (split) {
            if (C.blk < 128) { const int u = C.blk >> 1, kh = C.blk & 1, b = u >> 5, qb = u & 3; hq = (u >> 2) & 7; row0 = NCTX + b * 1024 + qb * 256; krow0 = 8192 + b * 1280 + kh * 640; seq = 640;
                po = P.part_o + (size_t)C.blk * 32768; pml = P.part_ml + (size_t)C.blk * 512; oo = P.part_o + (size_t)(C.blk ^ 1) * 32768; oml = P.part_ml + (size_t)(C.blk ^ 1) * 512; cw = P.cnt + u; }
            else { const int c = (C.blk - 128) + 128 * r, b = c >> 3; hq = c & 7; row0 = b * 256; krow0 = b * 256; seq = 256; }
        } else {
            const int u = C.blk + r * C.nblk; if (u >= 320) break;
            if (u < 64) { const int b = u >> 5, qb = u & 3; hq = (u >> 2) & 7; row0 = NCTX + b * 1024 + qb * 256; krow0 = 8192 + b * 1280; seq = 1280; }
            else { const int c = u - 64, b = c >> 3; hq = c & 7; row0 = b * 256; krow0 = b * 256; seq = 256; }
        }
        const int kvh = hq >> 2;
        if (r > 0) __syncthreads();
        int tidu = C.tid; asm volatile("" : "+v"(tidu));
        attn::attn_dense_body<attn::bf16>((const attn::bf16*)(P.QB + (size_t)row0 * 1024 + hq * 128), (const attn::bf16*)(P.KB + (size_t)krow0 * 256 + kvh * 128),
                                          (const attn::bf16*)(P.VB + (size_t)krow0 * 256 + kvh * 128), P.Y + (size_t)row0 * 1024 + hq * 128, seq, lds, tidu, po, pml, oo, oml, cw);
    }
}
struct GatePtrs { const bf16raw *OF, *OB, *PROJ; bf16raw* Y; const float* gain; };
__device__ __forceinline__ void phase_gate(Ctx& C, const GatePtrs& P) {
    const unsigned* F32 = (const unsigned*)P.OF; const unsigned* B32 = (const unsigned*)P.OB; const unsigned* P32 = (const unsigned*)P.PROJ; unsigned* Y32 = (unsigned*)P.Y;
    const int lane = C.lane;
    const f32x2_t g = *(const f32x2_t*)(P.gain + 2 * lane);
    for (int it = C.gw; it < MTOK * 8; it += C.ngw) {
        const int row = it >> 3, h = it & 7;
        const unsigned wf = F32[(size_t)row * 512 + h * 64 + lane], wb = B32[(size_t)row * 512 + h * 64 + lane], wz = P32[(size_t)row * 2048 + 1536 + h * 64 + lane];
        const float v0 = bf_lo(wf) + bf_lo(wb), v1 = bf_hi(wf) + bf_hi(wb);
        const float rinv = rsqrtf(wave_sum(v0 * v0 + v1 * v1, lane) * (1.f / 128.f) + EPS);
        Y32[(size_t)row * 512 + h * 64 + lane] = pk2(v0 * rinv * g.x * silu_f(bf_lo(wz)), v1 * rinv * g.y * silu_f(bf_hi(wz)));
    }
}
constexpr int REC_U = 0, REC_WN = 16384, REC_QT = 32768, REC_QK = 49152, REC_KT = 57344, REC_BYTES = 73728;
typedef short dn_bf16x8 __attribute__((ext_vector_type(8)));
typedef float dn_f32x16 __attribute__((ext_vector_type(16)));
__device__ __forceinline__ int dn_crow(int r, int hi) { return (r & 3) + 8 * (r >> 2) + 4 * hi; }
typedef __bf16 dn_bf16x2 __attribute__((ext_vector_type(2)));
__device__ __forceinline__ unsigned dn_cvt_pk(float lo, float hi) { const f32x2_t v = {lo, hi}; return __builtin_bit_cast(unsigned, __builtin_convertvector(v, dn_bf16x2)); }

__device__ __forceinline__ dn_bf16x8 dn_acc_frag(const dn_f32x16& a, int s) {
    u32x4_t w;
    if (s == 0) { w.x = dn_cvt_pk(a[0], a[1]); w.y = dn_cvt_pk(a[2], a[3]); w.z = dn_cvt_pk(a[4], a[5]); w.w = dn_cvt_pk(a[6], a[7]); }
    else { w.x = dn_cvt_pk(a[8], a[9]); w.y = dn_cvt_pk(a[10], a[11]); w.z = dn_cvt_pk(a[12], a[13]); w.w = dn_cvt_pk(a[14], a[15]); }
    return __builtin_bit_cast(dn_bf16x8, w);
}

struct DnLocalPtrs { const bf16raw* PROJ; const float *AB, *cw, *alog, *dtb; unsigned char* SOP; float* EGL; };

__device__ __forceinline__ void phase_dn_local(Ctx& C, const DnLocalPtrs& P) {
    constexpr int L_Q = 0, L_K = 17408, L_V = 34816, L_GC = 52224, L_BT = 52736, L_AM = 53248, L_QK = L_AM + 2 * 17408, L_TB = L_QK + 2 * 9216;
    LAS unsigned char* L = C.lds;
    const unsigned* P32 = (const unsigned*)P.PROJ;
    LAS float* gcs = (LAS float*)(L + L_GC); LAS float* bts = (LAS float*)(L + L_BT);
    for (int u = C.blk; u < 1280; u += C.nblk) {
        int tid = C.tid; asm volatile("" : "+v"(tid));
        const int lane = tid & 63, wid = __builtin_amdgcn_readfirstlane(tid >> 6), dir = wid >> 2, w4 = wid & 3, t256 = tid & 255, r32 = lane & 31, hi = lane >> 5;
        const int h = u & 7, cidx = u >> 3;
        int npr, N, T, base, cbase;
        if (cidx < 128) { const int seq = cidx >> 2; npr = cidx & 3; N = 4; T = 256; base = seq * 256; cbase = cidx - npr; }
        else { const int c2 = cidx - 128, sq = c2 >> 4; npr = c2 & 15; N = 16; T = 1024; base = NCTX + sq * 1024; cbase = cidx - npr; }
        if (wid < 2) {
            const int tau = wid ? 63 - lane : lane; const size_t row = (size_t)(base + 64 * npr + tau);
            const float a = P.AB[row * 32 + wid * 8 + h], b = P.AB[row * 32 + 16 + wid * 8 + h];
            const float x = a + P.dtb[wid * 8 + h]; const float sp = fmaxf(x, 0.f) + __logf(1.f + __expf(-fabsf(x)));
            float g = -__expf(P.alog[wid * 8 + h]) * sp;
#pragma unroll
            for (int o = 1; o < 64; o <<= 1) { const float t = __builtin_bit_cast(float, __builtin_amdgcn_ds_bpermute((lane - o) << 2, __builtin_bit_cast(int, g))); if (lane >= o) g += t; }
            gcs[wid * 64 + lane] = g; bts[wid * 64 + lane] = 1.f / (1.f + __expf(-b));
        }
        {
            const int tau0 = 8 * wid;
#pragma unroll
            for (int X = 0; X < 3; ++X) {
                const int cb = X * 1024 + h * 128;
                float w0[12], w1[12];
#pragma unroll
                for (int i = 0; i < 12; ++i) { const int tt = 64 * npr + tau0 - 2 + i; unsigned w = 0u;
                    if (tt >= 0 && tt < T) w = P32[(size_t)(base + tt) * 2048 + (cb >> 1) + lane];
                    w0[i] = bf_lo(w); w1[i] = bf_hi(w); }
                f32x2_t cwv[5];
#pragma unroll
                for (int i = 0; i < 5; ++i) cwv[i] = *(const f32x2_t*)(P.cw + i * 3072 + cb + 2 * lane);
#pragma unroll
                for (int r = 0; r < 8; ++r) {
                    float a0 = 0.f, a1 = 0.f;
#pragma unroll
                    for (int i = 0; i < 5; ++i) { a0 += w0[r + i] * cwv[i].x; a1 += w1[r + i] * cwv[i].y; }
                    a0 = silu_f(a0); a1 = silu_f(a1);
                    if (X < 2) { const float rinv = rsqrtf(wave_sum_dpp(a0 * a0 + a1 * a1) + EPS); a0 *= rinv; a1 *= rinv; }
                    *(LAS unsigned*)(L + (X == 0 ? L_Q : X == 1 ? L_K : L_V) + (tau0 + r) * 272 + lane * 4) = pk2(a0, a1);
                }
            }
        }
        __syncthreads();
        {
            const int ti = w4 >> 1, tj = w4 & 1;
            dn_f32x16 accK = {}, accQ = {};
            if (ti >= tj) {
                const int pa = 32 * ti + r32, pb = 32 * tj + r32;
                const int rowA = dir ? 63 - pa : pa, rowB = dir ? 63 - pb : pb;
#pragma unroll
                for (int s = 0; s < 8; ++s) {
                    const int co = (16 * s + 8 * hi) * 2;
                    const dn_bf16x8 Ak = *(const LAS dn_bf16x8*)(L + L_K + rowA * 272 + co), Aq = *(const LAS dn_bf16x8*)(L + L_Q + rowA * 272 + co), Bk = *(const LAS dn_bf16x8*)(L + L_K + rowB * 272 + co);
                    accK = __builtin_amdgcn_mfma_f32_32x32x16_bf16(Ak, Bk, accK, 0, 0, 0);
                    accQ = __builtin_amdgcn_mfma_f32_32x32x16_bf16(Aq, Bk, accQ, 0, 0, 0);
                }
            }
            const int pj = 32 * tj + r32; const float gcj = gcs[dir * 64 + pj];
#pragma unroll
            for (int reg = 0; reg < 16; ++reg) {
                const int pi = 32 * ti + dn_crow(reg, hi);
                const float dec = pi >= pj ? __expf(gcs[dir * 64 + pi] - gcj) : 0.f;
                const float am = pi > pj ? bts[dir * 64 + pi] * accK[reg] * dec : 0.f;
                const float qk = ATT_SCALE * accQ[reg] * dec;
                *(LAS float*)(L + L_AM + dir * 17408 + pi * 272 + pj * 4) = am;
                *(LAS bf16raw*)(L + L_QK + dir * 9216 + pi * 144 + pj * 2) = (bf16raw)f2bf(qk);
            }
        }
        __syncthreads();
        const int rec_n = dir ? N - 1 - npr : npr;
        const int recid = ((cbase + rec_n) * 8 + h) * 2 + dir;
        unsigned char* rec = P.SOP + (size_t)recid * REC_BYTES;
        if (w4 == 0) {
            const int hf = lane >> 5, c32 = lane & 31, off = 32 * hf;
            const LAS unsigned char* am = L + L_AM + dir * 17408 + off * 272 + off * 4;
            float x[32];
            f32x4_t nx[8];
            nx[0] = (f32x4_t){0.f, 0.f, 0.f, 0.f};
#pragma unroll
            for (int i = 0; i < 32; ++i) {
                f32x4_t cu[8];
#pragma unroll
                for (int j4 = 0; j4 < (i + 3) / 4; ++j4) cu[j4] = nx[j4];
                if (i + 1 < 32) {
#pragma unroll
                    for (int j4 = 0; j4 < (i + 4) / 4; ++j4) nx[j4] = *(const LAS f32x4_t*)(am + (i + 1) * 272 + j4 * 16);
                }
                asm volatile("" ::: "memory");
                float acc0 = (i == c32) ? 1.f : 0.f, acc1 = 0.f;
#pragma unroll
                for (int j4 = 0; j4 < (i + 3) / 4; ++j4) {
                    if (4 * j4 + 0 < i) acc0 -= cu[j4].x * x[4 * j4 + 0];
                    if (4 * j4 + 1 < i) acc1 -= cu[j4].y * x[4 * j4 + 1];
                    if (4 * j4 + 2 < i) acc0 -= cu[j4].z * x[4 * j4 + 2];
                    if (4 * j4 + 3 < i) acc1 -= cu[j4].w * x[4 * j4 + 3];
                }
                x[i] = acc0 + acc1;
            }
            LAS unsigned char* tbd = L + L_TB + dir * 9216;
#pragma unroll
            for (int i = 0; i < 32; ++i) *(LAS bf16raw*)(tbd + (off + i) * 144 + (off + c32) * 2) = (bf16raw)f2bf(x[i]);
            if (hf) {
#pragma unroll
                for (int i = 0; i < 32; ++i) *(LAS bf16raw*)(tbd + i * 144 + (32 + c32) * 2) = (bf16raw)0;
            }
            const LAS unsigned char* amf = L + L_AM + dir * 17408;
            dn_f32x16 Pm = {};
#pragma unroll
            for (int ks = 0; ks < 2; ++ks) {
                const f32x4_t a0 = *(const LAS f32x4_t*)(amf + (32 + r32) * 272 + (16 * ks + 8 * hi) * 4), a1 = *(const LAS f32x4_t*)(amf + (32 + r32) * 272 + (16 * ks + 8 * hi + 4) * 4);
                u32x4_t aw; aw.x = dn_cvt_pk(a0.x, a0.y); aw.y = dn_cvt_pk(a0.z, a0.w); aw.z = dn_cvt_pk(a1.x, a1.y); aw.w = dn_cvt_pk(a1.z, a1.w);
                unsigned short tv[8];
#pragma unroll
                for (int jj = 0; jj < 8; ++jj) tv[jj] = *(const LAS bf16raw*)(tbd + (16 * ks + 8 * hi + jj) * 144 + r32 * 2);
                u32x4_t bw; bw.x = tv[0] | ((unsigned)tv[1] << 16); bw.y = tv[2] | ((unsigned)tv[3] << 16); bw.z = tv[4] | ((unsigned)tv[5] << 16); bw.w = tv[6] | ((unsigned)tv[7] << 16);
                Pm = __builtin_amdgcn_mfma_f32_32x32x16_bf16(__builtin_bit_cast(dn_bf16x8, aw), __builtin_bit_cast(dn_bf16x8, bw), Pm, 0, 0, 0);
            }
            dn_f32x16 Tm = {};
#pragma unroll
            for (int ss = 0; ss < 2; ++ss) {
                const LAS unsigned char* tp = tbd + (32 + r32) * 144 + (32 + 16 * ss + 4 * hi) * 2;
                const u32x2_t tl = *(const LAS u32x2_t*)tp, th = *(const LAS u32x2_t*)(tp + 16);
                const u32x4_t aw = {tl.x, tl.y, th.x, th.y};
                Tm = __builtin_amdgcn_mfma_f32_32x32x16_bf16(__builtin_bit_cast(dn_bf16x8, aw), dn_acc_frag(Pm, ss), Tm, 0, 0, 0);
            }
#pragma unroll
            for (int reg = 0; reg < 16; ++reg) *(LAS bf16raw*)(tbd + (32 + dn_crow(reg, hi)) * 144 + r32 * 2) = (bf16raw)f2bf(-Tm[reg]);
        } else {
            const int t192 = (w4 - 1) * 64 + lane;
            const float glast = gcs[dir * 64 + 63];
            for (int id = t192; id < 1024; id += 192) {
                const int mt = id >> 9, kt = (id >> 6) & 7, r = id & 31, hh = (id >> 5) & 1;
                const int p = 32 * mt + r, dk0 = 32 * (kt >> 1) + 16 * (kt & 1) + 4 * hh;
                const int tau = dir ? 63 - p : p; const float sc = ATT_SCALE * __expf(gcs[dir * 64 + p]);
                const u32x2_t ql = *(const LAS u32x2_t*)(L + L_Q + tau * 272 + dk0 * 2), qh = *(const LAS u32x2_t*)(L + L_Q + tau * 272 + (dk0 + 8) * 2);
                u32x4_t qo; qo.x = dn_cvt_pk(bf_lo(ql.x) * sc, bf_hi(ql.x) * sc); qo.y = dn_cvt_pk(bf_lo(ql.y) * sc, bf_hi(ql.y) * sc);
                qo.z = dn_cvt_pk(bf_lo(qh.x) * sc, bf_hi(qh.x) * sc); qo.w = dn_cvt_pk(bf_lo(qh.y) * sc, bf_hi(qh.y) * sc);
                *(u32x4_t*)(rec + REC_QT + (size_t)id * 16) = qo;
            }
            for (int id = t192; id < 1024; id += 192) {
                const int mt = id >> 8, kt = (id >> 6) & 3, r = id & 31, hh = (id >> 5) & 1;
                const int c0 = 32 * (kt >> 1) + 16 * (kt & 1) + 4 * hh;
                float kv[8];
#pragma unroll
                for (int jj = 0; jj < 8; ++jj) { const int c = c0 + 8 * (jj >> 2) + (jj & 3); const int tau = dir ? 63 - c : c;
                    kv[jj] = bf2f(*(const LAS bf16raw*)(L + L_K + tau * 272 + (32 * mt + r) * 2)) * __expf(glast - gcs[dir * 64 + c]); }
                u32x4_t ko; ko.x = dn_cvt_pk(kv[0], kv[1]); ko.y = dn_cvt_pk(kv[2], kv[3]); ko.z = dn_cvt_pk(kv[4], kv[5]); ko.w = dn_cvt_pk(kv[6], kv[7]);
                *(u32x4_t*)(rec + REC_KT + (size_t)id * 16) = ko;
            }
            for (int id = t192; id < 512; id += 192) {
                const int mt = id >> 8, kt = (id >> 6) & 3, r = id & 31, hh = (id >> 5) & 1;
                const int c0 = 32 * (kt >> 1) + 16 * (kt & 1) + 4 * hh;
                const LAS unsigned char* qp = L + L_QK + dir * 9216 + (32 * mt + r) * 144;
                const u32x2_t qa = *(const LAS u32x2_t*)(qp + c0 * 2), qb = *(const LAS u32x2_t*)(qp + (c0 + 8) * 2);
                *(u32x4_t*)(rec + REC_QK + (size_t)id * 16) = (u32x4_t){qa.x, qa.y, qb.x, qb.y};
            }
            if (t192 == 0) P.EGL[recid] = __expf(glast);
        }
        __syncthreads();
        {
            const bool isK = w4 >= 2;
            const LAS unsigned char* srcb = L + (isK ? L_K : L_V);
            dn_f32x16 acc[2][2] = {};
#pragma unroll
            for (int ks = 0; ks < 4; ++ks) {
                dn_bf16x8 At[2];
#pragma unroll
                for (int mt = 0; mt < 2; ++mt) At[mt] = *(const LAS dn_bf16x8*)(L + L_TB + dir * 9216 + (32 * mt + r32) * 144 + (16 * ks + 8 * hi) * 2);
                float bt[8], eg8[8];
#pragma unroll
                for (int jj = 0; jj < 8; ++jj) { const int jrow = 16 * ks + 8 * hi + jj; bt[jj] = bts[dir * 64 + jrow]; eg8[jj] = isK ? __expf(gcs[dir * 64 + jrow]) : 1.f; }
#pragma unroll
                for (int nl = 0; nl < 2; ++nl) {
                    const int col = (32 * (2 * w4 + nl) + r32) & 127;
                    float rv[8];
#pragma unroll
                    for (int jj = 0; jj < 8; ++jj) { const int jrow = 16 * ks + 8 * hi + jj; const int tau = dir ? 63 - jrow : jrow;
                        rv[jj] = bf2f(*(const LAS bf16raw*)(srcb + tau * 272 + col * 2)) * bt[jj] * eg8[jj]; }
                    u32x4_t bw; bw.x = dn_cvt_pk(rv[0], rv[1]); bw.y = dn_cvt_pk(rv[2], rv[3]); bw.z = dn_cvt_pk(rv[4], rv[5]); bw.w = dn_cvt_pk(rv[6], rv[7]);
                    const dn_bf16x8 Bf = __builtin_bit_cast(dn_bf16x8, bw);
#pragma unroll
                    for (int mt = 0; mt < 2; ++mt) acc[mt][nl] = __builtin_amdgcn_mfma_f32_32x32x16_bf16(At[mt], Bf, acc[mt][nl], 0, 0, 0);
                }
            }
            if (!isK) {
#pragma unroll
                for (int mt = 0; mt < 2; ++mt)
#pragma unroll
                    for (int nl = 0; nl < 2; ++nl) { const dn_f32x16 a = acc[mt][nl];
                        u32x4_t o0, o1; o0.x = dn_cvt_pk(a[0], a[1]); o0.y = dn_cvt_pk(a[2], a[3]); o0.z = dn_cvt_pk(a[4], a[5]); o0.w = dn_cvt_pk(a[6], a[7]);
                        o1.x = dn_cvt_pk(a[8], a[9]); o1.y = dn_cvt_pk(a[10], a[11]); o1.z = dn_cvt_pk(a[12], a[13]); o1.w = dn_cvt_pk(a[14], a[15]);
                        unsigned char* up = rec + REC_U + (size_t)(((mt * 4 + 2 * w4 + nl) * 64 + lane) * 32);
                        *(u32x4_t*)up = o0; *(u32x4_t*)(up + 16) = o1; }
            } else {
#pragma unroll
                for (int mt = 0; mt < 2; ++mt)
#pragma unroll
                    for (int nl = 0; nl < 2; ++nl) { const int dk = 32 * (2 * (w4 - 2) + nl) + r32;
#pragma unroll
                        for (int reg = 0; reg < 16; ++reg) *(LAS bf16raw*)(L + L_AM + dir * 17408 + (32 * mt + dn_crow(reg, hi)) * 264 + dk * 2) = (bf16raw)f2bf(-acc[mt][nl][reg]); }
            }
        }
        __syncthreads();
        {
            const LAS unsigned char* wt = L + L_AM + dir * 17408;
#pragma unroll
            for (int i = 0; i < 4; ++i) {
                const int id = t256 + 256 * i, mt = id >> 9, kt = (id >> 6) & 7, r = id & 31, hh = (id >> 5) & 1;
                const int p = 32 * mt + r, dk0 = 32 * (kt >> 1) + 16 * (kt & 1) + 4 * hh;
                const u32x2_t wl = *(const LAS u32x2_t*)(wt + p * 264 + dk0 * 2), wh = *(const LAS u32x2_t*)(wt + p * 264 + (dk0 + 8) * 2);
                *(u32x4_t*)(rec + REC_WN + (size_t)id * 16) = (u32x4_t){wl.x, wl.y, wh.x, wh.y};
            }
        }
        __syncthreads();
    }
}

struct DnScanPtrs { const unsigned char* SOP; const float *EGL, *state_delta; bf16raw *OF, *OB; float* out; };


__device__ __forceinline__ void phase_dn_scan(Ctx& C, const DnScanPtrs& P, int j) {
    const int slot = C.wid * C.nblk + C.blk, nslot = C.ngw;
    for (int r = 0; r * nslot < 2176; ++r) {
        const int u = r * nslot + (slot + r * (nslot - 128)) % nslot;
        if (u >= 2176) continue;
        int lane = C.lane; asm volatile("" : "+v"(lane));
        const int r32 = lane & 31, hi = lane >> 5;
        int seq, h, dir, sl, N, T, base, cbase; bool lat = u < 128;
        if (lat) { seq = 32 + (u >> 6); h = (u >> 3) & 7; dir = (u >> 2) & 1; sl = u & 3; N = 16; T = 1024; base = NCTX + (seq - 32) * 1024; cbase = 128 + 16 * (seq - 32); }
        else { const int c = u - 128; seq = c >> 6; h = (c >> 3) & 7; dir = (c >> 2) & 1; sl = c & 3; N = 4; T = 256; base = seq * 256; cbase = 4 * seq; }
        dn_f32x16 S[4];
        if (lat) { const float* sp = P.state_delta + ((((size_t)(seq - 32) * 2 + j) * 2 + dir) * 8 + h) * 16384 + 32 * sl + r32;
#pragma unroll
            for (int t4 = 0; t4 < 4; ++t4)
#pragma unroll
                for (int reg = 0; reg < 16; ++reg) S[t4][reg] = sp[(size_t)(32 * t4 + dn_crow(reg, hi)) * 128]; }
        else {
#pragma unroll
            for (int t4 = 0; t4 < 4; ++t4) S[t4] = (dn_f32x16){}; }
        bf16raw* Od = (dir ? P.OB : P.OF) + (size_t)base * 1024 + h * 128 + 32 * sl + r32;
        for (int n = 0; n < N; ++n) {
            const int recid = ((cbase + n) * 8 + h) * 2 + dir;
            const unsigned char* rec = P.SOP + (size_t)recid * REC_BYTES + lane * 16;
            const float eg = P.EGL[recid];
            dn_bf16x8 Sb[8];
#pragma unroll
            for (int kt = 0; kt < 8; ++kt) Sb[kt] = dn_acc_frag(S[kt >> 1], kt & 1);
#define DN_FENCE() asm volatile("" ::: "memory")
#define DN_LD8(F, off) do { _Pragma("unroll") for (int q_ = 0; q_ < 8; ++q_) F[q_] = *(const dn_bf16x8*)(rec + (off) + q_ * 1024); } while (0)
            dn_bf16x8 F[8];
            dn_f32x16 av[2];
#pragma unroll
            for (int mt = 0; mt < 2; ++mt) {
                const unsigned char* up = P.SOP + (size_t)recid * REC_BYTES + REC_U + (size_t)(((mt * 4 + sl) * 64 + lane) * 32);
                const u32x4_t u0 = *(const u32x4_t*)up, u1 = *(const u32x4_t*)(up + 16);
                DN_LD8(F, REC_WN + mt * 8192);
                DN_FENCE();
                dn_f32x16 a;
                a[0] = bf_lo(u0.x); a[1] = bf_hi(u0.x); a[2] = bf_lo(u0.y); a[3] = bf_hi(u0.y); a[4] = bf_lo(u0.z); a[5] = bf_hi(u0.z); a[6] = bf_lo(u0.w); a[7] = bf_hi(u0.w);
                a[8] = bf_lo(u1.x); a[9] = bf_hi(u1.x); a[10] = bf_lo(u1.y); a[11] = bf_hi(u1.y); a[12] = bf_lo(u1.z); a[13] = bf_hi(u1.z); a[14] = bf_lo(u1.w); a[15] = bf_hi(u1.w);
#pragma unroll
                for (int kt = 0; kt < 8; ++kt) a = __builtin_amdgcn_mfma_f32_32x32x16_bf16(F[kt], Sb[kt], a, 0, 0, 0);
                av[mt] = a;
                DN_FENCE();
            }
            dn_bf16x8 vb[4];
#pragma unroll
            for (int kt = 0; kt < 4; ++kt) vb[kt] = dn_acc_frag(av[kt >> 1], kt & 1);
            dn_f32x16 ao[2];
#pragma unroll
            for (int mt = 0; mt < 2; ++mt) {
                DN_LD8(F, REC_QT + mt * 8192);
                DN_FENCE();
                dn_f32x16 a = {};
#pragma unroll
                for (int kt = 0; kt < 8; ++kt) a = __builtin_amdgcn_mfma_f32_32x32x16_bf16(F[kt], Sb[kt], a, 0, 0, 0);
                ao[mt] = a;
                DN_FENCE();
            }
            DN_LD8(F, REC_QK);
            DN_FENCE();
#pragma unroll
            for (int mt = 0; mt < 2; ++mt) {
                dn_f32x16 a = ao[mt];
#pragma unroll
                for (int kt = 0; kt < 4; ++kt) a = __builtin_amdgcn_mfma_f32_32x32x16_bf16(F[mt * 4 + kt], vb[kt], a, 0, 0, 0);
#pragma unroll
                for (int reg = 0; reg < 16; ++reg) { const int p = 64 * n + 32 * mt + dn_crow(reg, hi); const int t = dir ? T - 1 - p : p;
                    Od[(size_t)t * 1024] = (bf16raw)f2bf(a[reg]); }
            }
            DN_FENCE();
#pragma unroll
            for (int t2 = 0; t2 < 2; ++t2) {
                DN_LD8(F, REC_KT + t2 * 8192);
                DN_FENCE();
#pragma unroll
                for (int tt = 0; tt < 2; ++tt) {
                    dn_f32x16 a = S[2 * t2 + tt] * eg;
#pragma unroll
                    for (int kt = 0; kt < 4; ++kt) a = __builtin_amdgcn_mfma_f32_32x32x16_bf16(F[tt * 4 + kt], vb[kt], a, 0, 0, 0);
                    S[2 * t2 + tt] = a;
                }
                DN_FENCE();
            }
#undef DN_FENCE
#undef DN_LD8
        }
        if (!lat) { float* sp = P.out + O_ST + ((((size_t)seq * 2 + j) * 2 + dir) * 8 + h) * 16384 + 32 * sl + r32;
#pragma unroll
            for (int t4 = 0; t4 < 4; ++t4)
#pragma unroll
                for (int reg = 0; reg < 16; ++reg) sp[(size_t)(32 * t4 + dn_crow(reg, hi)) * 128] = S[t4][reg]; }
    }
}

__device__ __forceinline__ void phase_dn_scan2(Ctx& C, const DnScanPtrs& P, int j) {
    LAS unsigned char* L = C.lds;
    const int wid = C.wid; const bool consumer = wid < 4; const int sl = wid & 3;
    const int nun = C.nblk == 256 ? (C.blk < 32 ? 1 : 3) : (544 + C.nblk - 1) / C.nblk;
    for (int ui = 0; ui < nun; ++ui) {
        int sid;
        if (C.nblk == 256) { if (C.blk < 32) sid = C.blk; else { const int c = (C.blk - 32) + 224 * ui; if (c >= 512) break; sid = 32 + c; } }
        else { sid = C.blk + ui * C.nblk; if (sid >= 544) break; }
        int lane = C.lane; asm volatile("" : "+v"(lane));
        const int r32 = lane & 31, hi = lane >> 5;
        int seq, h, dir, N, T, base, cbase; const bool lat = sid < 32;
        if (lat) { seq = 32 + (sid >> 4); h = (sid >> 1) & 7; dir = sid & 1; N = 16; T = 1024; base = NCTX + (seq - 32) * 1024; cbase = 128 + 16 * (seq - 32); }
        else { const int c = sid - 32; seq = c >> 4; h = (c >> 1) & 7; dir = c & 1; N = 4; T = 256; base = seq * 256; cbase = 4 * seq; }
        const int rec0 = (cbase * 8 + h) * 2 + dir;
        const unsigned char* rbase = P.SOP + (size_t)rec0 * REC_BYTES;
        constexpr size_t RSTRIDE = (size_t)16 * REC_BYTES;
#define DN2_BAR() __builtin_amdgcn_s_barrier()
        if (consumer) {
            dn_f32x16 S[4];
            if (lat) { const float* sp = P.state_delta + ((((size_t)(seq - 32) * 2 + j) * 2 + dir) * 8 + h) * 16384 + 32 * sl + r32;
#pragma unroll
                for (int t4 = 0; t4 < 4; ++t4)
#pragma unroll
                    for (int reg = 0; reg < 16; ++reg) S[t4][reg] = sp[(size_t)(32 * t4 + dn_crow(reg, hi)) * 128]; }
            else {
#pragma unroll
                for (int t4 = 0; t4 < 4; ++t4) S[t4] = (dn_f32x16){}; }
            bf16raw* Od = (dir ? P.OB : P.OF) + (size_t)base * 1024 + h * 128 + 32 * sl + r32;
            u32x4_t ua[2][2];
#pragma unroll
            for (int mt = 0; mt < 2; ++mt) { const unsigned char* up = rbase + REC_U + (size_t)(((mt * 4 + sl) * 64 + lane) * 32); ua[mt][0] = *(const u32x4_t*)up; ua[mt][1] = *(const u32x4_t*)(up + 16); }
            int g = 0;
#define DN2_CSYNC() do { asm volatile("s_waitcnt lgkmcnt(0)" ::: "memory"); DN2_BAR(); asm volatile("" ::: "memory"); } while (0)
#define DN2_RD8(F) do { const LAS unsigned char* sp_ = L + (g & 15) * 8192 + lane * 16; _Pragma("unroll") for (int q_ = 0; q_ < 8; ++q_) F[q_] = *(const LAS dn_bf16x8*)(sp_ + q_ * 1024); ++g; } while (0)
            for (int n = 0; n < N; ++n) {
                const float eg = P.EGL[rec0 + 16 * n];
                dn_bf16x8 Sb[8];
#pragma unroll
                for (int kt = 0; kt < 8; ++kt) Sb[kt] = dn_acc_frag(S[kt >> 1], kt & 1);
                dn_bf16x8 F[8];
                dn_f32x16 av[2];
#pragma unroll
                for (int mt = 0; mt < 2; ++mt) {
                    DN2_CSYNC(); DN2_RD8(F);
                    const u32x4_t u0 = ua[mt][0], u1 = ua[mt][1];
                    dn_f32x16 a;
                    a[0] = bf_lo(u0.x); a[1] = bf_hi(u0.x); a[2] = bf_lo(u0.y); a[3] = bf_hi(u0.y); a[4] = bf_lo(u0.z); a[5] = bf_hi(u0.z); a[6] = bf_lo(u0.w); a[7] = bf_hi(u0.w);
                    a[8] = bf_lo(u1.x); a[9] = bf_hi(u1.x); a[10] = bf_lo(u1.y); a[11] = bf_hi(u1.y); a[12] = bf_lo(u1.z); a[13] = bf_hi(u1.z); a[14] = bf_lo(u1.w); a[15] = bf_hi(u1.w);
#pragma unroll
                    for (int kt = 0; kt < 8; ++kt) a = __builtin_amdgcn_mfma_f32_32x32x16_bf16(F[kt], Sb[kt], a, 0, 0, 0);
                    av[mt] = a;
                }
                if (n + 1 < N) {
#pragma unroll
                    for (int mt = 0; mt < 2; ++mt) { const unsigned char* up = rbase + (size_t)(n + 1) * RSTRIDE + REC_U + (size_t)(((mt * 4 + sl) * 64 + lane) * 32); ua[mt][0] = *(const u32x4_t*)up; ua[mt][1] = *(const u32x4_t*)(up + 16); }
                }
                dn_bf16x8 vb[4];
#pragma unroll
                for (int kt = 0; kt < 4; ++kt) vb[kt] = dn_acc_frag(av[kt >> 1], kt & 1);
                dn_f32x16 ao[2];
#pragma unroll
                for (int mt = 0; mt < 2; ++mt) {
                    DN2_CSYNC(); DN2_RD8(F);
                    dn_f32x16 a = {};
#pragma unroll
                    for (int kt = 0; kt < 8; ++kt) a = __builtin_amdgcn_mfma_f32_32x32x16_bf16(F[kt], Sb[kt], a, 0, 0, 0);
                    ao[mt] = a;
                }
                DN2_CSYNC(); DN2_RD8(F);
#pragma unroll
                for (int mt = 0; mt < 2; ++mt) {
                    dn_f32x16 a = ao[mt];
#pragma unroll
                    for (int kt = 0; kt < 4; ++kt) a = __builtin_amdgcn_mfma_f32_32x32x16_bf16(F[mt * 4 + kt], vb[kt], a, 0, 0, 0);
#pragma unroll
                    for (int reg = 0; reg < 16; ++reg) { const int p = 64 * n + 32 * mt + dn_crow(reg, hi); const int t = dir ? T - 1 - p : p;
                        Od[(size_t)t * 1024] = (bf16raw)f2bf(a[reg]); }
                }
#pragma unroll
                for (int t2 = 0; t2 < 2; ++t2) {
                    DN2_CSYNC(); DN2_RD8(F);
#pragma unroll
                    for (int tt = 0; tt < 2; ++tt) {
                        dn_f32x16 a = S[2 * t2 + tt] * eg;
#pragma unroll
                        for (int kt = 0; kt < 4; ++kt) a = __builtin_amdgcn_mfma_f32_32x32x16_bf16(F[tt * 4 + kt], vb[kt], a, 0, 0, 0);
                        S[2 * t2 + tt] = a;
                    }
                }
            }
            DN2_CSYNC();
            if (!lat) { float* sp = P.out + O_ST + ((((size_t)seq * 2 + j) * 2 + dir) * 8 + h) * 16384 + 32 * sl + r32;
#pragma unroll
                for (int t4 = 0; t4 < 4; ++t4)
#pragma unroll
                    for (int reg = 0; reg < 16; ++reg) sp[(size_t)(32 * t4 + dn_crow(reg, hi)) * 128] = S[t4][reg]; }
#undef DN2_CSYNC
#undef DN2_RD8
        } else {
            const int ld = wid - 4;
            int ln = 0, ls = 0;
            const unsigned char* gsrc = rbase + REC_WN + (size_t)(2 * ld) * 1024 + lane * 16;
#define DN2_ISSUE(slot) do { const unsigned char* s_ = gsrc + (size_t)ln * RSTRIDE + ls * 8192; LAS unsigned char* d_ = L + (slot) * 8192 + (2 * ld) * 1024; \
        __builtin_amdgcn_global_load_lds((const unsigned*)s_, (LAS unsigned*)d_, 16, 0, 0); __builtin_amdgcn_global_load_lds((const unsigned*)(s_ + 1024), (LAS unsigned*)(d_ + 1024), 16, 0, 0); \
        if (++ls == 7) { ls = 0; if (ln < N - 1) ++ln; } } while (0)
            for (int q = 0; q < 15; ++q) DN2_ISSUE(q);
            const int G = 7 * N;
            for (int g = 0; g < G; ++g) {
                asm volatile("s_waitcnt vmcnt(28)" ::: "memory");
                DN2_BAR();
                DN2_ISSUE((g + 15) & 15);
            }
            asm volatile("s_waitcnt vmcnt(0)" ::: "memory");
            DN2_BAR();
#undef DN2_ISSUE
        }
#undef DN2_BAR
    }
}
#define XB_TMO      128
#define XB_XCNT(j)  (256  + 64 * (j))
#define XB_XSUB(j)  (1280 + 64 * (j))
#define XB_XGEN(j)  (2304 + 64 * (j))
#define XB_TOP      3328
#define XB_TOPGEN   3392
#define XCD_BAR_WORDS 3456
#define XB_SPIN_CAP (1u << 18)

__device__ __forceinline__ unsigned xb_ld(unsigned* p)              { return __hip_atomic_load(p, __ATOMIC_RELAXED, __HIP_MEMORY_SCOPE_AGENT); }
__device__ __forceinline__ unsigned xb_add(unsigned* p, unsigned v) { return __hip_atomic_fetch_add(p, v, __ATOMIC_RELAXED, __HIP_MEMORY_SCOPE_AGENT); }
__device__ __forceinline__ unsigned xb_xcc_id() { return (unsigned)__builtin_amdgcn_s_getreg((3 << 11) | 20) & 0xFu; }
#define XB_SPIN(cond, bar) do { unsigned _sp = 0; while (cond) { __builtin_amdgcn_s_sleep(1); \
    if ((++_sp & 255u) == 0u) { if (xb_ld(&(bar)[XB_TMO])) break; if (_sp > XB_SPIN_CAP) { atomicAdd(&(bar)[XB_TMO], 1u); break; } } } } while (0)

struct XcdBarrier {
    unsigned* bar; unsigned x;
    volatile LAS unsigned* st;
};

__device__ __forceinline__ XcdBarrier xcd_barrier_post(unsigned* bar, volatile LAS unsigned* st) {
    XcdBarrier b; b.bar = bar; b.x = xb_xcc_id(); b.st = st;
    if (threadIdx.x == 0) (void)xb_add(&bar[XB_XCNT(b.x)], 1u);
    return b;
}
__device__ __forceinline__ void xcd_barrier_complete(unsigned* bar, unsigned x, unsigned& nloc, unsigned& nx) {
    const unsigned G = gridDim.x * gridDim.y * gridDim.z;
    unsigned sum, cnt, mine, sp = 0u;
    for (;;) {
        sum = 0u; cnt = 0u; mine = 0u;
#pragma unroll
        for (unsigned j = 0; j < 16; ++j) { const unsigned c = xb_ld(&bar[XB_XCNT(j)]); sum += c; cnt += (c > 0u) ? 1u : 0u; mine = (j == x) ? c : mine; }
        if (sum == G) break;
        __builtin_amdgcn_s_sleep(1);
        if ((++sp & 255u) == 0u) { if (xb_ld(&bar[XB_TMO])) break; if (sp > XB_SPIN_CAP) { atomicAdd(&bar[XB_TMO], 1u); break; } }
    }
    nloc = mine > 0u ? mine : 1u; nx = cnt > 0u ? cnt : 1u;
}

__device__ __forceinline__ void xcd_barrier(const XcdBarrier& b) {
    asm volatile("s_waitcnt vmcnt(0)" ::: "memory");
    __syncthreads();
    if (threadIdx.x == 0) {
        unsigned* bar = b.bar;
        __builtin_amdgcn_s_waitcnt(0);
        unsigned nloc = b.st[0], nx = b.st[1];
        const unsigned old = xb_add(&bar[XB_XSUB(b.x)], 1u);
        const unsigned gen = old / nloc;
        if (old + 1u == (gen + 1u) * nloc) {
            __builtin_amdgcn_fence(__ATOMIC_RELEASE, "agent");
            asm volatile("s_waitcnt vmcnt(0)" ::: "memory");
            const unsigned og = xb_add(&bar[XB_TOP], 1u);
            const unsigned tg = og / nx;
            if (og + 1u == (tg + 1u) * nx) xb_add(&bar[XB_TOPGEN], 1u);
            else XB_SPIN(xb_ld(&bar[XB_TOPGEN]) == tg, bar);
            __builtin_amdgcn_fence(__ATOMIC_ACQUIRE, "agent");
            xb_add(&bar[XB_XGEN(b.x)], 1u);
            asm volatile("s_waitcnt vmcnt(0)" ::: "memory");
        } else {
            XB_SPIN(xb_ld(&bar[XB_XGEN(b.x)]) == gen, bar);
            __builtin_amdgcn_fence(__ATOMIC_ACQUIRE, "agent");
            asm volatile("s_waitcnt vmcnt(0)" ::: "memory");
        }
    }
    __syncthreads();
}

constexpr int LDSCTL_OFF = 131072, MISC_OFF = LDSCTL_OFF + 320, CW_BAR = 4096;
struct Args { const float* in[24]; float* out; unsigned char* ws; int ph_lo, ph_hi; };
enum { I_XP = 0, I_XS, I_CK, I_CV, I_SD, I_C, I_CCTX, I_WMOD, I_BMOD, I_N1, I_N2, I_AWIN, I_AQG, I_AKG, I_AWOUT, I_DWIN, I_DCONV, I_DALOG, I_DDTB, I_DNORM, I_DWOUT, I_W1, I_W2, I_FN };

__global__ void __launch_bounds__(NWAVES * 64, 2) mk_fwd(Args args) {
    extern __shared__ __attribute__((aligned(16))) unsigned char lds_raw[];
    cg::grid_group grid = cg::this_grid();
    for (int u = threadIdx.x; u < (LDS_BYTES - LDSCTL_OFF) / 4; u += NWAVES * 64) ((LAS unsigned*)((LAS unsigned char*)lds_raw + LDSCTL_OFF))[u] = 0u;
    __syncthreads();
    const XcdBarrier bar = xcd_barrier_post((unsigned*)(args.ws + WS_CTL) + CW_BAR, (volatile LAS unsigned*)((LAS unsigned char*)lds_raw + MISC_OFF) + 8);

    const int lo = args.ph_lo, hi = args.ph_hi;
    int ph = 0;
#define PHASE_BEGIN() if (ph >= lo && ph < hi) { int z = 0; asm volatile("" : "+s"(z)); unsigned char* const ws = args.ws + z; (void)ws; \
    Ctx C; C.lds = (LAS unsigned char*)lds_raw + z; C.tid = threadIdx.x + z; C.lane = C.tid & 63; C.wid = __builtin_amdgcn_readfirstlane(C.tid >> 6); \
    C.nblk = gridDim.x + z; C.blk = blockIdx.x + z; C.gw = C.blk * NWAVES + C.wid; C.ngw = C.nblk * NWAVES;
#ifndef REP_KIND
#define REP_KIND -1
#endif
#define BARX() do { XcdBarrier b2_ = bar; asm volatile("" : "+s"(b2_.bar)); xcd_barrier(b2_); } while (0)
#define PHASE_END() if (ph + 1 < hi) { if (ph == 0) { grid.sync(); if (threadIdx.x == 0) { unsigned nloc_, nx_; xcd_barrier_complete(bar.bar, bar.x, nloc_, nx_); bar.st[0] = nloc_; bar.st[1] = nx_; } __syncthreads(); } else BARX(); } } ++ph;
#define INP(i) (args.in[(i) + z])
#define WSF(off) ((float*)(ws + (off)))
#define WSB(off) ((bf16raw*)(ws + (off)))

    PHASE_BEGIN() {
        ProPtrs P{INP(I_C), INP(I_CCTX), INP(I_WMOD), INP(I_BMOD), INP(I_AWIN), INP(I_AWOUT), INP(I_DWIN), INP(I_DWOUT), INP(I_W1), INP(I_W2), WSF(WS_MODS), WSF(WS_ROPE),
                  WSB(WS_WT_AIN), WSB(WS_WT_AOUT), WSB(WS_WT_DIN), WSB(WS_WT_DOUT), WSB(WS_WT_W1), WSB(WS_WT_W2), INP(I_XP), INP(I_XS), WSB(WS_X)};
        phase_prologue(C, P); } PHASE_END()
    for (int l = 0; l < 4; ++l) {
        const int j = l >> 1;
        PHASE_BEGIN() { const float* mods_l = WSF(WS_MODS) + (size_t)l * 3 * 6144;
            phase_norm(C, WSB(WS_X), INP(I_N1) + l * D, mods_l, WSB(WS_H)); } PHASE_END()
        if ((l & 1) == 0) {
            PHASE_BEGIN() { pg8::Gemm g{WSB(WS_H), WSB(WS_WT_AIN) + (size_t)j * QKVW * D, MTOK, QKVW, D, z}; pg8::StaticOrder S; S.init(MTOK, QKVW, C.nblk, C.blk);
                pg8::EpiBf16<0> E{WSB(WS_PROJ), QKVW, nullptr, 0, 0, 1.f};
                pg8::gemm_phase<pg8::EpiBf16<0>, pg8::StaticOrder, true, true>(C.lds, g, S, E); } PHASE_END()
            PHASE_BEGIN() { QknPtrs P{WSB(WS_PROJ), WSB(WS_QB), WSB(WS_KB), WSB(WS_VB), INP(I_AQG) + j * 128, INP(I_AKG) + j * 128, WSF(WS_ROPE), INP(I_CK), INP(I_CV), args.out + z};
                phase_qkn(C, P, j); if (REP_KIND == 3) { BARX(); phase_qkn(C, P, j); } } PHASE_END()
            PHASE_BEGIN() { AttnPtrs P{WSB(WS_QB), WSB(WS_KB), WSB(WS_VB), WSB(WS_Y), WSF(WS_PART_O), WSF(WS_PART_ML), (unsigned*)(ws + WS_CTL) + CW_ATT + 64 * j}; phase_attn(C, P); if (REP_KIND == 4) { BARX(); phase_attn(C, P); } } PHASE_END()
        } else {
            PHASE_BEGIN() { pg8::Gemm g{WSB(WS_H), WSB(WS_WT_DIN) + (size_t)j * DNINP * D, MTOK, DNINP, D, z}; pg8::StaticOrder S; S.init(MTOK, DNINP, C.nblk, C.blk);
                pg8::EpiDnIn E{WSB(WS_PROJ), WSF(WS_AB)};
                pg8::gemm_phase<pg8::EpiDnIn, pg8::StaticOrder, true, true>(C.lds, g, S, E); } PHASE_END()
            PHASE_BEGIN() { DnLocalPtrs P{WSB(WS_PROJ), WSF(WS_AB), INP(I_DCONV) + (size_t)j * 5 * 3072, INP(I_DALOG) + j * 16, INP(I_DDTB) + j * 16, ws + WS_SOP, WSF(WS_EGL)};
                phase_dn_local(C, P); if (REP_KIND == 6) { BARX(); phase_dn_local(C, P); } } PHASE_END()
            PHASE_BEGIN() { DnScanPtrs P{ws + WS_SOP, WSF(WS_EGL), INP(I_SD), WSB(WS_OF), WSB(WS_OB), args.out + z}; phase_dn_scan2(C, P, j); } PHASE_END()
            PHASE_BEGIN() { GatePtrs P{WSB(WS_OF), WSB(WS_OB), WSB(WS_PROJ), WSB(WS_Y), INP(I_DNORM) + j * 128}; phase_gate(C, P); if (REP_KIND == 8) { BARX(); phase_gate(C, P); } } PHASE_END()
        }
        PHASE_BEGIN() { const float* mods_l = WSF(WS_MODS) + (size_t)l * 3 * 6144;
            pg8::Gemm g{WSB(WS_Y), ((l & 1) ? WSB(WS_WT_DOUT) : WSB(WS_WT_AOUT)) + (size_t)j * D * D, MTOK, D, D, z}; pg8::StaticOrder S; S.init(64 * 256, D, C.nblk, C.blk);
            pg8::EpiRes160 E{WSB(WS_X), mods_l + 2048};
            pg8::gemm_phase<pg8::EpiRes160, pg8::StaticOrder, true, true, true>(C.lds, g, S, E, NCTX); } PHASE_END()
        PHASE_BEGIN() { const float* mods_l = WSF(WS_MODS) + (size_t)l * 3 * 6144;
            phase_norm(C, WSB(WS_X), INP(I_N2) + l * D, mods_l + 3072, WSB(WS_H)); } PHASE_END()
        PHASE_BEGIN() { pg8::Gemm g{WSB(WS_H), WSB(WS_WT_W1) + (size_t)l * FF * D, MTOK, FF, D, z}; pg8::StaticOrder S; S.init(MTOK, FF, C.nblk, C.blk);
            pg8::EpiBf16<2> E{WSB(WS_PROJ), FF, nullptr, 0, 0, 1.f};
            for (int rep = 0; rep < (REP_KIND == 10 ? 2 : 1); ++rep) { if (rep) BARX(); pg8::gemm_phase<pg8::EpiBf16<2>, pg8::StaticOrder, true, true>(C.lds, g, S, E); } } PHASE_END()
        PHASE_BEGIN() { const float* mods_l = WSF(WS_MODS) + (size_t)l * 3 * 6144;
            pg8::Gemm g{WSB(WS_PROJ), WSB(WS_WT_W2) + (size_t)l * D * FF, MTOK, D, FF, z}; pg8::StaticOrder S; S.init(64 * 256, D, C.nblk, C.blk);
            pg8::EpiRes160 E{WSB(WS_X), mods_l + 5120};
            pg8::gemm_phase<pg8::EpiRes160, pg8::StaticOrder, true, true, true>(C.lds, g, S, E, NCTX); } PHASE_END()
    }
    PHASE_BEGIN() { phase_final(C, WSB(WS_X), INP(I_FN), args.out + z); } PHASE_END()
#undef PHASE_BEGIN
#undef PHASE_END
}

extern "C" void kernel_launch(void* const* d_in, const int* in_sizes, int n_in, void* d_out, int out_size, void* d_ws, size_t ws_size, hipStream_t stream) {
    static int grid = 0;
    if (grid == 0) {
        if (n_in != 24 || ws_size < WS_END) { fprintf(stderr, "kernel_launch: unexpected n_in %d / ws %zu\n", n_in, ws_size); grid = -1; return; }
        int dev = 0, cus = 0, per_cu = 0;
        if (hipGetDevice(&dev) != hipSuccess || hipDeviceGetAttribute(&cus, hipDeviceAttributeMultiprocessorCount, dev) != hipSuccess) { grid = -1; return; }
        if (hipFuncSetAttribute((const void*)mk_fwd, hipFuncAttributeMaxDynamicSharedMemorySize, LDS_BYTES) != hipSuccess) { fprintf(stderr, "kernel_launch: hipFuncSetAttribute failed\n"); grid = -1; return; }
        if (hipOccupancyMaxActiveBlocksPerMultiprocessor(&per_cu, (const void*)mk_fwd, NWAVES * 64, LDS_BYTES) != hipSuccess || per_cu < 1) { fprintf(stderr, "kernel_launch: occupancy query failed (%d)\n", per_cu); (void)hipGetLastError(); grid = -1; return; }
        grid = cus * 1;
    }
    if (grid < 0) return;
    (void)hipMemsetAsync((char*)d_ws + WS_CTL, 0, CTL_ZERO_BYTES, stream);
    Args a; memset(&a, 0, sizeof(a));
    for (int i = 0; i < 24; ++i) a.in[i] = (const float*)d_in[i];
    a.out = (float*)d_out; a.ws = (unsigned char*)d_ws; a.ph_lo = 0; a.ph_hi = 1000;
    void* kargs[] = {&a};
    hipError_t e = hipLaunchCooperativeKernel((const void*)mk_fwd, dim3(grid), dim3(NWAVES * 64), kargs, LDS_BYTES, stream);
    if (e != hipSuccess) fprintf(stderr, "kernel_launch: cooperative launch failed: %s (grid %d)\n", hipGetErrorString(e), grid);
}
```
